# Optimizing an MI355X kernel written in HIP

```python
import jax
import jax.numpy as jnp
from jax import lax
import numpy as np


D_MODEL = 1024
BATCH = 8
SEQ = 2048
DEPTH = 4

N_BRANCH = 4
BRANCH_WIDTH = 512
RWKV_HEADS = 8
RWKV_HEAD_DIM = BRANCH_WIDTH // RWKV_HEADS
RWKV_DECAY_RANK = 64
RWKV_ICL_RANK = 64
RWKV_VALUE_RANK = 32
RWKV_GATE_RANK = 128
RWKV_LNX_EPS = 64e-5
HGRN_HEADS = 4
HGRN_HEAD_DIM = BRANCH_WIDTH // HGRN_HEADS
MLSTM_HEADS = 4
MLSTM_HEAD_DIM = BRANCH_WIDTH // MLSTM_HEADS
CHUNK = 64
LRU_BLOCKS = 8
LRU_BLOCK_DIM = BRANCH_WIDTH // LRU_BLOCKS
LRU_C = 8.0
CONV_WIDTH = 4
N_EXPERTS = 32
TOP_K = 4
D_EXPERT = 1024
SWIGLU_LIMIT = 7.0
SWIGLU_ALPHA = 1.702
EXPERT_BLOCK = 128
D_PLE = 256
LN_EPS = 1e-5
NORM_EPS = 1e-6
DEEPNORM_ALPHA = (2 * DEPTH) ** 0.25
DEEPNORM_BETA = (8 * DEPTH) ** -0.25

RWKV_SPLITS = (BRANCH_WIDTH, BRANCH_WIDTH, BRANCH_WIDTH, RWKV_DECAY_RANK, RWKV_ICL_RANK, RWKV_GATE_RANK)
RWKV_COLS = 3 * BRANCH_WIDTH + RWKV_DECAY_RANK + RWKV_ICL_RANK + RWKV_GATE_RANK
HGRN_COLS = 4 * BRANCH_WIDTH
MLSTM_SPLITS = (BRANCH_WIDTH, BRANCH_WIDTH, BRANCH_WIDTH, BRANCH_WIDTH, MLSTM_HEADS, MLSTM_HEADS)
MLSTM_COLS = 4 * BRANCH_WIDTH + 2 * MLSTM_HEADS
LRU_COLS = 2 * BRANCH_WIDTH
GATE_COLS = N_BRANCH * D_MODEL
N_COLS_BASE = RWKV_COLS + HGRN_COLS + MLSTM_COLS + LRU_COLS + GATE_COLS
N_COLS_REST = N_COLS_BASE + RWKV_VALUE_RANK

F32 = jnp.float32

kernel_name = 'hybrid_rwkv7_hgrn2_mlstm_rglru_moe_deepnorm'


def _split(z, sizes):
    return jnp.split(z, np.cumsum(sizes)[:-1].tolist(), axis=-1)


def _layernorm(x, g, b, dtype):
    xf = x.astype(F32)
    xc = xf - jnp.mean(xf, -1, keepdims=True)
    var = jnp.mean(xc * xc, -1, keepdims=True)
    return (xc * lax.rsqrt(var + LN_EPS) * g + b).astype(dtype)


def _head_layernorm(y, eps):
    yc = y - jnp.mean(y, -1, keepdims=True)
    out = yc * lax.rsqrt(jnp.mean(yc * yc, -1, keepdims=True) + eps)
    return out.reshape(out.shape[:-2] + (-1,))


def _head_rmsnorm(y, eps):
    out = y * lax.rsqrt(jnp.mean(y * y, -1, keepdims=True) + eps)
    return out.reshape(out.shape[:-2] + (-1,))


def _token_shift(z):
    return jnp.pad(z, ((0, 0), (1, 0), (0, 0)))[:, :-1]


def _causal_conv(z, w, b):
    seq = z.shape[1]
    zp = jnp.pad(z, ((0, 0), (CONV_WIDTH - 1, 0), (0, 0)))
    out = b
    for j in range(CONV_WIDTH):
        out = out + zp[:, j:j + seq] * w[j]
    return out


def _to_heads(t, n_heads):
    bsz, seq, width = t.shape
    return t.reshape(bsz, seq, n_heads, width // n_heads).transpose(0, 2, 1, 3)


def _from_heads(t):
    return t.transpose(0, 2, 1, 3)


def _to_chunks(t):
    bsz, nh, seq = t.shape[:3]
    t = t.reshape((bsz, nh, seq // CHUNK, CHUNK) + t.shape[3:])
    return jnp.moveaxis(t, 2, 0)


def _from_chunks(t):
    nc, bsz, nh, c, dv = t.shape
    return jnp.moveaxis(t, 0, 2).reshape(bsz, nh, nc * c, dv)


def rwkv7_mix(zA, v_first, v_mix, mu, w0, w2, a0, a2, g2, k_k, k_a, r_k, lnx_g, lnx_b):
    bsz, seq = zA.shape[:2]
    zA = zA + (_token_shift(zA) - zA) * mu
    r, k, v, xw, xa, xg = _split(zA, RWKV_SPLITS)
    w_log = -jax.nn.softplus(-(w0 + jnp.tanh(xw) @ w2)) - 0.5
    decay = jnp.exp(-jnp.exp(w_log))
    a = jax.nn.sigmoid(a0 + xa @ a2)
    g = jax.nn.sigmoid(xg) @ g2
    if v_mix is not None:
        v = v + (v_first - v) * jax.nn.sigmoid(v_mix)

    def hs(t):
        return t.reshape(bsz, seq, RWKV_HEADS, RWKV_HEAD_DIM)

    kk = hs(k * k_k)
    kk = kk / jnp.maximum(jnp.sqrt(jnp.sum(kk * kk, -1, keepdims=True)), 1e-12)
    k = k * (1.0 + (a - 1.0) * k_a)
    rh, kh, vh, dh, ah = hs(r), hs(k), hs(v), hs(decay), hs(a)
    neg_kk = -kk
    kk_a = kk * ah

    def step(state, inp):
        r_t, w_t, k_t, v_t, a_t, b_t = inp
        sa = jnp.einsum('bhvk,bhk->bhv', state, a_t)
        state = state * w_t[:, :, None, :] + sa[..., None] * b_t[:, :, None, :] + v_t[..., None] * k_t[:, :, None, :]
        return state, jnp.einsum('bhvk,bhk->bhv', state, r_t)

    xs = tuple(jnp.moveaxis(t, 1, 0) for t in (rh, dh, kh, vh, neg_kk, kk_a))
    state0 = jnp.zeros((bsz, RWKV_HEADS, RWKV_HEAD_DIM, RWKV_HEAD_DIM), F32)
    _, y = lax.scan(step, state0, xs)
    y = jnp.moveaxis(y, 0, 1)
    y = _head_layernorm(y, RWKV_LNX_EPS) * lnx_g + lnx_b
    bonus = (jnp.sum(rh * kh * r_k, -1, keepdims=True) * vh).reshape(bsz, seq, BRANCH_WIDTH)
    return (y + bonus) * g, v


def _gla_chunked(q, k, v, log_f):
    bsz, nh, _, dk = q.shape
    dv = v.shape[-1]
    causal = jnp.tril(jnp.ones((CHUNK, CHUNK), bool))

    def chunk(state, inp):
        qc, kc, vc, lf = inp
        bcum = jnp.cumsum(lf, axis=-2)
        o_inter = jnp.einsum('bhtd,bhde->bhte', qc * jnp.exp(bcum), state)
        diff = bcum[:, :, :, None, :] - bcum[:, :, None, :, :]
        pair_decay = jnp.exp(jnp.where(causal[:, :, None], diff, -jnp.inf))
        attn = jnp.einsum('bhtd,bhsd,bhtsd->bhts', qc, kc, pair_decay)
        o = o_inter + jnp.einsum('bhts,bhse->bhte', attn, vc)
        b_last = bcum[:, :, -1]
        state = jnp.exp(b_last)[..., None] * state + jnp.einsum('bhsd,bhse->bhde', kc * jnp.exp(b_last[:, :, None] - bcum), vc)
        return state, o

    state0 = jnp.zeros((bsz, nh, dk, dv), F32)
    _, o = lax.scan(chunk, state0, tuple(_to_chunks(t) for t in (q, k, v, log_f)))
    return _from_chunks(o)


def hgrn2_mix(zB, lb, norm_w):
    q, f, i, g = _split(zB, (BRANCH_WIDTH,) * 4)
    q = jax.nn.silu(q)
    log_f = jnp.logaddexp(jnp.log(lb), jnp.log1p(-lb) + jax.nn.log_sigmoid(f))
    k = (1.0 - lb) * jax.nn.sigmoid(-f)
    o = _gla_chunked(*(_to_heads(t, HGRN_HEADS) for t in (q, k, i, log_f)))
    o = _head_rmsnorm(_from_heads(o), NORM_EPS) * norm_w
    return o * jax.nn.silu(g)


def _mlstm_chunked(q, k, v, i_pre, log_f):
    bsz, nh, _, dk = q.shape
    dv = v.shape[-1]
    causal = jnp.tril(jnp.ones((CHUNK, CHUNK), bool))

    def chunk(carry, inp):
        c_mat, n_vec, m_prev = carry
        qc, kc, vc, ic, lf = inp
        fcum = jnp.cumsum(lf, axis=-1)
        log_w = jnp.where(causal, fcum[..., :, None] - fcum[..., None, :] + ic[..., None, :], -jnp.inf)
        log_inter = fcum + m_prev[..., None]
        m_t = jnp.maximum(log_inter, jnp.max(log_w, -1))
        w_intra = jnp.exp(log_w - m_t[..., None])
        w_inter = jnp.exp(log_inter - m_t)
        s_qk = jnp.einsum('bhtd,bhsd->bhts', qc, kc) * w_intra
        num = w_inter[..., None] * jnp.einsum('bhtd,bhde->bhte', qc, c_mat) + jnp.einsum('bhts,bhse->bhte', s_qk, vc)
        den = w_inter * jnp.einsum('bhtd,bhd->bht', qc, n_vec) + jnp.sum(s_qk, -1)
        h = num / jnp.maximum(jnp.abs(den), jnp.exp(-m_t))[..., None]
        f_last = fcum[..., -1]
        log_s = f_last[..., None] - fcum + ic
        m_new = jnp.maximum(f_last + m_prev, jnp.max(log_s, -1))
        ws = jnp.exp(log_s - m_new[..., None])
        carry_decay = jnp.exp(f_last + m_prev - m_new)
        c_mat = carry_decay[..., None, None] * c_mat + jnp.einsum('bhs,bhsd,bhse->bhde', ws, kc, vc)
        n_vec = carry_decay[..., None] * n_vec + jnp.einsum('bhs,bhsd->bhd', ws, kc)
        return (c_mat, n_vec, m_new), h

    carry0 = (jnp.zeros((bsz, nh, dk, dv), F32), jnp.zeros((bsz, nh, dk), F32), jnp.full((bsz, nh), -1e30, F32))
    _, h = lax.scan(chunk, carry0, tuple(_to_chunks(t) for t in (q, k, v, i_pre, log_f)))
    return _from_chunks(h)


def mlstm_mix(zC, conv_w, conv_b, i_bias, f_bias, norm_w):
    q, k, v, o, ig, fg = _split(zC, MLSTM_SPLITS)
    qk = jax.nn.silu(_causal_conv(jnp.concatenate([q, k], -1), conv_w, conv_b))
    q, k = _split(qk, (BRANCH_WIDTH, BRANCH_WIDTH))
    qh = _to_heads(q, MLSTM_HEADS)
    kh = _to_heads(k, MLSTM_HEADS) * MLSTM_HEAD_DIM ** -0.5
    vh = _to_heads(v, MLSTM_HEADS)
    i_pre = (ig + i_bias).transpose(0, 2, 1)
    log_f = jax.nn.log_sigmoid(fg + f_bias).transpose(0, 2, 1)
    h = _mlstm_chunked(qh, kh, vh, i_pre, log_f)
    h = _head_layernorm(_from_heads(h), NORM_EPS) * norm_w
    return jax.nn.sigmoid(o) * h


def _linear_combine(left, right):
    a_l, b_l = left
    a_r, b_r = right
    return a_l * a_r, a_r * b_l + b_r


def rglru_mix(zD, conv_w, conv_b, wx, bx, wa, ba, lam):
    xr, gate = _split(zD, (BRANCH_WIDTH, BRANCH_WIDTH))
    xc = _causal_conv(xr, conv_w, conv_b)
    bsz, seq = xc.shape[:2]
    xb = xc.reshape(bsz, seq, LRU_BLOCKS, LRU_BLOCK_DIM)
    gate_x = jax.nn.sigmoid(jnp.einsum('bsgi,gij->bsgj', xb, wx) + bx).reshape(bsz, seq, BRANCH_WIDTH)
    gate_a = jax.nn.sigmoid(jnp.einsum('bsgi,gij->bsgj', xb, wa) + ba).reshape(bsz, seq, BRANCH_WIDTH)
    log_a = LRU_C * gate_a * jax.nn.log_sigmoid(lam)
    mult = jnp.sqrt(-jnp.expm1(2.0 * log_a)).at[:, 0].set(1.0)
    _, h = lax.associative_scan(_linear_combine, (jnp.exp(log_a), mult * gate_x * xc), axis=1)
    return h * jax.nn.gelu(gate)


def _expert_ffn(xb, w_gu, b_gu, w_down, b_down):
    gu = xb @ w_gu + b_gu
    gate, up = gu[:, :D_EXPERT], gu[:, D_EXPERT:]
    gate = jnp.minimum(gate, SWIGLU_LIMIT)
    up = jnp.clip(up, -SWIGLU_LIMIT, SWIGLU_LIMIT)
    glu = gate * jax.nn.sigmoid(SWIGLU_ALPHA * gate)
    return ((up + 1.0) * glu) @ w_down + b_down


def moe(xf, router_w, router_b, w_gu, b_gu, w_down, b_down):
    n_tok = xf.shape[0]
    logits = (xf @ router_w + router_b).astype(F32)
    top_val, top_idx = lax.top_k(logits, TOP_K)
    gate = jax.nn.softmax(top_val, axis=-1)
    n_assign = n_tok * TOP_K
    n_blocks = -(-n_assign // EXPERT_BLOCK) + N_EXPERTS
    n_slots = n_blocks * EXPERT_BLOCK
    e_flat = top_idx.reshape(-1)
    order = jnp.argsort(e_flat)
    e_sorted = e_flat[order]
    counts = jnp.bincount(e_flat, length=N_EXPERTS)
    padded = (counts + EXPERT_BLOCK - 1) // EXPERT_BLOCK * EXPERT_BLOCK
    start = jnp.cumsum(counts) - counts
    pad_end = jnp.cumsum(padded)
    pad_start = pad_end - padded
    dest = pad_start[e_sorted] + jnp.arange(n_assign) - start[e_sorted]
    slot_tok = jnp.zeros((n_slots,), jnp.int32).at[dest].set((order // TOP_K).astype(jnp.int32))
    slot_w = jnp.zeros((n_slots,), F32).at[dest].set(gate.reshape(-1)[order])
    block_e = jnp.minimum(jnp.searchsorted(pad_end, jnp.arange(n_blocks) * EXPERT_BLOCK, side='right'), N_EXPERTS - 1)
    xs = xf[slot_tok].reshape(n_blocks, EXPERT_BLOCK, -1)

    def run_block(args):
        xb, e = args
        return _expert_ffn(xb, w_gu[e], b_gu[e], w_down[e], b_down[e])

    ys = lax.map(run_block, (xs, block_e)).reshape(n_slots, -1)
    return jnp.zeros(xf.shape, F32).at[slot_tok].add(ys.astype(F32) * slot_w[:, None])


def setup_inputs(seed: int = 0) -> dict:
    key = jax.random.key(seed)
    ks = iter(jax.random.split(key, 64))
    L, W, D = DEPTH, BRANCH_WIDTH, D_MODEL

    def nrm(shape, scale):
        return scale * jax.random.normal(next(ks), shape, F32)

    def uni(shape, lo, hi):
        return jax.random.uniform(next(ks), shape, F32, lo, hi)

    return {
        'x': nrm((BATCH, SEQ, D), 1.0),
        'p': nrm((L, BATCH, SEQ, D_PLE), 1.0),
        'w_in_first': nrm((D, N_COLS_BASE), D ** -0.5),
        'w_in_rest': nrm((L - 1, D, N_COLS_REST), D ** -0.5),
        'rwkv_mu': uni((L, RWKV_COLS), 0.0, 1.0),
        'rwkv_w0': uni((L, W), -6.0, 0.0),
        'rwkv_w2': nrm((L, RWKV_DECAY_RANK, W), 0.5 * RWKV_DECAY_RANK ** -0.5),
        'rwkv_a0': nrm((L, W), 0.1),
        'rwkv_a2': nrm((L, RWKV_ICL_RANK, W), 0.5 * RWKV_ICL_RANK ** -0.5),
        'rwkv_v0': nrm((L - 1, W), 0.1),
        'rwkv_v2': nrm((L - 1, RWKV_VALUE_RANK, W), 0.5 * RWKV_VALUE_RANK ** -0.5),
        'rwkv_g2': nrm((L, RWKV_GATE_RANK, W), RWKV_GATE_RANK ** -0.5),
        'rwkv_k_k': 0.85 + nrm((L, W), 0.05),
        'rwkv_k_a': 1.0 + nrm((L, W), 0.05),
        'rwkv_r_k': nrm((L, RWKV_HEADS, RWKV_HEAD_DIM), 0.1),
        'rwkv_lnx_g': 1.0 + nrm((L, W), 0.05),
        'rwkv_lnx_b': nrm((L, W), 0.02),
        'hgrn_lower_bounds': nrm((L, W), 1.0),
        'hgrn_norm_w': 1.0 + nrm((L, W), 0.05),
        'mlstm_conv_w': nrm((L, CONV_WIDTH, 2 * W), CONV_WIDTH ** -0.5),
        'mlstm_conv_b': nrm((L, 2 * W), 0.02),
        'mlstm_i_bias': nrm((L, MLSTM_HEADS), 0.1),
        'mlstm_f_bias': jnp.linspace(3.0, 6.0, MLSTM_HEADS, dtype=F32) + nrm((L, MLSTM_HEADS), 0.1),
        'mlstm_norm_w': 1.0 + nrm((L, W), 0.05),
        'lru_conv_w': nrm((L, CONV_WIDTH, W), CONV_WIDTH ** -0.5),
        'lru_conv_b': nrm((L, W), 0.02),
        'lru_wx': nrm((L, LRU_BLOCKS, LRU_BLOCK_DIM, LRU_BLOCK_DIM), LRU_BLOCK_DIM ** -0.5),
        'lru_bx': nrm((L, LRU_BLOCKS, LRU_BLOCK_DIM), 0.02),
        'lru_wa': nrm((L, LRU_BLOCKS, LRU_BLOCK_DIM, LRU_BLOCK_DIM), LRU_BLOCK_DIM ** -0.5),
        'lru_ba': nrm((L, LRU_BLOCKS, LRU_BLOCK_DIM), 0.02),
        'lru_lambda': uni((L, W), 3.5, 9.0),
        'w_branch': nrm((L, N_BRANCH, W, D), W ** -0.5),
        'w_out': nrm((L, D, D), DEEPNORM_BETA * D ** -0.5),
        'ln1_g': 1.0 + nrm((L, D), 0.05),
        'ln1_b': nrm((L, D), 0.02),
        'router_w': nrm((L, D, N_EXPERTS), D ** -0.5),
        'router_b': nrm((L, N_EXPERTS), 0.01),
        'expert_w_gu': nrm((L, N_EXPERTS, D, 2 * D_EXPERT), D ** -0.5),
        'expert_b_gu': nrm((L, N_EXPERTS, 2 * D_EXPERT), 0.02),
        'expert_w_down': nrm((L, N_EXPERTS, D_EXPERT, D), DEEPNORM_BETA * D_EXPERT ** -0.5),
        'expert_b_down': nrm((L, N_EXPERTS, D), 0.02),
        'ple_gate_w': nrm((L, D, D), D ** -0.5),
        'ple_proj_w': nrm((L, D_PLE, D), DEEPNORM_BETA * D_PLE ** -0.5),
        'ln2_g': 1.0 + nrm((L, D), 0.05),
        'ln2_b': nrm((L, D), 0.02),
    }


def reference(x, p, w_in_first, w_in_rest, rwkv_mu, rwkv_w0, rwkv_w2, rwkv_a0, rwkv_a2, rwkv_v0, rwkv_v2,
              rwkv_g2, rwkv_k_k, rwkv_k_a, rwkv_r_k, rwkv_lnx_g, rwkv_lnx_b, hgrn_lower_bounds, hgrn_norm_w,
              mlstm_conv_w, mlstm_conv_b, mlstm_i_bias, mlstm_f_bias, mlstm_norm_w, lru_conv_w, lru_conv_b,
              lru_wx, lru_bx, lru_wa, lru_ba, lru_lambda, w_branch, w_out, ln1_g, ln1_b, router_w, router_b,
              expert_w_gu, expert_b_gu, expert_w_down, expert_b_down, ple_gate_w, ple_proj_w, ln2_g, ln2_b):
    dt = x.dtype
    bsz, seq, _ = x.shape
    lb_all = jnp.cumsum(jax.nn.softmax(hgrn_lower_bounds.astype(F32), axis=0), axis=0)
    lb_all = lb_all - lb_all[0]
    v_first = None
    for layer in range(DEPTH):
        w_in = w_in_first if layer == 0 else w_in_rest[layer - 1]
        z = (x @ w_in).astype(F32)
        zA, zB, zC, zD, zG = _split(z[..., :N_COLS_BASE], (RWKV_COLS, HGRN_COLS, MLSTM_COLS, LRU_COLS, GATE_COLS))
        v_mix = None if layer == 0 else rwkv_v0[layer - 1] + z[..., N_COLS_BASE:] @ rwkv_v2[layer - 1]
        yA, v_cur = rwkv7_mix(zA, v_first, v_mix, rwkv_mu[layer], rwkv_w0[layer], rwkv_w2[layer], rwkv_a0[layer],
                              rwkv_a2[layer], rwkv_g2[layer], rwkv_k_k[layer], rwkv_k_a[layer], rwkv_r_k[layer],
                              rwkv_lnx_g[layer], rwkv_lnx_b[layer])
        if layer == 0:
            v_first = v_cur
        yB = hgrn2_mix(zB, lb_all[layer], hgrn_norm_w[layer])
        yC = mlstm_mix(zC, mlstm_conv_w[layer], mlstm_conv_b[layer], mlstm_i_bias[layer], mlstm_f_bias[layer],
                       mlstm_norm_w[layer])
        yD = rglru_mix(zD, lru_conv_w[layer], lru_conv_b[layer], lru_wx[layer], lru_bx[layer], lru_wa[layer],
                       lru_ba[layer], lru_lambda[layer])
        gates = jax.nn.sigmoid(zG).reshape(bsz, seq, N_BRANCH, D_MODEL)
        merged = jnp.zeros((bsz, seq, D_MODEL), F32)
        for n, yb in enumerate((yA, yB, yC, yD)):
            merged = merged + gates[:, :, n] * (yb @ w_branch[layer, n])
        mix = merged @ w_out[layer]
        x = _layernorm(DEEPNORM_ALPHA * x + mix, ln1_g[layer], ln1_b[layer], dt)
        moe_out = moe(x.reshape(bsz * seq, D_MODEL), router_w[layer], router_b[layer], expert_w_gu[layer],
                      expert_b_gu[layer], expert_w_down[layer], expert_b_down[layer]).reshape(bsz, seq, D_MODEL)
        ple = jax.nn.sigmoid(x @ ple_gate_w[layer]) * (p[layer] @ ple_proj_w[layer])
        x = _layernorm(DEEPNORM_ALPHA * x + moe_out + ple, ln2_g[layer], ln2_b[layer], dt)
    return x
```

```cpp
#include <hip/hip_runtime.h>
#include <cstdio>
#include <cstdint>
namespace pg8 {
#define PG8_LAS __attribute__((address_space(3)))
typedef unsigned short bf16_t;
typedef short bf16x8 __attribute__((ext_vector_type(8)));
typedef float f32x4 __attribute__((ext_vector_type(4)));
typedef unsigned u32x4 __attribute__((ext_vector_type(4)));
constexpr int BM = 256, BK = 64, HALF = 128, HTB = HALF * BK * 2  , STAGE_BYTES = 8 * HTB, NXCD = 8, WGM = 8;

__host__ __device__ __forceinline__ int lds_byte(int r, int c) { const int st = (r >> 4) * 2 + (c >> 5), rr = r & 15, cc = c & 31, ob = rr * 64 + cc * 2; return st * 1024 + (ob ^ (((ob >> 9) & 1) << 5)); }
__host__ __device__ __forceinline__ void stage_rc(int b, int& R, int& C) { const int st = b / 1024, sb = b % 1024, swz = sb ^ (((sb >> 9) & 1) << 5); R = (st >> 1) * 16 + swz / 64; C = (st & 1) * 32 + (swz % 64) / 2; }
__host__ __device__ __forceinline__ int perm32(int rho) { const int n = rho >> 4, i = rho & 15; return 8 * (i >> 2) + 4 * n + (i & 3); }

struct Unit { int pm, pn, po; };
struct Gemm { const bf16_t* A; const bf16_t* Bt; int M, N, K; };

struct StaticOrder {
    int nM, nN, nwg, G, c;
    __host__ __device__ void init(int M, int N, int G_, int c_) { nM = M / BM; nN = N / BM; nwg = nM * nN; G = G_; c = c_; }
    __host__ __device__ bool next(int i, Unit& u) const {
        const long L = (long)i * G + c; if (L >= nwg) return false;
        int wgid = (int)L; { const int q = nwg / NXCD, r = nwg % NXCD, xcd = wgid % NXCD, off = wgid / NXCD; wgid = (xcd < r ? xcd * (q + 1) : r * (q + 1) + (xcd - r) * q) + off; }
        const int nig = WGM * nN, gid = wgid / nig, fm = gid * WGM, gsz = (nM - fm) < WGM ? (nM - fm) : WGM;
        u.pm = fm + ((wgid % nig) % gsz); u.pn = (wgid % nig) / gsz; return true;
    }
    __device__ __forceinline__ void a_ready(const Unit&) const {}
    __device__ __forceinline__ void done(const Unit&) const {}
};

__device__ __forceinline__ unsigned cvt_pk_bf16(float lo, float hi) { unsigned r; asm volatile("v_cvt_pk_bf16_f32 %0, %1, %2" : "=v"(r) : "v"(lo), "v"(hi)); return r; }
typedef float f32x2 __attribute__((ext_vector_type(2)));
__device__ __forceinline__ int lane_id_fresh() { int l; asm volatile("v_mbcnt_lo_u32_b32 %0, -1, 0\n\tv_mbcnt_hi_u32_b32 %0, -1, %0" : "=v"(l)); return l; }
__device__ __forceinline__ f32x2 gelu_pk(f32x2 v) {
    const f32x2 av = __builtin_elementwise_abs(v), d = av * 0.2316418882f + 1.0f;
    f32x2 t; t.x = __builtin_amdgcn_rcpf(d.x); t.y = __builtin_amdgcn_rcpf(d.y);
    f32x2 q = t * 0.5307027145f + (-0.7265760135f); q = q * t + 0.7107068705f; q = q * t + (-0.142248368f); q = q * t + 0.127414796f; q = q * t;
    const f32x2 s = (v * v) * (-0.72134752044f);
    f32x2 e; e.x = __builtin_amdgcn_exp2f(s.x); e.y = __builtin_amdgcn_exp2f(s.y);
    const f32x2 m = v * (q * e), r = v - m;
    f32x2 o; o.x = v.x < 0.f ? m.x : r.x; o.y = v.y < 0.f ? m.y : r.y; return o;
}

template <int ACT  > struct EpiBf16 {
    static constexpr bool PERM = true, AFTER_DRAIN = false; static_assert(ACT == 0 || ACT == 1, "EpiBf16: ACT is 0 (none) or 1 (gelu_pk)");
    bf16_t* O; int ldc; const float* bias; int split_cols; size_t split_stride; float scale0;
    __device__ __forceinline__ void operator()(const f32x4 (&acc)[2][2][4][2], const Unit& u, int wr, int wc, int fr, int fq) const {
        const int row0 = u.pm * BM + wr * 64 + fr; int colt = u.pn * BM; bf16_t* base = O;
        float sc = 1.f; if (split_cols) { const int t = colt / split_cols; base += (size_t)t * split_stride; colt -= t * split_cols; if (t == 0) sc = scale0; }
        const int col0 = colt + wc * 32 + 8 * fq, bcol0 = u.pn * BM + wc * 32 + 8 * fq;
        f32x4 bv[2][2];
#pragma unroll
        for (int bj = 0; bj < 2; ++bj)
#pragma unroll
            for (int n = 0; n < 2; ++n) bv[bj][n] = bias ? *(const f32x4*)(bias + bcol0 + bj * HALF + 4 * n) : (f32x4){0.f, 0.f, 0.f, 0.f};
#pragma unroll
        for (int ai = 0; ai < 2; ++ai)
#pragma unroll
            for (int m = 0; m < 4; ++m) { bf16_t* rowp = base + (size_t)(row0 + ai * HALF + m * 16) * ldc + col0;
#pragma unroll
                for (int bj = 0; bj < 2; ++bj) { f32x4 v0 = acc[ai][bj][m][0] + bv[bj][0], v1 = acc[ai][bj][m][1] + bv[bj][1];
                    if (ACT == 1) { f32x2 a = gelu_pk((f32x2){v0[0], v0[1]}), b = gelu_pk((f32x2){v0[2], v0[3]}), c = gelu_pk((f32x2){v1[0], v1[1]}), d = gelu_pk((f32x2){v1[2], v1[3]});
                        v0 = (f32x4){a.x, a.y, b.x, b.y}; v1 = (f32x4){c.x, c.y, d.x, d.y}; }
                    v0 = v0 * sc; v1 = v1 * sc; u32x4 w; w.x = cvt_pk_bf16(v0[0], v0[1]); w.y = cvt_pk_bf16(v0[2], v0[3]); w.z = cvt_pk_bf16(v1[0], v1[1]); w.w = cvt_pk_bf16(v1[2], v1[3]);
                    *(u32x4*)(rowp + bj * HALF) = w; } }
    }
};


constexpr int ZLD = 11264;
__device__ __forceinline__ float bflo(unsigned w) { return __builtin_bit_cast(float, w << 16); }
__device__ __forceinline__ float bfhi(unsigned w) { return __builtin_bit_cast(float, w & 0xffff0000u); }
__device__ __forceinline__ float sigm(float x) { return __builtin_amdgcn_rcpf(1.0f + __expf(-x)); }
__device__ __forceinline__ float clamp8(float x) { return __builtin_fminf(__builtin_fmaxf(x, -448.0f), 448.0f); }

struct EpiBranch {
    static constexpr bool PERM = true, AFTER_DRAIN = false, KEEP_ACC = true;
    const unsigned char* G8; unsigned char* MB8;
    __device__ __forceinline__ void operator()(f32x4 (&acc)[2][2][4][2], const Unit& u, int wr, int wc, int fr, int fq) const {
        const int n = u.pn >> 2, pn = u.pn & 3, pm = u.pm & 63;
        const int row0 = pm * BM + wr * 64 + fr, col0 = pn * BM + wc * 32 + 8 * fq;
        typedef unsigned u32x2b_ __attribute__((ext_vector_type(2)));
#pragma unroll
        for (int ai = 0; ai < 2; ++ai)
#pragma unroll
            for (int m = 0; m < 4; ++m) { const size_t row = (size_t)(row0 + ai * HALF + m * 16);
#pragma unroll
                for (int bj = 0; bj < 2; ++bj) { const int c = col0 + bj * HALF;
                    const unsigned char* gp = G8 + row * 4096 + n * 1024 + c;
                    const u32x2b_ gq = *(const u32x2b_*)gp;
                    f32x4 s0 = (f32x4){(float)(gq.x & 255u), (float)((gq.x >> 8) & 255u), (float)((gq.x >> 16) & 255u), (float)(gq.x >> 24)}, s1 = (f32x4){(float)(gq.y & 255u), (float)((gq.y >> 8) & 255u), (float)((gq.y >> 16) & 255u), (float)(gq.y >> 24)};
                    if (n < 3) { const u32x2b_ hq = *(const u32x2b_*)(gp + 1024);
                        s0[0] *= __builtin_amdgcn_rcpf((float)(hq.x & 255u)); s0[1] *= __builtin_amdgcn_rcpf((float)((hq.x >> 8) & 255u)); s0[2] *= __builtin_amdgcn_rcpf((float)((hq.x >> 16) & 255u)); s0[3] *= __builtin_amdgcn_rcpf((float)(hq.x >> 24));
                        s1[0] *= __builtin_amdgcn_rcpf((float)(hq.y & 255u)); s1[1] *= __builtin_amdgcn_rcpf((float)((hq.y >> 8) & 255u)); s1[2] *= __builtin_amdgcn_rcpf((float)((hq.y >> 16) & 255u)); s1[3] *= __builtin_amdgcn_rcpf((float)(hq.y >> 24));
                        acc[ai][bj][m][0] = acc[ai][bj][m][0] * s0; acc[ai][bj][m][1] = acc[ai][bj][m][1] * s1; }
                    else { const f32x4 v0 = acc[ai][bj][m][0] * s0 * (16.0f / 255.0f), v1 = acc[ai][bj][m][1] * s1 * (16.0f / 255.0f);
                        unsigned w0 = 0u, w1 = 0u;
                        w0 = __builtin_amdgcn_cvt_pk_fp8_f32(clamp8(v0[0]), clamp8(v0[1]), w0, false); w0 = __builtin_amdgcn_cvt_pk_fp8_f32(clamp8(v0[2]), clamp8(v0[3]), w0, true);
                        w1 = __builtin_amdgcn_cvt_pk_fp8_f32(clamp8(v1[0]), clamp8(v1[1]), w1, false); w1 = __builtin_amdgcn_cvt_pk_fp8_f32(clamp8(v1[2]), clamp8(v1[3]), w1, true);
                        *(u32x2b_*)(MB8 + row * 1024 + c) = (u32x2b_){w0, w1};
                        acc[ai][bj][m][0] = (f32x4){0.f, 0.f, 0.f, 0.f}; acc[ai][bj][m][1] = (f32x4){0.f, 0.f, 0.f, 0.f}; } } }
    }
};
struct EpiGate8 {
    static constexpr bool PERM = true, AFTER_DRAIN = false;
    unsigned char* G8;
    __device__ __forceinline__ void operator()(const f32x4 (&acc)[2][2][4][2], const Unit& u, int wr, int wc, int fr, int fq) const {
        const int row0 = u.pm * BM + wr * 64 + fr, col0 = u.pn * BM + wc * 32 + 8 * fq;
        typedef unsigned u32x2b_ __attribute__((ext_vector_type(2)));
#pragma unroll
        for (int ai = 0; ai < 2; ++ai)
#pragma unroll
            for (int m = 0; m < 4; ++m) { unsigned char* rowp = G8 + (size_t)(row0 + ai * HALF + m * 16) * 4096 + col0;
#pragma unroll
                for (int bj = 0; bj < 2; ++bj) { const f32x4 v0 = acc[ai][bj][m][0], v1 = acc[ai][bj][m][1]; unsigned q[8];
#pragma unroll
                    for (int i = 0; i < 4; ++i) { q[i] = (unsigned)__builtin_fmaxf(255.0f * sigm(v0[i]) + 0.5f, 1.0f); q[4 + i] = (unsigned)__builtin_fmaxf(255.0f * sigm(v1[i]) + 0.5f, 1.0f); }
                    *(u32x2b_*)(rowp + bj * HALF) = (u32x2b_){q[0] | (q[1] << 8) | (q[2] << 16) | (q[3] << 24), q[4] | (q[5] << 8) | (q[6] << 16) | (q[7] << 24)}; } }
    }
};
struct EpiWout {
    static constexpr bool PERM = true, AFTER_DRAIN = false;
    const bf16_t* XB; bf16_t* PRE; float alpha;
    __device__ __forceinline__ void operator()(const f32x4 (&acc)[2][2][4][2], const Unit& u, int wr, int wc, int fr, int fq) const {
        const int row0 = u.pm * BM + wr * 64 + fr, col0 = u.pn * BM + wc * 32 + 8 * fq;
#pragma unroll
        for (int ai = 0; ai < 2; ++ai)
#pragma unroll
            for (int m = 0; m < 4; ++m) { const size_t ro = (size_t)(row0 + ai * HALF + m * 16) * 1024 + col0;
#pragma unroll
                for (int bj = 0; bj < 2; ++bj) { const u32x4 xz = *(const u32x4*)(XB + ro + bj * HALF); const f32x4 v0 = acc[ai][bj][m][0], v1 = acc[ai][bj][m][1];
                    u32x4 w; w.x = cvt_pk_bf16(bflo(xz.x) * alpha + v0[0], bfhi(xz.x) * alpha + v0[1]); w.y = cvt_pk_bf16(bflo(xz.y) * alpha + v0[2], bfhi(xz.y) * alpha + v0[3]);
                    w.z = cvt_pk_bf16(bflo(xz.z) * alpha + v1[0], bfhi(xz.z) * alpha + v1[1]); w.w = cvt_pk_bf16(bflo(xz.w) * alpha + v1[2], bfhi(xz.w) * alpha + v1[3]);
                    *(u32x4*)(PRE + ro + bj * HALF) = w; } }
    }
};
struct EpiGU {
    static constexpr bool PERM = true, AFTER_DRAIN = false;
    bf16_t* H; const float* bgu;
    __device__ __forceinline__ void operator()(const f32x4 (&acc)[2][2][4][2], const Unit& u, int wr, int wc, int fr, int fq) const {
        const int e = u.pn >> 3, j = u.pn & 7;
        const int row0 = u.po * BM + wr * 64 + fr, cl = j * 128 + wc * 32 + 8 * fq;
        const float* bg = bgu + (size_t)e * 2048 + cl; const float* bu = bg + 1024;
        const f32x4 bg0 = *(const f32x4*)bg, bg1 = *(const f32x4*)(bg + 4), bu0 = *(const f32x4*)bu, bu1 = *(const f32x4*)(bu + 4);
#pragma unroll
        for (int ai = 0; ai < 2; ++ai)
#pragma unroll
            for (int m = 0; m < 4; ++m) { const size_t row = (size_t)(row0 + ai * HALF + m * 16);
                f32x4 g0 = acc[ai][0][m][0] + bg0, g1 = acc[ai][0][m][1] + bg1, u0 = acc[ai][1][m][0] + bu0, u1 = acc[ai][1][m][1] + bu1;
                f32x4 h0, h1;
#pragma unroll
                for (int i = 0; i < 4; ++i) {
                    const float ga = fminf(g0[i], 7.0f), ua = fminf(fmaxf(u0[i], -7.0f), 7.0f); h0[i] = (ua + 1.0f) * ga * sigm(1.702f * ga);
                    const float gb = fminf(g1[i], 7.0f), ub = fminf(fmaxf(u1[i], -7.0f), 7.0f); h1[i] = (ub + 1.0f) * gb * sigm(1.702f * gb); }
                unsigned w0 = 0u, w1 = 0u;
                w0 = __builtin_amdgcn_cvt_pk_fp8_f32(h0[0] * 4.f, h0[1] * 4.f, w0, false); w0 = __builtin_amdgcn_cvt_pk_fp8_f32(h0[2] * 4.f, h0[3] * 4.f, w0, true);
                w1 = __builtin_amdgcn_cvt_pk_fp8_f32(h1[0] * 4.f, h1[1] * 4.f, w1, false); w1 = __builtin_amdgcn_cvt_pk_fp8_f32(h1[2] * 4.f, h1[3] * 4.f, w1, true);
                typedef unsigned u32x2_ __attribute__((ext_vector_type(2)));
                *(u32x2_*)((unsigned char*)H + row * 1024 + cl) = (u32x2_){w0, w1}; }
    }
};
struct EpiPle {
    static constexpr bool PERM = true, AFTER_DRAIN = false;
    const bf16_t* PP; bf16_t* PLEG;
    __device__ __forceinline__ void operator()(const f32x4 (&acc)[2][2][4][2], const Unit& u, int wr, int wc, int fr, int fq) const {
        const int row0 = u.pm * BM + wr * 64 + fr, col0 = u.pn * BM + wc * 32 + 8 * fq;
#pragma unroll
        for (int ai = 0; ai < 2; ++ai)
#pragma unroll
            for (int m = 0; m < 4; ++m) { const size_t ro = (size_t)(row0 + ai * HALF + m * 16) * 1024 + col0;
#pragma unroll
                for (int bj = 0; bj < 2; ++bj) { const u32x4 pz = *(const u32x4*)(PP + ro + bj * HALF);
                    const f32x4 v0 = acc[ai][bj][m][0], v1 = acc[ai][bj][m][1];
                    u32x4 w; w.x = cvt_pk_bf16(sigm(v0[0]) * bflo(pz.x), sigm(v0[1]) * bfhi(pz.x)); w.y = cvt_pk_bf16(sigm(v0[2]) * bflo(pz.y), sigm(v0[3]) * bfhi(pz.y));
                    w.z = cvt_pk_bf16(sigm(v1[0]) * bflo(pz.z), sigm(v1[1]) * bfhi(pz.z)); w.w = cvt_pk_bf16(sigm(v1[2]) * bflo(pz.w), sigm(v1[3]) * bfhi(pz.w));
                    *(u32x4*)(PLEG + ro + bj * HALF) = w; } }
    }
};

template <int NTN> struct EpiB16 {
    static constexpr bool PERM = true, AFTER_DRAIN = false;
    bf16_t* O; int ldc; const float* bias; int gate_tile0 = 1 << 30;
    __device__ __forceinline__ void operator()(const f32x4 (&acc)[2][2][4][2], const Unit& u, int wr, int wc, int fr, int fq) const {
        const int row0 = u.pm * BM + wr * 64 + fr, col0 = (NTN ? (u.pn % NTN) : u.pn) * BM + wc * 32 + 8 * fq, bcol0 = u.pn * BM + wc * 32 + 8 * fq;
        f32x4 bv[2][2];
#pragma unroll
        for (int bj = 0; bj < 2; ++bj)
#pragma unroll
            for (int n = 0; n < 2; ++n) bv[bj][n] = bias ? *(const f32x4*)(bias + bcol0 + bj * HALF + 4 * n) : (f32x4){0.f, 0.f, 0.f, 0.f};
#pragma unroll
        for (int ai = 0; ai < 2; ++ai)
#pragma unroll
            for (int m = 0; m < 4; ++m) { bf16_t* rowp = O + (size_t)(row0 + ai * HALF + m * 16) * ldc + col0;
#pragma unroll
                for (int bj = 0; bj < 2; ++bj) { f32x4 v0 = acc[ai][bj][m][0] + bv[bj][0], v1 = acc[ai][bj][m][1] + bv[bj][1];
                    if (u.pn >= gate_tile0) {
#pragma unroll
                        for (int i = 0; i < 4; ++i) { v0[i] = 1.0f + __expf(-v0[i]); v1[i] = 1.0f + __expf(-v1[i]); } }
                    u32x4 w; w.x = cvt_pk_bf16(v0[0], v0[1]); w.y = cvt_pk_bf16(v0[2], v0[3]); w.z = cvt_pk_bf16(v1[0], v1[1]); w.w = cvt_pk_bf16(v1[2], v1[3]);
                    *(u32x4*)(rowp + bj * HALF) = w; } }
    }
};
struct EpiYS8 {
    static constexpr bool PERM = true, AFTER_DRAIN = false;
    unsigned char* O; const float* bias;
    __device__ __forceinline__ void operator()(const f32x4 (&acc)[2][2][4][2], const Unit& u, int wr, int wc, int fr, int fq) const {
        const int row0 = u.pm * BM + wr * 64 + fr, col0 = (u.pn & 3) * BM + wc * 32 + 8 * fq, bcol0 = u.pn * BM + wc * 32 + 8 * fq;
        typedef unsigned u32x2b_ __attribute__((ext_vector_type(2)));
        f32x4 bv[2][2];
#pragma unroll
        for (int bj = 0; bj < 2; ++bj)
#pragma unroll
            for (int n = 0; n < 2; ++n) bv[bj][n] = *(const f32x4*)(bias + bcol0 + bj * HALF + 4 * n);
#pragma unroll
        for (int ai = 0; ai < 2; ++ai)
#pragma unroll
            for (int m = 0; m < 4; ++m) { unsigned char* rowp = O + (size_t)(row0 + ai * HALF + m * 16) * 1024 + col0;
#pragma unroll
                for (int bj = 0; bj < 2; ++bj) { const f32x4 v0 = (acc[ai][bj][m][0] + bv[bj][0]) * 64.0f, v1 = (acc[ai][bj][m][1] + bv[bj][1]) * 64.0f;
                    unsigned w0 = 0u, w1 = 0u;
                    w0 = __builtin_amdgcn_cvt_pk_fp8_f32(clamp8(v0[0]), clamp8(v0[1]), w0, false); w0 = __builtin_amdgcn_cvt_pk_fp8_f32(clamp8(v0[2]), clamp8(v0[3]), w0, true);
                    w1 = __builtin_amdgcn_cvt_pk_fp8_f32(clamp8(v1[0]), clamp8(v1[1]), w1, false); w1 = __builtin_amdgcn_cvt_pk_fp8_f32(clamp8(v1[2]), clamp8(v1[3]), w1, true);
                    *(u32x2b_*)(rowp + bj * HALF) = (u32x2b_){w0, w1}; } }
    }
};
struct LayerGroupOrder {
    int G, c;
    __device__ __forceinline__ bool next(int i, Unit& u) const { const int L = i * G + c; if (L >= 1024) return false; const int l = L >> 8, r = L & 255; u.pm = l * 64 + (r >> 2); u.pn = l * 4 + (r & 3); return true; }
    __device__ __forceinline__ void a_ready(const Unit&) const {}
    __device__ __forceinline__ void done(const Unit&) const {}
};
struct BranchOrder {
    StaticOrder base;
    __device__ __forceinline__ bool next(int i, Unit& u) const { Unit b; if (!base.next(i >> 2, b)) return false; const int n = i & 3; u.pm = b.pm + 64 * n; u.pn = b.pn + 4 * n; return true; }
    __device__ __forceinline__ void a_ready(const Unit&) const {}
    __device__ __forceinline__ void done(const Unit&) const {}
};
template <int NT, bool VIRT> struct MoeOrder {
    const PG8_LAS int* tileE; const PG8_LAS int* pstart; int ntiles, G, c;
    __device__ __forceinline__ bool next(int i, Unit& u) const { const int L = i * G + c; if (L >= ntiles * NT) return false; const int mt = L / NT, j = L % NT; const int e = __builtin_amdgcn_readfirstlane(tileE[mt]);
        u.po = mt; u.pm = VIRT ? 64 * e + (mt - __builtin_amdgcn_readfirstlane(pstart[e])) : mt; u.pn = e * NT + j; return true; }
    __device__ __forceinline__ void a_ready(const Unit&) const {}
    __device__ __forceinline__ void done(const Unit&) const {}
};
template <class E, class = void> struct epi_keeps_acc { static constexpr bool value = false; };
template <class E> struct epi_keeps_acc<E, decltype((void)E::KEEP_ACC)> { static constexpr bool value = E::KEEP_ACC; };
typedef int i32x4 __attribute__((ext_vector_type(4))); typedef int i32x8 __attribute__((ext_vector_type(8)));
__device__ __forceinline__ i32x8 cat8(bf16x8 lo, bf16x8 hi) { return __builtin_shufflevector(__builtin_bit_cast(i32x4, lo), __builtin_bit_cast(i32x4, hi), 0, 1, 2, 3, 4, 5, 6, 7); }
template <class Epi, class Sched, bool ALIGN_EPI = false, bool SP2 = false, bool F8 = false, int F8_SW = 0x7f, int F8_SX = 0x7f>
__device__ __forceinline__ void gemm_phase(PG8_LAS unsigned char* lds, const Gemm g, const Sched& S, const Epi& E, int tid_in) {
    int tid = tid_in; asm volatile("" : "+v"(tid));
    const int wid = __builtin_amdgcn_readfirstlane(tid >> 6), lane = tid & 63, wr = wid >> 2, wc = wid & 3, fr = lane & 15, fq = lane >> 4;
    const int K = g.K, nt = K / BK;
    int f8sw = F8_SW, f8sx = F8_SX; if constexpr (F8) asm volatile("" : "+v"(f8sw), "+v"(f8sx));
    unsigned voffA[2], voffB[2];
#pragma unroll
    for (int i = 0; i < 2; ++i) { int R, C; stage_rc(tid * 16 + i * 8192, R, C); const int Rb = Epi::PERM ? ((R & ~31) + perm32(R & 31)) : R;
        voffA[i] = (unsigned)(R * K + C) * 2u; voffB[i] = (unsigned)(Rb * K + C) * 2u; }
    asm volatile("" : "+v"(voffA[0]), "+v"(voffA[1]), "+v"(voffB[0]), "+v"(voffB[1]));
    const size_t kstep = (size_t)(BK * 2);
    const size_t hstep = (size_t)HALF * K * 2;
    const size_t tstep = 2 * hstep;
    const unsigned ldsw = (unsigned)wid * 1024u;
    const int aoff = lds_byte(wr * 64 + fr, fq * 8), boff = lds_byte(wc * 32 + fr, fq * 8);
#define PG8_SA(b, h) (((b) * 2 + (h)) * HTB)
#define PG8_SB(b, h) ((4 + (b) * 2 + (h)) * HTB)
#define PG8_STAGE(bufoff, gbase, voff) do { _Pragma("unroll") for (int _i = 0; _i < 2; ++_i) \
        __builtin_amdgcn_global_load_lds((const unsigned*)((const char*)(gbase) + (voff)[_i]), (PG8_LAS unsigned*)(lds + (bufoff) + ldsw + _i * 8192), 16, 0, 0); } while (0)
#define PG8_LDA(dst, b, h) do { _Pragma("unroll") for (int m = 0; m < 4; ++m) _Pragma("unroll") for (int k = 0; k < 2; ++k) dst[m][k] = *(const PG8_LAS bf16x8*)(lds + PG8_SA(b, h) + aoff + m * 2048 + k * 1024); } while (0)
#define PG8_LDB(dst, b, h) do { _Pragma("unroll") for (int n = 0; n < 2; ++n) _Pragma("unroll") for (int k = 0; k < 2; ++k) dst[n][k] = *(const PG8_LAS bf16x8*)(lds + PG8_SB(b, h) + boff + n * 2048 + k * 1024); } while (0)
#define PG8_MMA(ai, bj, At, Bt) do { __builtin_amdgcn_s_setprio(1); _Pragma("unroll") for (int m = 0; m < 4; ++m) _Pragma("unroll") for (int n = 0; n < 2; ++n) { \
        if constexpr (F8) { asm volatile("v_mfma_scale_f32_16x16x128_f8f6f4 %0, %1, %2, %0, %3, %4 op_sel_hi:[0,0,0]" : "+v"(acc[ai][bj][m][n]) : "v"(cat8(Bt[n][0], Bt[n][1])), "v"(cat8(At[m][0], At[m][1])), "v"(f8sw), "v"(f8sx)); } \
        else { _Pragma("unroll") for (int k = 0; k < 2; ++k) acc[ai][bj][m][n] = __builtin_amdgcn_mfma_f32_16x16x32_bf16(Bt[n][k], At[m][k], acc[ai][bj][m][n], 0, 0, 0); } } __builtin_amdgcn_s_setprio(0); } while (0)
#define PG8_WAIT_V(n) asm volatile("s_waitcnt vmcnt(" #n ")" ::: "memory")
#define PG8_WAIT_L(n) asm volatile("s_waitcnt lgkmcnt(" #n ")" ::: "memory")
#define PG8_BAR __builtin_amdgcn_s_barrier()
#define PG8_SCHED __builtin_amdgcn_sched_barrier(0)
    Unit cur, nxt; int ui = 0;
    if (!S.next(0, cur)) return;
    f32x4 acc[2][2][4][2];
#pragma unroll
    for (int a = 0; a < 2; ++a)
#pragma unroll
        for (int b = 0; b < 2; ++b)
#pragma unroll
            for (int m = 0; m < 4; ++m)
#pragma unroll
                for (int n = 0; n < 2; ++n) acc[a][b][m][n] = (f32x4){0.f, 0.f, 0.f, 0.f};
    bf16x8 At[4][2], B0[2][2], B1[2][2];
    const char* cA = (const char*)g.A + (size_t)cur.pm * tstep; const char* cB = (const char*)g.Bt + (size_t)cur.pn * tstep;
    S.a_ready(cur);
    if constexpr (SP2) {
        PG8_STAGE(PG8_SB(0, 0), cB, voffB); PG8_STAGE(PG8_SB(0, 1), cB + hstep, voffB); PG8_STAGE(PG8_SA(0, 0), cA, voffA); PG8_STAGE(PG8_SA(0, 1), cA + hstep, voffA);
        if (wr == 1) PG8_BAR;
        PG8_WAIT_V(2); PG8_BAR;
        PG8_STAGE(PG8_SB(1, 0), cB + kstep, voffB); PG8_STAGE(PG8_SA(1, 0), cA + kstep, voffA); PG8_STAGE(PG8_SB(1, 1), cB + hstep + kstep, voffB);
        PG8_WAIT_V(6); PG8_BAR;
    } else {
        PG8_STAGE(PG8_SB(0, 0), cB, voffB); PG8_STAGE(PG8_SA(0, 0), cA, voffA); PG8_STAGE(PG8_SB(0, 1), cB + hstep, voffB); PG8_STAGE(PG8_SA(0, 1), cA + hstep, voffA);
        if (wr == 1) PG8_BAR;
        PG8_WAIT_V(4); PG8_BAR;
        PG8_STAGE(PG8_SB(1, 0), cB + kstep, voffB); PG8_STAGE(PG8_SA(1, 0), cA + kstep, voffA); PG8_STAGE(PG8_SB(1, 1), cB + hstep + kstep, voffB);
        PG8_WAIT_V(6); PG8_BAR;
    }
    for (;;) {
        const bool has_next = S.next(ui + 1, nxt);
        const char* nA = has_next ? (const char*)g.A + (size_t)nxt.pm * tstep : cA; const char* nB = has_next ? (const char*)g.Bt + (size_t)nxt.pn * tstep : cB;
#pragma nounroll
        for (int t = 0; t < nt; t += 2) {
            const bool last = (t == nt - 2);
            const char* a1 = cA + (size_t)(t + 1) * kstep;
            const char* a2 = last ? nA : cA + (size_t)(t + 2) * kstep; const char* b2 = last ? nB : cB + (size_t)(t + 2) * kstep;
            const char* a3 = a2 + kstep; const char* b3 = b2 + kstep;
            if (last && has_next) S.a_ready(nxt);
            if constexpr (SP2) {
            PG8_LDB(B0, 0, 0); PG8_LDB(B1, 0, 1); PG8_SCHED; PG8_LDA(At, 0, 0); PG8_STAGE(PG8_SA(1, 1), a1 + hstep, voffA);
            PG8_WAIT_V(8); PG8_WAIT_L(0); PG8_BAR; PG8_MMA(0, 0, At, B0); PG8_MMA(0, 1, At, B1); PG8_BAR; PG8_SCHED;
            PG8_LDA(At, 0, 1); PG8_STAGE(PG8_SB(0, 0), b2, voffB); PG8_STAGE(PG8_SB(0, 1), b2 + hstep, voffB); PG8_STAGE(PG8_SA(0, 0), a2, voffA);
            PG8_WAIT_V(8); PG8_WAIT_L(0); PG8_BAR; PG8_MMA(1, 0, At, B0); PG8_MMA(1, 1, At, B1); PG8_BAR; PG8_SCHED;
            PG8_LDB(B0, 1, 0); PG8_LDB(B1, 1, 1); PG8_SCHED; PG8_LDA(At, 1, 0); PG8_STAGE(PG8_SA(0, 1), a2 + hstep, voffA);
            PG8_WAIT_V(8); PG8_WAIT_L(0); PG8_BAR; PG8_MMA(0, 0, At, B0); PG8_MMA(0, 1, At, B1); PG8_BAR; PG8_SCHED;
            PG8_LDA(At, 1, 1); PG8_STAGE(PG8_SB(1, 0), b3, voffB); PG8_STAGE(PG8_SB(1, 1), b3 + hstep, voffB); PG8_STAGE(PG8_SA(1, 0), a3, voffA);
            PG8_WAIT_V(8); PG8_WAIT_L(0); PG8_BAR; PG8_MMA(1, 0, At, B0); PG8_MMA(1, 1, At, B1); PG8_BAR; PG8_SCHED;
            } else {
            PG8_LDB(B0, 0, 0); PG8_SCHED; PG8_LDA(At, 0, 0); PG8_STAGE(PG8_SA(1, 1), a1 + hstep, voffA);
            PG8_WAIT_L(8); PG8_BAR; PG8_WAIT_L(0); PG8_MMA(0, 0, At, B0); PG8_BAR; PG8_SCHED;
            PG8_LDB(B1, 0, 1); PG8_STAGE(PG8_SB(0, 0), b2, voffB);
            PG8_BAR; PG8_WAIT_L(0); PG8_MMA(0, 1, At, B1); PG8_BAR;
            PG8_LDA(At, 0, 1); PG8_STAGE(PG8_SA(0, 0), a2, voffA);
            PG8_BAR; PG8_WAIT_L(0); PG8_MMA(1, 0, At, B0); PG8_BAR; PG8_SCHED;
            PG8_STAGE(PG8_SB(0, 1), b2 + hstep, voffB);
            PG8_WAIT_V(6); PG8_BAR; PG8_MMA(1, 1, At, B1); PG8_BAR;
            PG8_LDB(B0, 1, 0); PG8_SCHED; PG8_LDA(At, 1, 0); PG8_STAGE(PG8_SA(0, 1), a2 + hstep, voffA);
            PG8_WAIT_L(8); PG8_BAR; PG8_WAIT_L(0); PG8_MMA(0, 0, At, B0); PG8_BAR; PG8_SCHED;
            PG8_LDB(B1, 1, 1); PG8_STAGE(PG8_SB(1, 0), b3, voffB);
            PG8_BAR; PG8_WAIT_L(0); PG8_MMA(0, 1, At, B1); PG8_BAR;
            PG8_LDA(At, 1, 1); PG8_STAGE(PG8_SA(1, 0), a3, voffA);
            PG8_BAR; PG8_WAIT_L(0); PG8_MMA(1, 0, At, B0); PG8_BAR; PG8_SCHED;
            PG8_STAGE(PG8_SB(1, 1), b3 + hstep, voffB);
            PG8_WAIT_V(6); PG8_BAR; PG8_MMA(1, 1, At, B1); PG8_BAR;
            }
        }
        if constexpr (F8) asm volatile("s_nop 15\n\ts_nop 15" ::: "memory");
        if constexpr (ALIGN_EPI) { if (wr == 0) PG8_BAR; }
        if constexpr (!Epi::AFTER_DRAIN) { const int l2 = lane_id_fresh(); E(acc, cur, wr, wc, l2 & 15, l2 >> 4); S.done(cur); }
        if (!has_next) break;
        if constexpr (!epi_keeps_acc<Epi>::value) {
#pragma unroll
        for (int a = 0; a < 2; ++a)
#pragma unroll
            for (int b = 0; b < 2; ++b)
#pragma unroll
                for (int m = 0; m < 4; ++m)
#pragma unroll
                    for (int n = 0; n < 2; ++n) acc[a][b][m][n] = (f32x4){0.f, 0.f, 0.f, 0.f};
        }
        cur = nxt; cA = nA; cB = nB; ++ui;
        if constexpr (ALIGN_EPI) { if (wr == 1) PG8_BAR; }
    }
    PG8_WAIT_V(0);
    if constexpr (!ALIGN_EPI) { if (wr == 0) PG8_BAR; }
    PG8_BAR;
    if constexpr (Epi::AFTER_DRAIN) { E.fused(acc, cur, wr, wc, fr, fq, lds, wid, lane); S.done(cur); }
#undef PG8_SA
#undef PG8_SB
#undef PG8_STAGE
#undef PG8_LDA
#undef PG8_LDB
#undef PG8_MMA
#undef PG8_WAIT_V
#undef PG8_WAIT_L
#undef PG8_BAR
#undef PG8_SCHED
}
}

#ifndef PG8_SP2
#define PG8_SP2 true
#endif
#ifndef PG8_ALIGN
#define PG8_ALIGN true
#endif

constexpr int NWAVES = 8, NTHR = 512;
constexpr int NL = 4, M = 16384, D = 1024, SEQ = 2048, W = 512, NE = 32, ZLD = 11264, DPLE = 256;
constexpr int NC_BASE = 11016, NC_REST = 11048;
constexpr int ZA = 0, ZB = 1792, ZC = 3840, ZD = 5896, ZX = 6920, ZG = 7168;
constexpr float ALPHA = 1.681792830507429f;
constexpr int MOE_ROWS = 73728;
constexpr size_t MiB = 1u << 20;
constexpr size_t WS_CTL = 0, CTL_ZERO_BYTES = 128 * 1024;
constexpr size_t WS_WIN = 2 * MiB, WS_WBR = 90 * MiB, WS_WOUT = 106 * MiB, WS_WPG = 114 * MiB, WS_WPP = 122 * MiB, WS_WSM = 124 * MiB, WS_WLRU = 126 * MiB;
constexpr size_t WS_WGU = 128 * MiB, WS_WDN = 640 * MiB, WS_PB = 896 * MiB, WS_PP = 928 * MiB, WS_XB = 1056 * MiB, WS_XF = 1088 * MiB, WS_Z = 1152 * MiB;
constexpr size_t WS_RW = 1504 * MiB, WS_BON = 1728 * MiB, WS_VF = 1730 * MiB, WS_LA = 1762 * MiB, WS_LB = 1794 * MiB, WS_YA = 1826 * MiB, WS_OB = 1858 * MiB, WS_HC = 1890 * MiB;
constexpr size_t WS_Y = 1922 * MiB, WS_MF = 1986 * MiB, WS_MB = 2050 * MiB, WS_PRE = 2082 * MiB, WS_X1F = 2146 * MiB, WS_X1B = 2210 * MiB;
constexpr size_t WS_SLOT = 2242 * MiB, WS_TREC = 2244 * MiB, WS_GATE = 2245 * MiB, WS_XS = 2246 * MiB, WS_XB8 = 2246 * MiB, WS_X1B8 = 2262 * MiB, WS_WIN8 = 2278 * MiB, WS_WPG8 = 2294 * MiB, WS_H = 2390 * MiB, WS_YS = 2534 * MiB, WS_PLEG = 2678 * MiB, WS_FR = 2710 * MiB, WS_FRH = 2810 * MiB, WS_FRM = 2890 * MiB, WS_XSV = 2970 * MiB, WS_END = 3994 * MiB;
constexpr size_t RWSZ = 32 * MiB;
constexpr size_t RHSZ = 16 * MiB, WS_LW = WS_RW + 6 * RHSZ;
constexpr int CW_TMO = 0, CW_BAR = 4096, CW_CNT = 16384;
constexpr int RING_BYTES = 131072, LDSCTL_OFF = RING_BYTES, LDSCTL_BYTES = 8192, LDS_USED = RING_BYTES + LDSCTL_BYTES, LDS_BYTES = 147456;
constexpr int LC_BAR = 0  , LC_TILEE = 16  , LC_PSTART = 352  , LC_CNT = 400  , LC_BASE = 432  , LC_NT = 464, LC_REC = 512  ;

#define GAS __attribute__((address_space(1)))
#define LAS __attribute__((address_space(3)))
#define DI __device__ __forceinline__
typedef unsigned short bf16;
typedef unsigned v4u __attribute__((ext_vector_type(4)));
typedef unsigned v2u __attribute__((ext_vector_type(2)));
typedef float f32x4 __attribute__((ext_vector_type(4)));
typedef float f32x2 __attribute__((ext_vector_type(2)));
typedef short bf16x8 __attribute__((ext_vector_type(8)));
typedef GAS unsigned gu32;
#define RLX_AGENT __ATOMIC_RELAXED, __HIP_MEMORY_SCOPE_AGENT
#define LDS_WAIT() asm volatile("s_waitcnt lgkmcnt(0)" ::: "memory")
#define VM_WAIT() asm volatile("s_waitcnt vmcnt(0)" ::: "memory")
DI unsigned f2bf(float f) { unsigned u = __builtin_bit_cast(unsigned, f); return (u + 0x7fffu + ((u >> 16) & 1u)) >> 16; }
typedef __bf16 bf16x2_t __attribute__((ext_vector_type(2)));
DI unsigned pk2(float lo, float hi) { const f32x2 v = {lo, hi}; const bf16x2_t b = __builtin_convertvector(v, bf16x2_t); return __builtin_bit_cast(unsigned, b); }
DI float bf2f(unsigned short b) { return __builtin_bit_cast(float, (unsigned)b << 16); }
DI float blo(unsigned w) { return __builtin_bit_cast(float, w << 16); }
DI float bhi(unsigned w) { return __builtin_bit_cast(float, w & 0xffff0000u); }
DI float sigm(float x) { return __builtin_amdgcn_rcpf(1.0f + __expf(-x)); }
DI float tanh_fast(float x) { return 1.0f - 2.0f * __builtin_amdgcn_rcpf(1.0f + __expf(2.0f * x)); }
DI float siluf(float x) { return x * sigm(x); }
DI float softplusf(float x) { return x > 20.0f ? x : __logf(1.0f + __expf(x)); }
DI float logsigm(float x) { return -softplusf(-x); }
DI unsigned pk4f8(float a, float b, float c, float d) {
    unsigned w = 0u; w = __builtin_amdgcn_cvt_pk_fp8_f32(pg8::clamp8(a * 8.0f), pg8::clamp8(b * 8.0f), w, false); return __builtin_amdgcn_cvt_pk_fp8_f32(pg8::clamp8(c * 8.0f), pg8::clamp8(d * 8.0f), w, true); }
DI float gelu_tanh(float x) { return 0.5f * x * (1.0f + tanh_fast(0.7978845608028654f * (x + 0.044715f * x * x * x))); }

#define XB_TMO      128
#define XB_XCNT(j)  (256  + 64 * (j))
#define XB_XSUB(j)  (1280 + 64 * (j))
#define XB_XGEN(j)  (2304 + 64 * (j))
#define XB_TOP      3328
#define XB_TOPGEN   3392
#define XCD_BAR_WORDS 3456
#define XB_SPIN_CAP (1u << 18)
DI unsigned xb_ld(unsigned* p)              { return __hip_atomic_load(p, __ATOMIC_RELAXED, __HIP_MEMORY_SCOPE_AGENT); }
DI unsigned xb_add(unsigned* p, unsigned v) { return __hip_atomic_fetch_add(p, v, __ATOMIC_RELAXED, __HIP_MEMORY_SCOPE_AGENT); }
DI unsigned xb_xcc_id() { return (unsigned)__builtin_amdgcn_s_getreg((3 << 11) | 20) & 0xFu; }
#define XB_SPIN(cond, bar) do { unsigned _sp = 0; while (cond) { __builtin_amdgcn_s_sleep(1); \
    if ((++_sp & 255u) == 0u) { if (xb_ld(&(bar)[XB_TMO])) break; if (_sp > XB_SPIN_CAP) { atomicAdd(&(bar)[XB_TMO], 1u); break; } } } } while (0)
struct XcdBarrier { unsigned* bar; unsigned x; volatile LAS unsigned* st; };
DI XcdBarrier xcd_barrier_post(unsigned* bar, volatile LAS unsigned* st) {
    XcdBarrier b; b.bar = bar; b.x = xb_xcc_id(); b.st = st;
    if (threadIdx.x == 0) (void)xb_add(&bar[XB_XCNT(b.x)], 1u);
    return b;
}
DI void xcd_barrier_complete(unsigned* bar, unsigned x, unsigned& nloc, unsigned& nx) {
    const unsigned G = gridDim.x * gridDim.y * gridDim.z;
    unsigned sum, cnt, mine, sp = 0u;
    for (;;) {
        sum = 0u; cnt = 0u; mine = 0u;
#pragma unroll
        for (unsigned j = 0; j < 16; ++j) { const unsigned c = xb_ld(&bar[XB_XCNT(j)]); sum += c; cnt += (c > 0u) ? 1u : 0u; mine = (j == x) ? c : mine; }
        if (sum == G) break;
        __builtin_amdgcn_s_sleep(1);
        if ((++sp & 255u) == 0u) { if (xb_ld(&bar[XB_TMO])) break; if (sp > XB_SPIN_CAP) { atomicAdd(&bar[XB_TMO], 1u); break; } }
    }
    nloc = mine > 0u ? mine : 1u; nx = cnt > 0u ? cnt : 1u;
}
DI void xcd_barrier(const XcdBarrier& b) {
    asm volatile("s_waitcnt vmcnt(0)" ::: "memory");
    __syncthreads();
    if (threadIdx.x == 0) {
        unsigned* bar = b.bar;
        __builtin_amdgcn_s_waitcnt(0);
        unsigned nloc = b.st[0], nx = b.st[1];
        if (nloc == 0u) { xcd_barrier_complete(bar, b.x, nloc, nx); b.st[0] = nloc; b.st[1] = nx; }
        const unsigned old = xb_add(&bar[XB_XSUB(b.x)], 1u);
        const unsigned gen = old / nloc;
        if (old + 1u == (gen + 1u) * nloc) {
            __builtin_amdgcn_fence(__ATOMIC_RELEASE, "agent");
            asm volatile("s_waitcnt vmcnt(0)" ::: "memory");
            const unsigned og = xb_add(&bar[XB_TOP], 1u);
            const unsigned tg = og / nx;
            if (og + 1u == (tg + 1u) * nx) xb_add(&bar[XB_TOPGEN], 1u);
            else XB_SPIN(xb_ld(&bar[XB_TOPGEN]) == tg, bar);
            __builtin_amdgcn_fence(__ATOMIC_ACQUIRE, "agent");
            xb_add(&bar[XB_XGEN(b.x)], 1u);
            asm volatile("s_waitcnt vmcnt(0)" ::: "memory");
        } else {
            XB_SPIN(xb_ld(&bar[XB_XGEN(b.x)]) == gen, bar);
            __builtin_amdgcn_fence(__ATOMIC_ACQUIRE, "agent");
            asm volatile("s_waitcnt vmcnt(0)" ::: "memory");
        }
    }
    __syncthreads();
}

struct Args { const float* in[45]; float* out; unsigned char* ws; int ph_lo, ph_hi; };
typedef const __attribute__((address_space(4))) Args* KA;
struct Frame {
    LAS unsigned char* lds; LAS unsigned* LC;
    unsigned char* ws; gu32* ctl;
    int tid, lane, wave, vcu, G, gw, NGW;
};
DI void rebind(Frame& F) {
    int w = F.wave, vc = F.vcu, gg = F.G; asm volatile("" : "+s"(w), "+s"(vc), "+s"(gg)); F.vcu = vc; F.G = gg; F.NGW = gg * NWAVES;
    const int ln = pg8::lane_id_fresh();
    F.wave = w; F.lane = ln; F.tid = w * 64 + ln; F.gw = F.vcu * NWAVES + w;
}

template <int CTRL> DI float dpp_f(float v) { return __builtin_bit_cast(float, __builtin_amdgcn_update_dpp(0, __builtin_bit_cast(int, v), CTRL, 0xf, 0xf, true)); }
template <int MSK> DI int shx_i(int v) {
    if constexpr (MSK < 32) return __builtin_amdgcn_ds_swizzle(v, (MSK << 10) | 0x1f);
    else { const int l = pg8::lane_id_fresh(); return __builtin_amdgcn_ds_bpermute((l ^ MSK) << 2, v); }
}
template <int MSK> DI float shx(float v) { return __builtin_bit_cast(float, shx_i<MSK>(__builtin_bit_cast(int, v))); }
DI float wave_sum(float v) { v += dpp_f<0xB1>(v); v += dpp_f<0x4E>(v); v += dpp_f<0x124>(v); v += dpp_f<0x128>(v); v += shx<16>(v); v += shx<32>(v); return v; }
DI float row16_sum(float v) {
    v += dpp_f<0xB1>(v); v += dpp_f<0x4E>(v); v += dpp_f<0x124>(v); v += dpp_f<0x128>(v); return v;
}

template <int MODE  >
DI void cvt_item(const float* W, int ldw, int N, int K, int kb, int nb, bf16* WT, LAS float* scr, int lane) {
    const int k0 = 64 * kb, n0 = 32 * nb, nl = lane & 31;
    if (MODE == 5 && (n0 + 32 <= 6920 || n0 >= 11016)) return;
    if (MODE == 4 && n0 >= 6920 && n0 + 32 <= 11016) return;
    float v32[32]; const bool okn = (n0 + nl < N); const float* wp = W + (size_t)(k0 + (lane >> 5)) * ldw + n0 + nl;
#pragma unroll
    for (int i = 0; i < 32; ++i) v32[i] = okn ? wp[(size_t)(2 * i) * ldw] : 0.0f;
#pragma unroll
    for (int i = 0; i < 32; ++i) scr[(2 * i + (lane >> 5)) * 33 + nl] = v32[i];
    LDS_WAIT(); asm volatile("" ::: "memory");
    const int c = lane & 7;
#pragma unroll
    for (int j = 0; j < 4; ++j) { const int nn = (lane >> 3) + 8 * j, n = n0 + nn; const LAS float* s = scr + (8 * c) * 33 + nn;
        int ro = n; if (MODE == 1 || MODE == 2) { const int cc = n & 1023; ro = (cc >> 7) * 256 + (n >> 10) * 128 + (cc & 127); }
        if (MODE == 4) ro = (n < 6920) ? n : n - 4096;
        if (MODE == 5) ro = n - 6920;
        const bool gate_col = (n >= 6920 && n < 11016);
        if (MODE == 2 || MODE == 3 || MODE == 5) { unsigned w0 = 0u, w1 = 0u;
            w0 = __builtin_amdgcn_cvt_pk_fp8_f32(s[0 * 33] * 64.0f, s[1 * 33] * 64.0f, w0, false); w0 = __builtin_amdgcn_cvt_pk_fp8_f32(s[2 * 33] * 64.0f, s[3 * 33] * 64.0f, w0, true);
            w1 = __builtin_amdgcn_cvt_pk_fp8_f32(s[4 * 33] * 64.0f, s[5 * 33] * 64.0f, w1, false); w1 = __builtin_amdgcn_cvt_pk_fp8_f32(s[6 * 33] * 64.0f, s[7 * 33] * 64.0f, w1, true);
            if (n < N && (MODE != 5 || gate_col)) *(GAS v2u*)((unsigned char*)WT + (size_t)ro * K + k0 + 8 * c) = (v2u){w0, w1}; }
        else { v4u o; o.x = pk2(s[0 * 33], s[1 * 33]); o.y = pk2(s[2 * 33], s[3 * 33]); o.z = pk2(s[4 * 33], s[5 * 33]); o.w = pk2(s[6 * 33], s[7 * 33]);
            if (n < N && (MODE != 4 || !gate_col)) *(GAS v4u*)(WT + (size_t)ro * K + k0 + 8 * c) = o; } }
    LDS_WAIT(); asm volatile("" ::: "memory");
}
template <int MODE> DI void cvt_item8(const float* W, int ldw, int N, int K, int kb, int nb, unsigned char* WT8, LAS float* scr, int lane) {
    const int k0 = 128 * kb, n0 = 32 * nb, nl = lane & 31, half = lane >> 5;
    if (MODE == 5 && (n0 + 32 <= 6920 || n0 >= 11016)) return;
    float v64[64]; const bool okn = (n0 + nl < N); const float* wp = W + (size_t)(k0 + half) * ldw + n0 + nl;
#pragma unroll
    for (int i = 0; i < 64; ++i) v64[i] = okn ? wp[(size_t)(2 * i) * ldw] : 0.0f;
#pragma unroll
    for (int i = 0; i < 64; ++i) { const int row = 2 * i + half; scr[row * 32 + (nl ^ ((row >> 3) & 31))] = v64[i]; }
    LDS_WAIT(); asm volatile("" ::: "memory");
    const int c = lane & 15, nq = lane >> 4;
#pragma unroll
    for (int j = 0; j < 8; ++j) { const int nn = nq + 4 * j, n = n0 + nn; const LAS float* sp = scr + (8 * c) * 32 + (nn ^ c);
        int ro = n; if (MODE == 2) { const int cc = n & 1023; ro = (cc >> 7) * 256 + (n >> 10) * 128 + (cc & 127); }
        if (MODE == 5) ro = n - 6920;
        const bool ok = (n < N) && (MODE != 5 || (n >= 6920 && n < 11016));
        unsigned w0 = 0u, w1 = 0u;
        w0 = __builtin_amdgcn_cvt_pk_fp8_f32(sp[0 * 32] * 64.0f, sp[1 * 32] * 64.0f, w0, false); w0 = __builtin_amdgcn_cvt_pk_fp8_f32(sp[2 * 32] * 64.0f, sp[3 * 32] * 64.0f, w0, true);
        w1 = __builtin_amdgcn_cvt_pk_fp8_f32(sp[4 * 32] * 64.0f, sp[5 * 32] * 64.0f, w1, false); w1 = __builtin_amdgcn_cvt_pk_fp8_f32(sp[6 * 32] * 64.0f, sp[7 * 32] * 64.0f, w1, true);
        if (ok) *(GAS v2u*)(WT8 + (size_t)ro * K + k0 + 8 * c) = (v2u){w0, w1}; }
    LDS_WAIT(); asm volatile("" ::: "memory");
}
template <int MODE> DI void cvt_class(Frame& F, int& off, const float* W, int K, int N, int ldw, size_t src_stride, bf16* WT, size_t dst_stride, int nmat) {
    LAS float* scr = (LAS float*)(F.lds + F.wave * 16384);
    constexpr bool F8M = (MODE == 2 || MODE == 3 || MODE == 5);
    const int nkb = K / (F8M ? 128 : 64), nnb = (N + 31) / 32, per = nkb * nnb, total = per * nmat;
    int start = (F.gw - off) % F.NGW; if (start < 0) start += F.NGW;
    for (int it = start; it < total; it += F.NGW) { const int mi = it / per, r = it % per;
        if constexpr (F8M) cvt_item8<MODE>(W + (size_t)mi * src_stride, ldw, N, K, r / nnb, r % nnb, (unsigned char*)(WT + (size_t)mi * dst_stride), scr, F.lane);
        else cvt_item<MODE>(W + (size_t)mi * src_stride, ldw, N, K, r / nnb, r % nnb, WT + (size_t)mi * dst_stride, scr, F.lane); }
    off = (off + total) % F.NGW;
}
constexpr int EXP_ITEMS = NE * 512 + NE * 256;
DI void cvt_expert_item(Frame& F, KA a, int l, int it) {
    LAS float* scr = (LAS float*)(F.lds + F.wave * 16384);
    if (it < NE * 512) { const int e = it >> 9, r = it & 511; const size_t mi = (size_t)l * NE + e;
        cvt_item8<2>(a->in[37] + mi * 1024 * 2048, 2048, 2048, 1024, r >> 6, r & 63, F.ws + WS_WGU + mi * 2048 * 1024, scr, F.lane); }
    else { const int i2 = it - NE * 512, e = i2 >> 8, r = i2 & 255; const size_t mi = (size_t)l * NE + e;
        cvt_item8<3>(a->in[39] + mi * 1024 * 1024, 1024, 1024, 1024, r >> 5, r & 31, F.ws + WS_WDN + mi * 1024 * 1024, scr, F.lane); }
}
constexpr int CW_Q = 28672;
DI void cvt_expert_queue(Frame& F, KA a, int l) {
    LAS unsigned* qh = F.LC + 480;
    unsigned nxt = 0u;
    if (F.tid == 0) qh[0] = __hip_atomic_fetch_add((unsigned*)(F.ctl + CW_Q + l * 64), 8u, __ATOMIC_RELAXED, __HIP_MEMORY_SCOPE_AGENT);
    for (int r = 0;; ++r) {
        __syncthreads();
        const int base = (int)qh[r & 1];
        if (base >= EXP_ITEMS) break;
        if (F.tid == 0) nxt = __hip_atomic_fetch_add((unsigned*)(F.ctl + CW_Q + l * 64), 8u, __ATOMIC_RELAXED, __HIP_MEMORY_SCOPE_AGENT);
        if (base + F.wave < EXP_ITEMS) cvt_expert_item(F, a, l, base + F.wave);
        if (F.tid == 0) qh[(r + 1) & 1] = nxt;
    }
}
DI void p0_convert(Frame& F, KA a) {
    int off = 0;
    cvt_class<4>(F, off, a->in[2], 1024, NC_BASE, NC_BASE, 0, (bf16*)(F.ws + WS_WIN), 0, 1);
    cvt_class<4>(F, off, a->in[3], 1024, NC_REST, NC_REST, (size_t)1024 * NC_REST, (bf16*)(F.ws + WS_WIN) + (size_t)ZLD * 1024, (size_t)ZLD * 1024, NL - 1);
    cvt_class<3>(F, off, a->in[31], 512, 1024, 1024, (size_t)512 * 1024, (bf16*)(F.ws + WS_WBR), (size_t)1024 * 512 / 2, NL * 4);
    cvt_class<3>(F, off, a->in[32], 1024, 1024, 1024, (size_t)1024 * 1024, (bf16*)(F.ws + WS_WOUT), (size_t)1024 * 1024 / 2, NL);
    cvt_class<3>(F, off, a->in[41], 1024, 1024, 1024, (size_t)1024 * 1024, (bf16*)(F.ws + WS_WPG8), (size_t)1024 * 1024 / 2, NL);
    cvt_class<5>(F, off, a->in[2], 1024, NC_BASE, NC_BASE, 0, (bf16*)(F.ws + WS_WIN8), 0, 1);
    cvt_class<5>(F, off, a->in[3], 1024, NC_REST, NC_REST, (size_t)1024 * NC_REST, (bf16*)(F.ws + WS_WIN8 + (size_t)4096 * 1024), (size_t)4096 * 1024 / 2, NL - 1);
    cvt_class<0>(F, off, a->in[42], 256, 1024, 1024, (size_t)256 * 1024, (bf16*)(F.ws + WS_WPP), (size_t)1024 * 256, NL);
    const int gt = F.vcu * NTHR + F.tid, NGT = F.G * NTHR;
    for (int l = 0; l < NL; ++l) { const int n0 = (l == 0) ? ZX : ZX + 32; bf16* wt = (bf16*)(F.ws + WS_WIN) + (size_t)l * ZLD * 1024;
        const int nq = (ZG - n0) * 1024 / 8;
        for (int i = gt; i < nq; i += NGT) *(GAS v4u*)(wt + (size_t)n0 * 1024 + (size_t)i * 8) = (v4u){0u, 0u, 0u, 0u}; }
    { bf16* wsm = (bf16*)(F.ws + WS_WSM);
      for (int i = gt; i < NL * 512 * 288; i += NGT) { const int l = i / (512 * 288), r = i % (512 * 288), c = r / 288, k = r % 288; float v;
          if (k < 64) v = a->in[6][((size_t)l * 64 + k) * 512 + c];
          else if (k < 128) v = a->in[8][((size_t)l * 64 + (k - 64)) * 512 + c];
          else if (k < 256) v = a->in[11][((size_t)l * 128 + (k - 128)) * 512 + c];
          else v = (l > 0) ? a->in[10][((size_t)(l - 1) * 32 + (k - 256)) * 512 + c] : 0.0f;
          wsm[i] = (bf16)f2bf(v); }
      bf16* wl = (bf16*)(F.ws + WS_WLRU);
      for (int i = gt; i < NL * 2 * 8 * 64 * 64; i += NGT) { const int l = i >> 16, r = i & 65535, which = r >> 15, g = (r >> 12) & 7, j = (r >> 6) & 63, ii = r & 63;
          const float* src = which ? a->in[28] : a->in[26];
          wl[i] = (bf16)f2bf(src[(((size_t)l * 8 + g) * 64 + ii) * 64 + j]); } }
    { const GAS f32x4* xs = (const GAS f32x4*)a->in[0]; GAS v2u* xb = (GAS v2u*)(F.ws + WS_XB);
      GAS unsigned* xb8 = (GAS unsigned*)(F.ws + WS_XB8);
      for (int i = gt; i < M * D / 4; i += NGT) { const f32x4 v = xs[i]; xb[i] = (v2u){pk2(v.x, v.y), pk2(v.z, v.w)}; unsigned w8 = __builtin_amdgcn_cvt_pk_fp8_f32(v.x * 16.f, v.y * 16.f, 0u, false); xb8[i] = __builtin_amdgcn_cvt_pk_fp8_f32(v.z * 16.f, v.w * 16.f, w8, true); }
      const GAS f32x4* ps = (const GAS f32x4*)a->in[1]; GAS v2u* pb = (GAS v2u*)(F.ws + WS_PB);
      for (int i = gt; i < NL * M * DPLE / 4; i += NGT) { const f32x4 v = ps[i]; pb[i] = (v2u){pk2(v.x, v.y), pk2(v.z, v.w)}; } }
}

DI f32x4 mfma16(bf16x8 a, bf16x8 b, f32x4 c) { return __builtin_amdgcn_mfma_f32_16x16x32_bf16(a, b, c, 0, 0, 0); }
DI f32x4 fresh_zero4() { float z0 = 0.f; asm volatile("" : "+v"(z0)); return (f32x4){z0, z0, z0, z0}; }
constexpr int XS_LD = 296, XCB_LD = 520, XCF_LD = 516;
static_assert(16 * XS_LD * 2 <= 9728 && 9728 + 16 * XCB_LD * 2 <= 26624 && 26624 + 16 * XCF_LD * 4 <= 59904 && 59904 + 18 * 512 * 4 <= RING_BYTES, "prep LDS map");
DI void phase_prep(Frame& F, KA a, int l) {
    LAS bf16* X = (LAS bf16*)F.lds;
    LAS bf16* XCb = (LAS bf16*)(F.lds + 9728);
    LAS float* XCf = (LAS float*)(F.lds + 26624);
    const bf16* z = (const bf16*)(F.ws + WS_Z);
    const bf16* wsm = (const bf16*)(F.ws + WS_WSM) + (size_t)l * 512 * 288;
    const bf16* wlru = (const bf16*)(F.ws + WS_WLRU) + (size_t)l * 65536;
    const float* mu = a->in[4] + l * 1792; const float* w0 = a->in[5] + l * 512; const float* a0 = a->in[7] + l * 512;
    const float* v0 = a->in[9] + (l > 0 ? (l - 1) * 512 : 0); const float* k_k = a->in[12] + l * 512; const float* k_a = a->in[13] + l * 512; const float* r_k = a->in[14] + l * 512;
    const float* cw = a->in[24] + l * 4 * 512; const float* cb = a->in[25] + l * 512; const float* bx = a->in[27] + l * 512; const float* ba = a->in[29] + l * 512; const float* lam = a->in[30] + l * 512;
    bf16* RWH = (bf16*)(F.ws + WS_RW); float* LW = (float*)(F.ws + WS_LW); bf16* VF = (bf16*)(F.ws + WS_VF);     float* BON = (float*)(F.ws + WS_BON);
    float* LA = (float*)(F.ws + WS_LA); bf16* LB = (bf16*)(F.ws + WS_LB);
    const int h = F.wave, lane = F.lane, tok = lane & 15, quad = lane >> 4;
    LAS float* PT = (LAS float*)(F.lds + 59904);
    for (int i = F.tid; i < 18 * 512; i += NTHR) { const int f = i >> 9, c = i & 511; float v;
        if (f < 3) v = mu[f * 512 + c]; else if (f == 3) v = w0[c]; else if (f == 4) v = a0[c]; else if (f == 5) v = (l > 0) ? v0[c] : 0.f; else if (f == 6) v = k_k[c]; else if (f == 7) v = k_a[c]; else if (f == 8) v = r_k[c];
        else if (f == 9) v = bx[c]; else if (f == 10) v = ba[c]; else if (f == 11) v = 8.0f * logsigm(lam[c]); else if (f == 12) v = cb[c]; else if (f < 17) v = cw[(f - 13) * 512 + c]; else v = (c < 256) ? mu[1536 + c] : 0.f;
        PT[i] = v; }
    __syncthreads();
#define PTV(f, c) (*(const LAS f32x4*)(PT + (f) * 512 + (c)))
    for (int item = F.vcu; item < M / 16; item += F.G) {
        const int t0 = item * 16;
        const int t = t0 + tok; const bool first = (t & (SEQ - 1)) == 0;
        v2u kpre[8];
#pragma unroll
        for (int nt = 0; nt < 4; ++nt) { const bf16* zr_ = z + (size_t)t * ZLD + 512 + 64 * h + 16 * quad + 4 * nt; kpre[nt] = *(const v2u*)zr_; kpre[4 + nt] = first ? (v2u){0u, 0u} : *(const v2u*)(zr_ - ZLD); }
        for (int idx = F.tid; idx < 16 * 36; idx += NTHR) {
            const int tk = idx / 36, ch = idx % 36, j0 = 8 * ch, t = t0 + tk; float v8[8];
            if (ch < 32) { const int col = 1536 + j0; const v4u cz = *(const v4u*)(z + (size_t)t * ZLD + col);
                const v4u pz = (t & (SEQ - 1)) ? *(const v4u*)(z + (size_t)(t - 1) * ZLD + col) : (v4u){0u, 0u, 0u, 0u};
                const f32x4 m0 = PTV(17, j0), m1 = PTV(17, j0 + 4);
                const float cu[8] = {blo(cz.x), bhi(cz.x), blo(cz.y), bhi(cz.y), blo(cz.z), bhi(cz.z), blo(cz.w), bhi(cz.w)}, pr[8] = {blo(pz.x), bhi(pz.x), blo(pz.y), bhi(pz.y), blo(pz.z), bhi(pz.z), blo(pz.w), bhi(pz.w)};
                const float mm[8] = {m0[0], m0[1], m0[2], m0[3], m1[0], m1[1], m1[2], m1[3]};
#pragma unroll
                for (int j = 0; j < 8; ++j) { const float xv = cu[j] + (pr[j] - cu[j]) * mm[j]; v8[j] = (ch < 8) ? tanh_fast(xv) : (ch < 16 ? xv : sigm(xv)); } }
            else { const v4u cz = (l > 0) ? *(const v4u*)(z + (size_t)t * ZLD + ZX + (j0 - 256)) : (v4u){0u, 0u, 0u, 0u};
                v8[0] = blo(cz.x); v8[1] = bhi(cz.x); v8[2] = blo(cz.y); v8[3] = bhi(cz.y); v8[4] = blo(cz.z); v8[5] = bhi(cz.z); v8[6] = blo(cz.w); v8[7] = bhi(cz.w); }
            *(LAS v4u*)(X + tk * XS_LD + j0) = (v4u){pk2(v8[0], v8[1]), pk2(v8[2], v8[3]), pk2(v8[4], v8[5]), pk2(v8[6], v8[7])}; }
        for (int idx = F.tid; idx < 16 * 64; idx += NTHR) {
            const int tk = idx >> 6, c = 8 * (idx & 63), t = t0 + tk, tt = t & (SEQ - 1);
            const f32x4 b0 = PTV(12, c), b1 = PTV(12, c + 4); float acc[8] = {b0[0], b0[1], b0[2], b0[3], b1[0], b1[1], b1[2], b1[3]};
#pragma unroll
            for (int j = 0; j < 4; ++j) { if (tt - 3 + j >= 0) { const v4u rz = *(const v4u*)(z + (size_t)(t - 3 + j) * ZLD + ZD + c); const f32x4 w0 = PTV(13 + j, c), w1 = PTV(13 + j, c + 4);
                acc[0] += blo(rz.x) * w0[0]; acc[1] += bhi(rz.x) * w0[1]; acc[2] += blo(rz.y) * w0[2]; acc[3] += bhi(rz.y) * w0[3]; acc[4] += blo(rz.z) * w1[0]; acc[5] += bhi(rz.z) * w1[1]; acc[6] += blo(rz.w) * w1[2]; acc[7] += bhi(rz.w) * w1[3]; } }
            *(LAS f32x4*)(XCf + tk * XCF_LD + c) = (f32x4){acc[0], acc[1], acc[2], acc[3]}; *(LAS f32x4*)(XCf + tk * XCF_LD + c + 4) = (f32x4){acc[4], acc[5], acc[6], acc[7]};
            *(LAS v4u*)(XCb + tk * XCB_LD + c) = (v4u){pk2(acc[0], acc[1]), pk2(acc[2], acc[3]), pk2(acc[4], acc[5]), pk2(acc[6], acc[7])}; }
        __syncthreads();
        {
            float ss = 0.f, bs = 0.f;
#pragma unroll
            for (int nt = 0; nt < 4; ++nt) { const int c = 64 * h + 16 * quad + 4 * nt; const v2u kc_ = kpre[nt], kp_ = kpre[4 + nt];
                const f32x4 mk = PTV(1, c), kkv = PTV(6, c); const f32x4 kc = (f32x4){blo(kc_.x), bhi(kc_.x), blo(kc_.y), bhi(kc_.y)}, kp = (f32x4){blo(kp_.x), bhi(kp_.x), blo(kp_.y), bhi(kp_.y)};
                const f32x4 kk = (kc + (kp - kc) * mk) * kkv; ss += (kk[0] * kk[0] + kk[1] * kk[1]) + (kk[2] * kk[2] + kk[3] * kk[3]); }
            ss += shx<16>(ss); ss += shx<32>(ss);
            const float inv = 1.0f / fmaxf(sqrtf(ss), 1e-12f);
            bf16x8 wf[9]; v2u zc[6]; v2u vfc = (v2u){0u, 0u};
#define PREP_LOAD(NT, WF, ZC, VFC) do { const bf16* wrow_ = wsm + (size_t)(64 * h + 16 * (tok >> 2) + 4 * (NT) + (tok & 3)) * 288 + 8 * quad; \
                _Pragma("unroll") for (int i_ = 0; i_ < 9; ++i_) WF[i_] = *(const bf16x8*)(wrow_ + 32 * i_); \
                const int c_ = 64 * h + 16 * quad + 4 * (NT); const bf16* zr_ = z + (size_t)t * ZLD + c_; const bf16* zp_ = first ? zr_ : zr_ - ZLD; \
                ZC[0] = *(const v2u*)(zr_); ZC[1] = *(const v2u*)(zr_ + 512); ZC[2] = *(const v2u*)(zr_ + 1024); ZC[3] = *(const v2u*)(zp_); ZC[4] = *(const v2u*)(zp_ + 512); ZC[5] = *(const v2u*)(zp_ + 1024); \
                if (l > 0) VFC = *(const v2u*)(VF + (size_t)t * 512 + c_); } while (0)
            v2u oR[4] = {}, oK[4] = {}, oV[4] = {}, oA[4] = {}, oB[4] = {}, oG[4] = {}; f32x4 oW[4] = {};
#define SEL4(O, val) do { _Pragma("unroll") for (int q_ = 0; q_ < 4; ++q_) O[q_] = (nt == q_) ? (val) : O[q_]; } while (0)
#pragma unroll 1
            for (int nt = 0; nt < 4; ++nt) {
                PREP_LOAD(nt, wf, zc, vfc);
                f32x4 aw = (f32x4){0.f, 0.f, 0.f, 0.f}, aa = aw, ag = aw, av = aw;
                bf16x8 xfr[9];
#pragma unroll
                for (int i_ = 0; i_ < 9; ++i_) xfr[i_] = *(const LAS bf16x8*)(X + tok * XS_LD + 8 * quad + 32 * i_);
                __builtin_amdgcn_sched_barrier(0);
#pragma unroll
                for (int ks = 0; ks < 2; ++ks) aw = mfma16(wf[ks], xfr[ks], aw);
#pragma unroll
                for (int ks = 0; ks < 2; ++ks) aa = mfma16(wf[2 + ks], xfr[2 + ks], aa);
#pragma unroll
                for (int ks = 0; ks < 4; ++ks) ag = mfma16(wf[4 + ks], xfr[4 + ks], ag);
                av = mfma16(wf[8], xfr[8], av);
                const int c = 64 * h + 16 * quad + 4 * nt;
                const v2u r_c = zc[0], k_c = zc[1], v_c = zc[2];
                v2u r_p = zc[3], k_p = zc[4], v_p = zc[5];
                if (first) { r_p = (v2u){0u, 0u}; k_p = r_p; v_p = r_p; }
                const f32x4 mr = PTV(0, c), mk = PTV(1, c), mv = PTV(2, c);
                const f32x4 rc = (f32x4){blo(r_c.x), bhi(r_c.x), blo(r_c.y), bhi(r_c.y)}, rp = (f32x4){blo(r_p.x), bhi(r_p.x), blo(r_p.y), bhi(r_p.y)};
                const f32x4 kc = (f32x4){blo(k_c.x), bhi(k_c.x), blo(k_c.y), bhi(k_c.y)}, kp = (f32x4){blo(k_p.x), bhi(k_p.x), blo(k_p.y), bhi(k_p.y)};
                const f32x4 vc = (f32x4){blo(v_c.x), bhi(v_c.x), blo(v_c.y), bhi(v_c.y)}, vp = (f32x4){blo(v_p.x), bhi(v_p.x), blo(v_p.y), bhi(v_p.y)};
                const f32x4 r = rc + (rp - rc) * mr, k = kc + (kp - kc) * mk; f32x4 v = vc + (vp - vc) * mv;
                const f32x4 w0v = PTV(3, c), a0v = PTV(4, c), kkv = PTV(6, c), kav = PTV(7, c), rkv = PTV(8, c);
                f32x4 aval, dc, kkn, k2v;
#pragma unroll
                for (int j = 0; j < 4; ++j) { dc[j] = -0.6065306597126334f * sigm(w0v[j] + aw[j]);     aval[j] = sigm(a0v[j] + aa[j]);
                    kkn[j] = k[j] * kkv[j] * inv; k2v[j] = k[j] * (1.0f + (aval[j] - 1.0f) * kav[j]); bs += r[j] * k2v[j] * rkv[j]; }
                const size_t o = (size_t)t * 512 + c;
                if (l > 0) { const f32x4 v0v = PTV(5, c); const f32x4 vf = (f32x4){blo(vfc.x), bhi(vfc.x), blo(vfc.y), bhi(vfc.y)};
#pragma unroll
                    for (int j = 0; j < 4; ++j) v[j] = v[j] + (vf[j] - v[j]) * sigm(v0v[j] + av[j]); }
#define PK4(val) ((v2u){pk2((val)[0], (val)[1]), pk2((val)[2], (val)[3])})
                { const v2u pr_ = PK4(r), pk_ = PK4(k2v), pv_ = PK4(v), pg_ = PK4(ag); SEL4(oR, pr_); SEL4(oW, dc); SEL4(oK, pk_); SEL4(oV, pv_); SEL4(oG, pg_); }
                { const f32x4 nkn = -kkn, kna = kkn * aval; const v2u pa_ = PK4(nkn), pb_ = PK4(kna); SEL4(oA, pa_); SEL4(oB, pb_); }
            }
#undef PREP_LOAD
            bs += shx<16>(bs); bs += shx<32>(bs);
            if (quad == 0) BON[(size_t)t * 8 + h] = bs;
            { const size_t o = (size_t)t * 512 + 64 * h + 16 * quad;
#define ST16H(arr, O) do { bf16* d_ = RWH + (size_t)(arr) * (RHSZ / 2) + o; *(v4u*)d_ = (v4u){O[0].x, O[0].y, O[1].x, O[1].y}; *(v4u*)(d_ + 8) = (v4u){O[2].x, O[2].y, O[3].x, O[3].y}; } while (0)
              ST16H(0, oR); ST16H(1, oK); ST16H(2, oV); ST16H(3, oA); ST16H(4, oB); ST16H(5, oG);
#pragma unroll
              for (int nt = 0; nt < 4; ++nt) *(f32x4*)(LW + o + 4 * nt) = oW[nt];
              if (l == 0) { bf16* d_ = VF + o; *(v4u*)d_ = (v4u){oV[0].x, oV[0].y, oV[1].x, oV[1].y}; *(v4u*)(d_ + 8) = (v4u){oV[2].x, oV[2].y, oV[3].x, oV[3].y}; } }
#undef ST16H
#undef PK4
#undef SEL4
        }
        {
            bf16x8 lf[4], ln[4];
#define LRU_LOAD(NT, LF) do { const bf16* wxr_ = wlru + ((size_t)h * 64 + 16 * (NT) + tok) * 64 + 8 * quad; LF[0] = *(const bf16x8*)(wxr_); LF[1] = *(const bf16x8*)(wxr_ + 32); LF[2] = *(const bf16x8*)(wxr_ + 8 * 64 * 64); LF[3] = *(const bf16x8*)(wxr_ + 8 * 64 * 64 + 32); } while (0)
            LRU_LOAD(0, lf);
#pragma unroll 1
            for (int nt = 0; nt < 4; ++nt) { f32x4 gx = (f32x4){0.f, 0.f, 0.f, 0.f}, ga = gx;
                if (nt < 3) LRU_LOAD(nt + 1, ln);
                const LAS bf16* xrow = XCb + tok * XCB_LD + 64 * h + 8 * quad;
#pragma unroll
                for (int ks = 0; ks < 2; ++ks) { const bf16x8 xf = *(const LAS bf16x8*)(xrow + 32 * ks); gx = mfma16(lf[ks], xf, gx); ga = mfma16(lf[2 + ks], xf, ga); }
                const int c = 64 * h + 16 * nt + 4 * quad;
                const f32x4 bxv = PTV(9, c), bav = PTV(10, c), lmv = PTV(11, c);
                const f32x4 xc = *(const LAS f32x4*)(XCf + tok * XCF_LD + c);
                f32x4 oa, ob;
#pragma unroll
                for (int j = 0; j < 4; ++j) { const float gxs = sigm(gx[j] + bxv[j]), gas = sigm(ga[j] + bav[j]); const float la = gas * lmv[j];
                    oa[j] = __expf(la); const float mult = first ? 1.0f : sqrtf(1.0f - __expf(2.0f * la)); ob[j] = mult * gxs * xc[j]; }
                *(f32x4*)(LA + (size_t)t * 512 + c) = oa; *(v2u*)(LB + (size_t)t * 512 + c) = (v2u){pk2(ob[0], ob[1]), pk2(ob[2], ob[3])};
#pragma unroll
                for (int i_ = 0; i_ < 4; ++i_) lf[i_] = ln[i_]; }
#undef LRU_LOAD
        }
        __syncthreads();
    }
#undef PTV
}

DI void scan_rwkv_item(Frame& F, int item) {
    constexpr int T = 32, BUF = 5 * T * 64 + T * 32;
    LAS float* stg = (LAS float*)F.lds;
    LAS float* yout = (LAS float*)(F.lds + 2 * BUF * 4);
    const int half = item & 1, h = (item >> 1) & 7, b = item >> 4;
    const float* RWb = (const float*)(F.ws + WS_RW); float* YA = (float*)(F.ws + WS_YA);
    const int rl = F.tid >> 4, kq = F.tid & 15;
    const size_t tb0 = (size_t)b * SEQ;
    f32x4 pre[6];
    auto issue = [&](int blk) {
#pragma unroll
        for (int i = 0; i < 6; ++i) { const int idx = F.tid + i * NTHR; if (idx < BUF / 4) {
            const float* src;
            if (idx < 2560) { const int arr = idx >> 9, rem = idx & 511, st = rem >> 4, c4 = rem & 15; const int ga = (arr == 3) ? 4 : (arr == 4 ? 5 : arr);
                src = RWb + (size_t)ga * (RWSZ / 4) + (tb0 + blk * T + st) * 512 + 64 * h + 4 * c4; }
            else { const int rem = idx - 2560, st = rem >> 3, c4 = rem & 7; src = RWb + (size_t)3 * (RWSZ / 4) + (tb0 + blk * T + st) * 512 + 64 * h + 32 * half + 4 * c4; }
            pre[i] = *(const f32x4*)src; } }
    };
    auto commit = [&](int buf) {
#pragma unroll
        for (int i = 0; i < 6; ++i) { const int idx = F.tid + i * NTHR; if (idx < BUF / 4) *(LAS f32x4*)(stg + buf * BUF + idx * 4) = pre[i]; }
    };
    issue(0); commit(0); __syncthreads();
    f32x4 S = (f32x4){0.f, 0.f, 0.f, 0.f};
    for (int blk = 0; blk < SEQ / T; ++blk) {
        const int buf = blk & 1;
        if (blk + 1 < SEQ / T) issue(blk + 1);
        const LAS float* sb = stg + buf * BUF;
#pragma unroll 4
        for (int s = 0; s < T; ++s) {
            const f32x4 r4 = *(const LAS f32x4*)(sb + 0 * T * 64 + s * 64 + 4 * kq), w4 = *(const LAS f32x4*)(sb + 1 * T * 64 + s * 64 + 4 * kq), k4 = *(const LAS f32x4*)(sb + 2 * T * 64 + s * 64 + 4 * kq);
            const f32x4 a4 = *(const LAS f32x4*)(sb + 3 * T * 64 + s * 64 + 4 * kq), b4 = *(const LAS f32x4*)(sb + 4 * T * 64 + s * 64 + 4 * kq);
            const float v = sb[5 * T * 64 + s * 32 + rl];
            const float sa = row16_sum((S[0] * a4[0] + S[1] * a4[1]) + (S[2] * a4[2] + S[3] * a4[3]));
            S = S * w4 + b4 * sa + k4 * v;
            const float y = row16_sum((S[0] * r4[0] + S[1] * r4[1]) + (S[2] * r4[2] + S[3] * r4[3]));
            if (kq == 0) yout[s * 32 + rl] = y;
        }
        __syncthreads();
        for (int i = F.tid; i < T * 32; i += NTHR) { const int st = i >> 5, r = i & 31; YA[(tb0 + blk * T + st) * 512 + 64 * h + 32 * half + r] = yout[i]; }
        if (blk + 1 < SEQ / T) commit(buf ^ 1);
        __syncthreads();
    }
}
DI void scan_hgrn_item(Frame& F, KA a, int l, int item) {
    constexpr int T = 32;
    LAS float* Fd = (LAS float*)F.lds; LAS float* Kk = Fd + T * 128; LAS float* Qs = Kk + T * 128; LAS float* Is = Qs + T * 128; LAS float* Oo = Is + T * 16; LAS float* lbs = Oo + T * 16;
    const int vs = item & 7, h = (item >> 3) & 3, b = item >> 5;
    const bf16* z = (const bf16*)(F.ws + WS_Z); float* OB = (float*)(F.ws + WS_OB);
    const size_t tb0 = (size_t)b * SEQ;
    if (F.tid < 128) { const int c = 128 * h + F.tid; const float* hb = a->in[17];
        const float x0 = hb[c], x1 = hb[512 + c], x2 = hb[1024 + c], x3 = hb[1536 + c]; const float mx = fmaxf(fmaxf(x0, x1), fmaxf(x2, x3));
        const float e0 = __expf(x0 - mx), e1 = __expf(x1 - mx), e2 = __expf(x2 - mx), e3 = __expf(x3 - mx); const float inv = 1.0f / (e0 + e1 + e2 + e3);
        lbs[F.tid] = (l == 0) ? 0.0f : (l == 1 ? e1 * inv : (l == 2 ? (e1 + e2) * inv : (e1 + e2 + e3) * inv)); }
    v4u pre[3];
    auto issue = [&](int blk) {
#pragma unroll
        for (int i = 0; i < 3; ++i) { const int idx = F.tid + i * NTHR; if (idx < 1088) { const bf16* src;
            if (idx < 1024) { const int arr = idx >> 9, rem = idx & 511, st = rem >> 4, ch = rem & 15; src = z + (tb0 + blk * T + st) * ZLD + ZB + arr * 512 + 128 * h + 8 * ch; }
            else { const int rem = idx - 1024, st = rem >> 1, ch = rem & 1; src = z + (tb0 + blk * T + st) * ZLD + ZB + 1024 + 128 * h + 16 * vs + 8 * ch; }
            pre[i] = *(const v4u*)src; } }
    };
    auto commit = [&]() {
#pragma unroll
        for (int i = 0; i < 3; ++i) { const int idx = F.tid + i * NTHR; if (idx < 1088) { float v[8]; v[0] = blo(pre[i].x); v[1] = bhi(pre[i].x); v[2] = blo(pre[i].y); v[3] = bhi(pre[i].y); v[4] = blo(pre[i].z); v[5] = bhi(pre[i].z); v[6] = blo(pre[i].w); v[7] = bhi(pre[i].w);
            if (idx < 512) { const int st = idx >> 4, ch = idx & 15;
#pragma unroll
                for (int j = 0; j < 8; ++j) Qs[st * 128 + 8 * ch + j] = siluf(v[j]); }
            else if (idx < 1024) { const int rem = idx & 511, st = rem >> 4, ch = rem & 15;
#pragma unroll
                for (int j = 0; j < 8; ++j) { const float lb = lbs[8 * ch + j], sg = sigm(v[j]); Fd[st * 128 + 8 * ch + j] = lb + (1.0f - lb) * sg; Kk[st * 128 + 8 * ch + j] = (1.0f - lb) * (1.0f - sg); } }
            else { const int rem = idx - 1024, st = rem >> 1, ch = rem & 1;
#pragma unroll
                for (int j = 0; j < 8; ++j) Is[st * 16 + 8 * ch + j] = v[j]; } } }
    };
    __syncthreads();
    issue(0); commit(); __syncthreads();
    const int vl = 2 * F.wave + (F.lane >> 5), kg = F.lane & 31;
    f32x4 S = (f32x4){0.f, 0.f, 0.f, 0.f};
    for (int blk = 0; blk < SEQ / T; ++blk) {
        if (blk + 1 < SEQ / T) issue(blk + 1);
#pragma unroll 4
        for (int s = 0; s < T; ++s) {
            const f32x4 f4 = *(const LAS f32x4*)(Fd + s * 128 + 4 * kg), k4 = *(const LAS f32x4*)(Kk + s * 128 + 4 * kg), q4 = *(const LAS f32x4*)(Qs + s * 128 + 4 * kg);
            const float iv = Is[s * 16 + vl];
            S = S * f4 + k4 * iv;
            float o = row16_sum((S[0] * q4[0] + S[1] * q4[1]) + (S[2] * q4[2] + S[3] * q4[3]));
            o += shx<16>(o);
            if (kg == 0) Oo[s * 16 + vl] = o;
        }
        __syncthreads();
        { const int st = F.tid >> 4, r = F.tid & 15; OB[(tb0 + blk * T + st) * 512 + 128 * h + 16 * vs + r] = Oo[F.tid]; }
        if (blk + 1 < SEQ / T) commit();
        __syncthreads();
    }
}
DI void scan_mlstm_item(Frame& F, KA a, int l, int item) {
    constexpr int T = 32;
    LAS float* Qs = (LAS float*)F.lds; LAS float* Ks = Qs + T * 128; LAS float* Vs = Ks + T * 128; LAS float* Ho = Vs + T * 16;
    LAS float* FD = Ho + T * 16; LAS float* IW = FD + T; LAS float* EM = IW + T; LAS float* IG = EM + T; LAS float* FG = IG + T; LAS float* mst = FG + T;
    LAS float* raw = mst + 32;
    const int vs = item & 7, h = (item >> 3) & 3, b = item >> 5;
    const bf16* z = (const bf16*)(F.ws + WS_Z); float* HC = (float*)(F.ws + WS_HC);
    const float* cw = a->in[19] + l * 4 * 1024; const float* cb = a->in[20] + l * 1024; const float ib = a->in[21][l * 4 + h], fb = a->in[22][l * 4 + h];
    const size_t tb0 = (size_t)b * SEQ;
    v4u pre[3]; v4u prev_; float pig = 0.f, pfg = 0.f;
    auto issue = [&](int blk) {
#pragma unroll
        for (int i = 0; i < 3; ++i) { const int idx = F.tid + i * NTHR; if (idx < 1120) { const int row = idx >> 5, rem = idx & 31, arr = rem >> 4, ch = rem & 15; const int tt = blk * T - 3 + row;
            pre[i] = (tt >= 0) ? *(const v4u*)(z + (tb0 + tt) * ZLD + ZC + arr * 512 + 128 * h + 8 * ch) : (v4u){0u, 0u, 0u, 0u}; } }
        if (F.tid < 64) { const int st = F.tid >> 1, ch = F.tid & 1; prev_ = *(const v4u*)(z + (tb0 + blk * T + st) * ZLD + ZC + 1024 + 128 * h + 16 * vs + 8 * ch); }
        if (F.tid >= 64 && F.tid < 96) { const int st = F.tid - 64; const bf16* zr = z + (tb0 + blk * T + st) * ZLD + ZC + 2048; pig = bf2f(zr[h]); pfg = bf2f(zr[4 + h]); }
    };
    auto commit = [&]() {
#pragma unroll
        for (int i = 0; i < 3; ++i) { const int idx = F.tid + i * NTHR; if (idx < 1120) { const int row = idx >> 5, rem = idx & 31;
            LAS float* d = raw + row * 256 + 8 * rem; d[0] = blo(pre[i].x); d[1] = bhi(pre[i].x); d[2] = blo(pre[i].y); d[3] = bhi(pre[i].y); d[4] = blo(pre[i].z); d[5] = bhi(pre[i].z); d[6] = blo(pre[i].w); d[7] = bhi(pre[i].w); } }
        if (F.tid < 64) { const int st = F.tid >> 1, ch = F.tid & 1; LAS float* d = Vs + st * 16 + 8 * ch; d[0] = blo(prev_.x); d[1] = bhi(prev_.x); d[2] = blo(prev_.y); d[3] = bhi(prev_.y); d[4] = blo(prev_.z); d[5] = bhi(prev_.z); d[6] = blo(prev_.w); d[7] = bhi(prev_.w); }
        if (F.tid >= 64 && F.tid < 96) { IG[F.tid - 64] = pig + ib; FG[F.tid - 64] = logsigm(pfg + fb); }
        __syncthreads();
        for (int idx = F.tid; idx < T * 256; idx += NTHR) { const int st = idx >> 8, cc = idx & 255, arr = cc >> 7, k = cc & 127; const int wc_ = arr * 512 + 128 * h + k;
            float acc = cb[wc_];
#pragma unroll
            for (int j = 0; j < 4; ++j) acc += raw[(st + j) * 256 + cc] * cw[j * 1024 + wc_];
            acc = siluf(acc);
            if (arr == 0) Qs[st * 128 + k] = acc; else Ks[st * 128 + k] = acc * 0.08838834764831845f; }
        if (F.tid == 0) { float m = mst[0];
            for (int s = 0; s < T; ++s) { const float lf = FG[s], ip = IG[s]; const float mn = fmaxf(lf + m, ip); FD[s] = __expf(lf + m - mn); IW[s] = __expf(ip - mn); EM[s] = __expf(-mn); m = mn; }
            mst[0] = m; }
    };
    if (F.tid == 0) mst[0] = -1e30f;
    __syncthreads();
    issue(0); commit(); __syncthreads();
    const int vl = 2 * F.wave + (F.lane >> 5), kg = F.lane & 31;
    f32x4 C = (f32x4){0.f, 0.f, 0.f, 0.f}, n = C;
    for (int blk = 0; blk < SEQ / T; ++blk) {
        if (blk + 1 < SEQ / T) issue(blk + 1);
#pragma unroll 4
        for (int s = 0; s < T; ++s) {
            const f32x4 k4 = *(const LAS f32x4*)(Ks + s * 128 + 4 * kg), q4 = *(const LAS f32x4*)(Qs + s * 128 + 4 * kg);
            const float fd = FD[s], iw = IW[s], vv = Vs[s * 16 + vl];
            C = C * fd + k4 * (iw * vv); n = n * fd + k4 * iw;
            float num = row16_sum((C[0] * q4[0] + C[1] * q4[1]) + (C[2] * q4[2] + C[3] * q4[3]));
            float den = row16_sum((n[0] * q4[0] + n[1] * q4[1]) + (n[2] * q4[2] + n[3] * q4[3]));
            num += shx<16>(num); den += shx<16>(den);
            if (kg == 0) Ho[s * 16 + vl] = num / fmaxf(fabsf(den), EM[s]);
        }
        __syncthreads();
        { const int st = F.tid >> 4, r = F.tid & 15; HC[(tb0 + blk * T + st) * 512 + 128 * h + 16 * vs + r] = Ho[F.tid]; }
        if (blk + 1 < SEQ / T) commit();
        __syncthreads();
    }
}
DI void scan_lru_item(Frame& F, int item) {
    LAS float* SA = (LAS float*)F.lds; LAS float* SB = SA + 512;
    const int cg = item & 31, b = item >> 5, ch = F.tid & 15, seg = F.tid >> 4, c = 16 * cg + ch;
    const float* LA = (const float*)(F.ws + WS_LA); const float* LB = (const float*)(F.ws + WS_LB); const bf16* z = (const bf16*)(F.ws + WS_Z);
    bf16* Y3 = (bf16*)(F.ws + WS_Y) + (size_t)3 * M * 512;
    const size_t t0 = (size_t)b * SEQ + seg * 64;
    float A = 1.0f, Bv = 0.0f;
    for (int s = 0; s < 64; ++s) { const float av = LA[(t0 + s) * 512 + c], bv = LB[(t0 + s) * 512 + c]; A *= av; Bv = av * Bv + bv; }
    SA[seg * 16 + ch] = A; SB[seg * 16 + ch] = Bv;
    __syncthreads();
    float hh = 0.0f;
    for (int s2 = 0; s2 < seg; ++s2) hh = SA[s2 * 16 + ch] * hh + SB[s2 * 16 + ch];
    for (int s = 0; s < 64; ++s) { const float av = LA[(t0 + s) * 512 + c], bv = LB[(t0 + s) * 512 + c]; hh = av * hh + bv;
        const float g = bf2f(z[(t0 + s) * ZLD + ZD + 512 + c]); Y3[(t0 + s) * 512 + c] = (bf16)f2bf(hh * gelu_tanh(g)); }
    __syncthreads();
}
DI bf16x8 pack8(f32x4 lo, f32x4 hi) { v4u w; w.x = pk2(lo[0], lo[1]); w.y = pk2(lo[2], lo[3]); w.z = pk2(hi[0], hi[1]); w.w = pk2(hi[2], hi[3]); return __builtin_bit_cast(bf16x8, w); }
DI bf16x8 ld_perm(const LAS bf16* row, int kbase, int quad) {
    const v2u a = *(const LAS v2u*)(row + kbase + 4 * quad), b = *(const LAS v2u*)(row + kbase + 16 + 4 * quad); v4u w; w.x = a.x; w.y = a.y; w.z = b.x; w.w = b.y; return __builtin_bit_cast(bf16x8, w); }
constexpr int CQ_LD = 136, CT_LD = 40;
constexpr int FH_STRIDE = 34 * 1024 + 512;
DI void st_frag(unsigned char* base, int f, int lane, bf16x8 v) { *(bf16x8*)(base + f * 1024 + lane * 16) = v; }
DI bf16x8 ld_vperm(const unsigned char* natfrag, int fr, int quad) { const unsigned char* p = natfrag + (fr + 16 * (quad >> 1)) * 16 + 8 * (quad & 1);
    const v2u a = *(const v2u*)p, b = *(const v2u*)(p + 512); return __builtin_bit_cast(bf16x8, (v4u){a.x, a.y, b.x, b.y}); }
DI void hgrn_raw_load(Frame& F, int prob, v4u& pq, v4u& pf, v4u& pi) {
    const int bh = prob >> 6, c = prob & 63, h = bh & 3, b = bh >> 2; const bf16* z = (const bf16*)(F.ws + WS_Z);
    const bf16* src = z + ((size_t)b * SEQ + c * 32 + (F.tid >> 4)) * ZLD + ZB + 128 * h + 8 * (F.tid & 15); pq = *(const v4u*)src; pf = *(const v4u*)(src + 512); pi = *(const v4u*)(src + 1024);
}
DI void hgrn_lower_bounds(Frame& F, KA a, int l) {
    constexpr int C = 32;
    LAS float* lbs = (LAS float*)((LAS bf16*)F.lds + 2 * C * CQ_LD + 2 * 128 * CT_LD) + C * 128 + 4 * 128;
    { const int cc = F.tid; const float* hb = a->in[17];
      const float x0 = hb[cc], x1 = hb[512 + cc], x2 = hb[1024 + cc], x3 = hb[1536 + cc]; const float mx = fmaxf(fmaxf(x0, x1), fmaxf(x2, x3));
      const float e0 = __expf(x0 - mx), e1 = __expf(x1 - mx), e2 = __expf(x2 - mx), e3 = __expf(x3 - mx); const float inv = 1.0f / (e0 + e1 + e2 + e3);
      lbs[cc] = (l == 0) ? 0.0f : (l == 1 ? e1 * inv : (l == 2 ? (e1 + e2) * inv : (e1 + e2 + e3) * inv)); }
    __syncthreads();
}
DI void prep_hgrn_item(Frame& F, KA a, int l, int prob, int nprob, v4u& pq, v4u& pf, v4u& pi) {
    constexpr int C = 32;
    LAS bf16* Qt = (LAS bf16*)F.lds; LAS bf16* Kt = Qt + C * CQ_LD; LAS bf16* KhT = Kt + C * CQ_LD; LAS bf16* VT = KhT + 128 * CT_LD;
    LAS float* bc = (LAS float*)(VT + 128 * CT_LD); LAS float* PS = bc + C * 128; LAS float* lbs = PS + 4 * 128;
    const int bh = prob >> 6, c = prob & 63, h = bh & 3, b = bh >> 2, w = F.wave, lane = F.lane, fr = lane & 15, quad = lane >> 4;
    const bf16* z = (const bf16*)(F.ws + WS_Z);
    unsigned char* fo = F.ws + WS_FRH + (size_t)prob * FH_STRIDE;
    const size_t row0 = (size_t)b * SEQ + c * C;
    const int tr = F.tid >> 4, k0 = 8 * (F.tid & 15);
    float qv[8], kv[8];
    { const float fr_[8] = {blo(pf.x), bhi(pf.x), blo(pf.y), bhi(pf.y), blo(pf.z), bhi(pf.z), blo(pf.w), bhi(pf.w)};
      const float qr[8] = {blo(pq.x), bhi(pq.x), blo(pq.y), bhi(pq.y), blo(pq.z), bhi(pq.z), blo(pq.w), bhi(pq.w)};
      float lf[8];
#pragma unroll
      for (int j = 0; j < 8; ++j) { const float lb = lbs[128 * h + k0 + j], sg = sigm(fr_[j]); const float f = lb + (1.0f - lb) * sg; lf[j] = __logf(fmaxf(f, 1e-37f)); kv[j] = (1.0f - lb) * (1.0f - sg); qv[j] = siluf(qr[j]); }
      *(LAS f32x4*)(bc + tr * 128 + k0) = (f32x4){lf[0], lf[1], lf[2], lf[3]}; *(LAS f32x4*)(bc + tr * 128 + k0 + 4) = (f32x4){lf[4], lf[5], lf[6], lf[7]};
      const unsigned iv[4] = {pi.x, pi.y, pi.z, pi.w};
#pragma unroll
      for (int j = 0; j < 4; ++j) { VT[(k0 + 2 * j) * CT_LD + tr] = (bf16)(iv[j] & 0xffffu); VT[(k0 + 2 * j + 1) * CT_LD + tr] = (bf16)(iv[j] >> 16); } }
    if (nprob >= 0) hgrn_raw_load(F, nprob, pq, pf, pi);
    __syncthreads();
    { const int k = F.tid & 127, part = F.tid >> 7; float v8[8], run = 0.f;
#pragma unroll
      for (int j = 0; j < 8; ++j) v8[j] = bc[(8 * part + j) * 128 + k];
#pragma unroll
      for (int j = 0; j < 8; ++j) { run += v8[j]; bc[(8 * part + j) * 128 + k] = run; }
      PS[part * 128 + k] = run; }
    __syncthreads();
    { float q8[8], k8[8]; const int part = tr >> 3;
#pragma unroll
      for (int j = 0; j < 8; ++j) { const int k = k0 + j; const float p0 = PS[k], p1 = PS[128 + k], p2 = PS[256 + k], p3 = PS[384 + k];
          const float off = (part > 0 ? p0 : 0.f) + (part > 1 ? p1 : 0.f) + (part > 2 ? p2 : 0.f); const float blast = (p0 + p1) + (p2 + p3);
          const float bcu = bc[tr * 128 + k] + off; q8[j] = qv[j] * __expf(bcu); k8[j] = kv[j] * __expf(-bcu);
          KhT[k * CT_LD + tr] = (bf16)f2bf(kv[j] * __expf(blast - bcu));
          if (tr == 0) ((float*)(fo + 34 * 1024))[k] = __expf(blast); }
      *(LAS v4u*)(Qt + tr * CQ_LD + k0) = (v4u){pk2(q8[0], q8[1]), pk2(q8[2], q8[3]), pk2(q8[4], q8[5]), pk2(q8[6], q8[7])};
      *(LAS v4u*)(Kt + tr * CQ_LD + k0) = (v4u){pk2(k8[0], k8[1]), pk2(k8[2], k8[3]), pk2(k8[4], k8[5]), pk2(k8[6], k8[7])}; }
    __syncthreads();
    st_frag(fo, w, lane, ld_perm(Qt + (16 * (w >> 2) + fr) * CQ_LD, 32 * (w & 3), quad));
    st_frag(fo, 8 + w, lane, *(const LAS bf16x8*)(KhT + (16 * w + fr) * CT_LD + 8 * quad));
    st_frag(fo, 19 + 2 * w, lane, *(const LAS bf16x8*)(VT + (16 * w + fr) * CT_LD + 8 * quad));
    if (w < 2) {
        const f32x4 zero4 = fresh_zero4(); f32x4 pa = zero4, pb = zero4;
#pragma unroll
        for (int ks = 0; ks < 4; ++ks) { const bf16x8 qb = *(const LAS bf16x8*)(Qt + (16 * w + fr) * CQ_LD + 32 * ks + 8 * quad);
            pa = mfma16(*(const LAS bf16x8*)(Kt + fr * CQ_LD + 32 * ks + 8 * quad), qb, pa);
            if (w == 1) pb = mfma16(*(const LAS bf16x8*)(Kt + (16 + fr) * CQ_LD + 32 * ks + 8 * quad), qb, pb); }
#pragma unroll
        for (int j = 0; j < 4; ++j) { if (4 * quad + j > fr) { if (w == 0) pa[j] = 0.f; else pb[j] = 0.f; } }
        st_frag(fo, 16 + w, lane, pack8(pa, pb));
    }
    __syncthreads();
}
template <int NF, int NW, int SB> struct ChainStage {
    static constexpr int MAXF = (NF + NW - 1) / NW, SLOT = NF * 1024 + 512;
    bf16x8 r[MAXF]; f32x4 sc;
    DI void load(const unsigned char* p, int wsub, int lane) {
#pragma unroll
        for (int i = 0; i < MAXF; ++i) { const int f = wsub + NW * i; if (f < NF) r[i] = *(const bf16x8*)(p + f * 1024 + lane * 16); }
        if (wsub == NW - 1 && lane < SB / 16) sc = *(const f32x4*)(p + NF * 1024 + lane * 16);
    }
    DI void store(LAS unsigned char* slot, int wsub, int lane) const {
#pragma unroll
        for (int i = 0; i < MAXF; ++i) { const int f = wsub + NW * i; if (f < NF) *(LAS bf16x8*)(slot + f * 1024 + lane * 16) = r[i]; }
        if (wsub == NW - 1 && lane < SB / 16) *(LAS f32x4*)(slot + NF * 1024 + lane * 16) = sc;
    }
};
#define LQ(slot, f) (*(const LAS bf16x8*)((slot) + (f) * 1024 + lane * 16))
DI void chain_hgrn(Frame& F, int item) {
    typedef ChainStage<18, 8, 512> St;
    const int bh = item, h = bh & 3, b = bh >> 2, w = F.wave, lane = F.lane, fr = lane & 15, quad = lane >> 4;
    const bool act = true; const int vs = w;
    const unsigned char* fb = F.ws + WS_FRH + (size_t)bh * 64 * FH_STRIDE;
    bf16* OB = (bf16*)(F.ws + WS_OB);
    LAS unsigned char* L = F.lds;
    f32x4 S[8];
#pragma unroll
    for (int i = 0; i < 8; ++i) S[i] = (f32x4){0.f, 0.f, 0.f, 0.f};
    St sa, sb, sc;
    auto ld = [&](St& s, int c) { const unsigned char* p = fb + (size_t)c * FH_STRIDE;
#pragma unroll
        for (int i = 0; i < St::MAXF; ++i) { const int f = w + 8 * i; if (f < 18) s.r[i] = *(const bf16x8*)(p + f * 1024 + lane * 16); }
        if (w == 7 && lane < 32) s.sc = *(const f32x4*)(p + 34 * 1024 + lane * 16); };
    ld(sa, 0); sa.store(L, w, lane); ld(sa, 1); ld(sb, 2);
    bf16x8 vp = ld_vperm(fb + (19 + 2 * vs) * 1024, fr, quad), vn = *(const bf16x8*)(fb + (19 + 2 * vs) * 1024 + lane * 16);
    bf16x8 vp1 = ld_vperm(fb + FH_STRIDE + (19 + 2 * vs) * 1024, fr, quad), vn1 = *(const bf16x8*)(fb + FH_STRIDE + (19 + 2 * vs) * 1024 + lane * 16);
    __syncthreads();
    const f32x4 zero4 = fresh_zero4();
#pragma unroll 1
    for (int c = 0; c < 64; ++c) {
        ld(sc, c + 3 < 64 ? c + 3 : 63);
        const unsigned char* pn = fb + (size_t)(c + 2 < 64 ? c + 2 : 63) * FH_STRIDE;
        const LAS unsigned char* sl = L + (c & 1) * St::SLOT;
        if (act) {
        bf16x8 q[18]; f32x4 gl[8];
#pragma unroll
        for (int i = 0; i < 18; ++i) q[i] = LQ(sl, i);
#pragma unroll
        for (int kk = 0; kk < 8; ++kk) gl[kk] = *(const LAS f32x4*)(sl + 18 * 1024 + (16 * kk + 4 * quad) * 4);
        __builtin_amdgcn_sched_barrier(0);
        f32x4 o0 = mfma16(q[16], vp, zero4), o1 = mfma16(q[17], vp, zero4); vp = vp1; vp1 = ld_vperm(pn + (19 + 2 * vs) * 1024, fr, quad);
#pragma unroll
        for (int kt = 0; kt < 4; ++kt) { const bf16x8 sf = pack8(S[2 * kt], S[2 * kt + 1]); o0 = mfma16(q[kt], sf, o0); o1 = mfma16(q[4 + kt], sf, o1); }
#pragma unroll
        for (int kk = 0; kk < 8; ++kk) S[kk] = mfma16(q[8 + kk], vn, S[kk] * gl[kk]);
        vn = vn1; vn1 = *(const bf16x8*)(pn + (19 + 2 * vs) * 1024 + lane * 16);
        bf16* ob = OB + ((size_t)b * SEQ + c * 32) * 512 + 128 * h + 16 * vs; const unsigned lo = 4u * quad * 512u + fr;
#pragma unroll
        for (int j = 0; j < 4; ++j) { const unsigned pw_ = pk2(o0[j], o1[j]); ob[lo + j * 512] = (bf16)(pw_ & 0xffffu); ob[lo + (16 + j) * 512] = (bf16)(pw_ >> 16); }
        }
        sa.store(L + ((c + 1) & 1) * St::SLOT, w, lane);
        __syncthreads();
        sa = sb; sb = sc;
    }
}
template <int CTRL, int RM> DI float dpp_rm(float old, float v) { return __builtin_bit_cast(float, __builtin_amdgcn_update_dpp(__builtin_bit_cast(int, old), __builtin_bit_cast(int, v), CTRL, RM, 0xf, false)); }
DI float scan32_add(float v) {
    v += dpp_rm<0x111, 0xf>(0.f, v); v += dpp_rm<0x112, 0xf>(0.f, v); v += dpp_rm<0x114, 0xf>(0.f, v); v += dpp_rm<0x118, 0xf>(0.f, v); v += dpp_rm<0x142, 0xa>(0.f, v); return v; }
DI float scan32_max(float v) {
    const float ninf = -3.0e38f;
    v = fmaxf(v, dpp_rm<0x111, 0xf>(ninf, v)); v = fmaxf(v, dpp_rm<0x112, 0xf>(ninf, v)); v = fmaxf(v, dpp_rm<0x114, 0xf>(ninf, v)); v = fmaxf(v, dpp_rm<0x118, 0xf>(ninf, v)); v = fmaxf(v, dpp_rm<0x142, 0xa>(ninf, v)); return v; }
struct MRaw { v4u r[3], v; float ig, fg; };
DI void mlstm_raw_load(Frame& F, int prob, MRaw& R) {
    const int bh = prob >> 6, c = prob & 63, h = bh & 3, b = bh >> 2; const bf16* z = (const bf16*)(F.ws + WS_Z);
#pragma unroll
    for (int i = 0; i < 3; ++i) { const int idx = F.tid + i * NTHR; if (idx < 1120) { const int row = idx >> 5, pc = idx & 31; const int tt = c * 32 - 3 + row;
        R.r[i] = (tt >= 0) ? *(const v4u*)(z + ((size_t)b * SEQ + tt) * ZLD + ZC + (pc >> 4) * 512 + 128 * h + 8 * (pc & 15)) : (v4u){0u, 0u, 0u, 0u}; } }
    R.v = *(const v4u*)(z + ((size_t)b * SEQ + c * 32 + (F.tid >> 4)) * ZLD + ZC + 1024 + 128 * h + 8 * (F.tid & 15));
    if (F.wave == 0) { const bf16* zr = z + ((size_t)b * SEQ + c * 32 + (F.lane & 31)) * ZLD + ZC + 2048; R.ig = bf2f(zr[h]); R.fg = bf2f(zr[4 + h]); }
}
DI void prep_mlstm_item(Frame& F, KA a, int l, int prob, int nprob, MRaw& R) {
    constexpr int C = 32;
    LAS bf16* Qs = (LAS bf16*)F.lds; LAS bf16* Ks = Qs + C * CQ_LD; LAS bf16* KhT = Ks + C * CQ_LD; LAS bf16* VT = KhT + 128 * CT_LD;
    LAS float* raw = (LAS float*)(VT + 128 * CT_LD);
    LAS float* WT = raw + 35 * 256;
    LAS float* sc = WT + 32 * 32;
    const int bh = prob >> 6, c = prob & 63, h = bh & 3, b = bh >> 2, w = F.wave, lane = F.lane, fr = lane & 15, quad = lane >> 4;
    const bf16* z = (const bf16*)(F.ws + WS_Z);
    unsigned char* fo = F.ws + WS_FRM + (size_t)prob * FH_STRIDE; float* fsc = (float*)(fo + 34 * 1024);
    const float* cw = a->in[19] + l * 4 * 1024; const float* cb = a->in[20] + l * 1024; const float ib = a->in[21][l * 4 + h], fb = a->in[22][l * 4 + h];
    const size_t row0 = (size_t)b * SEQ + c * C;
    const int tr = F.tid >> 4, k0 = 8 * (F.tid & 15);
    const int wc_ = ((F.tid & 255) >> 7) * 512 + 128 * h + (F.tid & 127);
    const float cw0_ = cw[wc_], cw1_ = cw[1024 + wc_], cw2_ = cw[2048 + wc_], cw3_ = cw[3072 + wc_], cbb_ = cb[wc_];
#pragma unroll
    for (int i = 0; i < 3; ++i) { const int idx = F.tid + i * NTHR; if (idx < 1120) { const int row = idx >> 5, pc = idx & 31;
        const v4u r = R.r[i];
        LAS float* d = raw + row * 256 + 8 * pc; *(LAS f32x4*)d = (f32x4){blo(r.x), bhi(r.x), blo(r.y), bhi(r.y)}; *(LAS f32x4*)(d + 4) = (f32x4){blo(r.z), bhi(r.z), blo(r.w), bhi(r.w)}; } }
    { const v4u pv = R.v; const unsigned iv[4] = {pv.x, pv.y, pv.z, pv.w};
#pragma unroll
      for (int j = 0; j < 4; ++j) { VT[(k0 + 2 * j) * CT_LD + tr] = (bf16)(iv[j] & 0xffffu); VT[(k0 + 2 * j + 1) * CT_LD + tr] = (bf16)(iv[j] >> 16); } }
    if (w == 0) {
        const int t = lane & 31;
        const float lf = logsigm(R.fg + fb), ip = R.ig + ib;
        const float fc = scan32_add(lf), g = ip - fc, lm = scan32_max(g);
        const float lml = __builtin_bit_cast(float, __builtin_amdgcn_readlane(__builtin_bit_cast(int, lm), 31));
        if (lane < 32) { sc[t] = g; sc[32 + t] = lm; sc[64 + t] = __expf(g - lml); fsc[t] = lm; fsc[32 + t] = fc; }
    }
    if (nprob >= 0) mlstm_raw_load(F, nprob, R);
    __syncthreads();
    { const int cc = F.tid & 255, tg = F.tid >> 8, arr = cc >> 7, k = cc & 127;
      const float w0 = cw0_, w1 = cw1_, w2 = cw2_, w3 = cw3_, bb = cbb_;
      float x0 = raw[(16 * tg + 0) * 256 + cc], x1 = raw[(16 * tg + 1) * 256 + cc], x2 = raw[(16 * tg + 2) * 256 + cc];
      float o16[16];
#pragma unroll
      for (int j = 0; j < 16; ++j) { const float x3 = raw[(16 * tg + 3 + j) * 256 + cc]; o16[j] = siluf(bb + x0 * w0 + x1 * w1 + x2 * w2 + x3 * w3); x0 = x1; x1 = x2; x2 = x3; }
      if (arr == 0) {
#pragma unroll
          for (int j = 0; j < 16; ++j) Qs[(16 * tg + j) * CQ_LD + k] = (bf16)f2bf(o16[j]);
      } else { unsigned pw[8];
#pragma unroll
          for (int j = 0; j < 16; ++j) { o16[j] *= 0.08838834764831845f; Ks[(16 * tg + j) * CQ_LD + k] = (bf16)f2bf(o16[j]); o16[j] *= sc[64 + 16 * tg + j]; }
#pragma unroll
          for (int j = 0; j < 8; ++j) pw[j] = pk2(o16[2 * j], o16[2 * j + 1]);
          *(LAS v4u*)(KhT + k * CT_LD + 16 * tg) = (v4u){pw[0], pw[1], pw[2], pw[3]}; *(LAS v4u*)(KhT + k * CT_LD + 16 * tg + 8) = (v4u){pw[4], pw[5], pw[6], pw[7]}; } }
    { const int t = F.tid >> 4, s0 = 2 * (F.tid & 15); const float lmt = sc[32 + t];
      WT[t * 32 + s0] = (s0 <= t) ? __expf(sc[s0] - lmt) : 0.f; WT[t * 32 + s0 + 1] = (s0 + 1 <= t) ? __expf(sc[s0 + 1] - lmt) : 0.f; }
    __syncthreads();
    st_frag(fo, w, lane, ld_perm(Qs + (16 * (w >> 2) + fr) * CQ_LD, 32 * (w & 3), quad));
    st_frag(fo, 8 + w, lane, *(const LAS bf16x8*)(KhT + (16 * w + fr) * CT_LD + 8 * quad));
    st_frag(fo, 19 + 2 * w, lane, *(const LAS bf16x8*)(VT + (16 * w + fr) * CT_LD + 8 * quad));
    if (w < 2) {
        const f32x4 zero4 = fresh_zero4(); f32x4 pa = zero4, pb = zero4;
#pragma unroll
        for (int ks = 0; ks < 4; ++ks) { const bf16x8 qb = *(const LAS bf16x8*)(Qs + (16 * w + fr) * CQ_LD + 32 * ks + 8 * quad);
            pa = mfma16(*(const LAS bf16x8*)(Ks + fr * CQ_LD + 32 * ks + 8 * quad), qb, pa);
            if (w == 1) pb = mfma16(*(const LAS bf16x8*)(Ks + (16 + fr) * CQ_LD + 32 * ks + 8 * quad), qb, pb); }
        pa = pa * *(const LAS f32x4*)(WT + (16 * w + fr) * 32 + 4 * quad);
        if (w == 1) pb = pb * *(const LAS f32x4*)(WT + (16 + fr) * 32 + 16 + 4 * quad);
        float d = ((pa[0] + pa[1]) + (pa[2] + pa[3])) + ((pb[0] + pb[1]) + (pb[2] + pb[3]));
        d += shx<16>(d); d += shx<32>(d);
        if (quad == 0) fsc[64 + 16 * w + fr] = d;
        st_frag(fo, 16 + w, lane, pack8(pa, pb));
    }
    __syncthreads();
}
DI void chain_mlstm(Frame& F, int item) {
    typedef ChainStage<18, 8, 384> St;
    const int bh = item >> 1, half = item & 1, h = bh & 3, b = bh >> 2, w = F.wave, lane = F.lane, fr = lane & 15, quad = lane >> 4;
    const bool act = w < 4, nrm = (w == 4); const int vs = 4 * half + (w & 3);
    const unsigned char* fb = F.ws + WS_FRM + (size_t)bh * 64 * FH_STRIDE;
    bf16* HC = (bf16*)(F.ws + WS_HC);
    LAS unsigned char* L = F.lds;
    LAS float* DN = (LAS float*)(F.lds + 2 * St::SLOT);
    f32x4 S[8];
#pragma unroll
    for (int i = 0; i < 8; ++i) S[i] = (f32x4){0.f, 0.f, 0.f, 0.f};
    St sa, sb, sc;
    auto ld = [&](St& s, int c) { const unsigned char* p = fb + (size_t)c * FH_STRIDE;
#pragma unroll
        for (int i = 0; i < St::MAXF; ++i) { const int f = w + 8 * i; if (f < 18) s.r[i] = *(const bf16x8*)(p + f * 1024 + lane * 16); }
        if (w == 7 && lane < 24) s.sc = *(const f32x4*)(p + 34 * 1024 + lane * 16); };
    ld(sa, 0); sa.store(L, w, lane); ld(sa, 1); ld(sb, 2);
    bf16x8 vp = ld_vperm(fb + (19 + 2 * vs) * 1024, fr, quad), vn = *(const bf16x8*)(fb + (19 + 2 * vs) * 1024 + lane * 16);
    bf16x8 vp1 = ld_vperm(fb + FH_STRIDE + (19 + 2 * vs) * 1024, fr, quad), vn1 = *(const bf16x8*)(fb + FH_STRIDE + (19 + 2 * vs) * 1024 + lane * 16);
    __syncthreads();
    const f32x4 zero4 = fresh_zero4();
    unsigned o1_ = 0x3f803f80u; asm volatile("" : "+v"(o1_)); const bf16x8 ones = __builtin_bit_cast(bf16x8, (v4u){o1_, o1_, o1_, o1_});
    float mprev = -1e30f;
    f32x4 iqp[2], op[2];
    iqp[0] = iqp[1] = op[0] = op[1] = zero4;
    const unsigned lo = 4u * quad * 512u + fr;
#pragma unroll 1
    for (int c = 0; c < 64; ++c) {
        ld(sc, c + 3 < 64 ? c + 3 : 63);
        const unsigned char* pn = fb + (size_t)(c + 2 < 64 ? c + 2 : 63) * FH_STRIDE;
        const LAS unsigned char* sl = L + (c & 1) * St::SLOT; const LAS float* ss = (const LAS float*)(sl + 18 * 1024);
        const float lml = ss[31], fcl = ss[63];
        const float cml = fmaxf(lml, mprev), rhol = __expf(lml - cml), cd = __expf(mprev - cml);
        if (act) {
            if (c > 0) {
                const LAS float* dn = DN + ((c - 1) & 1) * 64; bf16* hb = HC + ((size_t)b * SEQ + (c - 1) * 32) * 512 + 128 * h + 16 * vs;
#pragma unroll
                for (int tb = 0; tb < 2; ++tb) { const f32x4 wr = *(const LAS f32x4*)(dn + 16 * tb + 4 * quad), rr = *(const LAS f32x4*)(dn + 32 + 16 * tb + 4 * quad);
#pragma unroll
                    for (int j = 0; j < 4; j += 2) { const unsigned pw_ = pk2(wr[j] * iqp[tb][j] + rr[j] * op[tb][j], wr[j + 1] * iqp[tb][j + 1] + rr[j + 1] * op[tb][j + 1]); hb[lo + (16 * tb + j) * 512] = (bf16)(pw_ & 0xffffu); hb[lo + (16 * tb + j + 1) * 512] = (bf16)(pw_ >> 16); } }
            }
            bf16x8 sf[4];
#pragma unroll
            for (int kt = 0; kt < 4; ++kt) sf[kt] = pack8(S[2 * kt], S[2 * kt + 1]);
            { bf16x8 q[8]; const bf16x8 ap0 = LQ(sl, 16), ap1 = LQ(sl, 17);
#pragma unroll
              for (int i = 0; i < 8; ++i) q[i] = LQ(sl, i);
              __builtin_amdgcn_sched_barrier(0);
              f32x4 o0 = mfma16(ap0, vp, zero4), o1 = mfma16(ap1, vp, zero4), i0 = zero4, i1 = zero4;
#pragma unroll
              for (int kt = 0; kt < 4; ++kt) { i0 = mfma16(q[kt], sf[kt], i0); i1 = mfma16(q[4 + kt], sf[kt], i1); }
              op[0] = o0; op[1] = o1; iqp[0] = i0; iqp[1] = i1; }
            vp = vp1; vp1 = ld_vperm(pn + (19 + 2 * vs) * 1024, fr, quad);
            { bf16x8 kf[8];
#pragma unroll
              for (int kk = 0; kk < 8; ++kk) kf[kk] = LQ(sl, 8 + kk);
              __builtin_amdgcn_sched_barrier(0);
#pragma unroll
              for (int kk = 0; kk < 8; ++kk) { const f32x4 us = mfma16(kf[kk], vn, zero4); S[kk] = S[kk] * cd + us * rhol; } }
            vn = vn1; vn1 = *(const bf16x8*)(pn + (19 + 2 * vs) * 1024 + lane * 16);
        } else if (nrm) {
            bf16x8 nf[4];
#pragma unroll
            for (int kt = 0; kt < 4; ++kt) nf[kt] = pack8(S[2 * kt], S[2 * kt + 1]);
            LAS float* dn = DN + (c & 1) * 64;
#pragma unroll
            for (int tb = 0; tb < 2; ++tb) {
                bf16x8 q[4];
#pragma unroll
                for (int kt = 0; kt < 4; ++kt) q[kt] = LQ(sl, 4 * tb + kt);
                const f32x4 slm = *(const LAS f32x4*)(ss + 16 * tb + 4 * quad), sfc = *(const LAS f32x4*)(ss + 32 + 16 * tb + 4 * quad), srs = *(const LAS f32x4*)(ss + 64 + 16 * tb + 4 * quad);
                __builtin_amdgcn_sched_barrier(0);
                f32x4 nq = zero4;
#pragma unroll
                for (int kt = 0; kt < 4; ++kt) nq = mfma16(q[kt], nf[kt], nq);
                f32x4 wr, rr;
#pragma unroll
                for (int j = 0; j < 4; ++j) { const float cm = fmaxf(slm[j], mprev), rho = __expf(slm[j] - cm), wi = __expf(mprev - cm), em = __expf(-(sfc[j] + cm));
                    const float rd = __builtin_amdgcn_rcpf(fmaxf(fabsf(wi * nq[j] + rho * srs[j]), em)); wr[j] = wi * rd; rr[j] = rho * rd; }
                if (fr == 0) { *(LAS f32x4*)(dn + 16 * tb + 4 * quad) = wr; *(LAS f32x4*)(dn + 32 + 16 * tb + 4 * quad) = rr; }
            }
            { bf16x8 kf[8];
#pragma unroll
              for (int kk = 0; kk < 8; ++kk) kf[kk] = LQ(sl, 8 + kk);
              __builtin_amdgcn_sched_barrier(0);
#pragma unroll
              for (int kk = 0; kk < 8; ++kk) { const f32x4 un = mfma16(kf[kk], ones, zero4); S[kk] = S[kk] * cd + un * rhol; } }
        }
        mprev = fcl + cml;
        sa.store(L + ((c + 1) & 1) * St::SLOT, w, lane);
        __syncthreads();
        sa = sb; sb = sc;
    }
    if (act) {
        const LAS float* dn = DN + 64; bf16* hb = HC + ((size_t)b * SEQ + 63 * 32) * 512 + 128 * h + 16 * vs;
#pragma unroll
        for (int tb = 0; tb < 2; ++tb) { const f32x4 wr = *(const LAS f32x4*)(dn + 16 * tb + 4 * quad), rr = *(const LAS f32x4*)(dn + 32 + 16 * tb + 4 * quad);
#pragma unroll
            for (int j = 0; j < 4; j += 2) { const unsigned pw_ = pk2(wr[j] * iqp[tb][j] + rr[j] * op[tb][j], wr[j + 1] * iqp[tb][j + 1] + rr[j + 1] * op[tb][j + 1]); hb[lo + (16 * tb + j) * 512] = (bf16)(pw_ & 0xffffu); hb[lo + (16 * tb + j + 1) * 512] = (bf16)(pw_ >> 16); } }
    }
}
constexpr int FR_STRIDE = 22 * 1024 + 256;
constexpr int RK_LD = 72, RT_LD = 40, RAAB_LD = 36;
struct RRaw { float lw[8]; unsigned r[8], k[8], a[8], b[8], v[8]; };
DI void rwkv_raw_load(Frame& F, int prob, RRaw& R) {
    const bf16* RWH = (const bf16*)(F.ws + WS_RW); const float* LW = (const float*)(F.ws + WS_LW);
    const int tq = F.tid & 255, k = tq & 63, part = tq >> 6, wq = F.wave & 3, fr = F.lane & 15, quad = F.lane >> 4;
    const int bh = prob >> 6, c = prob & 63, b = bh >> 3, h = bh & 7; const size_t row0 = (size_t)b * SEQ + c * 32; const size_t o = (row0 + 8 * part) * 512 + 64 * h + k;
#pragma unroll
    for (int j = 0; j < 8; ++j) { R.lw[j] = LW[o + (size_t)j * 512]; R.r[j] = RWH[0 * (RHSZ / 2) + o + (size_t)j * 512]; R.k[j] = RWH[1 * (RHSZ / 2) + o + (size_t)j * 512]; R.a[j] = RWH[3 * (RHSZ / 2) + o + (size_t)j * 512]; R.b[j] = RWH[4 * (RHSZ / 2) + o + (size_t)j * 512]; }
    const bf16* vsrc = RWH + 2 * (RHSZ / 2) + row0 * 512 + 64 * h + 16 * wq + fr;
#pragma unroll
    for (int j = 0; j < 4; ++j) { R.v[j] = vsrc[(size_t)(4 * quad + j) * 512]; R.v[4 + j] = vsrc[(size_t)(16 + 4 * quad + j) * 512]; }
}
DI void phase_rwkv_chunkprep(Frame& F) {
    const int grp = F.wave >> 2, wq = F.wave & 3, lane = F.lane, fr = lane & 15, quad = lane >> 4, tq = F.tid & 255;
    LAS unsigned char* L = F.lds + grp * 65536;
    LAS bf16* At = (LAS bf16*)L;
    LAS bf16* Bt = At + 32 * RK_LD;
    LAS bf16* Kt = Bt + 32 * RK_LD;
    LAS bf16* Rt = Kt + 32 * RK_LD;
    LAS bf16* AT = Rt + 32 * RK_LD;
    LAS bf16* BhT = AT + 64 * RT_LD;
    LAS bf16* KhT = BhT + 64 * RT_LD;
    LAS bf16* Tm = KhT + 64 * RT_LD;
    LAS bf16* AakT = Tm + 32 * RT_LD;
    LAS bf16* Arb = AakT + 32 * RT_LD;
    LAS bf16* TaT = Arb + 32 * RT_LD;
    LAS bf16* TAkT = TaT + 64 * RT_LD;
    LAS float* Aab = (LAS float*)(TAkT + 32 * RT_LD);
    LAS float* PS = Aab + 32 * RAAB_LD;
    const bf16* RWH = (const bf16*)(F.ws + WS_RW); const float* LW = (const float*)(F.ws + WS_LW);
    unsigned char* FRb = F.ws + WS_FR;
    const f32x4 zero4 = fresh_zero4();
    RRaw RR; if (F.vcu < 2048) rwkv_raw_load(F, F.vcu * 2 + grp, RR);
    for (int it = F.vcu; it < 2048; it += F.G) {
        const int prob = it * 2 + grp;
        const int bh = prob >> 6, c = prob & 63, b = bh >> 3, h = bh & 7;
        const size_t row0 = (size_t)b * SEQ + c * 32;
        unsigned char* fr_out = FRb + (size_t)prob * FR_STRIDE;
        {
            const int k = tq & 63, part = tq >> 6; const size_t o = (row0 + 8 * part) * 512 + 64 * h + k;
            float lw[8], g[8]; float run = 0.f;
#pragma unroll
            for (int j = 0; j < 8; ++j) { lw[j] = RR.lw[j]; run += lw[j]; g[j] = run; }
            PS[part * 64 + k] = run;
            __syncthreads();
            float off = 0.f, tot = 0.f;
#pragma unroll
            for (int p = 0; p < 4; ++p) { const float v = PS[p * 64 + k]; tot += v; if (p < part) off += v; }
            unsigned pa[4], pb[4], pk[4];
            float av8[8], bv8[8], kv8[8];
#pragma unroll
            for (int j = 0; j < 8; ++j) { const float G = g[j] + off; const float r = bf2f((unsigned short)RR.r[j]), k2 = bf2f((unsigned short)RR.k[j]), a_ = bf2f((unsigned short)RR.a[j]), b_ = bf2f((unsigned short)RR.b[j]);
                const float eG = __expf(G), enG = __expf(-G), eGm1 = __expf(G - lw[j]), eh = __expf(tot - G);
                const int t = 8 * part + j;
                At[t * RK_LD + k] = (bf16)f2bf(a_ * eGm1); Bt[t * RK_LD + k] = (bf16)f2bf(b_ * enG); Kt[t * RK_LD + k] = (bf16)f2bf(k2 * enG); Rt[t * RK_LD + k] = (bf16)f2bf(r * eG);
                av8[j] = a_ * eGm1; bv8[j] = b_ * eh; kv8[j] = k2 * eh; }
#pragma unroll
            for (int j = 0; j < 4; ++j) { pa[j] = pk2(av8[2 * j], av8[2 * j + 1]); pb[j] = pk2(bv8[2 * j], bv8[2 * j + 1]); pk[j] = pk2(kv8[2 * j], kv8[2 * j + 1]); }
            *(LAS v4u*)(AT + k * RT_LD + 8 * part) = (v4u){pa[0], pa[1], pa[2], pa[3]};
            *(LAS v4u*)(BhT + k * RT_LD + 8 * part) = (v4u){pb[0], pb[1], pb[2], pb[3]};
            *(LAS v4u*)(KhT + k * RT_LD + 8 * part) = (v4u){pk[0], pk[1], pk[2], pk[3]};
            if (part == 0) ((float*)(fr_out + 22 * 1024))[k] = __expf(tot);
            { const unsigned (&vv)[8] = RR.v;
              *(v4u*)(fr_out + (18 + wq) * 1024 + lane * 16) = (v4u){vv[0] | (vv[1] << 16), vv[2] | (vv[3] << 16), vv[4] | (vv[5] << 16), vv[6] | (vv[7] << 16)}; }
            if (it + F.G < 2048) rwkv_raw_load(F, (it + F.G) * 2 + grp, RR);
        }
        __syncthreads();
        f32x4 ark[2][2];
        {
            const LAS bf16* Am = (wq == 0) ? At : (wq == 2 ? Rt : Kt);
            const LAS bf16* Bm = (wq == 0 || wq == 2) ? Bt : (wq == 1 ? At : Rt);
            f32x4 acc[2][2];
#pragma unroll
            for (int rb = 0; rb < 2; ++rb)
#pragma unroll
                for (int cbk = 0; cbk < 2; ++cbk) { f32x4 x = zero4;
#pragma unroll
                    for (int ks = 0; ks < 2; ++ks) x = mfma16(*(const LAS bf16x8*)(Am + (16 * rb + fr) * RK_LD + 32 * ks + 8 * quad), *(const LAS bf16x8*)(Bm + (16 * cbk + fr) * RK_LD + 32 * ks + 8 * quad), x);
                    acc[rb][cbk] = x; }
#pragma unroll
            for (int rb = 0; rb < 2; ++rb)
#pragma unroll
                for (int cbk = 0; cbk < 2; ++cbk)
#pragma unroll
                    for (int j = 0; j < 4; ++j) { const int row = 16 * rb + 4 * quad + j, col = 16 * cbk + fr; const int t = (wq == 0 || wq == 2) ? row : col, s = (wq == 0 || wq == 2) ? col : row;
                        const bool keep = (wq < 2) ? (s < t) : (s <= t); const float v = keep ? acc[rb][cbk][j] : 0.f; acc[rb][cbk][j] = v;
                        if (wq == 0) Aab[row * RAAB_LD + col] = v; else if (wq == 1) AakT[row * RT_LD + col] = (bf16)f2bf(v); else if (wq == 2) Arb[row * RT_LD + col] = (bf16)f2bf(v); }
#pragma unroll
            for (int rb = 0; rb < 2; ++rb)
#pragma unroll
                for (int cbk = 0; cbk < 2; ++cbk) ark[rb][cbk] = acc[rb][cbk];
        }
        __syncthreads();
        if (wq == 0) {
            float Tc[32]; const int cidx = lane & 31;
#pragma unroll
            for (int t = 0; t < 32; ++t) { float acc = (t == cidx) ? 1.0f : 0.0f;
#pragma unroll
                for (int s = 0; s < t; ++s) acc += Aab[t * RAAB_LD + s] * Tc[s];
                Tc[t] = acc; if (lane < 32) Tm[t * RT_LD + cidx] = (bf16)f2bf(acc); }
        }
        __syncthreads();
        {
            const bf16x8 aT = *(const LAS bf16x8*)(AT + (16 * wq + fr) * RT_LD + 8 * quad);
#pragma unroll
            for (int st = 0; st < 2; ++st) { const f32x4 x = mfma16(aT, *(const LAS bf16x8*)(Tm + (16 * st + fr) * RT_LD + 8 * quad), zero4);
#pragma unroll
                for (int j = 0; j < 4; ++j) TaT[(16 * wq + 4 * quad + j) * RT_LD + 16 * st + fr] = (bf16)f2bf(x[j]); }
            const int st = wq >> 1, ut = wq & 1;
            const f32x4 y = mfma16(*(const LAS bf16x8*)(AakT + (16 * st + fr) * RT_LD + 8 * quad), *(const LAS bf16x8*)(Tm + (16 * ut + fr) * RT_LD + 8 * quad), zero4);
#pragma unroll
            for (int j = 0; j < 4; ++j) TAkT[(16 * st + 4 * quad + j) * RT_LD + 16 * ut + fr] = (bf16)f2bf(y[j]);
        }
        __syncthreads();
        {
            { const int tb = wq & 1, i = wq >> 1; const bf16x8 bop = *(const LAS bf16x8*)(Arb + (16 * tb + fr) * RT_LD + 8 * quad); f32x4 x[2];
#pragma unroll
              for (int u = 0; u < 2; ++u) { const int kt = 2 * i + u; const v2u rz = *(const LAS v2u*)(Rt + (16 * tb + fr) * RK_LD + 16 * kt + 4 * quad);
                  x[u] = mfma16(*(const LAS bf16x8*)(TaT + (16 * kt + fr) * RT_LD + 8 * quad), bop, (f32x4){blo(rz.x), bhi(rz.x), blo(rz.y), bhi(rz.y)}); }
              *(bf16x8*)(fr_out + (tb * 2 + i) * 1024 + lane * 16) = pack8(x[0], x[1]); }
            { const bf16x8 bop = *(const LAS bf16x8*)(BhT + (16 * wq + fr) * RT_LD + 8 * quad); f32x4 x[4];
#pragma unroll
              for (int kt = 0; kt < 4; ++kt) x[kt] = mfma16(*(const LAS bf16x8*)(TaT + (16 * kt + fr) * RT_LD + 8 * quad), bop, zero4);
              *(bf16x8*)(fr_out + (6 + wq * 2 + 0) * 1024 + lane * 16) = pack8(x[0], x[1]); *(bf16x8*)(fr_out + (6 + wq * 2 + 1) * 1024 + lane * 16) = pack8(x[2], x[3]);
              f32x4 q[2];
#pragma unroll
              for (int sb = 0; sb < 2; ++sb) { const v2u kz = *(const LAS v2u*)(KhT + (16 * wq + fr) * RT_LD + 16 * sb + 4 * quad);
                  q[sb] = mfma16(*(const LAS bf16x8*)(TAkT + (16 * sb + fr) * RT_LD + 8 * quad), bop, (f32x4){blo(kz.x), bhi(kz.x), blo(kz.y), bhi(kz.y)}); }
              *(bf16x8*)(fr_out + (14 + wq) * 1024 + lane * 16) = pack8(q[0], q[1]); }
            if (wq == 3) {
#pragma unroll
                for (int tb = 0; tb < 2; ++tb) { const bf16x8 bop = *(const LAS bf16x8*)(Arb + (16 * tb + fr) * RT_LD + 8 * quad); f32x4 x[2];
#pragma unroll
                    for (int sb = 0; sb < 2; ++sb) x[sb] = mfma16(*(const LAS bf16x8*)(TAkT + (16 * sb + fr) * RT_LD + 8 * quad), bop, ark[sb][tb]);
                    *(bf16x8*)(fr_out + (4 + tb) * 1024 + lane * 16) = pack8(x[0], x[1]); } }
        }
        __syncthreads();
    }
}
DI void chunk_rwkv_chain(Frame& F, int item) {
    typedef ChainStage<18, 4, 256> St;
    const int grp = F.wave >> 2, w = F.wave & 3, lane = F.lane, fr = lane & 15, quad = lane >> 4;
    const int bh = item * 2 + grp, b = bh >> 3, h = bh & 7;
    const unsigned char* fb = F.ws + WS_FR + (size_t)bh * 64 * FR_STRIDE;
    bf16* YA = (bf16*)(F.ws + WS_YA);
    LAS unsigned char* L = F.lds + grp * (2 * St::SLOT);
    f32x4 H[4];
#pragma unroll
    for (int i = 0; i < 4; ++i) H[i] = (f32x4){0.f, 0.f, 0.f, 0.f};
    St sa, sb, sc;
    auto ld = [&](St& s, int c) { const unsigned char* p = fb + (size_t)c * FR_STRIDE;
#pragma unroll
        for (int i = 0; i < St::MAXF; ++i) { const int f = w + 4 * i; if (f < 18) s.r[i] = *(const bf16x8*)(p + f * 1024 + lane * 16); }
        if (w == 3 && lane < 16) s.sc = *(const f32x4*)(p + 22 * 1024 + lane * 16); };
    ld(sa, 0); sa.store(L, w, lane); ld(sa, 1); ld(sb, 2);
    bf16x8 vf = *(const bf16x8*)(fb + (18 + w) * 1024 + lane * 16), vf1 = *(const bf16x8*)(fb + FR_STRIDE + (18 + w) * 1024 + lane * 16);
    __syncthreads();
    const f32x4 zero4 = fresh_zero4();
#pragma unroll 1
    for (int c = 0; c < 64; ++c) {
        ld(sc, c + 3 < 64 ? c + 3 : 63);
        const unsigned char* pn = fb + (size_t)(c + 2 < 64 ? c + 2 : 63) * FR_STRIDE;
        const LAS unsigned char* sl = L + (c & 1) * St::SLOT;
        bf16x8 q[18]; f32x4 gl[4];
#pragma unroll
        for (int i = 0; i < 18; ++i) q[i] = LQ(sl, i);
#pragma unroll
        for (int kt = 0; kt < 4; ++kt) gl[kt] = *(const LAS f32x4*)(sl + 18 * 1024 + (16 * kt + 4 * quad) * 4);
        __builtin_amdgcn_sched_barrier(0);
        const bf16x8 hb0 = pack8(H[0], H[1]), hb1 = pack8(H[2], H[3]);
        f32x4 y0 = mfma16(q[4], vf, zero4), y1 = mfma16(q[5], vf, zero4);
        y0 = mfma16(q[0], hb0, y0); y0 = mfma16(q[1], hb1, y0); y1 = mfma16(q[2], hb0, y1); y1 = mfma16(q[3], hb1, y1);
#pragma unroll
        for (int kt = 0; kt < 4; ++kt) { f32x4 x = mfma16(q[14 + kt], vf, H[kt] * gl[kt]); x = mfma16(q[6 + 2 * kt], hb0, x); H[kt] = mfma16(q[7 + 2 * kt], hb1, x); }
        vf = vf1; vf1 = *(const bf16x8*)(pn + (18 + w) * 1024 + lane * 16);
        bf16* yb = YA + ((size_t)b * SEQ + c * 32) * 512 + 64 * h + 16 * w; const unsigned lo = 4u * quad * 512u + fr;
#pragma unroll
        for (int j = 0; j < 4; ++j) { const unsigned pw_ = pk2(y0[j], y1[j]); yb[lo + j * 512] = (bf16)(pw_ & 0xffffu); yb[lo + (16 + j) * 512] = (bf16)(pw_ >> 16); }
        sa.store(L + ((c + 1) & 1) * St::SLOT, w, lane);
        __syncthreads();
        sa = sb; sb = sc;
    }
}
#undef LQ
DI void scan_lru_item4(Frame& F, int item) {
    LAS f32x4* SA = (LAS f32x4*)F.lds; LAS f32x4* SB = SA + 512;
    const int cg = item & 7, b = item >> 3, cq = F.tid & 15, seg = F.tid >> 4, c = 64 * cg + 4 * cq;
    const float* LA = (const float*)(F.ws + WS_LA); const bf16* LB = (const bf16*)(F.ws + WS_LB); const bf16* z = (const bf16*)(F.ws + WS_Z);
    unsigned char* Y3 = F.ws + WS_Y + (size_t)3 * M * 512;
    const size_t t0 = (size_t)b * SEQ + seg * 64;
    const float* la = LA + t0 * 512 + c; const bf16* lb = LB + t0 * 512 + c; const bf16* gzp = z + t0 * ZLD + ZD + 512 + c; unsigned char* yp = Y3 + t0 * 512 + c;
    f32x4 A = (f32x4){1.f, 1.f, 1.f, 1.f}, Bv = (f32x4){0.f, 0.f, 0.f, 0.f};
    f32x4 av0[8], av1[8]; v2u bq0[8], bq1[8], gz0[8], gz1[8];
#define LRU_LD(AV, BQ, S0) do { _Pragma("unroll") for (int i_ = 0; i_ < 8; ++i_) { AV[i_] = *(const f32x4*)(la + (size_t)((S0) + i_) * 512); BQ[i_] = *(const v2u*)(lb + (size_t)((S0) + i_) * 512); } } while (0)
#define LRU_LDG(GZ, S0) do { _Pragma("unroll") for (int i_ = 0; i_ < 8; ++i_) GZ[i_] = *(const v2u*)(gzp + (size_t)((S0) + i_) * ZLD); } while (0)
#define LRU_C1(AV, BQ) do { _Pragma("unroll") for (int i_ = 0; i_ < 8; ++i_) { const f32x4 bv_ = (f32x4){blo(BQ[i_].x), bhi(BQ[i_].x), blo(BQ[i_].y), bhi(BQ[i_].y)}; A = A * AV[i_]; Bv = AV[i_] * Bv + bv_; } } while (0)
#define LRU_C2(AV, BQ, GZ, S0) do { _Pragma("unroll") for (int i_ = 0; i_ < 8; ++i_) { const f32x4 bv_ = (f32x4){blo(BQ[i_].x), bhi(BQ[i_].x), blo(BQ[i_].y), bhi(BQ[i_].y)}; hh = AV[i_] * hh + bv_; \
        *(unsigned*)(yp + (size_t)((S0) + i_) * 512) = pk4f8(hh[0] * gelu_tanh(blo(GZ[i_].x)), hh[1] * gelu_tanh(bhi(GZ[i_].x)), hh[2] * gelu_tanh(blo(GZ[i_].y)), hh[3] * gelu_tanh(bhi(GZ[i_].y))); } } while (0)
    LRU_LD(av0, bq0, 0);
#pragma unroll 1
    for (int k = 0; k < 64; k += 16) { LRU_LD(av1, bq1, k + 8); LRU_C1(av0, bq0); if (k + 16 < 64) LRU_LD(av0, bq0, k + 16); LRU_C1(av1, bq1); }
    LRU_LD(av0, bq0, 0); LRU_LDG(gz0, 0);
    SA[seg * 16 + cq] = A; SB[seg * 16 + cq] = Bv;
    __syncthreads();
    f32x4 hh = (f32x4){0.f, 0.f, 0.f, 0.f};
    for (int s2 = 0; s2 < seg; ++s2) hh = SA[s2 * 16 + cq] * hh + SB[s2 * 16 + cq];
#pragma unroll 1
    for (int k = 0; k < 64; k += 16) { LRU_LD(av1, bq1, k + 8); LRU_LDG(gz1, k + 8); LRU_C2(av0, bq0, gz0, k); if (k + 16 < 64) { LRU_LD(av0, bq0, k + 16); LRU_LDG(gz0, k + 16); } LRU_C2(av1, bq1, gz1, k + 8); }
#undef LRU_LD
#undef LRU_LDG
#undef LRU_C1
#undef LRU_C2
    __syncthreads();
}
DI void phase_chunkprep(Frame& F, KA a, int l) {
#ifndef DUPCP
#define DUPCP 0
#endif
    for (int rep = 0; rep < 1 + ((DUPCP >> 0) & 1); ++rep) { phase_rwkv_chunkprep(F); __syncthreads(); }
    for (int rep = 0; rep < 1 + ((DUPCP >> 1) & 1); ++rep) { v4u pq, pf, pi; if (F.vcu < 2048) hgrn_raw_load(F, F.vcu, pq, pf, pi); hgrn_lower_bounds(F, a, l);
      for (int it = F.vcu; it < 2048; it += F.G) prep_hgrn_item(F, a, l, it, (it + F.G < 2048) ? it + F.G : -1, pq, pf, pi); }
    for (int rep = 0; rep < 1 + ((DUPCP >> 2) & 1); ++rep) { MRaw R; if (F.vcu < 2048) mlstm_raw_load(F, F.vcu, R);
      for (int it = F.vcu; it < 2048; it += F.G) prep_mlstm_item(F, a, l, it, (it + F.G < 2048) ? it + F.G : -1, R); }
}
DI void phase_scan(Frame& F, KA a, int l) {
    int v = __builtin_amdgcn_readfirstlane((int)blockIdx.x); asm volatile("" : "+s"(v));
    if (F.G >= 160) {
#ifndef DUPSCAN
#define DUPSCAN 0
#endif
        if (v < 32) { for (int rep = 0; rep < 1 + ((DUPSCAN >> 0) & 1); ++rep) { chain_hgrn(F, v); __syncthreads(); } }
        else if (v < 96) { for (int rep = 0; rep < 1 + ((DUPSCAN >> 1) & 1); ++rep) { int mi_ = 2 * ((((v - 32) >> 4) << 3) + ((v - 32) & 7)) + (((v - 32) >> 3) & 1); asm volatile("" : "+s"(mi_)); chain_mlstm(F, mi_); __syncthreads(); } }
        else if (v < 128) { for (int rep = 0; rep < 1 + ((DUPSCAN >> 2) & 1); ++rep) { chunk_rwkv_chain(F, v - 96); __syncthreads(); } }
        else if (v < 192) { for (int rep = 0; rep < 1 + ((DUPSCAN >> 3) & 1); ++rep) { scan_lru_item4(F, v - 128); __syncthreads(); } }
    }
    __syncthreads(); cvt_expert_queue(F, a, l);
}

DI float xsum8(float v) { v += dpp_f<0xB1>(v); v += dpp_f<0x4E>(v); v += dpp_f<0x141>(v); return v; }
DI void phase_post(Frame& F, KA a, int l) {
    const bf16* z = (const bf16*)(F.ws + WS_Z); const bf16* RWH = (const bf16*)(F.ws + WS_RW); const float* BON = (const float*)(F.ws + WS_BON);
    const bf16* YA = (const bf16*)(F.ws + WS_YA); const bf16* OB = (const bf16*)(F.ws + WS_OB); const bf16* HC = (const bf16*)(F.ws + WS_HC);
    unsigned char* Y = F.ws + WS_Y;
    const float* lng = a->in[15] + l * 512; const float* lnb = a->in[16] + l * 512; const float* hnw = a->in[18] + l * 512; const float* mnw = a->in[23] + l * 512;
    const int c = 8 * F.lane;
    struct PTok { v4u ya, ob, hc; v4u gq, vq, gzb, gzc; float bon; };
    auto issue = [&](PTok& T, int t) { const size_t o = (size_t)t * 512 + c;
        T.ya = *(const v4u*)(YA + o); T.ob = *(const v4u*)(OB + o); T.hc = *(const v4u*)(HC + o);
        T.gq = *(const v4u*)(RWH + 5 * (RHSZ / 2) + o); T.vq = *(const v4u*)(RWH + 2 * (RHSZ / 2) + o); T.gzb = *(const v4u*)(z + (size_t)t * ZLD + ZB + 1536 + c); T.gzc = *(const v4u*)(z + (size_t)t * ZLD + ZC + 1536 + c);
        T.bon = BON[(size_t)t * 8 + (F.lane >> 3)]; };
    float lg[8], lb[8], nwh[8], nwm[8];
    *(f32x4*)&lg[0] = *(const f32x4*)(lng + c); *(f32x4*)&lg[4] = *(const f32x4*)(lng + c + 4); *(f32x4*)&lb[0] = *(const f32x4*)(lnb + c); *(f32x4*)&lb[4] = *(const f32x4*)(lnb + c + 4);
    *(f32x4*)&nwh[0] = *(const f32x4*)(hnw + c); *(f32x4*)&nwh[4] = *(const f32x4*)(hnw + c + 4); *(f32x4*)&nwm[0] = *(const f32x4*)(mnw + c); *(f32x4*)&nwm[4] = *(const f32x4*)(mnw + c + 4);
    const int t0 = F.gw, nt = (M - t0 + F.NGW - 1) / F.NGW;
    PTok cur, nxt;
    issue(cur, t0);
#pragma unroll 1
    for (int i = 0; i < nt; ++i) {
        const int t = t0 + i * F.NGW;
        if (i + 1 < nt) issue(nxt, t + F.NGW);
        const size_t o = (size_t)t * 512 + c;
        { const v4u yq_ = cur.ya; float y[8] = {blo(yq_.x), bhi(yq_.x), blo(yq_.y), bhi(yq_.y), blo(yq_.z), bhi(yq_.z), blo(yq_.w), bhi(yq_.w)};
          float s_ = 0.f; for (int j = 0; j < 8; ++j) s_ += y[j]; const float mean = xsum8(s_) * (1.0f / 64.0f);
          float q = 0.f; for (int j = 0; j < 8; ++j) { y[j] -= mean; q += y[j] * y[j]; } const float rstd = rsqrtf(xsum8(q) * (1.0f / 64.0f) + 64e-5f);
          const v4u gq = cur.gq, vq = cur.vq;
          const float g[8] = {blo(gq.x), bhi(gq.x), blo(gq.y), bhi(gq.y), blo(gq.z), bhi(gq.z), blo(gq.w), bhi(gq.w)}, v[8] = {blo(vq.x), bhi(vq.x), blo(vq.y), bhi(vq.y), blo(vq.z), bhi(vq.z), blo(vq.w), bhi(vq.w)};
          float r[8]; for (int j = 0; j < 8; ++j) r[j] = (y[j] * rstd * lg[j] + lb[j] + cur.bon * v[j]) * g[j];
          *(v2u*)(Y + o) = (v2u){pk4f8(r[0], r[1], r[2], r[3]), pk4f8(r[4], r[5], r[6], r[7])}; }
        { const v4u yq_ = cur.ob; float y[8] = {blo(yq_.x), bhi(yq_.x), blo(yq_.y), bhi(yq_.y), blo(yq_.z), bhi(yq_.z), blo(yq_.w), bhi(yq_.w)};
          float q = 0.f; for (int j = 0; j < 8; ++j) q += y[j] * y[j]; q = xsum8(q); q += dpp_f<0x128>(q); const float rstd = rsqrtf(q * (1.0f / 128.0f) + 1e-6f);
          const v4u gz = cur.gzb; const float g[8] = {blo(gz.x), bhi(gz.x), blo(gz.y), bhi(gz.y), blo(gz.z), bhi(gz.z), blo(gz.w), bhi(gz.w)};
          float r[8]; for (int j = 0; j < 8; ++j) r[j] = y[j] * rstd * nwh[j] * siluf(g[j]);
          *(v2u*)(Y + (size_t)M * 512 + o) = (v2u){pk4f8(r[0], r[1], r[2], r[3]), pk4f8(r[4], r[5], r[6], r[7])}; }
        { const v4u yq_ = cur.hc; float y[8] = {blo(yq_.x), bhi(yq_.x), blo(yq_.y), bhi(yq_.y), blo(yq_.z), bhi(yq_.z), blo(yq_.w), bhi(yq_.w)};
          float s_ = 0.f; for (int j = 0; j < 8; ++j) s_ += y[j]; s_ = xsum8(s_); s_ += dpp_f<0x128>(s_); const float mean = s_ * (1.0f / 128.0f);
          float q = 0.f; for (int j = 0; j < 8; ++j) { y[j] -= mean; q += y[j] * y[j]; } q = xsum8(q); q += dpp_f<0x128>(q); const float rstd = rsqrtf(q * (1.0f / 128.0f) + 1e-6f);
          const v4u gz = cur.gzc; const float g[8] = {blo(gz.x), bhi(gz.x), blo(gz.y), bhi(gz.y), blo(gz.z), bhi(gz.z), blo(gz.w), bhi(gz.w)};
          float r[8]; for (int j = 0; j < 8; ++j) r[j] = y[j] * rstd * nwm[j] * sigm(g[j]);
          *(v2u*)(Y + (size_t)2 * M * 512 + o) = (v2u){pk4f8(r[0], r[1], r[2], r[3]), pk4f8(r[4], r[5], r[6], r[7])}; }
        cur = nxt;
    }
}

DI void ln_row(const f32x4 (&v)[4], f32x4 (&o)[4], const float* g, const float* b, int lane) {
    float s = 0.f;
#pragma unroll
    for (int j = 0; j < 4; ++j) s += (v[j].x + v[j].y) + (v[j].z + v[j].w);
    const float mean = wave_sum(s) * (1.0f / D); float q = 0.f;
#pragma unroll
    for (int j = 0; j < 4; ++j) { o[j] = v[j] - mean; q += (o[j].x * o[j].x + o[j].y * o[j].y) + (o[j].z * o[j].z + o[j].w * o[j].w); }
    const float rstd = rsqrtf(wave_sum(q) * (1.0f / D) + 1e-5f);
#pragma unroll
    for (int j = 0; j < 4; ++j) { const f32x4 gg = *(const f32x4*)(g + 4 * lane + 256 * j), bb = *(const f32x4*)(b + 4 * lane + 256 * j); o[j] = o[j] * rstd * gg + bb; }
}
DI void phase_ln1_router(Frame& F, KA a, int l) {
    constexpr int WLD = 1032, LGLD = 33;
    LAS bf16* WrB = (LAS bf16*)F.lds;
    LAS float* LG = (LAS float*)(F.lds + 66560);
    LAS unsigned* cntL = F.LC + LC_CNT; LAS unsigned* baseL = F.LC + LC_BASE; LAS unsigned* rec = F.LC + LC_REC;
    const float* Wr = a->in[35] + (size_t)l * 1024 * 32; const float* rb = a->in[36] + l * 32;
    const float* g1 = a->in[33] + l * 1024; const float* b1 = a->in[34] + l * 1024;
    const bf16* PRE = (const bf16*)(F.ws + WS_PRE); bf16* X1B = (bf16*)(F.ws + WS_X1B);
    bf16* XSV = (bf16*)(F.ws + WS_XSV); unsigned* TREC = (unsigned*)(F.ws + WS_TREC); float* GATE = (float*)(F.ws + WS_GATE);
    for (int i4 = F.tid; i4 < 1024 * 8; i4 += NTHR) { const int c = i4 & 1023, e4 = i4 >> 10; const f32x4 w4 = *(const f32x4*)(Wr + c * 32 + 4 * e4);
        WrB[(4 * e4 + 0) * WLD + c] = (bf16)f2bf(w4[0]); WrB[(4 * e4 + 1) * WLD + c] = (bf16)f2bf(w4[1]); WrB[(4 * e4 + 2) * WLD + c] = (bf16)f2bf(w4[2]); WrB[(4 * e4 + 3) * WLD + c] = (bf16)f2bf(w4[3]); }
    const int lane = F.lane;
    for (int item = F.vcu; item < M / 64; item += F.G) {
        if (F.tid < 32) cntL[F.tid] = 0u;
        __syncthreads();
        v2u pzn[4];
#pragma unroll
        for (int j = 0; j < 4; ++j) pzn[j] = *(const v2u*)(PRE + (size_t)(item * 64 + F.wave) * D + 4 * lane + 256 * j);
        for (int tl = F.wave; tl < 64; tl += NWAVES) {
            const int t = item * 64 + tl;
            f32x4 v[4], x[4];
#pragma unroll
            for (int j = 0; j < 4; ++j) v[j] = (f32x4){blo(pzn[j].x), bhi(pzn[j].x), blo(pzn[j].y), bhi(pzn[j].y)};
            { const int tn = item * 64 + (tl + NWAVES < 64 ? tl + NWAVES : tl);
#pragma unroll
              for (int j = 0; j < 4; ++j) pzn[j] = *(const v2u*)(PRE + (size_t)tn * D + 4 * lane + 256 * j); }
            ln_row(v, x, g1, b1, lane);
#pragma unroll
            for (int j = 0; j < 4; ++j) { *(v2u*)(X1B + (size_t)t * D + 4 * lane + 256 * j) = (v2u){pk2(x[j].x, x[j].y), pk2(x[j].z, x[j].w)};
                unsigned w8 = __builtin_amdgcn_cvt_pk_fp8_f32(x[j].x * 16.f, x[j].y * 16.f, 0u, false); *(unsigned*)(F.ws + WS_X1B8 + (size_t)t * D + 4 * lane + 256 * j) = __builtin_amdgcn_cvt_pk_fp8_f32(x[j].z * 16.f, x[j].w * 16.f, w8, true); }
        }
        VM_WAIT(); __syncthreads();
        { const int tt = F.wave >> 1, eh = F.wave & 1, tok = lane & 15, quad = lane >> 4;
          const bf16* xr = X1B + (size_t)(item * 64 + 16 * tt + tok) * D + 8 * quad; const LAS bf16* wr_ = WrB + (16 * eh + tok) * WLD + 8 * quad;
          f32x4 acc = (f32x4){0.f, 0.f, 0.f, 0.f};
#pragma unroll
          for (int kb = 0; kb < 4; ++kb) { bf16x8 xf[8];
#pragma unroll
              for (int i = 0; i < 8; ++i) xf[i] = *(const bf16x8*)(xr + 32 * (8 * kb + i));
#pragma unroll
              for (int i = 0; i < 8; ++i) acc = mfma16(*(const LAS bf16x8*)(wr_ + 32 * (8 * kb + i)), xf[i], acc); }
          const f32x4 bb = *(const f32x4*)(rb + 16 * eh + 4 * quad);
#pragma unroll
          for (int j = 0; j < 4; ++j) LG[(16 * tt + tok) * LGLD + 16 * eh + 4 * quad + j] = acc[j] + bb[j]; }
        __syncthreads();
        for (int i2 = 0; i2 < 4; ++i2) {
            const int tl = F.wave * 8 + 2 * i2 + (lane >> 5), myE = lane & 31;
            float logit = LG[tl * LGLD + myE];
            float tv[4]; int ti[4];
#pragma unroll
            for (int k = 0; k < 4; ++k) { float bv = logit; int bi = myE;
#define AMXD(ctrl) { const float ov = dpp_f<ctrl>(bv); const int oi = __builtin_amdgcn_update_dpp(0, bi, ctrl, 0xf, 0xf, true); if (ov > bv || (ov == bv && oi < bi)) { bv = ov; bi = oi; } }
#define AMX(o) { const float ov = shx<o>(bv); const int oi = shx_i<o>(bi); if (ov > bv || (ov == bv && oi < bi)) { bv = ov; bi = oi; } }
                AMXD(0xB1) AMXD(0x4E) AMXD(0x124) AMXD(0x128) AMX(16)
#undef AMX
#undef AMXD
                tv[k] = bv; ti[k] = bi; if (myE == bi) logit = -3.0e38f; }
            const float e1 = __expf(tv[1] - tv[0]), e2 = __expf(tv[2] - tv[0]), e3 = __expf(tv[3] - tv[0]); const float inv = 1.0f / (1.0f + e1 + e2 + e3);
            if (myE < 4) { const int e = (myE == 0) ? ti[0] : (myE == 1 ? ti[1] : (myE == 2 ? ti[2] : ti[3]));
                const float gt = ((myE == 0) ? 1.0f : (myE == 1 ? e1 : (myE == 2 ? e2 : e3))) * inv;
                const unsigned pos = __hip_atomic_fetch_add(&cntL[e], 1u, __ATOMIC_RELAXED, __HIP_MEMORY_SCOPE_WORKGROUP);
                rec[(tl * 4 + myE) * 3 + 0] = (unsigned)e; rec[(tl * 4 + myE) * 3 + 1] = pos; rec[(tl * 4 + myE) * 3 + 2] = __builtin_bit_cast(unsigned, gt); }
        }
        __syncthreads();
        if (F.tid < 32) baseL[F.tid] = __hip_atomic_fetch_add((unsigned*)(F.ctl + CW_CNT + l * 2048 + F.tid * 64), cntL[F.tid], __ATOMIC_RELAXED, __HIP_MEMORY_SCOPE_AGENT);
        __syncthreads();
        if (F.tid < 256) { const int tl = F.tid >> 2, k = F.tid & 3, t = item * 64 + tl; const unsigned e = rec[F.tid * 3], pos = rec[F.tid * 3 + 1] + baseL[rec[F.tid * 3]];
            TREC[(size_t)t * 4 + k] = (e << 20) | pos; GATE[(size_t)t * 4 + k] = __builtin_bit_cast(float, rec[F.tid * 3 + 2]); }
        __syncthreads();
        for (int r0 = F.wave * 4; r0 < 256; r0 += NWAVES * 4) {
            const int t = item * 64 + (r0 >> 2); const GAS v4u* srow = (const GAS v4u*)(X1B + (size_t)t * D); const v4u q0 = srow[lane], q1 = srow[lane + 64];
            v2u f0, f1;
            f0.x = __builtin_amdgcn_cvt_pk_fp8_f32(blo(q0.x) * 16.f, bhi(q0.x) * 16.f, 0u, false); f0.x = __builtin_amdgcn_cvt_pk_fp8_f32(blo(q0.y) * 16.f, bhi(q0.y) * 16.f, f0.x, true);
            f0.y = __builtin_amdgcn_cvt_pk_fp8_f32(blo(q0.z) * 16.f, bhi(q0.z) * 16.f, 0u, false); f0.y = __builtin_amdgcn_cvt_pk_fp8_f32(blo(q0.w) * 16.f, bhi(q0.w) * 16.f, f0.y, true);
            f1.x = __builtin_amdgcn_cvt_pk_fp8_f32(blo(q1.x) * 16.f, bhi(q1.x) * 16.f, 0u, false); f1.x = __builtin_amdgcn_cvt_pk_fp8_f32(blo(q1.y) * 16.f, bhi(q1.y) * 16.f, f1.x, true);
            f1.y = __builtin_amdgcn_cvt_pk_fp8_f32(blo(q1.z) * 16.f, bhi(q1.z) * 16.f, 0u, false); f1.y = __builtin_amdgcn_cvt_pk_fp8_f32(blo(q1.w) * 16.f, bhi(q1.w) * 16.f, f1.y, true);
#pragma unroll
            for (int k = 0; k < 4; ++k) { const unsigned e = rec[(r0 + k) * 3]; const unsigned pos = rec[(r0 + k) * 3 + 1] + baseL[e]; GAS v2u* drow = (GAS v2u*)((unsigned char*)XSV + ((size_t)e * M + pos) * D); drow[lane] = f0; drow[lane + 64] = f1; } }
        __syncthreads();
    }
}
DI void moe_tables(Frame& F, int l) {
    if (F.tid < 32) F.LC[LC_CNT + F.tid] = __hip_atomic_load((unsigned*)(F.ctl + CW_CNT + l * 2048 + F.tid * 64), __ATOMIC_RELAXED, __HIP_MEMORY_SCOPE_AGENT);
    __syncthreads();
    if (F.tid == 0) { unsigned acc = 0; for (int e = 0; e < 32; ++e) { F.LC[LC_PSTART + e] = acc; const unsigned nt = (F.LC[LC_CNT + e] + 255u) >> 8;
#pragma clang loop vectorize(disable) unroll(disable)
            for (unsigned i = 0; i < nt; ++i) F.LC[LC_TILEE + acc + i] = (unsigned)e;
            acc += nt; } F.LC[LC_PSTART + 32] = acc; F.LC[LC_NT] = acc; }
    __syncthreads();
}
DI void phase_gather(Frame& F, int l) {
    moe_tables(F, l);
    const unsigned* SLOT = (const unsigned*)(F.ws + WS_SLOT); const bf16* X1B = (const bf16*)(F.ws + WS_X1B); bf16* XS = (bf16*)(F.ws + WS_XS);
    const int nrows = (int)F.LC[LC_NT] * 256;
    for (int row = F.gw; row < nrows; row += F.NGW) {
        const int mt = row >> 8; const int e = (int)F.LC[LC_TILEE + mt]; const int pos = row - (int)F.LC[LC_PSTART + e] * 256;
        if (pos < (int)F.LC[LC_CNT + e]) { const unsigned t = SLOT[(size_t)e * M + pos];
            const GAS v4u* s = (const GAS v4u*)(X1B + (size_t)t * D); GAS v4u* d = (GAS v4u*)(XS + (size_t)row * D);
            d[F.lane] = s[F.lane]; d[F.lane + 64] = s[F.lane + 64]; }
    }
}
DI void phase_combine_ln2(Frame& F, KA a, int l) {
    moe_tables(F, l);
    const bf16* X1B = (const bf16*)(F.ws + WS_X1B); const unsigned* TREC = (const unsigned*)(F.ws + WS_TREC); const float* GATE = (const float*)(F.ws + WS_GATE);
    const unsigned char* YS = F.ws + WS_YS;     const bf16* PLEG = (const bf16*)(F.ws + WS_PLEG);
    bf16* XB = (bf16*)(F.ws + WS_XB);
    const float* g2 = a->in[43] + l * 1024; const float* b2 = a->in[44] + l * 1024; const int lane = F.lane;
    struct Tok { v2u xz[4], pz[4]; unsigned yz[4][4]; float gt[4]; };
    auto issue = [&](Tok& T, int t, const unsigned (&rr)[4], const float (&gg)[4]) {
#pragma unroll
        for (int j = 0; j < 4; ++j) { T.xz[j] = *(const v2u*)(X1B + (size_t)t * D + 4 * lane + 256 * j); T.pz[j] = *(const v2u*)(PLEG + (size_t)t * D + 4 * lane + 256 * j); }
#pragma unroll
        for (int k = 0; k < 4; ++k) { const size_t row = (size_t)F.LC[LC_PSTART + (rr[k] >> 20)] * 256 + (rr[k] & 0xfffffu); T.gt[k] = gg[k];
#pragma unroll
            for (int j = 0; j < 4; ++j) T.yz[k][j] = *(const unsigned*)(YS + row * D + 4 * lane + 256 * j); } };
    const int t0 = F.gw, nt = (M - t0 + F.NGW - 1) / F.NGW;
    unsigned r1[4], r2[4]; float g1_[4], g2_[4];
#pragma unroll
    for (int k = 0; k < 4; ++k) { r1[k] = TREC[(size_t)t0 * 4 + k]; g1_[k] = GATE[(size_t)t0 * 4 + k]; const int tb = (nt > 1) ? t0 + F.NGW : t0; r2[k] = TREC[(size_t)tb * 4 + k]; g2_[k] = GATE[(size_t)tb * 4 + k]; }
    Tok cur, nxt;
    issue(cur, t0, r1, g1_);
#pragma unroll 1
    for (int i = 0; i < nt; ++i) {
        const int t = t0 + i * F.NGW;
        if (i + 1 < nt) issue(nxt, t + F.NGW, r2, g2_);
        { const int tc = (i + 2 < nt) ? t + 2 * F.NGW : t;
#pragma unroll
          for (int k = 0; k < 4; ++k) { r2[k] = TREC[(size_t)tc * 4 + k]; g2_[k] = GATE[(size_t)tc * 4 + k]; } }
        f32x4 v[4], x[4];
#pragma unroll
        for (int j = 0; j < 4; ++j) v[j] = (f32x4){blo(cur.xz[j].x), bhi(cur.xz[j].x), blo(cur.xz[j].y), bhi(cur.xz[j].y)} * ALPHA + (f32x4){blo(cur.pz[j].x), bhi(cur.pz[j].x), blo(cur.pz[j].y), bhi(cur.pz[j].y)};
#pragma unroll
        for (int k = 0; k < 4; ++k)
#pragma unroll
            for (int j = 0; j < 4; ++j) { const unsigned yw = cur.yz[k][j]; const f32x2 ylo = __builtin_amdgcn_cvt_pk_f32_fp8(yw, false), yhi = __builtin_amdgcn_cvt_pk_f32_fp8(yw, true);
                v[j] = v[j] + (f32x4){ylo[0], ylo[1], yhi[0], yhi[1]} * (cur.gt[k] * (1.0f / 64.0f)); }
        ln_row(v, x, g2, b2, lane);
        if (l == NL - 1) {
#pragma unroll
            for (int j = 0; j < 4; ++j) *(f32x4*)(a->out + (size_t)t * D + 4 * lane + 256 * j) = x[j];
        } else {
#pragma unroll
            for (int j = 0; j < 4; ++j) { *(v2u*)(XB + (size_t)t * D + 4 * lane + 256 * j) = (v2u){pk2(x[j].x, x[j].y), pk2(x[j].z, x[j].w)};
                unsigned w8 = __builtin_amdgcn_cvt_pk_fp8_f32(x[j].x * 16.f, x[j].y * 16.f, 0u, false); *(unsigned*)(F.ws + WS_XB8 + (size_t)t * D + 4 * lane + 256 * j) = __builtin_amdgcn_cvt_pk_fp8_f32(x[j].z * 16.f, x[j].w * 16.f, w8, true); }
        }
        cur = nxt;
    }
}

constexpr int PH_PER_LAYER = 12, N_PHASES = 2 + NL * PH_PER_LAYER;
__global__ void __launch_bounds__(NTHR, 2) mega_fwd(Args args) {
    extern __shared__ __attribute__((aligned(16))) unsigned char lds_raw[];
    Frame F;
    F.lds = (LAS unsigned char*)lds_raw; F.LC = (LAS unsigned*)(F.lds + LDSCTL_OFF);
    F.G = gridDim.x; { const int bx = blockIdx.x; F.vcu = (F.G % 8 == 0) ? (bx % 8) * (F.G / 8) + bx / 8 : bx; }
    F.NGW = F.G * NWAVES; F.wave = __builtin_amdgcn_readfirstlane((int)threadIdx.x >> 6); rebind(F);
    F.ws = args.ws; F.ctl = (gu32*)(args.ws + WS_CTL);
    KA ap = (KA)__builtin_amdgcn_kernarg_segment_ptr();
#define PHASE_BEGIN() do { ap = (KA)__builtin_amdgcn_kernarg_segment_ptr(); asm volatile("" : "+s"(ap)); F.ws = ap->ws; F.ctl = (gu32*)(F.ws + WS_CTL); rebind(F); } while (0)
#pragma clang loop vectorize(disable) unroll(disable)
    for (int u = F.tid; u < LDSCTL_BYTES / 4; u += NTHR) F.LC[u] = 0u;
    __syncthreads();
    const int lo = args.ph_lo, hi = args.ph_hi;
    const bool multi = (hi - lo) > 1;
    XcdBarrier bar; bar.bar = (unsigned*)(F.ctl + CW_BAR); bar.x = 0; bar.st = nullptr;
    if (multi) bar = xcd_barrier_post((unsigned*)(F.ctl + CW_BAR), (volatile LAS unsigned*)(F.LC + LC_BAR));
#ifndef PHMASK
#define PHMASK 0xffffffffu
#endif
#ifndef DUPMASK
#define DUPMASK 0x0u
#endif
#define EN(j) ((PHMASK >> (j)) & 1u)
#define DUP(j) ((DUPMASK >> (j)) & 1u)
#define IN(k) (lo <= (k) && (k) < hi)
#define SEAM(k) do { if (IN(k) && IN((k) + 1)) xcd_barrier(bar); } while (0)
    LAS unsigned char* ring = F.lds;

    PHASE_BEGIN(); if (EN(0) && IN(0)) { p0_convert(F, ap); if (DUP(0)) { __syncthreads(); p0_convert(F, ap); } } SEAM(0);
    PHASE_BEGIN(); if (EN(1) && IN(1)) { for (int rep_ = 0; rep_ < 1 + (int)DUP(1); ++rep_) { if (rep_) __syncthreads();
        pg8::Gemm g{(const bf16*)(F.ws + WS_PB), (const bf16*)(F.ws + WS_WPP), NL * M, NL * 1024, DPLE};
        pg8::LayerGroupOrder S{F.G, (int)blockIdx.x};
        pg8::EpiB16<4> E{(bf16*)(F.ws + WS_PP), 1024, nullptr};
        pg8::gemm_phase<pg8::EpiB16<4>, pg8::LayerGroupOrder, PG8_ALIGN, PG8_SP2>(ring, g, S, E, F.tid); }
    } SEAM(1);

    for (int l = 0; l < NL; ++l) {
        const int pb = 2 + l * PH_PER_LAYER;
        PHASE_BEGIN(); if (EN(2) && IN(pb + 0)) { for (int rep_ = 0; rep_ < 1 + (int)DUP(2); ++rep_) { if (rep_) __syncthreads();
            { pg8::Gemm g{(const bf16*)(F.ws + WS_XB8), (const bf16*)(F.ws + WS_WIN8 + (size_t)l * 4096 * 1024), M, 4096, D / 2};
              pg8::StaticOrder S; S.init(M, 4096, F.G, (int)blockIdx.x);
              pg8::EpiGate8 E{F.ws + WS_MF};
              pg8::gemm_phase<pg8::EpiGate8, pg8::StaticOrder, PG8_ALIGN, PG8_SP2, true, 0x79, 0x7b>(ring, g, S, E, F.tid); }
            { pg8::Gemm g{(const bf16*)(F.ws + WS_XB), (const bf16*)(F.ws + WS_WIN) + (size_t)l * ZLD * 1024, M, ZG, D};
              pg8::StaticOrder S; S.init(M, ZG, F.G, (int)blockIdx.x);
              pg8::EpiB16<0> E{(bf16*)(F.ws + WS_Z), ZLD, nullptr};
              pg8::gemm_phase<pg8::EpiB16<0>, pg8::StaticOrder, PG8_ALIGN, PG8_SP2>(ring, g, S, E, F.tid); } }
        } SEAM(pb + 0);
        PHASE_BEGIN(); if (EN(3) && IN(pb + 1)) { phase_prep(F, ap, l); if (DUP(3)) { __syncthreads(); phase_prep(F, ap, l); } } SEAM(pb + 1);
        PHASE_BEGIN(); if (EN(14) && IN(pb + 2)) { phase_chunkprep(F, ap, l); if (DUP(14)) { __syncthreads(); phase_chunkprep(F, ap, l); } } SEAM(pb + 2);
        PHASE_BEGIN(); if (EN(4) && IN(pb + 3)) { phase_scan(F, ap, l); if (DUP(4)) { __syncthreads(); phase_scan(F, ap, l); } } SEAM(pb + 3);
        PHASE_BEGIN(); if (EN(5) && IN(pb + 4)) { phase_post(F, ap, l); if (DUP(5)) { __syncthreads(); phase_post(F, ap, l); } } SEAM(pb + 4);
        PHASE_BEGIN(); if (EN(6) && IN(pb + 5)) { for (int rep_ = 0; rep_ < 1 + (int)DUP(6); ++rep_) { if (rep_) __syncthreads();
            pg8::Gemm g{(const bf16*)(F.ws + WS_Y), (const bf16*)(F.ws + WS_WBR + (size_t)l * 4 * 1024 * 512), 4 * M, 4 * 1024, W / 2};
            pg8::BranchOrder S; S.base.init(M, D, F.G, (int)blockIdx.x);
            pg8::EpiBranch E{F.ws + WS_MF, F.ws + WS_MB};
            pg8::gemm_phase<pg8::EpiBranch, pg8::BranchOrder, PG8_ALIGN, PG8_SP2, true, 0x79, 0x7c>(ring, g, S, E, F.tid); }
        } SEAM(pb + 5);
        PHASE_BEGIN(); if (EN(7) && IN(pb + 6)) { for (int rep_ = 0; rep_ < 1 + (int)DUP(7); ++rep_) { if (rep_) __syncthreads();
            pg8::Gemm g{(const bf16*)(F.ws + WS_MB), (const bf16*)(F.ws + WS_WOUT + (size_t)l * 1024 * 1024), M, D, D / 2};
            pg8::StaticOrder S; S.init(M, D, F.G, (int)blockIdx.x);
            pg8::EpiWout E{(const bf16*)(F.ws + WS_XB), (bf16*)(F.ws + WS_PRE), ALPHA};
            pg8::gemm_phase<pg8::EpiWout, pg8::StaticOrder, PG8_ALIGN, PG8_SP2, true, 0x79, 0x7b>(ring, g, S, E, F.tid); }
        } SEAM(pb + 6);
        PHASE_BEGIN(); if (EN(8) && IN(pb + 7)) { phase_ln1_router(F, ap, l); } SEAM(pb + 7);
        PHASE_BEGIN(); if (EN(10) && IN(pb + 8)) { for (int rep_ = 0; rep_ < 1 + (int)DUP(10); ++rep_) { if (rep_) __syncthreads();
            moe_tables(F, l);
            { pg8::Gemm g{(const bf16*)(F.ws + WS_XSV), (const bf16*)(F.ws + WS_WGU + (size_t)l * NE * 2048 * 1024), NE * M, NE * 2048, D / 2};
              pg8::MoeOrder<8, true> S{(const LAS int*)(F.LC + LC_TILEE), (const LAS int*)(F.LC + LC_PSTART), __builtin_amdgcn_readfirstlane((int)F.LC[LC_NT]), F.G, F.vcu};
              pg8::EpiGU E{(bf16*)(F.ws + WS_H), ap->in[38] + (size_t)l * NE * 2048};
              pg8::gemm_phase<pg8::EpiGU, pg8::MoeOrder<8, true>, PG8_ALIGN, PG8_SP2, true, 0x79, 0x7b>(ring, g, S, E, F.tid);     } }
        }
        PHASE_BEGIN(); if (EN(13) && IN(pb + 9)) { for (int rep_ = 0; rep_ < 1 + (int)DUP(13); ++rep_) { if (rep_) __syncthreads();
            { pg8::Gemm g{(const bf16*)(F.ws + WS_X1B8), (const bf16*)(F.ws + WS_WPG8 + (size_t)l * 1024 * 1024), M, D, D / 2};
              pg8::StaticOrder S; S.init(M, D, F.G, (int)blockIdx.x);
              pg8::EpiPle E{(const bf16*)(F.ws + WS_PP) + (size_t)l * M * 1024, (bf16*)(F.ws + WS_PLEG)};
              pg8::gemm_phase<pg8::EpiPle, pg8::StaticOrder, PG8_ALIGN, PG8_SP2, true, 0x79, 0x7b>(ring, g, S, E, F.tid); } }
        } SEAM(pb + 9);
        PHASE_BEGIN(); if (EN(11) && IN(pb + 10)) { for (int rep_ = 0; rep_ < 1 + (int)DUP(11); ++rep_) { if (rep_) __syncthreads();
            moe_tables(F, l);
            pg8::Gemm g{(const bf16*)(F.ws + WS_H), (const bf16*)(F.ws + WS_WDN + (size_t)l * NE * 1024 * 1024), MOE_ROWS, NE * 1024, D / 2};
            pg8::MoeOrder<4, false> S{(const LAS int*)(F.LC + LC_TILEE), (const LAS int*)(F.LC + LC_PSTART), __builtin_amdgcn_readfirstlane((int)F.LC[LC_NT]), F.G, F.vcu};
            pg8::EpiYS8 E{F.ws + WS_YS, ap->in[40] + (size_t)l * NE * 1024};
            pg8::gemm_phase<pg8::EpiYS8, pg8::MoeOrder<4, false>, PG8_ALIGN, PG8_SP2, true, 0x79, 0x7d>(ring, g, S, E, F.tid);     }
        } SEAM(pb + 10);
        PHASE_BEGIN(); if (EN(12) && IN(pb + 11)) { phase_combine_ln2(F, ap, l); if (DUP(12)) { __syncthreads(); phase_combine_ln2(F, ap, l); } } SEAM(pb + 11);
    }
#undef IN
#undef SEAM
}

#ifndef MK_ONE_LAUNCH
#define MK_ONE_LAUNCH 1
#endif
extern "C" void kernel_launch(void* const* d_in, const int* in_sizes, int n_in, void* d_out, int out_size, void* d_ws, size_t ws_size, hipStream_t stream) {
    static int grid = 0;
    if (grid == 0) {
        if (n_in != 45 || out_size != M * D || ws_size < WS_END) { fprintf(stderr, "kernel_launch: unexpected problem (n_in %d, out %d, ws %zu)\n", n_in, out_size, ws_size); grid = -1; return; }
        int dev = 0, cus = 0, per_cu = 0;
        if (hipGetDevice(&dev) != hipSuccess || hipDeviceGetAttribute(&cus, hipDeviceAttributeMultiprocessorCount, dev) != hipSuccess) { grid = -1; return; }
        if (hipFuncSetAttribute((const void*)mega_fwd, hipFuncAttributeMaxDynamicSharedMemorySize, LDS_BYTES) != hipSuccess) { fprintf(stderr, "kernel_launch: hipFuncSetAttribute failed\n"); grid = -1; return; }
        if (hipOccupancyMaxActiveBlocksPerMultiprocessor(&per_cu, (const void*)mega_fwd, NTHR, LDS_BYTES) != hipSuccess || per_cu < 1) fprintf(stderr, "kernel_launch: occupancy query says %d\n", per_cu);
        (void)hipGetLastError();
        grid = cus;
    }
    if (grid < 0) return;
    if (hipMemsetAsync((char*)d_ws + WS_CTL, 0, CTL_ZERO_BYTES, stream) != hipSuccess) return;
    Args a{};
    for (int i = 0; i < 45; ++i) a.in[i] = (const float*)d_in[i];
    a.out = (float*)d_out; a.ws = (unsigned char*)d_ws;
#if MK_ONE_LAUNCH
    a.ph_lo = 0; a.ph_hi = N_PHASES;
    hipLaunchKernelGGL(mega_fwd, dim3(grid), dim3(NTHR), LDS_BYTES, stream, a);
#else
    for (int ph = 0; ph < N_PHASES; ++ph) { a.ph_lo = ph; a.ph_hi = ph + 1; hipLaunchKernelGGL(mega_fwd, dim3(grid), dim3(NTHR), LDS_BYTES, stream, a); }
#endif
}
```

```cpp
#include <hip/hip_runtime.h>
#include <cstdio>
#include <cstdint>
namespace pg8 {
#define PG8_LAS __attribute__((address_space(3)))
typedef unsigned short bf16_t;
typedef short bf16x8 __attribute__((ext_vector_type(8)));
typedef float f32x4 __attribute__((ext_vector_type(4)));
typedef unsigned u32x4 __attribute__((ext_vector_type(4)));
constexpr int BM = 256, BK = 64, HALF = 128, HTB = HALF * BK * 2  , STAGE_BYTES = 8 * HTB, NXCD = 8, WGM = 8;

__host__ __device__ __forceinline__ int lds_byte(int r, int c) { const int st = (r >> 4) * 2 + (c >> 5), rr = r & 15, cc = c & 31, ob = rr * 64 + cc * 2; return st * 1024 + (ob ^ (((ob >> 9) & 1) << 5)); }
__host__ __device__ __forceinline__ void stage_rc(int b, int& R, int& C) { const int st = b / 1024, sb = b % 1024, swz = sb ^ (((sb >> 9) & 1) << 5); R = (st >> 1) * 16 + swz / 64; C = (st & 1) * 32 + (swz % 64) / 2; }
__host__ __device__ __forceinline__ int perm32(int rho) { const int n = rho >> 4, i = rho & 15; return 8 * (i >> 2) + 4 * n + (i & 3); }

struct Unit { int pm, pn, po; };
struct Gemm { const bf16_t* A; const bf16_t* Bt; int M, N, K; };

struct StaticOrder {
    int nM, nN, nwg, G, c;
    __host__ __device__ void init(int M, int N, int G_, int c_) { nM = M / BM; nN = N / BM; nwg = nM * nN; G = G_; c = c_; }
    __host__ __device__ bool next(int i, Unit& u) const {
        const long L = (long)i * G + c; if (L >= nwg) return false;
        int wgid = (int)L; { const int q = nwg / NXCD, r = nwg % NXCD, xcd = wgid % NXCD, off = wgid / NXCD; wgid = (xcd < r ? xcd * (q + 1) : r * (q + 1) + (xcd - r) * q) + off; }
        const int nig = WGM * nN, gid = wgid / nig, fm = gid * WGM, gsz = (nM - fm) < WGM ? (nM - fm) : WGM;
        u.pm = fm + ((wgid % nig) % gsz); u.pn = (wgid % nig) / gsz; return true;
    }
    __device__ __forceinline__ void a_ready(const Unit&) const {}
    __device__ __forceinline__ void done(const Unit&) const {}
};

__device__ __forceinline__ unsigned cvt_pk_bf16(float lo, float hi) { unsigned r; asm volatile("v_cvt_pk_bf16_f32 %0, %1, %2" : "=v"(r) : "v"(lo), "v"(hi)); return r; }
typedef float f32x2 __attribute__((ext_vector_type(2)));
__device__ __forceinline__ int lane_id_fresh() { int l; asm volatile("v_mbcnt_lo_u32_b32 %0, -1, 0\n\tv_mbcnt_hi_u32_b32 %0, -1, %0" : "=v"(l)); return l; }
__device__ __forceinline__ f32x2 gelu_pk(f32x2 v) {
    const f32x2 av = __builtin_elementwise_abs(v), d = av * 0.2316418882f + 1.0f;
    f32x2 t; t.x = __builtin_amdgcn_rcpf(d.x); t.y = __builtin_amdgcn_rcpf(d.y);
    f32x2 q = t * 0.5307027145f + (-0.7265760135f); q = q * t + 0.7107068705f; q = q * t + (-0.142248368f); q = q * t + 0.127414796f; q = q * t;
    const f32x2 s = (v * v) * (-0.72134752044f);
    f32x2 e; e.x = __builtin_amdgcn_exp2f(s.x); e.y = __builtin_amdgcn_exp2f(s.y);
    const f32x2 m = v * (q * e), r = v - m;
    f32x2 o; o.x = v.x < 0.f ? m.x : r.x; o.y = v.y < 0.f ? m.y : r.y; return o;
}

template <int ACT  > struct EpiBf16 {
    static constexpr bool PERM = true, AFTER_DRAIN = false; static_assert(ACT == 0 || ACT == 1, "EpiBf16: ACT is 0 (none) or 1 (gelu_pk)");
    bf16_t* O; int ldc; const float* bias; int split_cols; size_t split_stride; float scale0;
    __device__ __forceinline__ void operator()(const f32x4 (&acc)[2][2][4][2], const Unit& u, int wr, int wc, int fr, int fq) const {
        const int row0 = u.pm * BM + wr * 64 + fr; int colt = u.pn * BM; bf16_t* base = O;
        float sc = 1.f; if (split_cols) { const int t = colt / split_cols; base += (size_t)t * split_stride; colt -= t * split_cols; if (t == 0) sc = scale0; }
        const int col0 = colt + wc * 32 + 8 * fq, bcol0 = u.pn * BM + wc * 32 + 8 * fq;
        f32x4 bv[2][2];
#pragma unroll
        for (int bj = 0; bj < 2; ++bj)
#pragma unroll
            for (int n = 0; n < 2; ++n) bv[bj][n] = bias ? *(const f32x4*)(bias + bcol0 + bj * HALF + 4 * n) : (f32x4){0.f, 0.f, 0.f, 0.f};
#pragma unroll
        for (int ai = 0; ai < 2; ++ai)
#pragma unroll
            for (int m = 0; m < 4; ++m) { bf16_t* rowp = base + (size_t)(row0 + ai * HALF + m * 16) * ldc + col0;
#pragma unroll
                for (int bj = 0; bj < 2; ++bj) { f32x4 v0 = acc[ai][bj][m][0] + bv[bj][0], v1 = acc[ai][bj][m][1] + bv[bj][1];
                    if (ACT == 1) { f32x2 a = gelu_pk((f32x2){v0[0], v0[1]}), b = gelu_pk((f32x2){v0[2], v0[3]}), c = gelu_pk((f32x2){v1[0], v1[1]}), d = gelu_pk((f32x2){v1[2], v1[3]});
                        v0 = (f32x4){a.x, a.y, b.x, b.y}; v1 = (f32x4){c.x, c.y, d.x, d.y}; }
                    v0 = v0 * sc; v1 = v1 * sc; u32x4 w; w.x = cvt_pk_bf16(v0[0], v0[1]); w.y = cvt_pk_bf16(v0[2], v0[3]); w.z = cvt_pk_bf16(v1[0], v1[1]); w.w = cvt_pk_bf16(v1[2], v1[3]);
                    *(u32x4*)(rowp + bj * HALF) = w; } }
    }
};


constexpr int ZLD = 11264;
__device__ __forceinline__ float bflo(unsigned w) { return __builtin_bit_cast(float, w << 16); }
__device__ __forceinline__ float bfhi(unsigned w) { return __builtin_bit_cast(float, w & 0xffff0000u); }
__device__ __forceinline__ float sigm(float x) { return __builtin_amdgcn_rcpf(1.0f + __expf(-x)); }
__device__ __forceinline__ float clamp8(float x) { return __builtin_fminf(__builtin_fmaxf(x, -448.0f), 448.0f); }

struct EpiBranch {
    static constexpr bool PERM = true, AFTER_DRAIN = false, KEEP_ACC = true;
    const unsigned char* G8; unsigned char* MB8;
    __device__ __forceinline__ void operator()(f32x4 (&acc)[2][2][4][2], const Unit& u, int wr, int wc, int fr, int fq) const {
        const int n = u.pn >> 2, pn = u.pn & 3, pm = u.pm & 63;
        const int row0 = pm * BM + wr * 64 + fr, col0 = pn * BM + wc * 32 + 8 * fq;
        typedef unsigned u32x2b_ __attribute__((ext_vector_type(2)));
#pragma unroll
        for (int ai = 0; ai < 2; ++ai)
#pragma unroll
            for (int m = 0; m < 4; ++m) { const size_t row = (size_t)(row0 + ai * HALF + m * 16);
#pragma unroll
                for (int bj = 0; bj < 2; ++bj) { const int c = col0 + bj * HALF;
                    const unsigned char* gp = G8 + row * 4096 + n * 1024 + c;
                    const u32x2b_ gq = *(const u32x2b_*)gp;
                    f32x4 s0 = (f32x4){(float)(gq.x & 255u), (float)((gq.x >> 8) & 255u), (float)((gq.x >> 16) & 255u), (float)(gq.x >> 24)}, s1 = (f32x4){(float)(gq.y & 255u), (float)((gq.y >> 8) & 255u), (float)((gq.y >> 16) & 255u), (float)(gq.y >> 24)};
                    if (n < 3) { const u32x2b_ hq = *(const u32x2b_*)(gp + 1024);
                        s0[0] *= __builtin_amdgcn_rcpf((float)(hq.x & 255u)); s0[1] *= __builtin_amdgcn_rcpf((float)((hq.x >> 8) & 255u)); s0[2] *= __builtin_amdgcn_rcpf((float)((hq.x >> 16) & 255u)); s0[3] *= __builtin_amdgcn_rcpf((float)(hq.x >> 24));
                        s1[0] *= __builtin_amdgcn_rcpf((float)(hq.y & 255u)); s1[1] *= __builtin_amdgcn_rcpf((float)((hq.y >> 8) & 255u)); s1[2] *= __builtin_amdgcn_rcpf((float)((hq.y >> 16) & 255u)); s1[3] *= __builtin_amdgcn_rcpf((float)(hq.y >> 24));
                        acc[ai][bj][m][0] = acc[ai][bj][m][0] * s0; acc[ai][bj][m][1] = acc[ai][bj][m][1] * s1; }
                    else { const f32x4 v0 = acc[ai][bj][m][0] * s0 * (16.0f / 255.0f), v1 = acc[ai][bj][m][1] * s1 * (16.0f / 255.0f);
                        unsigned w0 = 0u, w1 = 0u;
                        w0 = __builtin_amdgcn_cvt_pk_fp8_f32(clamp8(v0[0]), clamp8(v0[1]), w0, false); w0 = __builtin_amdgcn_cvt_pk_fp8_f32(clamp8(v0[2]), clamp8(v0[3]), w0, true);
                        w1 = __builtin_amdgcn_cvt_pk_fp8_f32(clamp8(v1[0]), clamp8(v1[1]), w1, false); w1 = __builtin_amdgcn_cvt_pk_fp8_f32(clamp8(v1[2]), clamp8(v1[3]), w1, true);
                        *(u32x2b_*)(MB8 + row * 1024 + c) = (u32x2b_){w0, w1};
                        acc[ai][bj][m][0] = (f32x4){0.f, 0.f, 0.f, 0.f}; acc[ai][bj][m][1] = (f32x4){0.f, 0.f, 0.f, 0.f}; } } }
    }
};
struct EpiGate8 {
    static constexpr bool PERM = true, AFTER_DRAIN = false;
    unsigned char* G8;
    __device__ __forceinline__ void operator()(const f32x4 (&acc)[2][2][4][2], const Unit& u, int wr, int wc, int fr, int fq) const {
        const int row0 = u.pm * BM + wr * 64 + fr, col0 = u.pn * BM + wc * 32 + 8 * fq;
        typedef unsigned u32x2b_ __attribute__((ext_vector_type(2)));
#pragma unroll
        for (int ai = 0; ai < 2; ++ai)
#pragma unroll
            for (int m = 0; m < 4; ++m) { unsigned char* rowp = G8 + (size_t)(row0 + ai * HALF + m * 16) * 4096 + col0;
#pragma unroll
                for (int bj = 0; bj < 2; ++bj) { const f32x4 v0 = acc[ai][bj][m][0], v1 = acc[ai][bj][m][1]; unsigned q[8];
#pragma unroll
                    for (int i = 0; i < 4; ++i) { q[i] = (unsigned)__builtin_fmaxf(255.0f * sigm(v0[i]) + 0.5f, 1.0f); q[4 + i] = (unsigned)__builtin_fmaxf(255.0f * sigm(v1[i]) + 0.5f, 1.0f); }
                    *(u32x2b_*)(rowp + bj * HALF) = (u32x2b_){q[0] | (q[1] << 8) | (q[2] << 16) | (q[3] << 24), q[4] | (q[5] << 8) | (q[6] << 16) | (q[7] << 24)}; } }
    }
};
struct EpiWout {
    static constexpr bool PERM = true, AFTER_DRAIN = false;
    const bf16_t* XB; bf16_t* PRE; float alpha;
    __device__ __forceinline__ void operator()(const f32x4 (&acc)[2][2][4][2], const Unit& u, int wr, int wc, int fr, int fq) const {
        const int row0 = u.pm * BM + wr * 64 + fr, col0 = u.pn * BM + wc * 32 + 8 * fq;
#pragma unroll
        for (int ai = 0; ai < 2; ++ai)
#pragma unroll
            for (int m = 0; m < 4; ++m) { const size_t ro = (size_t)(row0 + ai * HALF + m * 16) * 1024 + col0;
#pragma unroll
                for (int bj = 0; bj < 2; ++bj) { const u32x4 xz = *(const u32x4*)(XB + ro + bj * HALF); const f32x4 v0 = acc[ai][bj][m][0], v1 = acc[ai][bj][m][1];
                    u32x4 w; w.x = cvt_pk_bf16(bflo(xz.x) * alpha + v0[0], bfhi(xz.x) * alpha + v0[1]); w.y = cvt_pk_bf16(bflo(xz.y) * alpha + v0[2], bfhi(xz.y) * alpha + v0[3]);
                    w.z = cvt_pk_bf16(bflo(xz.z) * alpha + v1[0], bfhi(xz.z) * alpha + v1[1]); w.w = cvt_pk_bf16(bflo(xz.w) * alpha + v1[2], bfhi(xz.w) * alpha + v1[3]);
                    *(u32x4*)(PRE + ro + bj * HALF) = w; } }
    }
};
struct EpiGU {
    static constexpr bool PERM = true, AFTER_DRAIN = false;
    bf16_t* H; const float* bgu;
    __device__ __forceinline__ void operator()(const f32x4 (&acc)[2][2][4][2], const Unit& u, int wr, int wc, int fr, int fq) const {
        const int e = u.pn >> 3, j = u.pn & 7;
        const int row0 = u.po * BM + wr * 64 + fr, cl = j * 128 + wc * 32 + 8 * fq;
        const float* bg = bgu + (size_t)e * 2048 + cl; const float* bu = bg + 1024;
        const f32x4 bg0 = *(const f32x4*)bg, bg1 = *(const f32x4*)(bg + 4), bu0 = *(const f32x4*)bu, bu1 = *(const f32x4*)(bu + 4);
#pragma unroll
        for (int ai = 0; ai < 2; ++ai)
#pragma unroll
            for (int m = 0; m < 4; ++m) { const size_t row = (size_t)(row0 + ai * HALF + m * 16);
                f32x4 g0 = acc[ai][0][m][0] + bg0, g1 = acc[ai][0][m][1] + bg1, u0 = acc[ai][1][m][0] + bu0, u1 = acc[ai][1][m][1] + bu1;
                f32x4 h0, h1;
#pragma unroll
                for (int i = 0; i < 4; ++i) {
                    const float ga = fminf(g0[i], 7.0f), ua = fminf(fmaxf(u0[i], -7.0f), 7.0f); h0[i] = (ua + 1.0f) * ga * sigm(1.702f * ga);
                    const float gb = fminf(g1[i], 7.0f), ub = fminf(fmaxf(u1[i], -7.0f), 7.0f); h1[i] = (ub + 1.0f) * gb * sigm(1.702f * gb); }
                unsigned w0 = 0u, w1 = 0u;
                w0 = __builtin_amdgcn_cvt_pk_fp8_f32(h0[0] * 4.f, h0[1] * 4.f, w0, false); w0 = __builtin_amdgcn_cvt_pk_fp8_f32(h0[2] * 4.f, h0[3] * 4.f, w0, true);
                w1 = __builtin_amdgcn_cvt_pk_fp8_f32(h1[0] * 4.f, h1[1] * 4.f, w1, false); w1 = __builtin_amdgcn_cvt_pk_fp8_f32(h1[2] * 4.f, h1[3] * 4.f, w1, true);
                typedef unsigned u32x2_ __attribute__((ext_vector_type(2)));
                *(u32x2_*)((unsigned char*)H + row * 1024 + cl) = (u32x2_){w0, w1}; }
    }
};
struct EpiPle {
    static constexpr bool PERM = true, AFTER_DRAIN = false;
    const bf16_t* PP; bf16_t* PLEG;
    __device__ __forceinline__ void operator()(const f32x4 (&acc)[2][2][4][2], const Unit& u, int wr, int wc, int fr, int fq) const {
        const int row0 = u.pm * BM + wr * 64 + fr, col0 = u.pn * BM + wc * 32 + 8 * fq;
#pragma unroll
        for (int ai = 0; ai < 2; ++ai)
#pragma unroll
            for (int m = 0; m < 4; ++m) { const size_t ro = (size_t)(row0 + ai * HALF + m * 16) * 1024 + col0;
#pragma unroll
                for (int bj = 0; bj < 2; ++bj) { const u32x4 pz = *(const u32x4*)(PP + ro + bj * HALF);
                    const f32x4 v0 = acc[ai][bj][m][0], v1 = acc[ai][bj][m][1];
                    u32x4 w; w.x = cvt_pk_bf16(sigm(v0[0]) * bflo(pz.x), sigm(v0[1]) * bfhi(pz.x)); w.y = cvt_pk_bf16(sigm(v0[2]) * bflo(pz.y), sigm(v0[3]) * bfhi(pz.y));
                    w.z = cvt_pk_bf16(sigm(v1[0]) * bflo(pz.z), sigm(v1[1]) * bfhi(pz.z)); w.w = cvt_pk_bf16(sigm(v1[2]) * bflo(pz.w), sigm(v1[3]) * bfhi(pz.w));
                    *(u32x4*)(PLEG + ro + bj * HALF) = w; } }
    }
};

template <int NTN> struct EpiB16 {
    static constexpr bool PERM = true, AFTER_DRAIN = false;
    bf16_t* O; int ldc; const float* bias; int gate_tile0 = 1 << 30;
    __device__ __forceinline__ void operator()(const f32x4 (&acc)[2][2][4][2], const Unit& u, int wr, int wc, int fr, int fq) const {
        const int row0 = u.pm * BM + wr * 64 + fr, col0 = (NTN ? (u.pn % NTN) : u.pn) * BM + wc * 32 + 8 * fq, bcol0 = u.pn * BM + wc * 32 + 8 * fq;
        f32x4 bv[2][2];
#pragma unroll
        for (int bj = 0; bj < 2; ++bj)
#pragma unroll
            for (int n = 0; n < 2; ++n) bv[bj][n] = bias ? *(const f32x4*)(bias + bcol0 + bj * HALF + 4 * n) : (f32x4){0.f, 0.f, 0.f, 0.f};
#pragma unroll
        for (int ai = 0; ai < 2; ++ai)
#pragma unroll
            for (int m = 0; m < 4; ++m) { bf16_t* rowp = O + (size_t)(row0 + ai * HALF + m * 16) * ldc + col0;
#pragma unroll
                for (int bj = 0; bj < 2; ++bj) { f32x4 v0 = acc[ai][bj][m][0] + bv[bj][0], v1 = acc[ai][bj][m][1] + bv[bj][1];
                    if (u.pn >= gate_tile0) {
#pragma unroll
                        for (int i = 0; i < 4; ++i) { v0[i] = 1.0f + __expf(-v0[i]); v1[i] = 1.0f + __expf(-v1[i]); } }
                    u32x4 w; w.x = cvt_pk_bf16(v0[0], v0[1]); w.y = cvt_pk_bf16(v0[2], v0[3]); w.z = cvt_pk_bf16(v1[0], v1[1]); w.w = cvt_pk_bf16(v1[2], v1[3]);
                    *(u32x4*)(rowp + bj * HALF) = w; } }
    }
};
struct EpiYS8 {
    static constexpr bool PERM = true, AFTER_DRAIN = false;
    unsigned char* O; const float* bias;
    __device__ __forceinline__ void operator()(const f32x4 (&acc)[2][2][4][2], const Unit& u, int wr, int wc, int fr, int fq) const {
        const int row0 = u.pm * BM + wr * 64 + fr, col0 = (u.pn & 3) * BM + wc * 32 + 8 * fq, bcol0 = u.pn * BM + wc * 32 + 8 * fq;
        typedef unsigned u32x2b_ __attribute__((ext_vector_type(2)));
        f32x4 bv[2][2];
#pragma unroll
        for (int bj = 0; bj < 2; ++bj)
#pragma unroll
            for (int n = 0; n < 2; ++n) bv[bj][n] = *(const f32x4*)(bias + bcol0 + bj * HALF + 4 * n);
#pragma unroll
        for (int ai = 0; ai < 2; ++ai)
#pragma unroll
            for (int m = 0; m < 4; ++m) { unsigned char* rowp = O + (size_t)(row0 + ai * HALF + m * 16) * 1024 + col0;
#pragma unroll
                for (int bj = 0; bj < 2; ++bj) { const f32x4 v0 = (acc[ai][bj][m][0] + bv[bj][0]) * 64.0f, v1 = (acc[ai][bj][m][1] + bv[bj][1]) * 64.0f;
                    unsigned w0 = 0u, w1 = 0u;
                    w0 = __builtin_amdgcn_cvt_pk_fp8_f32(clamp8(v0[0]), clamp8(v0[1]), w0, false); w0 = __builtin_amdgcn_cvt_pk_fp8_f32(clamp8(v0[2]), clamp8(v0[3]), w0, true);
                    w1 = __builtin_amdgcn_cvt_pk_fp8_f32(clamp8(v1[0]), clamp8(v1[1]), w1, false); w1 = __builtin_amdgcn_cvt_pk_fp8_f32(clamp8(v1[2]), clamp8(v1[3]), w1, true);
                    *(u32x2b_*)(rowp + bj * HALF) = (u32x2b_){w0, w1}; } }
    }
};
struct LayerGroupOrder {
    int G, c;
    __device__ __forceinline__ bool next(int i, Unit& u) const { const int L = i * G + c; if (L >= 1024) return false; const int l = L >> 8, r = L & 255; u.pm = l * 64 + (r >> 2); u.pn = l * 4 + (r & 3); return true; }
    __device__ __forceinline__ void a_ready(const Unit&) const {}
    __device__ __forceinline__ void done(const Unit&) const {}
};
struct BranchOrder {
    StaticOrder base;
    __device__ __forceinline__ bool next(int i, Unit& u) const { Unit b; if (!base.next(i >> 2, b)) return false; const int n = i & 3; u.pm = b.pm + 64 * n; u.pn = b.pn + 4 * n; return true; }
    __device__ __forceinline__ void a_ready(const Unit&) const {}
    __device__ __forceinline__ void done(const Unit&) const {}
};
template <int NT, bool VIRT> struct MoeOrder {
    const PG8_LAS int* tileE; const PG8_LAS int* pstart; int ntiles, G, c;
    __device__ __forceinline__ bool next(int i, Unit& u) const { const int L = i * G + c; if (L >= ntiles * NT) return false; const int mt = L / NT, j = L % NT; const int e = __builtin_amdgcn_readfirstlane(tileE[mt]);
        u.po = mt; u.pm = VIRT ? 64 * e + (mt - __builtin_amdgcn_readfirstlane(pstart[e])) : mt; u.pn = e * NT + j; return true; }
    __device__ __forceinline__ void a_ready(const Unit&) const {}
    __device__ __forceinline__ void done(const Unit&) const {}
};
template <class E, class = void> struct epi_keeps_acc { static constexpr bool value = false; };
template <class E> struct epi_keeps_acc<E, decltype((void)E::KEEP_ACC)> { static constexpr bool value = E::KEEP_ACC; };
typedef int i32x4 __attribute__((ext_vector_type(4))); typedef int i32x8 __attribute__((ext_vector_type(8)));
__device__ __forceinline__ i32x8 cat8(bf16x8 lo, bf16x8 hi) { return __builtin_shufflevector(__builtin_bit_cast(i32x4, lo), __builtin_bit_cast(i32x4, hi), 0, 1, 2, 3, 4, 5, 6, 7); }
template <class Epi, class Sched, bool ALIGN_EPI = false, bool SP2 = false, bool F8 = false, int F8_SW = 0x7f, int F8_SX = 0x7f>
__device__ __forceinline__ void gemm_phase(PG8_LAS unsigned char* lds, const Gemm g, const Sched& S, const Epi& E, int tid_in) {
    int tid = tid_in; asm volatile("" : "+v"(tid));
    const int wid = __builtin_amdgcn_readfirstlane(tid >> 6), lane = tid & 63, wr = wid >> 2, wc = wid & 3, fr = lane & 15, fq = lane >> 4;
    const int K = g.K, nt = K / BK;
    int f8sw = F8_SW, f8sx = F8_SX; if constexpr (F8) asm volatile("" : "+v"(f8sw), "+v"(f8sx));
    unsigned voffA[2], voffB[2];
#pragma unroll
    for (int i = 0; i < 2; ++i) { int R, C; stage_rc(tid * 16 + i * 8192, R, C); const int Rb = Epi::PERM ? ((R & ~31) + perm32(R & 31)) : R;
        voffA[i] = (unsigned)(R * K + C) * 2u; voffB[i] = (unsigned)(Rb * K + C) * 2u; }
    asm volatile("" : "+v"(voffA[0]), "+v"(voffA[1]), "+v"(voffB[0]), "+v"(voffB[1]));
    const size_t kstep = (size_t)(BK * 2);
    const size_t hstep = (size_t)HALF * K * 2;
    const size_t tstep = 2 * hstep;
    const unsigned ldsw = (unsigned)wid * 1024u;
    const int aoff = lds_byte(wr * 64 + fr, fq * 8), boff = lds_byte(wc * 32 + fr, fq * 8);
#define PG8_SA(b, h) (((b) * 2 + (h)) * HTB)
#define PG8_SB(b, h) ((4 + (b) * 2 + (h)) * HTB)
#define PG8_STAGE(bufoff, gbase, voff) do { _Pragma("unroll") for (int _i = 0; _i < 2; ++_i) \
        __builtin_amdgcn_global_load_lds((const unsigned*)((const char*)(gbase) + (voff)[_i]), (PG8_LAS unsigned*)(lds + (bufoff) + ldsw + _i * 8192), 16, 0, 0); } while (0)
#define PG8_LDA(dst, b, h) do { _Pragma("unroll") for (int m = 0; m < 4; ++m) _Pragma("unroll") for (int k = 0; k < 2; ++k) dst[m][k] = *(const PG8_LAS bf16x8*)(lds + PG8_SA(b, h) + aoff + m * 2048 + k * 1024); } while (0)
#define PG8_LDB(dst, b, h) do { _Pragma("unroll") for (int n = 0; n < 2; ++n) _Pragma("unroll") for (int k = 0; k < 2; ++k) dst[n][k] = *(const PG8_LAS bf16x8*)(lds + PG8_SB(b, h) + boff + n * 2048 + k * 1024); } while (0)
#define PG8_MMA(ai, bj, At, Bt) do { __builtin_amdgcn_s_setprio(1); _Pragma("unroll") for (int m = 0; m < 4; ++m) _Pragma("unroll") for (int n = 0; n < 2; ++n) { \
        if constexpr (F8) { asm volatile("v_mfma_scale_f32_16x16x128_f8f6f4 %0, %1, %2, %0, %3, %4 op_sel_hi:[0,0,0]" : "+v"(acc[ai][bj][m][n]) : "v"(cat8(Bt[n][0], Bt[n][1])), "v"(cat8(At[m][0], At[m][1])), "v"(f8sw), "v"(f8sx)); } \
        else { _Pragma("unroll") for (int k = 0; k < 2; ++k) acc[ai][bj][m][n] = __builtin_amdgcn_mfma_f32_16x16x32_bf16(Bt[n][k], At[m][k], acc[ai][bj][m][n], 0, 0, 0); } } __builtin_amdgcn_s_setprio(0); } while (0)
#define PG8_WAIT_V(n) asm volatile("s_waitcnt vmcnt(" #n ")" ::: "memory")
#define PG8_WAIT_L(n) asm volatile("s_waitcnt lgkmcnt(" #n ")" ::: "memory")
#define PG8_BAR __builtin_amdgcn_s_barrier()
#define PG8_SCHED __builtin_amdgcn_sched_barrier(0)
    Unit cur, nxt; int ui = 0;
    if (!S.next(0, cur)) return;
    f32x4 acc[2][2][4][2];
#pragma unroll
    for (int a = 0; a < 2; ++a)
#pragma unroll
        for (int b = 0; b < 2; ++b)
#pragma unroll
            for (int m = 0; m < 4; ++m)
#pragma unroll
                for (int n = 0; n < 2; ++n) acc[a][b][m][n] = (f32x4){0.f, 0.f, 0.f, 0.f};
    bf16x8 At[4][2], B0[2][2], B1[2][2];
    const char* cA = (const char*)g.A + (size_t)cur.pm * tstep; const char* cB = (const char*)g.Bt + (size_t)cur.pn * tstep;
    S.a_ready(cur);
    if constexpr (SP2) {
        PG8_STAGE(PG8_SB(0, 0), cB, voffB); PG8_STAGE(PG8_SB(0, 1), cB + hstep, voffB); PG8_STAGE(PG8_SA(0, 0), cA, voffA); PG8_STAGE(PG8_SA(0, 1), cA + hstep, voffA);
        if (wr == 1) PG8_BAR;
        PG8_WAIT_V(2); PG8_BAR;
        PG8_STAGE(PG8_SB(1, 0), cB + kstep, voffB); PG8_STAGE(PG8_SA(1, 0), cA + kstep, voffA); PG8_STAGE(PG8_SB(1, 1), cB + hstep + kstep, voffB);
        PG8_WAIT_V(6); PG8_BAR;
    } else {
        PG8_STAGE(PG8_SB(0, 0), cB, voffB); PG8_STAGE(PG8_SA(0, 0), cA, voffA); PG8_STAGE(PG8_SB(0, 1), cB + hstep, voffB); PG8_STAGE(PG8_SA(0, 1), cA + hstep, voffA);
        if (wr == 1) PG8_BAR;
        PG8_WAIT_V(4); PG8_BAR;
        PG8_STAGE(PG8_SB(1, 0), cB + kstep, voffB); PG8_STAGE(PG8_SA(1, 0), cA + kstep, voffA); PG8_STAGE(PG8_SB(1, 1), cB + hstep + kstep, voffB);
        PG8_WAIT_V(6); PG8_BAR;
    }
    for (;;) {
        const bool has_next = S.next(ui + 1, nxt);
        const char* nA = has_next ? (const char*)g.A + (size_t)nxt.pm * tstep : cA; const char* nB = has_next ? (const char*)g.Bt + (size_t)nxt.pn * tstep : cB;
#pragma nounroll
        for (int t = 0; t < nt; t += 2) {
            const bool last = (t == nt - 2);
            const char* a1 = cA + (size_t)(t + 1) * kstep;
            const char* a2 = last ? nA : cA + (size_t)(t + 2) * kstep; const char* b2 = last ? nB : cB + (size_t)(t + 2) * kstep;
            const char* a3 = a2 + kstep; const char* b3 = b2 + kstep;
            if (last && has_next) S.a_ready(nxt);
            if constexpr (SP2) {
            PG8_LDB(B0, 0, 0); PG8_LDB(B1, 0, 1); PG8_SCHED; PG8_LDA(At, 0, 0); PG8_STAGE(PG8_SA(1, 1), a1 + hstep, voffA);
            PG8_WAIT_V(8); PG8_WAIT_L(0); PG8_BAR; PG8_MMA(0, 0, At, B0); PG8_MMA(0, 1, At, B1); PG8_BAR; PG8_SCHED;
            PG8_LDA(At, 0, 1); PG8_STAGE(PG8_SB(0, 0), b2, voffB); PG8_STAGE(PG8_SB(0, 1), b2 + hstep, voffB); PG8_STAGE(PG8_SA(0, 0), a2, voffA);
            PG8_WAIT_V(8); PG8_WAIT_L(0); PG8_BAR; PG8_MMA(1, 0, At, B0); PG8_MMA(1, 1, At, B1); PG8_BAR; PG8_SCHED;
            PG8_LDB(B0, 1, 0); PG8_LDB(B1, 1, 1); PG8_SCHED; PG8_LDA(At, 1, 0); PG8_STAGE(PG8_SA(0, 1), a2 + hstep, voffA);
            PG8_WAIT_V(8); PG8_WAIT_L(0); PG8_BAR; PG8_MMA(0, 0, At, B0); PG8_MMA(0, 1, At, B1); PG8_BAR; PG8_SCHED;
            PG8_LDA(At, 1, 1); PG8_STAGE(PG8_SB(1, 0), b3, voffB); PG8_STAGE(PG8_SB(1, 1), b3 + hstep, voffB); PG8_STAGE(PG8_SA(1, 0), a3, voffA);
            PG8_WAIT_V(8); PG8_WAIT_L(0); PG8_BAR; PG8_MMA(1, 0, At, B0); PG8_MMA(1, 1, At, B1); PG8_BAR; PG8_SCHED;
            } else {
            PG8_LDB(B0, 0, 0); PG8_SCHED; PG8_LDA(At, 0, 0); PG8_STAGE(PG8_SA(1, 1), a1 + hstep, voffA);
            PG8_WAIT_L(8); PG8_BAR; PG8_WAIT_L(0); PG8_MMA(0, 0, At, B0); PG8_BAR; PG8_SCHED;
            PG8_LDB(B1, 0, 1); PG8_STAGE(PG8_SB(0, 0), b2, voffB);
            PG8_BAR; PG8_WAIT_L(0); PG8_MMA(0, 1, At, B1); PG8_BAR;
            PG8_LDA(At, 0, 1); PG8_STAGE(PG8_SA(0, 0), a2, voffA);
            PG8_BAR; PG8_WAIT_L(0); PG8_MMA(1, 0, At, B0); PG8_BAR; PG8_SCHED;
            PG8_STAGE(PG8_SB(0, 1), b2 + hstep, voffB);
            PG8_WAIT_V(6); PG8_BAR; PG8_MMA(1, 1, At, B1); PG8_BAR;
            PG8_LDB(B0, 1, 0); PG8_SCHED; PG8_LDA(At, 1, 0); PG8_STAGE(PG8_SA(0, 1), a2 + hstep, voffA);
            PG8_WAIT_L(8); PG8_BAR; PG8_WAIT_L(0); PG8_MMA(0, 0, At, B0); PG8_BAR; PG8_SCHED;
            PG8_LDB(B1, 1, 1); PG8_STAGE(PG8_SB(1, 0), b3, voffB);
            PG8_BAR; PG8_WAIT_L(0); PG8_MMA(0, 1, At, B1); PG8_BAR;
            PG8_LDA(At, 1, 1); PG8_STAGE(PG8_SA(1, 0), a3, voffA);
            PG8_BAR; PG8_WAIT_L(0); PG8_MMA(1, 0, At, B0); PG8_BAR; PG8_SCHED;
            PG8_STAGE(PG8_SB(1, 1), b3 + hstep, voffB);
            PG8_WAIT_V(6); PG8_BAR; PG8_MMA(1, 1, At, B1); PG8_BAR;
            }
        }
        if constexpr (F8) asm volatile("s_nop 15\n\ts_nop 15" ::: "memory");
        if constexpr (ALIGN_EPI) { if (wr == 0) PG8_BAR; }
        if constexpr (!Epi::AFTER_DRAIN) { const int l2 = lane_id_fresh(); E(acc, cur, wr, wc, l2 & 15, l2 >> 4); S.done(cur); }
        if (!has_next) break;
        if constexpr (!epi_keeps_acc<Epi>::value) {
#pragma unroll
        for (int a = 0; a < 2; ++a)
#pragma unroll
            for (int b = 0; b < 2; ++b)
#pragma unroll
                for (int m = 0; m < 4; ++m)
#pragma unroll
                    for (int n = 0; n < 2; ++n) acc[a][b][m][n] = (f32x4){0.f, 0.f, 0.f, 0.f};
        }
        cur = nxt; cA = nA; cB = nB; ++ui;
        if constexpr (ALIGN_EPI) { if (wr == 1) PG8_BAR; }
    }
    PG8_WAIT_V(0);
    if constexpr (!ALIGN_EPI) { if (wr == 0) PG8_BAR; }
    PG8_BAR;
    if constexpr (Epi::AFTER_DRAIN) { E.fused(acc, cur, wr, wc, fr, fq, lds, wid, lane); S.done(cur); }
#undef PG8_SA
#undef PG8_SB
#undef PG8_STAGE
#undef PG8_LDA
#undef PG8_LDB
#undef PG8_MMA
#undef PG8_WAIT_V
#undef PG8_WAIT_L
#undef PG8_BAR
#undef PG8_SCHED
}
}

#ifndef PG8_SP2
#define PG8_SP2 true
#endif
#ifndef PG8_ALIGN
#define PG8_ALIGN true
#endif

constexpr int NWAVES = 8, NTHR = 512;
constexpr int NL = 4, M = 16384, D = 1024, SEQ = 2048, W = 512, NE = 32, ZLD = 11264, DPLE = 256;
constexpr int NC_BASE = 11016, NC_REST = 11048;
constexpr int ZA = 0, ZB = 1792, ZC = 3840, ZD = 5896, ZX = 6920, ZG = 7168;
constexpr float ALPHA = 1.681792830507429f;
constexpr int MOE_ROWS = 73728;
constexpr size_t MiB = 1u << 20;
constexpr size_t WS_CTL = 0, CTL_ZERO_BYTES = 128 * 1024;
constexpr size_t WS_WIN = 2 * MiB, WS_WBR = 90 * MiB, WS_WOUT = 106 * MiB, WS_WPG = 114 * MiB, WS_WPP = 122 * MiB, WS_WSM = 124 * MiB, WS_WLRU = 126 * MiB;
constexpr size_t WS_WGU = 128 * MiB, WS_WDN = 640 * MiB, WS_PB = 896 * MiB, WS_PP = 928 * MiB, WS_XB = 1056 * MiB, WS_XF = 1088 * MiB, WS_Z = 1152 * MiB;
constexpr size_t WS_RW = 1504 * MiB, WS_BON = 1728 * MiB, WS_VF = 1730 * MiB, WS_LA = 1762 * MiB, WS_LB = 1794 * MiB, WS_YA = 1826 * MiB, WS_OB = 1858 * MiB, WS_HC = 1890 * MiB;
constexpr size_t WS_Y = 1922 * MiB, WS_MF = 1986 * MiB, WS_MB = 2050 * MiB, WS_PRE = 2082 * MiB, WS_X1F = 2146 * MiB, WS_X1B = 2210 * MiB;
constexpr size_t WS_SLOT = 2242 * MiB, WS_TREC = 2244 * MiB, WS_GATE = 2245 * MiB, WS_XS = 2246 * MiB, WS_XB8 = 2246 * MiB, WS_X1B8 = 2262 * MiB, WS_WIN8 = 2278 * MiB, WS_WPG8 = 2294 * MiB, WS_H = 2390 * MiB, WS_YS = 2534 * MiB, WS_PLEG = 2678 * MiB, WS_FR = 2710 * MiB, WS_FRH = 2810 * MiB, WS_FRM = 2890 * MiB, WS_XSV = 2970 * MiB, WS_END = 3994 * MiB;
constexpr size_t RWSZ = 32 * MiB;
constexpr size_t RHSZ = 16 * MiB, WS_LW = WS_RW + 6 * RHSZ;
constexpr int CW_TMO = 0, CW_BAR = 4096, CW_CNT = 16384;
constexpr int RING_BYTES = 131072, LDSCTL_OFF = RING_BYTES, LDSCTL_BYTES = 8192, LDS_USED = RING_BYTES + LDSCTL_BYTES, LDS_BYTES = 147456;
constexpr int LC_BAR = 0  , LC_TILEE = 16  , LC_PSTART = 352  , LC_CNT = 400  , LC_BASE = 432  , LC_NT = 464, LC_REC = 512  ;

#define GAS __attribute__((address_space(1)))
#define LAS __attribute__((address_space(3)))
#define DI __device__ __forceinline__
typedef unsigned short bf16;
typedef unsigned v4u __attribute__((ext_vector_type(4)));
typedef unsigned v2u __attribute__((ext_vector_type(2)));
typedef float f32x4 __attribute__((ext_vector_type(4)));
typedef float f32x2 __attribute__((ext_vector_type(2)));
typedef short bf16x8 __attribute__((ext_vector_type(8)));
typedef GAS unsigned gu32;
#define RLX_AGENT __ATOMIC_RELAXED, __HIP_MEMORY_SCOPE_AGENT
#define LDS_WAIT() asm volatile("s_waitcnt lgkmcnt(0)" ::: "memory")
#define VM_WAIT() asm volatile("s_waitcnt vmcnt(0)" ::: "memory")
DI unsigned f2bf(float f) { unsigned u = __builtin_bit_cast(unsigned, f); return (u + 0x7fffu + ((u >> 16) & 1u)) >> 16; }
typedef __bf16 bf16x2_t __attribute__((ext_vector_type(2)));
DI unsigned pk2(float lo, float hi) { const f32x2 v = {lo, hi}; const bf16x2_t b = __builtin_convertvector(v, bf16x2_t); return __builtin_bit_cast(unsigned, b); }
DI float bf2f(unsigned short b) { return __builtin_bit_cast(float, (unsigned)b << 16); }
DI float blo(unsigned w) { return __builtin_bit_cast(float, w << 16); }
DI float bhi(unsigned w) { return __builtin_bit_cast(float, w & 0xffff0000u); }
DI float sigm(float x) { return __builtin_amdgcn_rcpf(1.0f + __expf(-x)); }
DI float tanh_fast(float x) { return 1.0f - 2.0f * __builtin_amdgcn_rcpf(1.0f + __expf(2.0f * x)); }
DI float siluf(float x) { return x * sigm(x); }
DI float softplusf(float x) { return x > 20.0f ? x : __logf(1.0f + __expf(x)); }
DI float logsigm(float x) { return -softplusf(-x); }
DI unsigned pk4f8(float a, float b, float c, float d) {
    unsigned w = 0u; w = __builtin_amdgcn_cvt_pk_fp8_f32(pg8::clamp8(a * 8.0f), pg8::clamp8(b * 8.0f), w, false); return __builtin_amdgcn_cvt_pk_fp8_f32(pg8::clamp8(c * 8.0f), pg8::clamp8(d * 8.0f), w, true); }
DI float gelu_tanh(float x) { return 0.5f * x * (1.0f + tanh_fast(0.7978845608028654f * (x + 0.044715f * x * x * x))); }

#define XB_TMO      128
#define XB_XCNT(j)  (256  + 64 * (j))
#define XB_XSUB(j)  (1280 + 64 * (j))
#define XB_XGEN(j)  (2304 + 64 * (j))
#define XB_TOP      3328
#define XB_TOPGEN   3392
#define XCD_BAR_WORDS 3456
#define XB_SPIN_CAP (1u << 18)
DI unsigned xb_ld(unsigned* p)              { return __hip_atomic_load(p, __ATOMIC_RELAXED, __HIP_MEMORY_SCOPE_AGENT); }
DI unsigned xb_add(unsigned* p, unsigned v) { return __hip_atomic_fetch_add(p, v, __ATOMIC_RELAXED, __HIP_MEMORY_SCOPE_AGENT); }
DI unsigned xb_xcc_id() { return (unsigned)__builtin_amdgcn_s_getreg((3 << 11) | 20) & 0xFu; }
#define XB_SPIN(cond, bar) do { unsigned _sp = 0; while (cond) { __builtin_amdgcn_s_sleep(1); \
    if ((++_sp & 255u) == 0u) { if (xb_ld(&(bar)[XB_TMO])) break; if (_sp > XB_SPIN_CAP) { atomicAdd(&(bar)[XB_TMO], 1u); break; } } } } while (0)
struct XcdBarrier { unsigned* bar; unsigned x; volatile LAS unsigned* st; };
DI XcdBarrier xcd_barrier_post(unsigned* bar, volatile LAS unsigned* st) {
    XcdBarrier b; b.bar = bar; b.x = xb_xcc_id(); b.st = st;
    if (threadIdx.x == 0) (void)xb_add(&bar[XB_XCNT(b.x)], 1u);
    return b;
}
DI void xcd_barrier_complete(unsigned* bar, unsigned x, unsigned& nloc, unsigned& nx) {
    const unsigned G = gridDim.x * gridDim.y * gridDim.z;
    unsigned sum, cnt, mine, sp = 0u;
    for (;;) {
        sum = 0u; cnt = 0u; mine = 0u;
#pragma unroll
        for (unsigned j = 0; j < 16; ++j) { const unsigned c = xb_ld(&bar[XB_XCNT(j)]); sum += c; cnt += (c > 0u) ? 1u : 0u; mine = (j == x) ? c : mine; }
        if (sum == G) break;
        __builtin_amdgcn_s_sleep(1);
        if ((++sp & 255u) == 0u) { if (xb_ld(&bar[XB_TMO])) break; if (sp > XB_SPIN_CAP) { atomicAdd(&bar[XB_TMO], 1u); break; } }
    }
    nloc = mine > 0u ? mine : 1u; nx = cnt > 0u ? cnt : 1u;
}
DI void xcd_barrier(const XcdBarrier& b) {
    asm volatile("s_waitcnt vmcnt(0)" ::: "memory");
    __syncthreads();
    if (threadIdx.x == 0) {
        unsigned* bar = b.bar;
        __builtin_amdgcn_s_waitcnt(0);
        unsigned nloc = b.st[0], nx = b.st[1];
        if (nloc == 0u) { xcd_barrier_complete(bar, b.x, nloc, nx); b.st[0] = nloc; b.st[1] = nx; }
        const unsigned old = xb_add(&bar[XB_XSUB(b.x)], 1u);
        const unsigned gen = old / nloc;
        if (old + 1u == (gen + 1u) * nloc) {
            __builtin_amdgcn_fence(__ATOMIC_RELEASE, "agent");
            asm volatile("s_waitcnt vmcnt(0)" ::: "memory");
            const unsigned og = xb_add(&bar[XB_TOP], 1u);
            const unsigned tg = og / nx;
            if (og + 1u == (tg + 1u) * nx) xb_add(&bar[XB_TOPGEN], 1u);
            else XB_SPIN(xb_ld(&bar[XB_TOPGEN]) == tg, bar);
            __builtin_amdgcn_fence(__ATOMIC_ACQUIRE, "agent");
            xb_add(&bar[XB_XGEN(b.x)], 1u);
            asm volatile("s_waitcnt vmcnt(0)" ::: "memory");
        } else {
            XB_SPIN(xb_ld(&bar[XB_XGEN(b.x)]) == gen, bar);
            __builtin_amdgcn_fence(__ATOMIC_ACQUIRE, "agent");
            asm volatile("s_waitcnt vmcnt(0)" ::: "memory");
        }
    }
    __syncthreads();
}

struct Args { const float* in[45]; float* out; unsigned char* ws; int ph_lo, ph_hi; };
typedef const __attribute__((address_space(4))) Args* KA;
struct Frame {
    LAS unsigned char* lds; LAS unsigned* LC;
    unsigned char* ws; gu32* ctl;
    int tid, lane, wave, vcu, G, gw, NGW;
};
DI void rebind(Frame& F) {
    int w = F.wave, vc = F.vcu, gg = F.G; asm volatile("" : "+s"(w), "+s"(vc), "+s"(gg)); F.vcu = vc; F.G = gg; F.NGW = gg * NWAVES;
    const int ln = pg8::lane_id_fresh();
    F.wave = w; F.lane = ln; F.tid = w * 64 + ln; F.gw = F.vcu * NWAVES + w;
}

template <int CTRL> DI float dpp_f(float v) { return __builtin_bit_cast(float, __builtin_amdgcn_update_dpp(0, __builtin_bit_cast(int, v), CTRL, 0xf, 0xf, true)); }
template <int MSK> DI int shx_i(int v) {
    if constexpr (MSK < 32) return __builtin_amdgcn_ds_swizzle(v, (MSK << 10) | 0x1f);
    else { const int l = pg8::lane_id_fresh(); return __builtin_amdgcn_ds_bpermute((l ^ MSK) << 2, v); }
}
template <int MSK> DI float shx(float v) { return __builtin_bit_cast(float, shx_i<MSK>(__builtin_bit_cast(int, v))); }
DI float wave_sum(float v) { v += dpp_f<0xB1>(v); v += dpp_f<0x4E>(v); v += dpp_f<0x124>(v); v += dpp_f<0x128>(v); v += shx<16>(v); v += shx<32>(v); return v; }
DI float row16_sum(float v) {
    v += dpp_f<0xB1>(v); v += dpp_f<0x4E>(v); v += dpp_f<0x124>(v); v += dpp_f<0x128>(v); return v;
}

template <int MODE  >
DI void cvt_item(const float* W, int ldw, int N, int K, int kb, int nb, bf16* WT, LAS float* scr, int lane) {
    const int k0 = 64 * kb, n0 = 32 * nb, nl = lane & 31;
    if (MODE == 5 && (n0 + 32 <= 6920 || n0 >= 11016)) return;
    if (MODE == 4 && n0 >= 6920 && n0 + 32 <= 11016) return;
    float v32[32]; const bool okn = (n0 + nl < N); const float* wp = W + (size_t)(k0 + (lane >> 5)) * ldw + n0 + nl;
#pragma unroll
    for (int i = 0; i < 32; ++i) v32[i] = okn ? wp[(size_t)(2 * i) * ldw] : 0.0f;
#pragma unroll
    for (int i = 0; i < 32; ++i) scr[(2 * i + (lane >> 5)) * 33 + nl] = v32[i];
    LDS_WAIT(); asm volatile("" ::: "memory");
    const int c = lane & 7;
#pragma unroll
    for (int j = 0; j < 4; ++j) { const int nn = (lane >> 3) + 8 * j, n = n0 + nn; const LAS float* s = scr + (8 * c) * 33 + nn;
        int ro = n; if (MODE == 1 || MODE == 2) { const int cc = n & 1023; ro = (cc >> 7) * 256 + (n >> 10) * 128 + (cc & 127); }
        if (MODE == 4) ro = (n < 6920) ? n : n - 4096;
        if (MODE == 5) ro = n - 6920;
        const bool gate_col = (n >= 6920 && n < 11016);
        if (MODE == 2 || MODE == 3 || MODE == 5) { unsigned w0 = 0u, w1 = 0u;
            w0 = __builtin_amdgcn_cvt_pk_fp8_f32(s[0 * 33] * 64.0f, s[1 * 33] * 64.0f, w0, false); w0 = __builtin_amdgcn_cvt_pk_fp8_f32(s[2 * 33] * 64.0f, s[3 * 33] * 64.0f, w0, true);
            w1 = __builtin_amdgcn_cvt_pk_fp8_f32(s[4 * 33] * 64.0f, s[5 * 33] * 64.0f, w1, false); w1 = __builtin_amdgcn_cvt_pk_fp8_f32(s[6 * 33] * 64.0f, s[7 * 33] * 64.0f, w1, true);
            if (n < N && (MODE != 5 || gate_col)) *(GAS v2u*)((unsigned char*)WT + (size_t)ro * K + k0 + 8 * c) = (v2u){w0, w1}; }
        else { v4u o; o.x = pk2(s[0 * 33], s[1 * 33]); o.y = pk2(s[2 * 33], s[3 * 33]); o.z = pk2(s[4 * 33], s[5 * 33]); o.w = pk2(s[6 * 33], s[7 * 33]);
            if (n < N && (MODE != 4 || !gate_col)) *(GAS v4u*)(WT + (size_t)ro * K + k0 + 8 * c) = o; } }
    LDS_WAIT(); asm volatile("" ::: "memory");
}
template <int MODE> DI void cvt_item8(const float* W, int ldw, int N, int K, int kb, int nb, unsigned char* WT8, LAS float* scr, int lane) {
    const int k0 = 128 * kb, n0 = 32 * nb, nl = lane & 31, half = lane >> 5;
    if (MODE == 5 && (n0 + 32 <= 6920 || n0 >= 11016)) return;
    float v64[64]; const bool okn = (n0 + nl < N); const float* wp = W + (size_t)(k0 + half) * ldw + n0 + nl;
#pragma unroll
    for (int i = 0; i < 64; ++i) v64[i] = okn ? wp[(size_t)(2 * i) * ldw] : 0.0f;
#pragma unroll
    for (int i = 0; i < 64; ++i) { const int row = 2 * i + half; scr[row * 32 + (nl ^ ((row >> 3) & 31))] = v64[i]; }
    LDS_WAIT(); asm volatile("" ::: "memory");
    const int c = lane & 15, nq = lane >> 4;
#pragma unroll
    for (int j = 0; j < 8; ++j) { const int nn = nq + 4 * j, n = n0 + nn; const LAS float* sp = scr + (8 * c) * 32 + (nn ^ c);
        int ro = n; if (MODE == 2) { const int cc = n & 1023; ro = (cc >> 7) * 256 + (n >> 10) * 128 + (cc & 127); }
        if (MODE == 5) ro = n - 6920;
        const bool ok = (n < N) && (MODE != 5 || (n >= 6920 && n < 11016));
        unsigned w0 = 0u, w1 = 0u;
        w0 = __builtin_amdgcn_cvt_pk_fp8_f32(sp[0 * 32] * 64.0f, sp[1 * 32] * 64.0f, w0, false); w0 = __builtin_amdgcn_cvt_pk_fp8_f32(sp[2 * 32] * 64.0f, sp[3 * 32] * 64.0f, w0, true);
        w1 = __builtin_amdgcn_cvt_pk_fp8_f32(sp[4 * 32] * 64.0f, sp[5 * 32] * 64.0f, w1, false); w1 = __builtin_amdgcn_cvt_pk_fp8_f32(sp[6 * 32] * 64.0f, sp[7 * 32] * 64.0f, w1, true);
        if (ok) *(GAS v2u*)(WT8 + (size_t)ro * K + k0 + 8 * c) = (v2u){w0, w1}; }
    LDS_WAIT(); asm volatile("" ::: "memory");
}
template <int MODE> DI void cvt_class(Frame& F, int& off, const float* W, int K, int N, int ldw, size_t src_stride, bf16* WT, size_t dst_stride, int nmat) {
    LAS float* scr = (LAS float*)(F.lds + F.wave * 16384);
    constexpr bool F8M = (MODE == 2 || MODE == 3 || MODE == 5);
    const int nkb = K / (F8M ? 128 : 64), nnb = (N + 31) / 32, per = nkb * nnb, total = per * nmat;
    int start = (F.gw - off) % F.NGW; if (start < 0) start += F.NGW;
    for (int it = start; it < total; it += F.NGW) { const int mi = it / per, r = it % per;
        if constexpr (F8M) cvt_item8<MODE>(W + (size_t)mi * src_stride, ldw, N, K, r / nnb, r % nnb, (unsigned char*)(WT + (size_t)mi * dst_stride), scr, F.lane);
        else cvt_item<MODE>(W + (size_t)mi * src_stride, ldw, N, K, r / nnb, r % nnb, WT + (size_t)mi * dst_stride, scr, F.lane); }
    off = (off + total) % F.NGW;
}
constexpr int EXP_ITEMS = NE * 512 + NE * 256;
DI void cvt_expert_item(Frame& F, KA a, int l, int it) {
    LAS float* scr = (LAS float*)(F.lds + F.wave * 16384);
    if (it < NE * 512) { const int e = it >> 9, r = it & 511; const size_t mi = (size_t)l * NE + e;
        cvt_item8<2>(a->in[37] + mi * 1024 * 2048, 2048, 2048, 1024, r >> 6, r & 63, F.ws + WS_WGU + mi * 2048 * 1024, scr, F.lane); }
    else { const int i2 = it - NE * 512, e = i2 >> 8, r = i2 & 255; const size_t mi = (size_t)l * NE + e;
        cvt_item8<3>(a->in[39] + mi * 1024 * 1024, 1024, 1024, 1024, r >> 5, r & 31, F.ws + WS_WDN + mi * 1024 * 1024, scr, F.lane); }
}
constexpr int CW_Q = 28672;
DI void cvt_expert_queue(Frame& F, KA a, int l) {
    LAS unsigned* qh = F.LC + 480;
    unsigned nxt = 0u;
    if (F.tid == 0) qh[0] = __hip_atomic_fetch_add((unsigned*)(F.ctl + CW_Q + l * 64), 8u, __ATOMIC_RELAXED, __HIP_MEMORY_SCOPE_AGENT);
    for (int r = 0;; ++r) {
        __syncthreads();
        const int base = (int)qh[r & 1];
        if (base >= EXP_ITEMS) break;
        if (F.tid == 0) nxt = __hip_atomic_fetch_add((unsigned*)(F.ctl + CW_Q + l * 64), 8u, __ATOMIC_RELAXED, __HIP_MEMORY_SCOPE_AGENT);
        if (base + F.wave < EXP_ITEMS) cvt_expert_item(F, a, l, base + F.wave);
        if (F.tid == 0) qh[(r + 1) & 1] = nxt;
    }
}
DI void p0_convert(Frame& F, KA a) {
    int off = 0;
    cvt_class<4>(F, off, a->in[2], 1024, NC_BASE, NC_BASE, 0, (bf16*)(F.ws + WS_WIN), 0, 1);
    cvt_class<4>(F, off, a->in[3], 1024, NC_REST, NC_REST, (size_t)1024 * NC_REST, (bf16*)(F.ws + WS_WIN) + (size_t)ZLD * 1024, (size_t)ZLD * 1024, NL - 1);
    cvt_class<3>(F, off, a->in[31], 512, 1024, 1024, (size_t)512 * 1024, (bf16*)(F.ws + WS_WBR), (size_t)1024 * 512 / 2, NL * 4);
    cvt_class<3>(F, off, a->in[32], 1024, 1024, 1024, (size_t)1024 * 1024, (bf16*)(F.ws + WS_WOUT), (size_t)1024 * 1024 / 2, NL);
    cvt_class<3>(F, off, a->in[41], 1024, 1024, 1024, (size_t)1024 * 1024, (bf16*)(F.ws + WS_WPG8), (size_t)1024 * 1024 / 2, NL);
    cvt_class<5>(F, off, a->in[2], 1024, NC_BASE, NC_BASE, 0, (bf16*)(F.ws + WS_WIN8), 0, 1);
    cvt_class<5>(F, off, a->in[3], 1024, NC_REST, NC_REST, (size_t)1024 * NC_REST, (bf16*)(F.ws + WS_WIN8 + (size_t)4096 * 1024), (size_t)4096 * 1024 / 2, NL - 1);
    cvt_class<0>(F, off, a->in[42], 256, 1024, 1024, (size_t)256 * 1024, (bf16*)(F.ws + WS_WPP), (size_t)1024 * 256, NL);
    const int gt = F.vcu * NTHR + F.tid, NGT = F.G * NTHR;
    for (int l = 0; l < NL; ++l) { const int n0 = (l == 0) ? ZX : ZX + 32; bf16* wt = (bf16*)(F.ws + WS_WIN) + (size_t)l * ZLD * 1024;
        const int nq = (ZG - n0) * 1024 / 8;
        for (int i = gt; i < nq; i += NGT) *(GAS v4u*)(wt + (size_t)n0 * 1024 + (size_t)i * 8) = (v4u){0u, 0u, 0u, 0u}; }
    { bf16* wsm = (bf16*)(F.ws + WS_WSM);
      for (int i = gt; i < NL * 512 * 288; i += NGT) { const int l = i / (512 * 288), r = i % (512 * 288), c = r / 288, k = r % 288; float v;
          if (k < 64) v = a->in[6][((size_t)l * 64 + k) * 512 + c];
          else if (k < 128) v = a->in[8][((size_t)l * 64 + (k - 64)) * 512 + c];
          else if (k < 256) v = a->in[11][((size_t)l * 128 + (k - 128)) * 512 + c];
          else v = (l > 0) ? a->in[10][((size_t)(l - 1) * 32 + (k - 256)) * 512 + c] : 0.0f;
          wsm[i] = (bf16)f2bf(v); }
      bf16* wl = (bf16*)(F.ws + WS_WLRU);
      for (int i = gt; i < NL * 2 * 8 * 64 * 64; i += NGT) { const int l = i >> 16, r = i & 65535, which = r >> 15, g = (r >> 12) & 7, j = (r >> 6) & 63, ii = r & 63;
          const float* src = which ? a->in[28] : a->in[26];
          wl[i] = (bf16)f2bf(src[(((size_t)l * 8 + g) * 64 + ii) * 64 + j]); } }
    { const GAS f32x4* xs = (const GAS f32x4*)a->in[0]; GAS v2u* xb = (GAS v2u*)(F.ws + WS_XB);
      GAS unsigned* xb8 = (GAS unsigned*)(F.ws + WS_XB8);
      for (int i = gt; i < M * D / 4; i += NGT) { const f32x4 v = xs[i]; xb[i] = (v2u){pk2(v.x, v.y), pk2(v.z, v.w)}; unsigned w8 = __builtin_amdgcn_cvt_pk_fp8_f32(v.x * 16.f, v.y * 16.f, 0u, false); xb8[i] = __builtin_amdgcn_cvt_pk_fp8_f32(v.z * 16.f, v.w * 16.f, w8, true); }
      const GAS f32x4* ps = (const GAS f32x4*)a->in[1]; GAS v2u* pb = (GAS v2u*)(F.ws + WS_PB);
      for (int i = gt; i < NL * M * DPLE / 4; i += NGT) { const f32x4 v = ps[i]; pb[i] = (v2u){pk2(v.x, v.y), pk2(v.z, v.w)}; } }
}

DI f32x4 mfma16(bf16x8 a, bf16x8 b, f32x4 c) { return __builtin_amdgcn_mfma_f32_16x16x32_bf16(a, b, c, 0, 0, 0); }
DI f32x4 fresh_zero4() { float z0 = 0.f; asm volatile("" : "+v"(z0)); return (f32x4){z0, z0, z0, z0}; }
constexpr int XS_LD = 296, XCB_LD = 520, XCF_LD = 516;
static_assert(16 * XS_LD * 2 <= 9728 && 9728 + 16 * XCB_LD * 2 <= 26624 && 26624 + 16 * XCF_LD * 4 <= 59904 && 59904 + 18 * 512 * 4 <= RING_BYTES, "prep LDS map");
DI void phase_prep(Frame& F, KA a, int l) {
    LAS bf16* X = (LAS bf16*)F.lds;
    LAS bf16* XCb = (LAS bf16*)(F.lds + 9728);
    LAS float* XCf = (LAS float*)(F.lds + 26624);
    const bf16* z = (const bf16*)(F.ws + WS_Z);
    const bf16* wsm = (const bf16*)(F.ws + WS_WSM) + (size_t)l * 512 * 288;
    const bf16* wlru = (const bf16*)(F.ws + WS_WLRU) + (size_t)l * 65536;
    const float* mu = a->in[4] + l * 1792; const float* w0 = a->in[5] + l * 512; const float* a0 = a->in[7] + l * 512;
    const float* v0 = a->in[9] + (l > 0 ? (l - 1) * 512 : 0); const float* k_k = a->in[12] + l * 512; const float* k_a = a->in[13] + l * 512; const float* r_k = a->in[14] + l * 512;
    const float* cw = a->in[24] + l * 4 * 512; const float* cb = a->in[25] + l * 512; const float* bx = a->in[27] + l * 512; const float* ba = a->in[29] + l * 512; const float* lam = a->in[30] + l * 512;
    bf16* RWH = (bf16*)(F.ws + WS_RW); float* LW = (float*)(F.ws + WS_LW); bf16* VF = (bf16*)(F.ws + WS_VF);     float* BON = (float*)(F.ws + WS_BON);
    float* LA = (float*)(F.ws + WS_LA); bf16* LB = (bf16*)(F.ws + WS_LB);
    const int h = F.wave, lane = F.lane, tok = lane & 15, quad = lane >> 4;
    LAS float* PT = (LAS float*)(F.lds + 59904);
    for (int i = F.tid; i < 18 * 512; i += NTHR) { const int f = i >> 9, c = i & 511; float v;
        if (f < 3) v = mu[f * 512 + c]; else if (f == 3) v = w0[c]; else if (f == 4) v = a0[c]; else if (f == 5) v = (l > 0) ? v0[c] : 0.f; else if (f == 6) v = k_k[c]; else if (f == 7) v = k_a[c]; else if (f == 8) v = r_k[c];
        else if (f == 9) v = bx[c]; else if (f == 10) v = ba[c]; else if (f == 11) v = 8.0f * logsigm(lam[c]); else if (f == 12) v = cb[c]; else if (f < 17) v = cw[(f - 13) * 512 + c]; else v = (c < 256) ? mu[1536 + c] : 0.f;
        PT[i] = v; }
    __syncthreads();
#define PTV(f, c) (*(const LAS f32x4*)(PT + (f) * 512 + (c)))
    for (int item = F.vcu; item < M / 16; item += F.G) {
        const int t0 = item * 16;
        const int t = t0 + tok; const bool first = (t & (SEQ - 1)) == 0;
        v2u kpre[8];
#pragma unroll
        for (int nt = 0; nt < 4; ++nt) { const bf16* zr_ = z + (size_t)t * ZLD + 512 + 64 * h + 16 * quad + 4 * nt; kpre[nt] = *(const v2u*)zr_; kpre[4 + nt] = first ? (v2u){0u, 0u} : *(const v2u*)(zr_ - ZLD); }
        for (int idx = F.tid; idx < 16 * 36; idx += NTHR) {
            const int tk = idx / 36, ch = idx % 36, j0 = 8 * ch, t = t0 + tk; float v8[8];
            if (ch < 32) { const int col = 1536 + j0; const v4u cz = *(const v4u*)(z + (size_t)t * ZLD + col);
                const v4u pz = (t & (SEQ - 1)) ? *(const v4u*)(z + (size_t)(t - 1) * ZLD + col) : (v4u){0u, 0u, 0u, 0u};
                const f32x4 m0 = PTV(17, j0), m1 = PTV(17, j0 + 4);
                const float cu[8] = {blo(cz.x), bhi(cz.x), blo(cz.y), bhi(cz.y), blo(cz.z), bhi(cz.z), blo(cz.w), bhi(cz.w)}, pr[8] = {blo(pz.x), bhi(pz.x), blo(pz.y), bhi(pz.y), blo(pz.z), bhi(pz.z), blo(pz.w), bhi(pz.w)};
                const float mm[8] = {m0[0], m0[1], m0[2], m0[3], m1[0], m1[1], m1[2], m1[3]};
#pragma unroll
                for (int j = 0; j < 8; ++j) { const float xv = cu[j] + (pr[j] - cu[j]) * mm[j]; v8[j] = (ch < 8) ? tanh_fast(xv) : (ch < 16 ? xv : sigm(xv)); } }
            else { const v4u cz = (l > 0) ? *(const v4u*)(z + (size_t)t * ZLD + ZX + (j0 - 256)) : (v4u){0u, 0u, 0u, 0u};
                v8[0] = blo(cz.x); v8[1] = bhi(cz.x); v8[2] = blo(cz.y); v8[3] = bhi(cz.y); v8[4] = blo(cz.z); v8[5] = bhi(cz.z); v8[6] = blo(cz.w); v8[7] = bhi(cz.w); }
            *(LAS v4u*)(X + tk * XS_LD + j0) = (v4u){pk2(v8[0], v8[1]), pk2(v8[2], v8[3]), pk2(v8[4], v8[5]), pk2(v8[6], v8[7])}; }
        for (int idx = F.tid; idx < 16 * 64; idx += NTHR) {
            const int tk = idx >> 6, c = 8 * (idx & 63), t = t0 + tk, tt = t & (SEQ - 1);
            const f32x4 b0 = PTV(12, c), b1 = PTV(12, c + 4); float acc[8] = {b0[0], b0[1], b0[2], b0[3], b1[0], b1[1], b1[2], b1[3]};
#pragma unroll
            for (int j = 0; j < 4; ++j) { if (tt - 3 + j >= 0) { const v4u rz = *(const v4u*)(z + (size_t)(t - 3 + j) * ZLD + ZD + c); const f32x4 w0 = PTV(13 + j, c), w1 = PTV(13 + j, c + 4);
                acc[0] += blo(rz.x) * w0[0]; acc[1] += bhi(rz.x) * w0[1]; acc[2] += blo(rz.y) * w0[2]; acc[3] += bhi(rz.y) * w0[3]; acc[4] += blo(rz.z) * w1[0]; acc[5] += bhi(rz.z) * w1[1]; acc[6] += blo(rz.w) * w1[2]; acc[7] += bhi(rz.w) * w1[3]; } }
            *(LAS f32x4*)(XCf + tk * XCF_LD + c) = (f32x4){acc[0], acc[1], acc[2], acc[3]}; *(LAS f32x4*)(XCf + tk * XCF_LD + c + 4) = (f32x4){acc[4], acc[5], acc[6], acc[7]};
            *(LAS v4u*)(XCb + tk * XCB_LD + c) = (v4u){pk2(acc[0], acc[1]), pk2(acc[2], acc[3]), pk2(acc[4], acc[5]), pk2(acc[6], acc[7])}; }
        __syncthreads();
        {
            float ss = 0.f, bs = 0.f;
#pragma unroll
            for (int nt = 0; nt < 4; ++nt) { const int c = 64 * h + 16 * quad + 4 * nt; const v2u kc_ = kpre[nt], kp_ = kpre[4 + nt];
                const f32x4 mk = PTV(1, c), kkv = PTV(6, c); const f32x4 kc = (f32x4){blo(kc_.x), bhi(kc_.x), blo(kc_.y), bhi(kc_.y)}, kp = (f32x4){blo(kp_.x), bhi(kp_.x), blo(kp_.y), bhi(kp_.y)};
                const f32x4 kk = (kc + (kp - kc) * mk) * kkv; ss += (kk[0] * kk[0] + kk[1] * kk[1]) + (kk[2] * kk[2] + kk[3] * kk[3]); }
            ss += shx<16>(ss); ss += shx<32>(ss);
            const float inv = 1.0f / fmaxf(sqrtf(ss), 1e-12f);
            bf16x8 wf[9]; v2u zc[6]; v2u vfc = (v2u){0u, 0u};
#define PREP_LOAD(NT, WF, ZC, VFC) do { const bf16* wrow_ = wsm + (size_t)(64 * h + 16 * (tok >> 2) + 4 * (NT) + (tok & 3)) * 288 + 8 * quad; \
                _Pragma("unroll") for (int i_ = 0; i_ < 9; ++i_) WF[i_] = *(const bf16x8*)(wrow_ + 32 * i_); \
                const int c_ = 64 * h + 16 * quad + 4 * (NT); const bf16* zr_ = z + (size_t)t * ZLD + c_; const bf16* zp_ = first ? zr_ : zr_ - ZLD; \
                ZC[0] = *(const v2u*)(zr_); ZC[1] = *(const v2u*)(zr_ + 512); ZC[2] = *(const v2u*)(zr_ + 1024); ZC[3] = *(const v2u*)(zp_); ZC[4] = *(const v2u*)(zp_ + 512); ZC[5] = *(const v2u*)(zp_ + 1024); \
                if (l > 0) VFC = *(const v2u*)(VF + (size_t)t * 512 + c_); } while (0)
            v2u oR[4] = {}, oK[4] = {}, oV[4] = {}, oA[4] = {}, oB[4] = {}, oG[4] = {}; f32x4 oW[4] = {};
#define SEL4(O, val) do { _Pragma("unroll") for (int q_ = 0; q_ < 4; ++q_) O[q_] = (nt == q_) ? (val) : O[q_]; } while (0)
#pragma unroll 1
            for (int nt = 0; nt < 4; ++nt) {
                PREP_LOAD(nt, wf, zc, vfc);
                f32x4 aw = (f32x4){0.f, 0.f, 0.f, 0.f}, aa = aw, ag = aw, av = aw;
                bf16x8 xfr[9];
#pragma unroll
                for (int i_ = 0; i_ < 9; ++i_) xfr[i_] = *(const LAS bf16x8*)(X + tok * XS_LD + 8 * quad + 32 * i_);
                __builtin_amdgcn_sched_barrier(0);
#pragma unroll
                for (int ks = 0; ks < 2; ++ks) aw = mfma16(wf[ks], xfr[ks], aw);
#pragma unroll
                for (int ks = 0; ks < 2; ++ks) aa = mfma16(wf[2 + ks], xfr[2 + ks], aa);
#pragma unroll
                for (int ks = 0; ks < 4; ++ks) ag = mfma16(wf[4 + ks], xfr[4 + ks], ag);
                av = mfma16(wf[8], xfr[8], av);
                const int c = 64 * h + 16 * quad + 4 * nt;
                const v2u r_c = zc[0], k_c = zc[1], v_c = zc[2];
                v2u r_p = zc[3], k_p = zc[4], v_p = zc[5];
                if (first) { r_p = (v2u){0u, 0u}; k_p = r_p; v_p = r_p; }
                const f32x4 mr = PTV(0, c), mk = PTV(1, c), mv = PTV(2, c);
                const f32x4 rc = (f32x4){blo(r_c.x), bhi(r_c.x), blo(r_c.y), bhi(r_c.y)}, rp = (f32x4){blo(r_p.x), bhi(r_p.x), blo(r_p.y), bhi(r_p.y)};
                const f32x4 kc = (f32x4){blo(k_c.x), bhi(k_c.x), blo(k_c.y), bhi(k_c.y)}, kp = (f32x4){blo(k_p.x), bhi(k_p.x), blo(k_p.y), bhi(k_p.y)};
                const f32x4 vc = (f32x4){blo(v_c.x), bhi(v_c.x), blo(v_c.y), bhi(v_c.y)}, vp = (f32x4){blo(v_p.x), bhi(v_p.x), blo(v_p.y), bhi(v_p.y)};
                const f32x4 r = rc + (rp - rc) * mr, k = kc + (kp - kc) * mk; f32x4 v = vc + (vp - vc) * mv;
                const f32x4 w0v = PTV(3, c), a0v = PTV(4, c), kkv = PTV(6, c), kav = PTV(7, c), rkv = PTV(8, c);
                f32x4 aval, dc, kkn, k2v;
#pragma unroll
                for (int j = 0; j < 4; ++j) { dc[j] = -0.6065306597126334f * sigm(w0v[j] + aw[j]);     aval[j] = sigm(a0v[j] + aa[j]);
                    kkn[j] = k[j] * kkv[j] * inv; k2v[j] = k[j] * (1.0f + (aval[j] - 1.0f) * kav[j]); bs += r[j] * k2v[j] * rkv[j]; }
                const size_t o = (size_t)t * 512 + c;
                if (l > 0) { const f32x4 v0v = PTV(5, c); const f32x4 vf = (f32x4){blo(vfc.x), bhi(vfc.x), blo(vfc.y), bhi(vfc.y)};
#pragma unroll
                    for (int j = 0; j < 4; ++j) v[j] = v[j] + (vf[j] - v[j]) * sigm(v0v[j] + av[j]); }
#define PK4(val) ((v2u){pk2((val)[0], (val)[1]), pk2((val)[2], (val)[3])})
                { const v2u pr_ = PK4(r), pk_ = PK4(k2v), pv_ = PK4(v), pg_ = PK4(ag); SEL4(oR, pr_); SEL4(oW, dc); SEL4(oK, pk_); SEL4(oV, pv_); SEL4(oG, pg_); }
                { const f32x4 nkn = -kkn, kna = kkn * aval; const v2u pa_ = PK4(nkn), pb_ = PK4(kna); SEL4(oA, pa_); SEL4(oB, pb_); }
            }
#undef PREP_LOAD
            bs += shx<16>(bs); bs += shx<32>(bs);
            if (quad == 0) BON[(size_t)t * 8 + h] = bs;
            { const size_t o = (size_t)t * 512 + 64 * h + 16 * quad;
#define ST16H(arr, O) do { bf16* d_ = RWH + (size_t)(arr) * (RHSZ / 2) + o; *(v4u*)d_ = (v4u){O[0].x, O[0].y, O[1].x, O[1].y}; *(v4u*)(d_ + 8) = (v4u){O[2].x, O[2].y, O[3].x, O[3].y}; } while (0)
              ST16H(0, oR); ST16H(1, oK); ST16H(2, oV); ST16H(3, oA); ST16H(4, oB); ST16H(5, oG);
#pragma unroll
              for (int nt = 0; nt < 4; ++nt) *(f32x4*)(LW + o + 4 * nt) = oW[nt];
              if (l == 0) { bf16* d_ = VF + o; *(v4u*)d_ = (v4u){oV[0].x, oV[0].y, oV[1].x, oV[1].y}; *(v4u*)(d_ + 8) = (v4u){oV[2].x, oV[2].y, oV[3].x, oV[3].y}; } }
#undef ST16H
#undef PK4
#undef SEL4
        }
        {
            bf16x8 lf[4], ln[4];
#define LRU_LOAD(NT, LF) do { const bf16* wxr_ = wlru + ((size_t)h * 64 + 16 * (NT) + tok) * 64 + 8 * quad; LF[0] = *(const bf16x8*)(wxr_); LF[1] = *(const bf16x8*)(wxr_ + 32); LF[2] = *(const bf16x8*)(wxr_ + 8 * 64 * 64); LF[3] = *(const bf16x8*)(wxr_ + 8 * 64 * 64 + 32); } while (0)
            LRU_LOAD(0, lf);
#pragma unroll 1
            for (int nt = 0; nt < 4; ++nt) { f32x4 gx = (f32x4){0.f, 0.f, 0.f, 0.f}, ga = gx;
                if (nt < 3) LRU_LOAD(nt + 1, ln);
                const LAS bf16* xrow = XCb + tok * XCB_LD + 64 * h + 8 * quad;
#pragma unroll
                for (int ks = 0; ks < 2; ++ks) { const bf16x8 xf = *(const LAS bf16x8*)(xrow + 32 * ks); gx = mfma16(lf[ks], xf, gx); ga = mfma16(lf[2 + ks], xf, ga); }
                const int c = 64 * h + 16 * nt + 4 * quad;
                const f32x4 bxv = PTV(9, c), bav = PTV(10, c), lmv = PTV(11, c);
                const f32x4 xc = *(const LAS f32x4*)(XCf + tok * XCF_LD + c);
                f32x4 oa, ob;
#pragma unroll
                for (int j = 0; j < 4; ++j) { const float gxs = sigm(gx[j] + bxv[j]), gas = sigm(ga[j] + bav[j]); const float la = gas * lmv[j];
                    oa[j] = __expf(la); const float mult = first ? 1.0f : sqrtf(1.0f - __expf(2.0f * la)); ob[j] = mult * gxs * xc[j]; }
                *(f32x4*)(LA + (size_t)t * 512 + c) = oa; *(v2u*)(LB + (size_t)t * 512 + c) = (v2u){pk2(ob[0], ob[1]), pk2(ob[2], ob[3])};
#pragma unroll
                for (int i_ = 0; i_ < 4; ++i_) lf[i_] = ln[i_]; }
#undef LRU_LOAD
        }
        __syncthreads();
    }
#undef PTV
}

DI void scan_rwkv_item(Frame& F, int item) {
    constexpr int T = 32, BUF = 5 * T * 64 + T * 32;
    LAS float* stg = (LAS float*)F.lds;
    LAS float* yout = (LAS float*)(F.lds + 2 * BUF * 4);
    const int half = item & 1, h = (item >> 1) & 7, b = item >> 4;
    const float* RWb = (const float*)(F.ws + WS_RW); float* YA = (float*)(F.ws + WS_YA);
    const int rl = F.tid >> 4, kq = F.tid & 15;
    const size_t tb0 = (size_t)b * SEQ;
    f32x4 pre[6];
    auto issue = [&](int blk) {
#pragma unroll
        for (int i = 0; i < 6; ++i) { const int idx = F.tid + i * NTHR; if (idx < BUF / 4) {
            const float* src;
            if (idx < 2560) { const int arr = idx >> 9, rem = idx & 511, st = rem >> 4, c4 = rem & 15; const int ga = (arr == 3) ? 4 : (arr == 4 ? 5 : arr);
                src = RWb + (size_t)ga * (RWSZ / 4) + (tb0 + blk * T + st) * 512 + 64 * h + 4 * c4; }
            else { const int rem = idx - 2560, st = rem >> 3, c4 = rem & 7; src = RWb + (size_t)3 * (RWSZ / 4) + (tb0 + blk * T + st) * 512 + 64 * h + 32 * half + 4 * c4; }
            pre[i] = *(const f32x4*)src; } }
    };
    auto commit = [&](int buf) {
#pragma unroll
        for (int i = 0; i < 6; ++i) { const int idx = F.tid + i * NTHR; if (idx < BUF / 4) *(LAS f32x4*)(stg + buf * BUF + idx * 4) = pre[i]; }
    };
    issue(0); commit(0); __syncthreads();
    f32x4 S = (f32x4){0.f, 0.f, 0.f, 0.f};
    for (int blk = 0; blk < SEQ / T; ++blk) {
        const int buf = blk & 1;
        if (blk + 1 < SEQ / T) issue(blk + 1);
        const LAS float* sb = stg + buf * BUF;
#pragma unroll 4
        for (int s = 0; s < T; ++s) {
            const f32x4 r4 = *(const LAS f32x4*)(sb + 0 * T * 64 + s * 64 + 4 * kq), w4 = *(const LAS f32x4*)(sb + 1 * T * 64 + s * 64 + 4 * kq), k4 = *(const LAS f32x4*)(sb + 2 * T * 64 + s * 64 + 4 * kq);
            const f32x4 a4 = *(const LAS f32x4*)(sb + 3 * T * 64 + s * 64 + 4 * kq), b4 = *(const LAS f32x4*)(sb + 4 * T * 64 + s * 64 + 4 * kq);
            const float v = sb[5 * T * 64 + s * 32 + rl];
            const float sa = row16_sum((S[0] * a4[0] + S[1] * a4[1]) + (S[2] * a4[2] + S[3] * a4[3]));
            S = S * w4 + b4 * sa + k4 * v;
            const float y = row16_sum((S[0] * r4[0] + S[1] * r4[1]) + (S[2] * r4[2] + S[3] * r4[3]));
            if (kq == 0) yout[s * 32 + rl] = y;
        }
        __syncthreads();
        for (int i = F.tid; i < T * 32; i += NTHR) { const int st = i >> 5, r = i & 31; YA[(tb0 + blk * T + st) * 512 + 64 * h + 32 * half + r] = yout[i]; }
        if (blk + 1 < SEQ / T) commit(buf ^ 1);
        __syncthreads();
    }
}
DI void scan_hgrn_item(Frame& F, KA a, int l, int item) {
    constexpr int T = 32;
    LAS float* Fd = (LAS float*)F.lds; LAS float* Kk = Fd + T * 128; LAS float* Qs = Kk + T * 128; LAS float* Is = Qs + T * 128; LAS float* Oo = Is + T * 16; LAS float* lbs = Oo + T * 16;
    const int vs = item & 7, h = (item >> 3) & 3, b = item >> 5;
    const bf16* z = (const bf16*)(F.ws + WS_Z); float* OB = (float*)(F.ws + WS_OB);
    const size_t tb0 = (size_t)b * SEQ;
    if (F.tid < 128) { const int c = 128 * h + F.tid; const float* hb = a->in[17];
        const float x0 = hb[c], x1 = hb[512 + c], x2 = hb[1024 + c], x3 = hb[1536 + c]; const float mx = fmaxf(fmaxf(x0, x1), fmaxf(x2, x3));
        const float e0 = __expf(x0 - mx), e1 = __expf(x1 - mx), e2 = __expf(x2 - mx), e3 = __expf(x3 - mx); const float inv = 1.0f / (e0 + e1 + e2 + e3);
        lbs[F.tid] = (l == 0) ? 0.0f : (l == 1 ? e1 * inv : (l == 2 ? (e1 + e2) * inv : (e1 + e2 + e3) * inv)); }
    v4u pre[3];
    auto issue = [&](int blk) {
#pragma unroll
        for (int i = 0; i < 3; ++i) { const int idx = F.tid + i * NTHR; if (idx < 1088) { const bf16* src;
            if (idx < 1024) { const int arr = idx >> 9, rem = idx & 511, st = rem >> 4, ch = rem & 15; src = z + (tb0 + blk * T + st) * ZLD + ZB + arr * 512 + 128 * h + 8 * ch; }
            else { const int rem = idx - 1024, st = rem >> 1, ch = rem & 1; src = z + (tb0 + blk * T + st) * ZLD + ZB + 1024 + 128 * h + 16 * vs + 8 * ch; }
            pre[i] = *(const v4u*)src; } }
    };
    auto commit = [&]() {
#pragma unroll
        for (int i = 0; i < 3; ++i) { const int idx = F.tid + i * NTHR; if (idx < 1088) { float v[8]; v[0] = blo(pre[i].x); v[1] = bhi(pre[i].x); v[2] = blo(pre[i].y); v[3] = bhi(pre[i].y); v[4] = blo(pre[i].z); v[5] = bhi(pre[i].z); v[6] = blo(pre[i].w); v[7] = bhi(pre[i].w);
            if (idx < 512) { const int st = idx >> 4, ch = idx & 15;
#pragma unroll
                for (int j = 0; j < 8; ++j) Qs[st * 128 + 8 * ch + j] = siluf(v[j]); }
            else if (idx < 1024) { const int rem = idx & 511, st = rem >> 4, ch = rem & 15;
#pragma unroll
                for (int j = 0; j < 8; ++j) { const float lb = lbs[8 * ch + j], sg = sigm(v[j]); Fd[st * 128 + 8 * ch + j] = lb + (1.0f - lb) * sg; Kk[st * 128 + 8 * ch + j] = (1.0f - lb) * (1.0f - sg); } }
            else { const int rem = idx - 1024, st = rem >> 1, ch = rem & 1;
#pragma unroll
                for (int j = 0; j < 8; ++j) Is[st * 16 + 8 * ch + j] = v[j]; } } }
    };
    __syncthreads();
    issue(0); commit(); __syncthreads();
    const int vl = 2 * F.wave + (F.lane >> 5), kg = F.lane & 31;
    f32x4 S = (f32x4){0.f, 0.f, 0.f, 0.f};
    for (int blk = 0; blk < SEQ / T; ++blk) {
        if (blk + 1 < SEQ / T) issue(blk + 1);
#pragma unroll 4
        for (int s = 0; s < T; ++s) {
            const f32x4 f4 = *(const LAS f32x4*)(Fd + s * 128 + 4 * kg), k4 = *(const LAS f32x4*)(Kk + s * 128 + 4 * kg), q4 = *(const LAS f32x4*)(Qs + s * 128 + 4 * kg);
            const float iv = Is[s * 16 + vl];
            S = S * f4 + k4 * iv;
            float o = row16_sum((S[0] * q4[0] + S[1] * q4[1]) + (S[2] * q4[2] + S[3] * q4[3]));
            o += shx<16>(o);
            if (kg == 0) Oo[s * 16 + vl] = o;
        }
        __syncthreads();
        { const int st = F.tid >> 4, r = F.tid & 15; OB[(tb0 + blk * T + st) * 512 + 128 * h + 16 * vs + r] = Oo[F.tid]; }
        if (blk + 1 < SEQ / T) commit();
        __syncthreads();
    }
}
DI void scan_mlstm_item(Frame& F, KA a, int l, int item) {
    constexpr int T = 32;
    LAS float* Qs = (LAS float*)F.lds; LAS float* Ks = Qs + T * 128; LAS float* Vs = Ks + T * 128; LAS float* Ho = Vs + T * 16;
    LAS float* FD = Ho + T * 16; LAS float* IW = FD + T; LAS float* EM = IW + T; LAS float* IG = EM + T; LAS float* FG = IG + T; LAS float* mst = FG + T;
    LAS float* raw = mst + 32;
    const int vs = item & 7, h = (item >> 3) & 3, b = item >> 5;
    const bf16* z = (const bf16*)(F.ws + WS_Z); float* HC = (float*)(F.ws + WS_HC);
    const float* cw = a->in[19] + l * 4 * 1024; const float* cb = a->in[20] + l * 1024; const float ib = a->in[21][l * 4 + h], fb = a->in[22][l * 4 + h];
    const size_t tb0 = (size_t)b * SEQ;
    v4u pre[3]; v4u prev_; float pig = 0.f, pfg = 0.f;
    auto issue = [&](int blk) {
#pragma unroll
        for (int i = 0; i < 3; ++i) { const int idx = F.tid + i * NTHR; if (idx < 1120) { const int row = idx >> 5, rem = idx & 31, arr = rem >> 4, ch = rem & 15; const int tt = blk * T - 3 + row;
            pre[i] = (tt >= 0) ? *(const v4u*)(z + (tb0 + tt) * ZLD + ZC + arr * 512 + 128 * h + 8 * ch) : (v4u){0u, 0u, 0u, 0u}; } }
        if (F.tid < 64) { const int st = F.tid >> 1, ch = F.tid & 1; prev_ = *(const v4u*)(z + (tb0 + blk * T + st) * ZLD + ZC + 1024 + 128 * h + 16 * vs + 8 * ch); }
        if (F.tid >= 64 && F.tid < 96) { const int st = F.tid - 64; const bf16* zr = z + (tb0 + blk * T + st) * ZLD + ZC + 2048; pig = bf2f(zr[h]); pfg = bf2f(zr[4 + h]); }
    };
    auto commit = [&]() {
#pragma unroll
        for (int i = 0; i < 3; ++i) { const int idx = F.tid + i * NTHR; if (idx < 1120) { const int row = idx >> 5, rem = idx & 31;
            LAS float* d = raw + row * 256 + 8 * rem; d[0] = blo(pre[i].x); d[1] = bhi(pre[i].x); d[2] = blo(pre[i].y); d[3] = bhi(pre[i].y); d[4] = blo(pre[i].z); d[5] = bhi(pre[i].z); d[6] = blo(pre[i].w); d[7] = bhi(pre[i].w); } }
        if (F.tid < 64) { const int st = F.tid >> 1, ch = F.tid & 1; LAS float* d = Vs + st * 16 + 8 * ch; d[0] = blo(prev_.x); d[1] = bhi(prev_.x); d[2] = blo(prev_.y); d[3] = bhi(prev_.y); d[4] = blo(prev_.z); d[5] = bhi(prev_.z); d[6] = blo(prev_.w); d[7] = bhi(prev_.w); }
        if (F.tid >= 64 && F.tid < 96) { IG[F.tid - 64] = pig + ib; FG[F.tid - 64] = logsigm(pfg + fb); }
        __syncthreads();
        for (int idx = F.tid; idx < T * 256; idx += NTHR) { const int st = idx >> 8, cc = idx & 255, arr = cc >> 7, k = cc & 127; const int wc_ = arr * 512 + 128 * h + k;
            float acc = cb[wc_];
#pragma unroll
            for (int j = 0; j < 4; ++j) acc += raw[(st + j) * 256 + cc] * cw[j * 1024 + wc_];
            acc = siluf(acc);
            if (arr == 0) Qs[st * 128 + k] = acc; else Ks[st * 128 + k] = acc * 0.08838834764831845f; }
        if (F.tid == 0) { float m = mst[0];
            for (int s = 0; s < T; ++s) { const float lf = FG[s], ip = IG[s]; const float mn = fmaxf(lf + m, ip); FD[s] = __expf(lf + m - mn); IW[s] = __expf(ip - mn); EM[s] = __expf(-mn); m = mn; }
            mst[0] = m; }
    };
    if (F.tid == 0) mst[0] = -1e30f;
    __syncthreads();
    issue(0); commit(); __syncthreads();
    const int vl = 2 * F.wave + (F.lane >> 5), kg = F.lane & 31;
    f32x4 C = (f32x4){0.f, 0.f, 0.f, 0.f}, n = C;
    for (int blk = 0; blk < SEQ / T; ++blk) {
        if (blk + 1 < SEQ / T) issue(blk + 1);
#pragma unroll 4
        for (int s = 0; s < T; ++s) {
            const f32x4 k4 = *(const LAS f32x4*)(Ks + s * 128 + 4 * kg), q4 = *(const LAS f32x4*)(Qs + s * 128 + 4 * kg);
            const float fd = FD[s], iw = IW[s], vv = Vs[s * 16 + vl];
            C = C * fd + k4 * (iw * vv); n = n * fd + k4 * iw;
            float num = row16_sum((C[0] * q4[0] + C[1] * q4[1]) + (C[2] * q4[2] + C[3] * q4[3]));
            float den = row16_sum((n[0] * q4[0] + n[1] * q4[1]) + (n[2] * q4[2] + n[3] * q4[3]));
            num += shx<16>(num); den += shx<16>(den);
            if (kg == 0) Ho[s * 16 + vl] = num / fmaxf(fabsf(den), EM[s]);
        }
        __syncthreads();
        { const int st = F.tid >> 4, r = F.tid & 15; HC[(tb0 + blk * T + st) * 512 + 128 * h + 16 * vs + r] = Ho[F.tid]; }
        if (blk + 1 < SEQ / T) commit();
        __syncthreads();
    }
}
DI void scan_lru_item(Frame& F, int item) {
    LAS float* SA = (LAS float*)F.lds; LAS float* SB = SA + 512;
    const int cg = item & 31, b = item >> 5, ch = F.tid & 15, seg = F.tid >> 4, c = 16 * cg + ch;
    const float* LA = (const float*)(F.ws + WS_LA); const float* LB = (const float*)(F.ws + WS_LB); const bf16* z = (const bf16*)(F.ws + WS_Z);
    bf16* Y3 = (bf16*)(F.ws + WS_Y) + (size_t)3 * M * 512;
    const size_t t0 = (size_t)b * SEQ + seg * 64;
    float A = 1.0f, Bv = 0.0f;
    for (int s = 0; s < 64; ++s) { const float av = LA[(t0 + s) * 512 + c], bv = LB[(t0 + s) * 512 + c]; A *= av; Bv = av * Bv + bv; }
    SA[seg * 16 + ch] = A; SB[seg * 16 + ch] = Bv;
    __syncthreads();
    float hh = 0.0f;
    for (int s2 = 0; s2 < seg; ++s2) hh = SA[s2 * 16 + ch] * hh + SB[s2 * 16 + ch];
    for (int s = 0; s < 64; ++s) { const float av = LA[(t0 + s) * 512 + c], bv = LB[(t0 + s) * 512 + c]; hh = av * hh + bv;
        const float g = bf2f(z[(t0 + s) * ZLD + ZD + 512 + c]); Y3[(t0 + s) * 512 + c] = (bf16)f2bf(hh * gelu_tanh(g)); }
    __syncthreads();
}
DI bf16x8 pack8(f32x4 lo, f32x4 hi) { v4u w; w.x = pk2(lo[0], lo[1]); w.y = pk2(lo[2], lo[3]); w.z = pk2(hi[0], hi[1]); w.w = pk2(hi[2], hi[3]); return __builtin_bit_cast(bf16x8, w); }
DI bf16x8 ld_perm(const LAS bf16* row, int kbase, int quad) {
    const v2u a = *(const LAS v2u*)(row + kbase + 4 * quad), b = *(const LAS v2u*)(row + kbase + 16 + 4 * quad); v4u w; w.x = a.x; w.y = a.y; w.z = b.x; w.w = b.y; return __builtin_bit_cast(bf16x8, w); }
constexpr int CQ_LD = 136, CT_LD = 40;
constexpr int FH_STRIDE = 34 * 1024 + 512;
DI void st_frag(unsigned char* base, int f, int lane, bf16x8 v) { *(bf16x8*)(base + f * 1024 + lane * 16) = v; }
DI bf16x8 ld_vperm(const unsigned char* natfrag, int fr, int quad) { const unsigned char* p = natfrag + (fr + 16 * (quad >> 1)) * 16 + 8 * (quad & 1);
    const v2u a = *(const v2u*)p, b = *(const v2u*)(p + 512); return __builtin_bit_cast(bf16x8, (v4u){a.x, a.y, b.x, b.y}); }
DI void hgrn_raw_load(Frame& F, int prob, v4u& pq, v4u& pf, v4u& pi) {
    const int bh = prob >> 6, c = prob & 63, h = bh & 3, b = bh >> 2; const bf16* z = (const bf16*)(F.ws + WS_Z);
    const bf16* src = z + ((size_t)b * SEQ + c * 32 + (F.tid >> 4)) * ZLD + ZB + 128 * h + 8 * (F.tid & 15); pq = *(const v4u*)src; pf = *(const v4u*)(src + 512); pi = *(const v4u*)(src + 1024);
}
DI void hgrn_lower_bounds(Frame& F, KA a, int l) {
    constexpr int C = 32;
    LAS float* lbs = (LAS float*)((LAS bf16*)F.lds + 2 * C * CQ_LD + 2 * 128 * CT_LD) + C * 128 + 4 * 128;
    { const int cc = F.tid; const float* hb = a->in[17];
      const float x0 = hb[cc], x1 = hb[512 + cc], x2 = hb[1024 + cc], x3 = hb[1536 + cc]; const float mx = fmaxf(fmaxf(x0, x1), fmaxf(x2, x3));
      const float e0 = __expf(x0 - mx), e1 = __expf(x1 - mx), e2 = __expf(x2 - mx), e3 = __expf(x3 - mx); const float inv = 1.0f / (e0 + e1 + e2 + e3);
      lbs[cc] = (l == 0) ? 0.0f : (l == 1 ? e1 * inv : (l == 2 ? (e1 + e2) * inv : (e1 + e2 + e3) * inv)); }
    __syncthreads();
}
DI void prep_hgrn_item(Frame& F, KA a, int l, int prob, int nprob, v4u& pq, v4u& pf, v4u& pi) {
    constexpr int C = 32;
    LAS bf16* Qt = (LAS bf16*)F.lds; LAS bf16* Kt = Qt + C * CQ_LD; LAS bf16* KhT = Kt + C * CQ_LD; LAS bf16* VT = KhT + 128 * CT_LD;
    LAS float* bc = (LAS float*)(VT + 128 * CT_LD); LAS float* PS = bc + C * 128; LAS float* lbs = PS + 4 * 128;
    const int bh = prob >> 6, c = prob & 63, h = bh & 3, b = bh >> 2, w = F.wave, lane = F.lane, fr = lane & 15, quad = lane >> 4;
    const bf16* z = (const bf16*)(F.ws + WS_Z);
    unsigned char* fo = F.ws + WS_FRH + (size_t)prob * FH_STRIDE;
    const size_t row0 = (size_t)b * SEQ + c * C;
    const int tr = F.tid >> 4, k0 = 8 * (F.tid & 15);
    float qv[8], kv[8];
    { const float fr_[8] = {blo(pf.x), bhi(pf.x), blo(pf.y), bhi(pf.y), blo(pf.z), bhi(pf.z), blo(pf.w), bhi(pf.w)};
      const float qr[8] = {blo(pq.x), bhi(pq.x), blo(pq.y), bhi(pq.y), blo(pq.z), bhi(pq.z), blo(pq.w), bhi(pq.w)};
      float lf[8];
#pragma unroll
      for (int j = 0; j < 8; ++j) { const float lb = lbs[128 * h + k0 + j], sg = sigm(fr_[j]); const float f = lb + (1.0f - lb) * sg; lf[j] = __logf(fmaxf(f, 1e-37f)); kv[j] = (1.0f - lb) * (1.0f - sg); qv[j] = siluf(qr[j]); }
      *(LAS f32x4*)(bc + tr * 128 + k0) = (f32x4){lf[0], lf[1], lf[2], lf[3]}; *(LAS f32x4*)(bc + tr * 128 + k0 + 4) = (f32x4){lf[4], lf[5], lf[6], lf[7]};
      const unsigned iv[4] = {pi.x, pi.y, pi.z, pi.w};
#pragma unroll
      for (int j = 0; j < 4; ++j) { VT[(k0 + 2 * j) * CT_LD + tr] = (bf16)(iv[j] & 0xffffu); VT[(k0 + 2 * j + 1) * CT_LD + tr] = (bf16)(iv[j] >> 16); } }
    if (nprob >= 0) hgrn_raw_load(F, nprob, pq, pf, pi);
    __syncthreads();
    { const int k = F.tid & 127, part = F.tid >> 7; float v8[8], run = 0.f;
#pragma unroll
      for (int j = 0; j < 8; ++j) v8[j] = bc[(8 * part + j) * 128 + k];
#pragma unroll
      for (int j = 0; j < 8; ++j) { run += v8[j]; bc[(8 * part + j) * 128 + k] = run; }
      PS[part * 128 + k] = run; }
    __syncthreads();
    { float q8[8], k8[8]; const int part = tr >> 3;
#pragma unroll
      for (int j = 0; j < 8; ++j) { const int k = k0 + j; const float p0 = PS[k], p1 = PS[128 + k], p2 = PS[256 + k], p3 = PS[384 + k];
          const float off = (part > 0 ? p0 : 0.f) + (part > 1 ? p1 : 0.f) + (part > 2 ? p2 : 0.f); const float blast = (p0 + p1) + (p2 + p3);
          const float bcu = bc[tr * 128 + k] + off; q8[j] = qv[j] * __expf(bcu); k8[j] = kv[j] * __expf(-bcu);
          KhT[k * CT_LD + tr] = (bf16)f2bf(kv[j] * __expf(blast - bcu));
          if (tr == 0) ((float*)(fo + 34 * 1024))[k] = __expf(blast); }
      *(LAS v4u*)(Qt + tr * CQ_LD + k0) = (v4u){pk2(q8[0], q8[1]), pk2(q8[2], q8[3]), pk2(q8[4], q8[5]), pk2(q8[6], q8[7])};
      *(LAS v4u*)(Kt + tr * CQ_LD + k0) = (v4u){pk2(k8[0], k8[1]), pk2(k8[2], k8[3]), pk2(k8[4], k8[5]), pk2(k8[6], k8[7])}; }
    __syncthreads();
    st_frag(fo, w, lane, ld_perm(Qt + (16 * (w >> 2) + fr) * CQ_LD, 32 * (w & 3), quad));
    st_frag(fo, 8 + w, lane, *(const LAS bf16x8*)(KhT + (16 * w + fr) * CT_LD + 8 * quad));
    st_frag(fo, 19 + 2 * w, lane, *(const LAS bf16x8*)(VT + (16 * w + fr) * CT_LD + 8 * quad));
    if (w < 2) {
        const f32x4 zero4 = fresh_zero4(); f32x4 pa = zero4, pb = zero4;
#pragma unroll
        for (int ks = 0; ks < 4; ++ks) { const bf16x8 qb = *(const LAS bf16x8*)(Qt + (16 * w + fr) * CQ_LD + 32 * ks + 8 * quad);
            pa = mfma16(*(const LAS bf16x8*)(Kt + fr * CQ_LD + 32 * ks + 8 * quad), qb, pa);
            if (w == 1) pb = mfma16(*(const LAS bf16x8*)(Kt + (16 + fr) * CQ_LD + 32 * ks + 8 * quad), qb, pb); }
#pragma unroll
        for (int j = 0; j < 4; ++j) { if (4 * quad + j > fr) { if (w == 0) pa[j] = 0.f; else pb[j] = 0.f; } }
        st_frag(fo, 16 + w, lane, pack8(pa, pb));
    }
    __syncthreads();
}
template <int NF, int NW, int SB> struct ChainStage {
    static constexpr int MAXF = (NF + NW - 1) / NW, SLOT = NF * 1024 + 512;
    bf16x8 r[MAXF]; f32x4 sc;
    DI void load(const unsigned char* p, int wsub, int lane) {
#pragma unroll
        for (int i = 0; i < MAXF; ++i) { const int f = wsub + NW * i; if (f < NF) r[i] = *(const bf16x8*)(p + f * 1024 + lane * 16); }
        if (wsub == NW - 1 && lane < SB / 16) sc = *(const f32x4*)(p + NF * 1024 + lane * 16);
    }
    DI void store(LAS unsigned char* slot, int wsub, int lane) const {
#pragma unroll
        for (int i = 0; i < MAXF; ++i) { const int f = wsub + NW * i; if (f < NF) *(LAS bf16x8*)(slot + f * 1024 + lane * 16) = r[i]; }
        if (wsub == NW - 1 && lane < SB / 16) *(LAS f32x4*)(slot + NF * 1024 + lane * 16) = sc;
    }
};
#define LQ(slot, f) (*(const LAS bf16x8*)((slot) + (f) * 1024 + lane * 16))
DI void chain_hgrn(Frame& F, int item) {
    typedef ChainStage<18, 8, 512> St;
    const int bh = item, h = bh & 3, b = bh >> 2, w = F.wave, lane = F.lane, fr = lane & 15, quad = lane >> 4;
    const bool act = true; const int vs = w;
    const unsigned char* fb = F.ws + WS_FRH + (size_t)bh * 64 * FH_STRIDE;
    bf16* OB = (bf16*)(F.ws + WS_OB);
    LAS unsigned char* L = F.lds;
    f32x4 S[8];
#pragma unroll
    for (int i = 0; i < 8; ++i) S[i] = (f32x4){0.f, 0.f, 0.f, 0.f};
    St sa, sb, sc;
    auto ld = [&](St& s, int c) { const unsigned char* p = fb + (size_t)c * FH_STRIDE;
#pragma unroll
        for (int i = 0; i < St::MAXF; ++i) { const int f = w + 8 * i; if (f < 18) s.r[i] = *(const bf16x8*)(p + f * 1024 + lane * 16); }
        if (w == 7 && lane < 32) s.sc = *(const f32x4*)(p + 34 * 1024 + lane * 16); };
    ld(sa, 0); sa.store(L, w, lane); ld(sa, 1); ld(sb, 2);
    bf16x8 vp = ld_vperm(fb + (19 + 2 * vs) * 1024, fr, quad), vn = *(const bf16x8*)(fb + (19 + 2 * vs) * 1024 + lane * 16);
    bf16x8 vp1 = ld_vperm(fb + FH_STRIDE + (19 + 2 * vs) * 1024, fr, quad), vn1 = *(const bf16x8*)(fb + FH_STRIDE + (19 + 2 * vs) * 1024 + lane * 16);
    __syncthreads();
    const f32x4 zero4 = fresh_zero4();
#pragma unroll 1
    for (int c = 0; c < 64; ++c) {
        ld(sc, c + 3 < 64 ? c + 3 : 63);
        const unsigned char* pn = fb + (size_t)(c + 2 < 64 ? c + 2 : 63) * FH_STRIDE;
        const LAS unsigned char* sl = L + (c & 1) * St::SLOT;
        if (act) {
        bf16x8 q[18]; f32x4 gl[8];
#pragma unroll
        for (int i = 0; i < 18; ++i) q[i] = LQ(sl, i);
#pragma unroll
        for (int kk = 0; kk < 8; ++kk) gl[kk] = *(const LAS f32x4*)(sl + 18 * 1024 + (16 * kk + 4 * quad) * 4);
        __builtin_amdgcn_sched_barrier(0);
        f32x4 o0 = mfma16(q[16], vp, zero4), o1 = mfma16(q[17], vp, zero4); vp = vp1; vp1 = ld_vperm(pn + (19 + 2 * vs) * 1024, fr, quad);
#pragma unroll
        for (int kt = 0; kt < 4; ++kt) { const bf16x8 sf = pack8(S[2 * kt], S[2 * kt + 1]); o0 = mfma16(q[kt], sf, o0); o1 = mfma16(q[4 + kt], sf, o1); }
#pragma unroll
        for (int kk = 0; kk < 8; ++kk) S[kk] = mfma16(q[8 + kk], vn, S[kk] * gl[kk]);
        vn = vn1; vn1 = *(const bf16x8*)(pn + (19 + 2 * vs) * 1024 + lane * 16);
        bf16* ob = OB + ((size_t)b * SEQ + c * 32) * 512 + 128 * h + 16 * vs; const unsigned lo = 4u * quad * 512u + fr;
#pragma unroll
        for (int j = 0; j < 4; ++j) { ob[lo + j * 512] = (bf16)f2bf(o0[j]); ob[lo + (16 + j) * 512] = (bf16)f2bf(o1[j]); }
        }
        sa.store(L + ((c + 1) & 1) * St::SLOT, w, lane);
        __syncthreads();
        sa = sb; sb = sc;
    }
}
template <int CTRL, int RM> DI float dpp_rm(float old, float v) { return __builtin_bit_cast(float, __builtin_amdgcn_update_dpp(__builtin_bit_cast(int, old), __builtin_bit_cast(int, v), CTRL, RM, 0xf, false)); }
DI float scan32_add(float v) {
    v += dpp_rm<0x111, 0xf>(0.f, v); v += dpp_rm<0x112, 0xf>(0.f, v); v += dpp_rm<0x114, 0xf>(0.f, v); v += dpp_rm<0x118, 0xf>(0.f, v); v += dpp_rm<0x142, 0xa>(0.f, v); return v; }
DI float scan32_max(float v) {
    const float ninf = -3.0e38f;
    v = fmaxf(v, dpp_rm<0x111, 0xf>(ninf, v)); v = fmaxf(v, dpp_rm<0x112, 0xf>(ninf, v)); v = fmaxf(v, dpp_rm<0x114, 0xf>(ninf, v)); v = fmaxf(v, dpp_rm<0x118, 0xf>(ninf, v)); v = fmaxf(v, dpp_rm<0x142, 0xa>(ninf, v)); return v; }
struct MRaw { v4u r[3], v; float ig, fg; };
DI void mlstm_raw_load(Frame& F, int prob, MRaw& R) {
    const int bh = prob >> 6, c = prob & 63, h = bh & 3, b = bh >> 2; const bf16* z = (const bf16*)(F.ws + WS_Z);
#pragma unroll
    for (int i = 0; i < 3; ++i) { const int idx = F.tid + i * NTHR; if (idx < 1120) { const int row = idx >> 5, pc = idx & 31; const int tt = c * 32 - 3 + row;
        R.r[i] = (tt >= 0) ? *(const v4u*)(z + ((size_t)b * SEQ + tt) * ZLD + ZC + (pc >> 4) * 512 + 128 * h + 8 * (pc & 15)) : (v4u){0u, 0u, 0u, 0u}; } }
    R.v = *(const v4u*)(z + ((size_t)b * SEQ + c * 32 + (F.tid >> 4)) * ZLD + ZC + 1024 + 128 * h + 8 * (F.tid & 15));
    if (F.wave == 0) { const bf16* zr = z + ((size_t)b * SEQ + c * 32 + (F.lane & 31)) * ZLD + ZC + 2048; R.ig = bf2f(zr[h]); R.fg = bf2f(zr[4 + h]); }
}
DI void prep_mlstm_item(Frame& F, KA a, int l, int prob, int nprob, MRaw& R) {
    constexpr int C = 32;
    LAS bf16* Qs = (LAS bf16*)F.lds; LAS bf16* Ks = Qs + C * CQ_LD; LAS bf16* KhT = Ks + C * CQ_LD; LAS bf16* VT = KhT + 128 * CT_LD;
    LAS float* raw = (LAS float*)(VT + 128 * CT_LD);
    LAS float* WT = raw + 35 * 256;
    LAS float* sc = WT + 32 * 32;
    const int bh = prob >> 6, c = prob & 63, h = bh & 3, b = bh >> 2, w = F.wave, lane = F.lane, fr = lane & 15, quad = lane >> 4;
    const bf16* z = (const bf16*)(F.ws + WS_Z);
    unsigned char* fo = F.ws + WS_FRM + (size_t)prob * FH_STRIDE; float* fsc = (float*)(fo + 34 * 1024);
    const float* cw = a->in[19] + l * 4 * 1024; const float* cb = a->in[20] + l * 1024; const float ib = a->in[21][l * 4 + h], fb = a->in[22][l * 4 + h];
    const size_t row0 = (size_t)b * SEQ + c * C;
    const int tr = F.tid >> 4, k0 = 8 * (F.tid & 15);
    const int wc_ = ((F.tid & 255) >> 7) * 512 + 128 * h + (F.tid & 127);
    const float cw0_ = cw[wc_], cw1_ = cw[1024 + wc_], cw2_ = cw[2048 + wc_], cw3_ = cw[3072 + wc_], cbb_ = cb[wc_];
#pragma unroll
    for (int i = 0; i < 3; ++i) { const int idx = F.tid + i * NTHR; if (idx < 1120) { const int row = idx >> 5, pc = idx & 31;
        const v4u r = R.r[i];
        LAS float* d = raw + row * 256 + 8 * pc; *(LAS f32x4*)d = (f32x4){blo(r.x), bhi(r.x), blo(r.y), bhi(r.y)}; *(LAS f32x4*)(d + 4) = (f32x4){blo(r.z), bhi(r.z), blo(r.w), bhi(r.w)}; } }
    { const v4u pv = R.v; const unsigned iv[4] = {pv.x, pv.y, pv.z, pv.w};
#pragma unroll
      for (int j = 0; j < 4; ++j) { VT[(k0 + 2 * j) * CT_LD + tr] = (bf16)(iv[j] & 0xffffu); VT[(k0 + 2 * j + 1) * CT_LD + tr] = (bf16)(iv[j] >> 16); } }
    if (w == 0) {
        const int t = lane & 31;
        const float lf = logsigm(R.fg + fb), ip = R.ig + ib;
        const float fc = scan32_add(lf), g = ip - fc, lm = scan32_max(g);
        const float lml = __builtin_bit_cast(float, __builtin_amdgcn_readlane(__builtin_bit_cast(int, lm), 31));
        if (lane < 32) { sc[t] = g; sc[32 + t] = lm; sc[64 + t] = __expf(g - lml); fsc[t] = lm; fsc[32 + t] = fc; }
    }
    if (nprob >= 0) mlstm_raw_load(F, nprob, R);
    __syncthreads();
    { const int cc = F.tid & 255, tg = F.tid >> 8, arr = cc >> 7, k = cc & 127;
      const float w0 = cw0_, w1 = cw1_, w2 = cw2_, w3 = cw3_, bb = cbb_;
      float x0 = raw[(16 * tg + 0) * 256 + cc], x1 = raw[(16 * tg + 1) * 256 + cc], x2 = raw[(16 * tg + 2) * 256 + cc];
      float o16[16];
#pragma unroll
      for (int j = 0; j < 16; ++j) { const float x3 = raw[(16 * tg + 3 + j) * 256 + cc]; o16[j] = siluf(bb + x0 * w0 + x1 * w1 + x2 * w2 + x3 * w3); x0 = x1; x1 = x2; x2 = x3; }
      if (arr == 0) {
#pragma unroll
          for (int j = 0; j < 16; ++j) Qs[(16 * tg + j) * CQ_LD + k] = (bf16)f2bf(o16[j]);
      } else { unsigned pw[8];
#pragma unroll
          for (int j = 0; j < 16; ++j) { o16[j] *= 0.08838834764831845f; Ks[(16 * tg + j) * CQ_LD + k] = (bf16)f2bf(o16[j]); o16[j] *= sc[64 + 16 * tg + j]; }
#pragma unroll
          for (int j = 0; j < 8; ++j) pw[j] = pk2(o16[2 * j], o16[2 * j + 1]);
          *(LAS v4u*)(KhT + k * CT_LD + 16 * tg) = (v4u){pw[0], pw[1], pw[2], pw[3]}; *(LAS v4u*)(KhT + k * CT_LD + 16 * tg + 8) = (v4u){pw[4], pw[5], pw[6], pw[7]}; } }
    { const int t = F.tid >> 4, s0 = 2 * (F.tid & 15); const float lmt = sc[32 + t];
      WT[t * 32 + s0] = (s0 <= t) ? __expf(sc[s0] - lmt) : 0.f; WT[t * 32 + s0 + 1] = (s0 + 1 <= t) ? __expf(sc[s0 + 1] - lmt) : 0.f; }
    __syncthreads();
    st_frag(fo, w, lane, ld_perm(Qs + (16 * (w >> 2) + fr) * CQ_LD, 32 * (w & 3), quad));
    st_frag(fo, 8 + w, lane, *(const LAS bf16x8*)(KhT + (16 * w + fr) * CT_LD + 8 * quad));
    st_frag(fo, 19 + 2 * w, lane, *(const LAS bf16x8*)(VT + (16 * w + fr) * CT_LD + 8 * quad));
    if (w < 2) {
        const f32x4 zero4 = fresh_zero4(); f32x4 pa = zero4, pb = zero4;
#pragma unroll
        for (int ks = 0; ks < 4; ++ks) { const bf16x8 qb = *(const LAS bf16x8*)(Qs + (16 * w + fr) * CQ_LD + 32 * ks + 8 * quad);
            pa = mfma16(*(const LAS bf16x8*)(Ks + fr * CQ_LD + 32 * ks + 8 * quad), qb, pa);
            if (w == 1) pb = mfma16(*(const LAS bf16x8*)(Ks + (16 + fr) * CQ_LD + 32 * ks + 8 * quad), qb, pb); }
        pa = pa * *(const LAS f32x4*)(WT + (16 * w + fr) * 32 + 4 * quad);
        if (w == 1) pb = pb * *(const LAS f32x4*)(WT + (16 + fr) * 32 + 16 + 4 * quad);
        float d = ((pa[0] + pa[1]) + (pa[2] + pa[3])) + ((pb[0] + pb[1]) + (pb[2] + pb[3]));
        d += shx<16>(d); d += shx<32>(d);
        if (quad == 0) fsc[64 + 16 * w + fr] = d;
        st_frag(fo, 16 + w, lane, pack8(pa, pb));
    }
    __syncthreads();
}
DI void chain_mlstm(Frame& F, int item) {
    typedef ChainStage<18, 8, 384> St;
    const int bh = item >> 1, half = item & 1, h = bh & 3, b = bh >> 2, w = F.wave, lane = F.lane, fr = lane & 15, quad = lane >> 4;
    const bool act = w < 4, nrm = (w == 4); const int vs = 4 * half + (w & 3);
    const unsigned char* fb = F.ws + WS_FRM + (size_t)bh * 64 * FH_STRIDE;
    bf16* HC = (bf16*)(F.ws + WS_HC);
    LAS unsigned char* L = F.lds;
    LAS float* DN = (LAS float*)(F.lds + 2 * St::SLOT);
    f32x4 S[8];
#pragma unroll
    for (int i = 0; i < 8; ++i) S[i] = (f32x4){0.f, 0.f, 0.f, 0.f};
    St sa, sb, sc;
    auto ld = [&](St& s, int c) { const unsigned char* p = fb + (size_t)c * FH_STRIDE;
#pragma unroll
        for (int i = 0; i < St::MAXF; ++i) { const int f = w + 8 * i; if (f < 18) s.r[i] = *(const bf16x8*)(p + f * 1024 + lane * 16); }
        if (w == 7 && lane < 24) s.sc = *(const f32x4*)(p + 34 * 1024 + lane * 16); };
    ld(sa, 0); sa.store(L, w, lane); ld(sa, 1); ld(sb, 2);
    bf16x8 vp = ld_vperm(fb + (19 + 2 * vs) * 1024, fr, quad), vn = *(const bf16x8*)(fb + (19 + 2 * vs) * 1024 + lane * 16);
    bf16x8 vp1 = ld_vperm(fb + FH_STRIDE + (19 + 2 * vs) * 1024, fr, quad), vn1 = *(const bf16x8*)(fb + FH_STRIDE + (19 + 2 * vs) * 1024 + lane * 16);
    __syncthreads();
    const f32x4 zero4 = fresh_zero4();
    unsigned o1_ = 0x3f803f80u; asm volatile("" : "+v"(o1_)); const bf16x8 ones = __builtin_bit_cast(bf16x8, (v4u){o1_, o1_, o1_, o1_});
    float mprev = -1e30f;
    f32x4 iqp[2], op[2];
    iqp[0] = iqp[1] = op[0] = op[1] = zero4;
    const unsigned lo = 4u * quad * 512u + fr;
#pragma unroll 1
    for (int c = 0; c < 64; ++c) {
        ld(sc, c + 3 < 64 ? c + 3 : 63);
        const unsigned char* pn = fb + (size_t)(c + 2 < 64 ? c + 2 : 63) * FH_STRIDE;
        const LAS unsigned char* sl = L + (c & 1) * St::SLOT; const LAS float* ss = (const LAS float*)(sl + 18 * 1024);
        const float lml = ss[31], fcl = ss[63];
        const float cml = fmaxf(lml, mprev), rhol = __expf(lml - cml), cd = __expf(mprev - cml);
        if (act) {
            if (c > 0) {
                const LAS float* dn = DN + ((c - 1) & 1) * 64; bf16* hb = HC + ((size_t)b * SEQ + (c - 1) * 32) * 512 + 128 * h + 16 * vs;
#pragma unroll
                for (int tb = 0; tb < 2; ++tb) { const f32x4 wr = *(const LAS f32x4*)(dn + 16 * tb + 4 * quad), rr = *(const LAS f32x4*)(dn + 32 + 16 * tb + 4 * quad);
#pragma unroll
                    for (int j = 0; j < 4; ++j) hb[lo + (16 * tb + j) * 512] = (bf16)f2bf(wr[j] * iqp[tb][j] + rr[j] * op[tb][j]); }
            }
            bf16x8 sf[4];
#pragma unroll
            for (int kt = 0; kt < 4; ++kt) sf[kt] = pack8(S[2 * kt], S[2 * kt + 1]);
            { bf16x8 q[8]; const bf16x8 ap0 = LQ(sl, 16), ap1 = LQ(sl, 17);
#pragma unroll
              for (int i = 0; i < 8; ++i) q[i] = LQ(sl, i);
              __builtin_amdgcn_sched_barrier(0);
              f32x4 o0 = mfma16(ap0, vp, zero4), o1 = mfma16(ap1, vp, zero4), i0 = zero4, i1 = zero4;
#pragma unroll
              for (int kt = 0; kt < 4; ++kt) { i0 = mfma16(q[kt], sf[kt], i0); i1 = mfma16(q[4 + kt], sf[kt], i1); }
              op[0] = o0; op[1] = o1; iqp[0] = i0; iqp[1] = i1; }
            vp = vp1; vp1 = ld_vperm(pn + (19 + 2 * vs) * 1024, fr, quad);
            { bf16x8 kf[8];
#pragma unroll
              for (int kk = 0; kk < 8; ++kk) kf[kk] = LQ(sl, 8 + kk);
              __builtin_amdgcn_sched_barrier(0);
#pragma unroll
              for (int kk = 0; kk < 8; ++kk) { const f32x4 us = mfma16(kf[kk], vn, zero4); S[kk] = S[kk] * cd + us * rhol; } }
            vn = vn1; vn1 = *(const bf16x8*)(pn + (19 + 2 * vs) * 1024 + lane * 16);
        } else if (nrm) {
            bf16x8 nf[4];
#pragma unroll
            for (int kt = 0; kt < 4; ++kt) nf[kt] = pack8(S[2 * kt], S[2 * kt + 1]);
            LAS float* dn = DN + (c & 1) * 64;
#pragma unroll
            for (int tb = 0; tb < 2; ++tb) {
                bf16x8 q[4];
#pragma unroll
                for (int kt = 0; kt < 4; ++kt) q[kt] = LQ(sl, 4 * tb + kt);
                const f32x4 slm = *(const LAS f32x4*)(ss + 16 * tb + 4 * quad), sfc = *(const LAS f32x4*)(ss + 32 + 16 * tb + 4 * quad), srs = *(const LAS f32x4*)(ss + 64 + 16 * tb + 4 * quad);
                __builtin_amdgcn_sched_barrier(0);
                f32x4 nq = zero4;
#pragma unroll
                for (int kt = 0; kt < 4; ++kt) nq = mfma16(q[kt], nf[kt], nq);
                f32x4 wr, rr;
#pragma unroll
                for (int j = 0; j < 4; ++j) { const float cm = fmaxf(slm[j], mprev), rho = __expf(slm[j] - cm), wi = __expf(mprev - cm), em = __expf(-(sfc[j] + cm));
                    const float rd = __builtin_amdgcn_rcpf(fmaxf(fabsf(wi * nq[j] + rho * srs[j]), em)); wr[j] = wi * rd; rr[j] = rho * rd; }
                if (fr == 0) { *(LAS f32x4*)(dn + 16 * tb + 4 * quad) = wr; *(LAS f32x4*)(dn + 32 + 16 * tb + 4 * quad) = rr; }
            }
            { bf16x8 kf[8];
#pragma unroll
              for (int kk = 0; kk < 8; ++kk) kf[kk] = LQ(sl, 8 + kk);
              __builtin_amdgcn_sched_barrier(0);
#pragma unroll
              for (int kk = 0; kk < 8; ++kk) { const f32x4 un = mfma16(kf[kk], ones, zero4); S[kk] = S[kk] * cd + un * rhol; } }
        }
        mprev = fcl + cml;
        sa.store(L + ((c + 1) & 1) * St::SLOT, w, lane);
        __syncthreads();
        sa = sb; sb = sc;
    }
    if (act) {
        const LAS float* dn = DN + 64; bf16* hb = HC + ((size_t)b * SEQ + 63 * 32) * 512 + 128 * h + 16 * vs;
#pragma unroll
        for (int tb = 0; tb < 2; ++tb) { const f32x4 wr = *(const LAS f32x4*)(dn + 16 * tb + 4 * quad), rr = *(const LAS f32x4*)(dn + 32 + 16 * tb + 4 * quad);
#pragma unroll
            for (int j = 0; j < 4; ++j) hb[lo + (16 * tb + j) * 512] = (bf16)f2bf(wr[j] * iqp[tb][j] + rr[j] * op[tb][j]); }
    }
}
constexpr int FR_STRIDE = 22 * 1024 + 256;
constexpr int RK_LD = 72, RT_LD = 40, RAAB_LD = 36;
struct RRaw { float lw[8]; unsigned r[8], k[8], a[8], b[8], v[8]; };
DI void rwkv_raw_load(Frame& F, int prob, RRaw& R) {
    const bf16* RWH = (const bf16*)(F.ws + WS_RW); const float* LW = (const float*)(F.ws + WS_LW);
    const int tq = F.tid & 255, k = tq & 63, part = tq >> 6, wq = F.wave & 3, fr = F.lane & 15, quad = F.lane >> 4;
    const int bh = prob >> 6, c = prob & 63, b = bh >> 3, h = bh & 7; const size_t row0 = (size_t)b * SEQ + c * 32; const size_t o = (row0 + 8 * part) * 512 + 64 * h + k;
#pragma unroll
    for (int j = 0; j < 8; ++j) { R.lw[j] = LW[o + (size_t)j * 512]; R.r[j] = RWH[0 * (RHSZ / 2) + o + (size_t)j * 512]; R.k[j] = RWH[1 * (RHSZ / 2) + o + (size_t)j * 512]; R.a[j] = RWH[3 * (RHSZ / 2) + o + (size_t)j * 512]; R.b[j] = RWH[4 * (RHSZ / 2) + o + (size_t)j * 512]; }
    const bf16* vsrc = RWH + 2 * (RHSZ / 2) + row0 * 512 + 64 * h + 16 * wq + fr;
#pragma unroll
    for (int j = 0; j < 4; ++j) { R.v[j] = vsrc[(size_t)(4 * quad + j) * 512]; R.v[4 + j] = vsrc[(size_t)(16 + 4 * quad + j) * 512]; }
}
DI void phase_rwkv_chunkprep(Frame& F) {
    const int grp = F.wave >> 2, wq = F.wave & 3, lane = F.lane, fr = lane & 15, quad = lane >> 4, tq = F.tid & 255;
    LAS unsigned char* L = F.lds + grp * 65536;
    LAS bf16* At = (LAS bf16*)L;
    LAS bf16* Bt = At + 32 * RK_LD;
    LAS bf16* Kt = Bt + 32 * RK_LD;
    LAS bf16* Rt = Kt + 32 * RK_LD;
    LAS bf16* AT = Rt + 32 * RK_LD;
    LAS bf16* BhT = AT + 64 * RT_LD;
    LAS bf16* KhT = BhT + 64 * RT_LD;
    LAS bf16* Tm = KhT + 64 * RT_LD;
    LAS bf16* AakT = Tm + 32 * RT_LD;
    LAS bf16* Arb = AakT + 32 * RT_LD;
    LAS bf16* TaT = Arb + 32 * RT_LD;
    LAS bf16* TAkT = TaT + 64 * RT_LD;
    LAS float* Aab = (LAS float*)(TAkT + 32 * RT_LD);
    LAS float* PS = Aab + 32 * RAAB_LD;
    const bf16* RWH = (const bf16*)(F.ws + WS_RW); const float* LW = (const float*)(F.ws + WS_LW);
    unsigned char* FRb = F.ws + WS_FR;
    const f32x4 zero4 = fresh_zero4();
    RRaw RR; if (F.vcu < 2048) rwkv_raw_load(F, F.vcu * 2 + grp, RR);
    for (int it = F.vcu; it < 2048; it += F.G) {
        const int prob = it * 2 + grp;
        const int bh = prob >> 6, c = prob & 63, b = bh >> 3, h = bh & 7;
        const size_t row0 = (size_t)b * SEQ + c * 32;
        unsigned char* fr_out = FRb + (size_t)prob * FR_STRIDE;
        {
            const int k = tq & 63, part = tq >> 6; const size_t o = (row0 + 8 * part) * 512 + 64 * h + k;
            float lw[8], g[8]; float run = 0.f;
#pragma unroll
            for (int j = 0; j < 8; ++j) { lw[j] = RR.lw[j]; run += lw[j]; g[j] = run; }
            PS[part * 64 + k] = run;
            __syncthreads();
            float off = 0.f, tot = 0.f;
#pragma unroll
            for (int p = 0; p < 4; ++p) { const float v = PS[p * 64 + k]; tot += v; if (p < part) off += v; }
            unsigned pa[4], pb[4], pk[4];
            float av8[8], bv8[8], kv8[8];
#pragma unroll
            for (int j = 0; j < 8; ++j) { const float G = g[j] + off; const float r = bf2f((unsigned short)RR.r[j]), k2 = bf2f((unsigned short)RR.k[j]), a_ = bf2f((unsigned short)RR.a[j]), b_ = bf2f((unsigned short)RR.b[j]);
                const float eG = __expf(G), enG = __expf(-G), eGm1 = __expf(G - lw[j]), eh = __expf(tot - G);
                const int t = 8 * part + j;
                At[t * RK_LD + k] = (bf16)f2bf(a_ * eGm1); Bt[t * RK_LD + k] = (bf16)f2bf(b_ * enG); Kt[t * RK_LD + k] = (bf16)f2bf(k2 * enG); Rt[t * RK_LD + k] = (bf16)f2bf(r * eG);
                av8[j] = a_ * eGm1; bv8[j] = b_ * eh; kv8[j] = k2 * eh; }
#pragma unroll
            for (int j = 0; j < 4; ++j) { pa[j] = pk2(av8[2 * j], av8[2 * j + 1]); pb[j] = pk2(bv8[2 * j], bv8[2 * j + 1]); pk[j] = pk2(kv8[2 * j], kv8[2 * j + 1]); }
            *(LAS v4u*)(AT + k * RT_LD + 8 * part) = (v4u){pa[0], pa[1], pa[2], pa[3]};
            *(LAS v4u*)(BhT + k * RT_LD + 8 * part) = (v4u){pb[0], pb[1], pb[2], pb[3]};
            *(LAS v4u*)(KhT + k * RT_LD + 8 * part) = (v4u){pk[0], pk[1], pk[2], pk[3]};
            if (part == 0) ((float*)(fr_out + 22 * 1024))[k] = __expf(tot);
            { const unsigned (&vv)[8] = RR.v;
              *(v4u*)(fr_out + (18 + wq) * 1024 + lane * 16) = (v4u){vv[0] | (vv[1] << 16), vv[2] | (vv[3] << 16), vv[4] | (vv[5] << 16), vv[6] | (vv[7] << 16)}; }
            if (it + F.G < 2048) rwkv_raw_load(F, (it + F.G) * 2 + grp, RR);
        }
        __syncthreads();
        f32x4 ark[2][2];
        {
            const LAS bf16* Am = (wq == 0) ? At : (wq == 2 ? Rt : Kt);
            const LAS bf16* Bm = (wq == 0 || wq == 2) ? Bt : (wq == 1 ? At : Rt);
            f32x4 acc[2][2];
#pragma unroll
            for (int rb = 0; rb < 2; ++rb)
#pragma unroll
                for (int cbk = 0; cbk < 2; ++cbk) { f32x4 x = zero4;
#pragma unroll
                    for (int ks = 0; ks < 2; ++ks) x = mfma16(*(const LAS bf16x8*)(Am + (16 * rb + fr) * RK_LD + 32 * ks + 8 * quad), *(const LAS bf16x8*)(Bm + (16 * cbk + fr) * RK_LD + 32 * ks + 8 * quad), x);
                    acc[rb][cbk] = x; }
#pragma unroll
            for (int rb = 0; rb < 2; ++rb)
#pragma unroll
                for (int cbk = 0; cbk < 2; ++cbk)
#pragma unroll
                    for (int j = 0; j < 4; ++j) { const int row = 16 * rb + 4 * quad + j, col = 16 * cbk + fr; const int t = (wq == 0 || wq == 2) ? row : col, s = (wq == 0 || wq == 2) ? col : row;
                        const bool keep = (wq < 2) ? (s < t) : (s <= t); const float v = keep ? acc[rb][cbk][j] : 0.f; acc[rb][cbk][j] = v;
                        if (wq == 0) Aab[row * RAAB_LD + col] = v; else if (wq == 1) AakT[row * RT_LD + col] = (bf16)f2bf(v); else if (wq == 2) Arb[row * RT_LD + col] = (bf16)f2bf(v); }
#pragma unroll
            for (int rb = 0; rb < 2; ++rb)
#pragma unroll
                for (int cbk = 0; cbk < 2; ++cbk) ark[rb][cbk] = acc[rb][cbk];
        }
        __syncthreads();
        if (wq == 0) {
            float Tc[32]; const int cidx = lane & 31;
#pragma unroll
            for (int t = 0; t < 32; ++t) { float acc = (t == cidx) ? 1.0f : 0.0f;
#pragma unroll
                for (int s = 0; s < t; ++s) acc += Aab[t * RAAB_LD + s] * Tc[s];
                Tc[t] = acc; if (lane < 32) Tm[t * RT_LD + cidx] = (bf16)f2bf(acc); }
        }
        __syncthreads();
        {
            const bf16x8 aT = *(const LAS bf16x8*)(AT + (16 * wq + fr) * RT_LD + 8 * quad);
#pragma unroll
            for (int st = 0; st < 2; ++st) { const f32x4 x = mfma16(aT, *(const LAS bf16x8*)(Tm + (16 * st + fr) * RT_LD + 8 * quad), zero4);
#pragma unroll
                for (int j = 0; j < 4; ++j) TaT[(16 * wq + 4 * quad + j) * RT_LD + 16 * st + fr] = (bf16)f2bf(x[j]); }
            const int st = wq >> 1, ut = wq & 1;
            const f32x4 y = mfma16(*(const LAS bf16x8*)(AakT + (16 * st + fr) * RT_LD + 8 * quad), *(const LAS bf16x8*)(Tm + (16 * ut + fr) * RT_LD + 8 * quad), zero4);
#pragma unroll
            for (int j = 0; j < 4; ++j) TAkT[(16 * st + 4 * quad + j) * RT_LD + 16 * ut + fr] = (bf16)f2bf(y[j]);
        }
        __syncthreads();
        {
            { const int tb = wq & 1, i = wq >> 1; const bf16x8 bop = *(const LAS bf16x8*)(Arb + (16 * tb + fr) * RT_LD + 8 * quad); f32x4 x[2];
#pragma unroll
              for (int u = 0; u < 2; ++u) { const int kt = 2 * i + u; const v2u rz = *(const LAS v2u*)(Rt + (16 * tb + fr) * RK_LD + 16 * kt + 4 * quad);
                  x[u] = mfma16(*(const LAS bf16x8*)(TaT + (16 * kt + fr) * RT_LD + 8 * quad), bop, (f32x4){blo(rz.x), bhi(rz.x), blo(rz.y), bhi(rz.y)}); }
              *(bf16x8*)(fr_out + (tb * 2 + i) * 1024 + lane * 16) = pack8(x[0], x[1]); }
            { const bf16x8 bop = *(const LAS bf16x8*)(BhT + (16 * wq + fr) * RT_LD + 8 * quad); f32x4 x[4];
#pragma unroll
              for (int kt = 0; kt < 4; ++kt) x[kt] = mfma16(*(const LAS bf16x8*)(TaT + (16 * kt + fr) * RT_LD + 8 * quad), bop, zero4);
              *(bf16x8*)(fr_out + (6 + wq * 2 + 0) * 1024 + lane * 16) = pack8(x[0], x[1]); *(bf16x8*)(fr_out + (6 + wq * 2 + 1) * 1024 + lane * 16) = pack8(x[2], x[3]);
              f32x4 q[2];
#pragma unroll
              for (int sb = 0; sb < 2; ++sb) { const v2u kz = *(const LAS v2u*)(KhT + (16 * wq + fr) * RT_LD + 16 * sb + 4 * quad);
                  q[sb] = mfma16(*(const LAS bf16x8*)(TAkT + (16 * sb + fr) * RT_LD + 8 * quad), bop, (f32x4){blo(kz.x), bhi(kz.x), blo(kz.y), bhi(kz.y)}); }
              *(bf16x8*)(fr_out + (14 + wq) * 1024 + lane * 16) = pack8(q[0], q[1]); }
            if (wq == 3) {
#pragma unroll
                for (int tb = 0; tb < 2; ++tb) { const bf16x8 bop = *(const LAS bf16x8*)(Arb + (16 * tb + fr) * RT_LD + 8 * quad); f32x4 x[2];
#pragma unroll
                    for (int sb = 0; sb < 2; ++sb) x[sb] = mfma16(*(const LAS bf16x8*)(TAkT + (16 * sb + fr) * RT_LD + 8 * quad), bop, ark[sb][tb]);
                    *(bf16x8*)(fr_out + (4 + tb) * 1024 + lane * 16) = pack8(x[0], x[1]); } }
        }
        __syncthreads();
    }
}
DI void chunk_rwkv_chain(Frame& F, int item) {
    typedef ChainStage<18, 4, 256> St;
    const int grp = F.wave >> 2, w = F.wave & 3, lane = F.lane, fr = lane & 15, quad = lane >> 4;
    const int bh = item * 2 + grp, b = bh >> 3, h = bh & 7;
    const unsigned char* fb = F.ws + WS_FR + (size_t)bh * 64 * FR_STRIDE;
    bf16* YA = (bf16*)(F.ws + WS_YA);
    LAS unsigned char* L = F.lds + grp * (2 * St::SLOT);
    f32x4 H[4];
#pragma unroll
    for (int i = 0; i < 4; ++i) H[i] = (f32x4){0.f, 0.f, 0.f, 0.f};
    St sa, sb, sc;
    auto ld = [&](St& s, int c) { const unsigned char* p = fb + (size_t)c * FR_STRIDE;
#pragma unroll
        for (int i = 0; i < St::MAXF; ++i) { const int f = w + 4 * i; if (f < 18) s.r[i] = *(const bf16x8*)(p + f * 1024 + lane * 16); }
        if (w == 3 && lane < 16) s.sc = *(const f32x4*)(p + 22 * 1024 + lane * 16); };
    ld(sa, 0); sa.store(L, w, lane); ld(sa, 1); ld(sb, 2);
    bf16x8 vf = *(const bf16x8*)(fb + (18 + w) * 1024 + lane * 16), vf1 = *(const bf16x8*)(fb + FR_STRIDE + (18 + w) * 1024 + lane * 16);
    __syncthreads();
    const f32x4 zero4 = fresh_zero4();
#pragma unroll 1
    for (int c = 0; c < 64; ++c) {
        ld(sc, c + 3 < 64 ? c + 3 : 63);
        const unsigned char* pn = fb + (size_t)(c + 2 < 64 ? c + 2 : 63) * FR_STRIDE;
        const LAS unsigned char* sl = L + (c & 1) * St::SLOT;
        bf16x8 q[18]; f32x4 gl[4];
#pragma unroll
        for (int i = 0; i < 18; ++i) q[i] = LQ(sl, i);
#pragma unroll
        for (int kt = 0; kt < 4; ++kt) gl[kt] = *(const LAS f32x4*)(sl + 18 * 1024 + (16 * kt + 4 * quad) * 4);
        __builtin_amdgcn_sched_barrier(0);
        const bf16x8 hb0 = pack8(H[0], H[1]), hb1 = pack8(H[2], H[3]);
        f32x4 y0 = mfma16(q[4], vf, zero4), y1 = mfma16(q[5], vf, zero4);
        y0 = mfma16(q[0], hb0, y0); y0 = mfma16(q[1], hb1, y0); y1 = mfma16(q[2], hb0, y1); y1 = mfma16(q[3], hb1, y1);
#pragma unroll
        for (int kt = 0; kt < 4; ++kt) { f32x4 x = mfma16(q[14 + kt], vf, H[kt] * gl[kt]); x = mfma16(q[6 + 2 * kt], hb0, x); H[kt] = mfma16(q[7 + 2 * kt], hb1, x); }
        vf = vf1; vf1 = *(const bf16x8*)(pn + (18 + w) * 1024 + lane * 16);
        bf16* yb = YA + ((size_t)b * SEQ + c * 32) * 512 + 64 * h + 16 * w; const unsigned lo = 4u * quad * 512u + fr;
#pragma unroll
        for (int j = 0; j < 4; ++j) { yb[lo + j * 512] = (bf16)f2bf(y0[j]); yb[lo + (16 + j) * 512] = (bf16)f2bf(y1[j]); }
        sa.store(L + ((c + 1) & 1) * St::SLOT, w, lane);
        __syncthreads();
        sa = sb; sb = sc;
    }
}
#undef LQ
DI void scan_lru_item4(Frame& F, int item) {
    LAS f32x4* SA = (LAS f32x4*)F.lds; LAS f32x4* SB = SA + 512;
    const int cg = item & 7, b = item >> 3, cq = F.tid & 15, seg = F.tid >> 4, c = 64 * cg + 4 * cq;
    const float* LA = (const float*)(F.ws + WS_LA); const bf16* LB = (const bf16*)(F.ws + WS_LB); const bf16* z = (const bf16*)(F.ws + WS_Z);
    unsigned char* Y3 = F.ws + WS_Y + (size_t)3 * M * 512;
    const size_t t0 = (size_t)b * SEQ + seg * 64;
    const float* la = LA + t0 * 512 + c; const bf16* lb = LB + t0 * 512 + c; const bf16* gzp = z + t0 * ZLD + ZD + 512 + c; unsigned char* yp = Y3 + t0 * 512 + c;
    f32x4 A = (f32x4){1.f, 1.f, 1.f, 1.f}, Bv = (f32x4){0.f, 0.f, 0.f, 0.f};
    f32x4 av0[8], av1[8]; v2u bq0[8], bq1[8], gz0[8], gz1[8];
#define LRU_LD(AV, BQ, S0) do { _Pragma("unroll") for (int i_ = 0; i_ < 8; ++i_) { AV[i_] = *(const f32x4*)(la + (size_t)((S0) + i_) * 512); BQ[i_] = *(const v2u*)(lb + (size_t)((S0) + i_) * 512); } } while (0)
#define LRU_LDG(GZ, S0) do { _Pragma("unroll") for (int i_ = 0; i_ < 8; ++i_) GZ[i_] = *(const v2u*)(gzp + (size_t)((S0) + i_) * ZLD); } while (0)
#define LRU_C1(AV, BQ) do { _Pragma("unroll") for (int i_ = 0; i_ < 8; ++i_) { const f32x4 bv_ = (f32x4){blo(BQ[i_].x), bhi(BQ[i_].x), blo(BQ[i_].y), bhi(BQ[i_].y)}; A = A * AV[i_]; Bv = AV[i_] * Bv + bv_; } } while (0)
#define LRU_C2(AV, BQ, GZ, S0) do { _Pragma("unroll") for (int i_ = 0; i_ < 8; ++i_) { const f32x4 bv_ = (f32x4){blo(BQ[i_].x), bhi(BQ[i_].x), blo(BQ[i_].y), bhi(BQ[i_].y)}; hh = AV[i_] * hh + bv_; \
        *(unsigned*)(yp + (size_t)((S0) + i_) * 512) = pk4f8(hh[0] * gelu_tanh(blo(GZ[i_].x)), hh[1] * gelu_tanh(bhi(GZ[i_].x)), hh[2] * gelu_tanh(blo(GZ[i_].y)), hh[3] * gelu_tanh(bhi(GZ[i_].y))); } } while (0)
    LRU_LD(av0, bq0, 0);
#pragma unroll 1
    for (int k = 0; k < 64; k += 16) { LRU_LD(av1, bq1, k + 8); LRU_C1(av0, bq0); if (k + 16 < 64) LRU_LD(av0, bq0, k + 16); LRU_C1(av1, bq1); }
    LRU_LD(av0, bq0, 0); LRU_LDG(gz0, 0);
    SA[seg * 16 + cq] = A; SB[seg * 16 + cq] = Bv;
    __syncthreads();
    f32x4 hh = (f32x4){0.f, 0.f, 0.f, 0.f};
    for (int s2 = 0; s2 < seg; ++s2) hh = SA[s2 * 16 + cq] * hh + SB[s2 * 16 + cq];
#pragma unroll 1
    for (int k = 0; k < 64; k += 16) { LRU_LD(av1, bq1, k + 8); LRU_LDG(gz1, k + 8); LRU_C2(av0, bq0, gz0, k); if (k + 16 < 64) { LRU_LD(av0, bq0, k + 16); LRU_LDG(gz0, k + 16); } LRU_C2(av1, bq1, gz1, k + 8); }
#undef LRU_LD
#undef LRU_LDG
#undef LRU_C1
#undef LRU_C2
    __syncthreads();
}
DI void phase_chunkprep(Frame& F, KA a, int l) {
#ifndef DUPCP
#define DUPCP 0
#endif
    for (int rep = 0; rep < 1 + ((DUPCP >> 0) & 1); ++rep) { phase_rwkv_chunkprep(F); __syncthreads(); }
    for (int rep = 0; rep < 1 + ((DUPCP >> 1) & 1); ++rep) { v4u pq, pf, pi; if (F.vcu < 2048) hgrn_raw_load(F, F.vcu, pq, pf, pi); hgrn_lower_bounds(F, a, l);
      for (int it = F.vcu; it < 2048; it += F.G) prep_hgrn_item(F, a, l, it, (it + F.G < 2048) ? it + F.G : -1, pq, pf, pi); }
    for (int rep = 0; rep < 1 + ((DUPCP >> 2) & 1); ++rep) { MRaw R; if (F.vcu < 2048) mlstm_raw_load(F, F.vcu, R);
      for (int it = F.vcu; it < 2048; it += F.G) prep_mlstm_item(F, a, l, it, (it + F.G < 2048) ? it + F.G : -1, R); }
}
DI void phase_scan(Frame& F, KA a, int l) {
    int v = __builtin_amdgcn_readfirstlane((int)blockIdx.x); asm volatile("" : "+s"(v));
    if (F.G >= 160) {
#ifndef DUPSCAN
#define DUPSCAN 0
#endif
        if (v < 32) { for (int rep = 0; rep < 1 + ((DUPSCAN >> 0) & 1); ++rep) { chain_hgrn(F, v); __syncthreads(); } }
        else if (v < 96) { for (int rep = 0; rep < 1 + ((DUPSCAN >> 1) & 1); ++rep) { int mi_ = 2 * ((((v - 32) >> 4) << 3) + ((v - 32) & 7)) + (((v - 32) >> 3) & 1); asm volatile("" : "+s"(mi_)); chain_mlstm(F, mi_); __syncthreads(); } }
        else if (v < 128) { for (int rep = 0; rep < 1 + ((DUPSCAN >> 2) & 1); ++rep) { chunk_rwkv_chain(F, v - 96); __syncthreads(); } }
        else if (v < 192) { for (int rep = 0; rep < 1 + ((DUPSCAN >> 3) & 1); ++rep) { scan_lru_item4(F, v - 128); __syncthreads(); } }
    }
    __syncthreads(); cvt_expert_queue(F, a, l);
}

DI float xsum8(float v) { v += dpp_f<0xB1>(v); v += dpp_f<0x4E>(v); v += dpp_f<0x141>(v); return v; }
DI void phase_post(Frame& F, KA a, int l) {
    const bf16* z = (const bf16*)(F.ws + WS_Z); const bf16* RWH = (const bf16*)(F.ws + WS_RW); const float* BON = (const float*)(F.ws + WS_BON);
    const bf16* YA = (const bf16*)(F.ws + WS_YA); const bf16* OB = (const bf16*)(F.ws + WS_OB); const bf16* HC = (const bf16*)(F.ws + WS_HC);
    unsigned char* Y = F.ws + WS_Y;
    const float* lng = a->in[15] + l * 512; const float* lnb = a->in[16] + l * 512; const float* hnw = a->in[18] + l * 512; const float* mnw = a->in[23] + l * 512;
    const int c = 8 * F.lane;
    struct PTok { v4u ya, ob, hc; v4u gq, vq, gzb, gzc; float bon; };
    auto issue = [&](PTok& T, int t) { const size_t o = (size_t)t * 512 + c;
        T.ya = *(const v4u*)(YA + o); T.ob = *(const v4u*)(OB + o); T.hc = *(const v4u*)(HC + o);
        T.gq = *(const v4u*)(RWH + 5 * (RHSZ / 2) + o); T.vq = *(const v4u*)(RWH + 2 * (RHSZ / 2) + o); T.gzb = *(const v4u*)(z + (size_t)t * ZLD + ZB + 1536 + c); T.gzc = *(const v4u*)(z + (size_t)t * ZLD + ZC + 1536 + c);
        T.bon = BON[(size_t)t * 8 + (F.lane >> 3)]; };
    float lg[8], lb[8], nwh[8], nwm[8];
    *(f32x4*)&lg[0] = *(const f32x4*)(lng + c); *(f32x4*)&lg[4] = *(const f32x4*)(lng + c + 4); *(f32x4*)&lb[0] = *(const f32x4*)(lnb + c); *(f32x4*)&lb[4] = *(const f32x4*)(lnb + c + 4);
    *(f32x4*)&nwh[0] = *(const f32x4*)(hnw + c); *(f32x4*)&nwh[4] = *(const f32x4*)(hnw + c + 4); *(f32x4*)&nwm[0] = *(const f32x4*)(mnw + c); *(f32x4*)&nwm[4] = *(const f32x4*)(mnw + c + 4);
    const int t0 = F.gw, nt = (M - t0 + F.NGW - 1) / F.NGW;
    PTok cur, nxt;
    issue(cur, t0);
#pragma unroll 1
    for (int i = 0; i < nt; ++i) {
        const int t = t0 + i * F.NGW;
        if (i + 1 < nt) issue(nxt, t + F.NGW);
        const size_t o = (size_t)t * 512 + c;
        { const v4u yq_ = cur.ya; float y[8] = {blo(yq_.x), bhi(yq_.x), blo(yq_.y), bhi(yq_.y), blo(yq_.z), bhi(yq_.z), blo(yq_.w), bhi(yq_.w)};
          float s_ = 0.f; for (int j = 0; j < 8; ++j) s_ += y[j]; const float mean = xsum8(s_) * (1.0f / 64.0f);
          float q = 0.f; for (int j = 0; j < 8; ++j) { y[j] -= mean; q += y[j] * y[j]; } const float rstd = rsqrtf(xsum8(q) * (1.0f / 64.0f) + 64e-5f);
          const v4u gq = cur.gq, vq = cur.vq;
          const float g[8] = {blo(gq.x), bhi(gq.x), blo(gq.y), bhi(gq.y), blo(gq.z), bhi(gq.z), blo(gq.w), bhi(gq.w)}, v[8] = {blo(vq.x), bhi(vq.x), blo(vq.y), bhi(vq.y), blo(vq.z), bhi(vq.z), blo(vq.w), bhi(vq.w)};
          float r[8]; for (int j = 0; j < 8; ++j) r[j] = (y[j] * rstd * lg[j] + lb[j] + cur.bon * v[j]) * g[j];
          *(v2u*)(Y + o) = (v2u){pk4f8(r[0], r[1], r[2], r[3]), pk4f8(r[4], r[5], r[6], r[7])}; }
        { const v4u yq_ = cur.ob; float y[8] = {blo(yq_.x), bhi(yq_.x), blo(yq_.y), bhi(yq_.y), blo(yq_.z), bhi(yq_.z), blo(yq_.w), bhi(yq_.w)};
          float q = 0.f; for (int j = 0; j < 8; ++j) q += y[j] * y[j]; q = xsum8(q); q += dpp_f<0x128>(q); const float rstd = rsqrtf(q * (1.0f / 128.0f) + 1e-6f);
          const v4u gz = cur.gzb; const float g[8] = {blo(gz.x), bhi(gz.x), blo(gz.y), bhi(gz.y), blo(gz.z), bhi(gz.z), blo(gz.w), bhi(gz.w)};
          float r[8]; for (int j = 0; j < 8; ++j) r[j] = y[j] * rstd * nwh[j] * siluf(g[j]);
          *(v2u*)(Y + (size_t)M * 512 + o) = (v2u){pk4f8(r[0], r[1], r[2], r[3]), pk4f8(r[4], r[5], r[6], r[7])}; }
        { const v4u yq_ = cur.hc; float y[8] = {blo(yq_.x), bhi(yq_.x), blo(yq_.y), bhi(yq_.y), blo(yq_.z), bhi(yq_.z), blo(yq_.w), bhi(yq_.w)};
          float s_ = 0.f; for (int j = 0; j < 8; ++j) s_ += y[j]; s_ = xsum8(s_); s_ += dpp_f<0x128>(s_); const float mean = s_ * (1.0f / 128.0f);
          float q = 0.f; for (int j = 0; j < 8; ++j) { y[j] -= mean; q += y[j] * y[j]; } q = xsum8(q); q += dpp_f<0x128>(q); const float rstd = rsqrtf(q * (1.0f / 128.0f) + 1e-6f);
          const v4u gz = cur.gzc; const float g[8] = {blo(gz.x), bhi(gz.x), blo(gz.y), bhi(gz.y), blo(gz.z), bhi(gz.z), blo(gz.w), bhi(gz.w)};
          float r[8]; for (int j = 0; j < 8; ++j) r[j] = y[j] * rstd * nwm[j] * sigm(g[j]);
          *(v2u*)(Y + (size_t)2 * M * 512 + o) = (v2u){pk4f8(r[0], r[1], r[2], r[3]), pk4f8(r[4], r[5], r[6], r[7])}; }
        cur = nxt;
    }
}

DI void ln_row(const f32x4 (&v)[4], f32x4 (&o)[4], const float* g, const float* b, int lane) {
    float s = 0.f;
#pragma unroll
    for (int j = 0; j < 4; ++j) s += (v[j].x + v[j].y) + (v[j].z + v[j].w);
    const float mean = wave_sum(s) * (1.0f / D); float q = 0.f;
#pragma unroll
    for (int j = 0; j < 4; ++j) { o[j] = v[j] - mean; q += (o[j].x * o[j].x + o[j].y * o[j].y) + (o[j].z * o[j].z + o[j].w * o[j].w); }
    const float rstd = rsqrtf(wave_sum(q) * (1.0f / D) + 1e-5f);
#pragma unroll
    for (int j = 0; j < 4; ++j) { const f32x4 gg = *(const f32x4*)(g + 4 * lane + 256 * j), bb = *(const f32x4*)(b + 4 * lane + 256 * j); o[j] = o[j] * rstd * gg + bb; }
}
DI void phase_ln1_router(Frame& F, KA a, int l) {
    constexpr int WLD = 1032, LGLD = 33;
    LAS bf16* WrB = (LAS bf16*)F.lds;
    LAS float* LG = (LAS float*)(F.lds + 66560);
    LAS unsigned* cntL = F.LC + LC_CNT; LAS unsigned* baseL = F.LC + LC_BASE; LAS unsigned* rec = F.LC + LC_REC;
    const float* Wr = a->in[35] + (size_t)l * 1024 * 32; const float* rb = a->in[36] + l * 32;
    const float* g1 = a->in[33] + l * 1024; const float* b1 = a->in[34] + l * 1024;
    const bf16* PRE = (const bf16*)(F.ws + WS_PRE); bf16* X1B = (bf16*)(F.ws + WS_X1B);
    bf16* XSV = (bf16*)(F.ws + WS_XSV); unsigned* TREC = (unsigned*)(F.ws + WS_TREC); float* GATE = (float*)(F.ws + WS_GATE);
    for (int i4 = F.tid; i4 < 1024 * 8; i4 += NTHR) { const int c = i4 & 1023, e4 = i4 >> 10; const f32x4 w4 = *(const f32x4*)(Wr + c * 32 + 4 * e4);
        WrB[(4 * e4 + 0) * WLD + c] = (bf16)f2bf(w4[0]); WrB[(4 * e4 + 1) * WLD + c] = (bf16)f2bf(w4[1]); WrB[(4 * e4 + 2) * WLD + c] = (bf16)f2bf(w4[2]); WrB[(4 * e4 + 3) * WLD + c] = (bf16)f2bf(w4[3]); }
    const int lane = F.lane;
    for (int item = F.vcu; item < M / 64; item += F.G) {
        if (F.tid < 32) cntL[F.tid] = 0u;
        __syncthreads();
        v2u pzn[4];
#pragma unroll
        for (int j = 0; j < 4; ++j) pzn[j] = *(const v2u*)(PRE + (size_t)(item * 64 + F.wave) * D + 4 * lane + 256 * j);
        for (int tl = F.wave; tl < 64; tl += NWAVES) {
            const int t = item * 64 + tl;
            f32x4 v[4], x[4];
#pragma unroll
            for (int j = 0; j < 4; ++j) v[j] = (f32x4){blo(pzn[j].x), bhi(pzn[j].x), blo(pzn[j].y), bhi(pzn[j].y)};
            { const int tn = item * 64 + (tl + NWAVES < 64 ? tl + NWAVES : tl);
#pragma unroll
              for (int j = 0; j < 4; ++j) pzn[j] = *(const v2u*)(PRE + (size_t)tn * D + 4 * lane + 256 * j); }
            ln_row(v, x, g1, b1, lane);
#pragma unroll
            for (int j = 0; j < 4; ++j) { *(v2u*)(X1B + (size_t)t * D + 4 * lane + 256 * j) = (v2u){pk2(x[j].x, x[j].y), pk2(x[j].z, x[j].w)};
                unsigned w8 = __builtin_amdgcn_cvt_pk_fp8_f32(x[j].x * 16.f, x[j].y * 16.f, 0u, false); *(unsigned*)(F.ws + WS_X1B8 + (size_t)t * D + 4 * lane + 256 * j) = __builtin_amdgcn_cvt_pk_fp8_f32(x[j].z * 16.f, x[j].w * 16.f, w8, true); }
        }
        VM_WAIT(); __syncthreads();
        { const int tt = F.wave >> 1, eh = F.wave & 1, tok = lane & 15, quad = lane >> 4;
          const bf16* xr = X1B + (size_t)(item * 64 + 16 * tt + tok) * D + 8 * quad; const LAS bf16* wr_ = WrB + (16 * eh + tok) * WLD + 8 * quad;
          f32x4 acc = (f32x4){0.f, 0.f, 0.f, 0.f};
#pragma unroll
          for (int kb = 0; kb < 4; ++kb) { bf16x8 xf[8];
#pragma unroll
              for (int i = 0; i < 8; ++i) xf[i] = *(const bf16x8*)(xr + 32 * (8 * kb + i));
#pragma unroll
              for (int i = 0; i < 8; ++i) acc = mfma16(*(const LAS bf16x8*)(wr_ + 32 * (8 * kb + i)), xf[i], acc); }
          const f32x4 bb = *(const f32x4*)(rb + 16 * eh + 4 * quad);
#pragma unroll
          for (int j = 0; j < 4; ++j) LG[(16 * tt + tok) * LGLD + 16 * eh + 4 * quad + j] = acc[j] + bb[j]; }
        __syncthreads();
        for (int i2 = 0; i2 < 4; ++i2) {
            const int tl = F.wave * 8 + 2 * i2 + (lane >> 5), myE = lane & 31;
            float logit = LG[tl * LGLD + myE];
            float tv[4]; int ti[4];
#pragma unroll
            for (int k = 0; k < 4; ++k) { float bv = logit; int bi = myE;
#define AMXD(ctrl) { const float ov = dpp_f<ctrl>(bv); const int oi = __builtin_amdgcn_update_dpp(0, bi, ctrl, 0xf, 0xf, true); if (ov > bv || (ov == bv && oi < bi)) { bv = ov; bi = oi; } }
#define AMX(o) { const float ov = shx<o>(bv); const int oi = shx_i<o>(bi); if (ov > bv || (ov == bv && oi < bi)) { bv = ov; bi = oi; } }
                AMXD(0xB1) AMXD(0x4E) AMXD(0x124) AMXD(0x128) AMX(16)
#undef AMX
#undef AMXD
                tv[k] = bv; ti[k] = bi; if (myE == bi) logit = -3.0e38f; }
            const float e1 = __expf(tv[1] - tv[0]), e2 = __expf(tv[2] - tv[0]), e3 = __expf(tv[3] - tv[0]); const float inv = 1.0f / (1.0f + e1 + e2 + e3);
            if (myE < 4) { const int e = (myE == 0) ? ti[0] : (myE == 1 ? ti[1] : (myE == 2 ? ti[2] : ti[3]));
                const float gt = ((myE == 0) ? 1.0f : (myE == 1 ? e1 : (myE == 2 ? e2 : e3))) * inv;
                const unsigned pos = __hip_atomic_fetch_add(&cntL[e], 1u, __ATOMIC_RELAXED, __HIP_MEMORY_SCOPE_WORKGROUP);
                rec[(tl * 4 + myE) * 3 + 0] = (unsigned)e; rec[(tl * 4 + myE) * 3 + 1] = pos; rec[(tl * 4 + myE) * 3 + 2] = __builtin_bit_cast(unsigned, gt); }
        }
        __syncthreads();
        if (F.tid < 32) baseL[F.tid] = __hip_atomic_fetch_add((unsigned*)(F.ctl + CW_CNT + l * 2048 + F.tid * 64), cntL[F.tid], __ATOMIC_RELAXED, __HIP_MEMORY_SCOPE_AGENT);
        __syncthreads();
        if (F.tid < 256) { const int tl = F.tid >> 2, k = F.tid & 3, t = item * 64 + tl; const unsigned e = rec[F.tid * 3], pos = rec[F.tid * 3 + 1] + baseL[rec[F.tid * 3]];
            TREC[(size_t)t * 4 + k] = (e << 20) | pos; GATE[(size_t)t * 4 + k] = __builtin_bit_cast(float, rec[F.tid * 3 + 2]); }
        __syncthreads();
        v4u qn0, qn1; { const GAS v4u* srow0 = (const GAS v4u*)(X1B + (size_t)(item * 64 + F.wave) * D); qn0 = srow0[lane]; qn1 = srow0[lane + 64]; }
#pragma unroll 2
        for (int r0 = F.wave * 4; r0 < 256; r0 += NWAVES * 4) {
            const v4u q0 = qn0, q1 = qn1; { const int tn = item * 64 + ((r0 + NWAVES * 4 < 256 ? r0 + NWAVES * 4 : r0) >> 2); const GAS v4u* srow = (const GAS v4u*)(X1B + (size_t)tn * D); qn0 = srow[lane]; qn1 = srow[lane + 64]; }
            v2u f0, f1;
            f0.x = __builtin_amdgcn_cvt_pk_fp8_f32(blo(q0.x) * 16.f, bhi(q0.x) * 16.f, 0u, false); f0.x = __builtin_amdgcn_cvt_pk_fp8_f32(blo(q0.y) * 16.f, bhi(q0.y) * 16.f, f0.x, true);
            f0.y = __builtin_amdgcn_cvt_pk_fp8_f32(blo(q0.z) * 16.f, bhi(q0.z) * 16.f, 0u, false); f0.y = __builtin_amdgcn_cvt_pk_fp8_f32(blo(q0.w) * 16.f, bhi(q0.w) * 16.f, f0.y, true);
            f1.x = __builtin_amdgcn_cvt_pk_fp8_f32(blo(q1.x) * 16.f, bhi(q1.x) * 16.f, 0u, false); f1.x = __builtin_amdgcn_cvt_pk_fp8_f32(blo(q1.y) * 16.f, bhi(q1.y) * 16.f, f1.x, true);
            f1.y = __builtin_amdgcn_cvt_pk_fp8_f32(blo(q1.z) * 16.f, bhi(q1.z) * 16.f, 0u, false); f1.y = __builtin_amdgcn_cvt_pk_fp8_f32(blo(q1.w) * 16.f, bhi(q1.w) * 16.f, f1.y, true);
#pragma unroll
            for (int k = 0; k < 4; ++k) { const unsigned e = rec[(r0 + k) * 3]; const unsigned pos = rec[(r0 + k) * 3 + 1] + baseL[e]; GAS v2u* drow = (GAS v2u*)((unsigned char*)XSV + ((size_t)e * M + pos) * D); drow[lane] = f0; drow[lane + 64] = f1; } }
        __syncthreads();
    }
}
DI void moe_tables(Frame& F, int l) {
    if (F.tid < 32) F.LC[LC_CNT + F.tid] = __hip_atomic_load((unsigned*)(F.ctl + CW_CNT + l * 2048 + F.tid * 64), __ATOMIC_RELAXED, __HIP_MEMORY_SCOPE_AGENT);
    __syncthreads();
    if (F.tid == 0) { unsigned acc = 0; for (int e = 0; e < 32; ++e) { F.LC[LC_PSTART + e] = acc; const unsigned nt = (F.LC[LC_CNT + e] + 255u) >> 8;
#pragma clang loop vectorize(disable) unroll(disable)
            for (unsigned i = 0; i < nt; ++i) F.LC[LC_TILEE + acc + i] = (unsigned)e;
            acc += nt; } F.LC[LC_PSTART + 32] = acc; F.LC[LC_NT] = acc; }
    __syncthreads();
}
DI void phase_gather(Frame& F, int l) {
    moe_tables(F, l);
    const unsigned* SLOT = (const unsigned*)(F.ws + WS_SLOT); const bf16* X1B = (const bf16*)(F.ws + WS_X1B); bf16* XS = (bf16*)(F.ws + WS_XS);
    const int nrows = (int)F.LC[LC_NT] * 256;
    for (int row = F.gw; row < nrows; row += F.NGW) {
        const int mt = row >> 8; const int e = (int)F.LC[LC_TILEE + mt]; const int pos = row - (int)F.LC[LC_PSTART + e] * 256;
        if (pos < (int)F.LC[LC_CNT + e]) { const unsigned t = SLOT[(size_t)e * M + pos];
            const GAS v4u* s = (const GAS v4u*)(X1B + (size_t)t * D); GAS v4u* d = (GAS v4u*)(XS + (size_t)row * D);
            d[F.lane] = s[F.lane]; d[F.lane + 64] = s[F.lane + 64]; }
    }
}
DI void phase_combine_ln2(Frame& F, KA a, int l) {
    moe_tables(F, l);
    const bf16* X1B = (const bf16*)(F.ws + WS_X1B); const unsigned* TREC = (const unsigned*)(F.ws + WS_TREC); const float* GATE = (const float*)(F.ws + WS_GATE);
    const unsigned char* YS = F.ws + WS_YS;     const bf16* PLEG = (const bf16*)(F.ws + WS_PLEG);
    bf16* XB = (bf16*)(F.ws + WS_XB);
    const float* g2 = a->in[43] + l * 1024; const float* b2 = a->in[44] + l * 1024; const int lane = F.lane;
    struct Tok { v2u xz[4], pz[4]; unsigned yz[4][4]; float gt[4]; };
    auto issue = [&](Tok& T, int t, const unsigned (&rr)[4], const float (&gg)[4]) {
#pragma unroll
        for (int j = 0; j < 4; ++j) { T.xz[j] = *(const v2u*)(X1B + (size_t)t * D + 4 * lane + 256 * j); T.pz[j] = *(const v2u*)(PLEG + (size_t)t * D + 4 * lane + 256 * j); }
#pragma unroll
        for (int k = 0; k < 4; ++k) { const size_t row = (size_t)F.LC[LC_PSTART + (rr[k] >> 20)] * 256 + (rr[k] & 0xfffffu); T.gt[k] = gg[k];
#pragma unroll
            for (int j = 0; j < 4; ++j) T.yz[k][j] = *(const unsigned*)(YS + row * D + 4 * lane + 256 * j); } };
    const int t0 = F.gw, nt = (M - t0 + F.NGW - 1) / F.NGW;
    unsigned r1[4], r2[4]; float g1_[4], g2_[4];
#pragma unroll
    for (int k = 0; k < 4; ++k) { r1[k] = TREC[(size_t)t0 * 4 + k]; g1_[k] = GATE[(size_t)t0 * 4 + k]; const int tb = (nt > 1) ? t0 + F.NGW : t0; r2[k] = TREC[(size_t)tb * 4 + k]; g2_[k] = GATE[(size_t)tb * 4 + k]; }
    Tok cur, nxt;
    issue(cur, t0, r1, g1_);
#pragma unroll 1
    for (int i = 0; i < nt; ++i) {
        const int t = t0 + i * F.NGW;
        if (i + 1 < nt) issue(nxt, t + F.NGW, r2, g2_);
        { const int tc = (i + 2 < nt) ? t + 2 * F.NGW : t;
#pragma unroll
          for (int k = 0; k < 4; ++k) { r2[k] = TREC[(size_t)tc * 4 + k]; g2_[k] = GATE[(size_t)tc * 4 + k]; } }
        f32x4 v[4], x[4];
#pragma unroll
        for (int j = 0; j < 4; ++j) v[j] = (f32x4){blo(cur.xz[j].x), bhi(cur.xz[j].x), blo(cur.xz[j].y), bhi(cur.xz[j].y)} * ALPHA + (f32x4){blo(cur.pz[j].x), bhi(cur.pz[j].x), blo(cur.pz[j].y), bhi(cur.pz[j].y)};
#pragma unroll
        for (int k = 0; k < 4; ++k)
#pragma unroll
            for (int j = 0; j < 4; ++j) { const unsigned yw = cur.yz[k][j]; const f32x2 ylo = __builtin_amdgcn_cvt_pk_f32_fp8(yw, false), yhi = __builtin_amdgcn_cvt_pk_f32_fp8(yw, true);
                v[j] = v[j] + (f32x4){ylo[0], ylo[1], yhi[0], yhi[1]} * (cur.gt[k] * (1.0f / 64.0f)); }
        ln_row(v, x, g2, b2, lane);
        if (l == NL - 1) {
#pragma unroll
            for (int j = 0; j < 4; ++j) *(f32x4*)(a->out + (size_t)t * D + 4 * lane + 256 * j) = x[j];
        } else {
#pragma unroll
            for (int j = 0; j < 4; ++j) { *(v2u*)(XB + (size_t)t * D + 4 * lane + 256 * j) = (v2u){pk2(x[j].x, x[j].y), pk2(x[j].z, x[j].w)};
                unsigned w8 = __builtin_amdgcn_cvt_pk_fp8_f32(x[j].x * 16.f, x[j].y * 16.f, 0u, false); *(unsigned*)(F.ws + WS_XB8 + (size_t)t * D + 4 * lane + 256 * j) = __builtin_amdgcn_cvt_pk_fp8_f32(x[j].z * 16.f, x[j].w * 16.f, w8, true); }
        }
        cur = nxt;
    }
}

constexpr int PH_PER_LAYER = 12, N_PHASES = 2 + NL * PH_PER_LAYER;
__global__ void __launch_bounds__(NTHR, 2) mega_fwd(Args args) {
    extern __shared__ __attribute__((aligned(16))) unsigned char lds_raw[];
    Frame F;
    F.lds = (LAS unsigned char*)lds_raw; F.LC = (LAS unsigned*)(F.lds + LDSCTL_OFF);
    F.G = gridDim.x; { const int bx = blockIdx.x; F.vcu = (F.G % 8 == 0) ? (bx % 8) * (F.G / 8) + bx / 8 : bx; }
    F.NGW = F.G * NWAVES; F.wave = __builtin_amdgcn_readfirstlane((int)threadIdx.x >> 6); rebind(F);
    F.ws = args.ws; F.ctl = (gu32*)(args.ws + WS_CTL);
    KA ap = (KA)__builtin_amdgcn_kernarg_segment_ptr();
#define PHASE_BEGIN() do { ap = (KA)__builtin_amdgcn_kernarg_segment_ptr(); asm volatile("" : "+s"(ap)); F.ws = ap->ws; F.ctl = (gu32*)(F.ws + WS_CTL); rebind(F); } while (0)
#pragma clang loop vectorize(disable) unroll(disable)
    for (int u = F.tid; u < LDSCTL_BYTES / 4; u += NTHR) F.LC[u] = 0u;
    __syncthreads();
    const int lo = args.ph_lo, hi = args.ph_hi;
    const bool multi = (hi - lo) > 1;
    XcdBarrier bar; bar.bar = (unsigned*)(F.ctl + CW_BAR); bar.x = 0; bar.st = nullptr;
    if (multi) bar = xcd_barrier_post((unsigned*)(F.ctl + CW_BAR), (volatile LAS unsigned*)(F.LC + LC_BAR));
#ifndef PHMASK
#define PHMASK 0xffffffffu
#endif
#ifndef DUPMASK
#define DUPMASK 0x0u
#endif
#define EN(j) ((PHMASK >> (j)) & 1u)
#define DUP(j) ((DUPMASK >> (j)) & 1u)
#define IN(k) (lo <= (k) && (k) < hi)
#define SEAM(k) do { if (IN(k) && IN((k) + 1)) xcd_barrier(bar); } while (0)
    LAS unsigned char* ring = F.lds;

    PHASE_BEGIN(); if (EN(0) && IN(0)) { p0_convert(F, ap); if (DUP(0)) { __syncthreads(); p0_convert(F, ap); } } SEAM(0);

    for (int l = 0; l < NL; ++l) {
        const int pb = 2 + l * PH_PER_LAYER;
        PHASE_BEGIN(); if (EN(2) && IN(pb + 0)) { for (int rep_ = 0; rep_ < 1 + (int)DUP(2); ++rep_) { if (rep_) __syncthreads();
            { pg8::Gemm g{(const bf16*)(F.ws + WS_XB8), (const bf16*)(F.ws + WS_WIN8 + (size_t)l * 4096 * 1024), M, 4096, D / 2};
              pg8::StaticOrder S; S.init(M, 4096, F.G, (int)blockIdx.x);
              pg8::EpiGate8 E{F.ws + WS_MF};
              pg8::gemm_phase<pg8::EpiGate8, pg8::StaticOrder, PG8_ALIGN, PG8_SP2, true, 0x79, 0x7b>(ring, g, S, E, F.tid); }
            { pg8::Gemm g{(const bf16*)(F.ws + WS_XB), (const bf16*)(F.ws + WS_WIN) + (size_t)l * ZLD * 1024, M, ZG, D};
              pg8::StaticOrder S; S.init(M, ZG, F.G, (int)blockIdx.x);
              pg8::EpiB16<0> E{(bf16*)(F.ws + WS_Z), ZLD, nullptr};
              pg8::gemm_phase<pg8::EpiB16<0>, pg8::StaticOrder, PG8_ALIGN, PG8_SP2>(ring, g, S, E, F.tid); }
            if (l == 0) { pg8::Gemm g{(const bf16*)(F.ws + WS_PB), (const bf16*)(F.ws + WS_WPP), NL * M, NL * 1024, DPLE};
              pg8::LayerGroupOrder S{F.G, (int)blockIdx.x};
              pg8::EpiB16<4> E{(bf16*)(F.ws + WS_PP), 1024, nullptr};
              pg8::gemm_phase<pg8::EpiB16<4>, pg8::LayerGroupOrder, PG8_ALIGN, PG8_SP2>(ring, g, S, E, F.tid); }
            }
        } SEAM(pb + 0);
        PHASE_BEGIN(); if (EN(3) && IN(pb + 1)) { phase_prep(F, ap, l); if (DUP(3)) { __syncthreads(); phase_prep(F, ap, l); } } SEAM(pb + 1);
        PHASE_BEGIN(); if (EN(14) && IN(pb + 2)) { phase_chunkprep(F, ap, l); if (DUP(14)) { __syncthreads(); phase_chunkprep(F, ap, l); } } SEAM(pb + 2);
        PHASE_BEGIN(); if (EN(4) && IN(pb + 3)) { phase_scan(F, ap, l); if (DUP(4)) { __syncthreads(); phase_scan(F, ap, l); } } SEAM(pb + 3);
        PHASE_BEGIN(); if (EN(5) && IN(pb + 4)) { phase_post(F, ap, l); if (DUP(5)) { __syncthreads(); phase_post(F, ap, l); } } SEAM(pb + 4);
        PHASE_BEGIN(); if (EN(6) && IN(pb + 5)) { for (int rep_ = 0; rep_ < 1 + (int)DUP(6); ++rep_) { if (rep_) __syncthreads();
            pg8::Gemm g{(const bf16*)(F.ws + WS_Y), (const bf16*)(F.ws + WS_WBR + (size_t)l * 4 * 1024 * 512), 4 * M, 4 * 1024, W / 2};
            pg8::BranchOrder S; S.base.init(M, D, F.G, (int)blockIdx.x);
            pg8::EpiBranch E{F.ws + WS_MF, F.ws + WS_MB};
            pg8::gemm_phase<pg8::EpiBranch, pg8::BranchOrder, PG8_ALIGN, PG8_SP2, true, 0x79, 0x7c>(ring, g, S, E, F.tid); }
        } SEAM(pb + 5);
        PHASE_BEGIN(); if (EN(7) && IN(pb + 6)) { for (int rep_ = 0; rep_ < 1 + (int)DUP(7); ++rep_) { if (rep_) __syncthreads();
            pg8::Gemm g{(const bf16*)(F.ws + WS_MB), (const bf16*)(F.ws + WS_WOUT + (size_t)l * 1024 * 1024), M, D, D / 2};
            pg8::StaticOrder S; S.init(M, D, F.G, (int)blockIdx.x);
            pg8::EpiWout E{(const bf16*)(F.ws + WS_XB), (bf16*)(F.ws + WS_PRE), ALPHA};
            pg8::gemm_phase<pg8::EpiWout, pg8::StaticOrder, PG8_ALIGN, PG8_SP2, true, 0x79, 0x7b>(ring, g, S, E, F.tid); }
        } SEAM(pb + 6);
        PHASE_BEGIN(); if (EN(8) && IN(pb + 7)) { phase_ln1_router(F, ap, l); } SEAM(pb + 7);
        PHASE_BEGIN(); if (EN(10) && IN(pb + 8)) { for (int rep_ = 0; rep_ < 1 + (int)DUP(10); ++rep_) { if (rep_) __syncthreads();
            moe_tables(F, l);
            { pg8::Gemm g{(const bf16*)(F.ws + WS_XSV), (const bf16*)(F.ws + WS_WGU + (size_t)l * NE * 2048 * 1024), NE * M, NE * 2048, D / 2};
              pg8::MoeOrder<8, true> S{(const LAS int*)(F.LC + LC_TILEE), (const LAS int*)(F.LC + LC_PSTART), __builtin_amdgcn_readfirstlane((int)F.LC[LC_NT]), F.G, F.vcu};
              pg8::EpiGU E{(bf16*)(F.ws + WS_H), ap->in[38] + (size_t)l * NE * 2048};
              pg8::gemm_phase<pg8::EpiGU, pg8::MoeOrder<8, true>, PG8_ALIGN, PG8_SP2, true, 0x79, 0x7b>(ring, g, S, E, F.tid);     } }
        }
        PHASE_BEGIN(); if (EN(13) && IN(pb + 9)) { for (int rep_ = 0; rep_ < 1 + (int)DUP(13); ++rep_) { if (rep_) __syncthreads();
            { pg8::Gemm g{(const bf16*)(F.ws + WS_X1B8), (const bf16*)(F.ws + WS_WPG8 + (size_t)l * 1024 * 1024), M, D, D / 2};
              pg8::StaticOrder S; S.init(M, D, F.G, (int)blockIdx.x);
              pg8::EpiPle E{(const bf16*)(F.ws + WS_PP) + (size_t)l * M * 1024, (bf16*)(F.ws + WS_PLEG)};
              pg8::gemm_phase<pg8::EpiPle, pg8::StaticOrder, PG8_ALIGN, PG8_SP2, true, 0x79, 0x7b>(ring, g, S, E, F.tid); } }
        } SEAM(pb + 9);
        PHASE_BEGIN(); if (EN(11) && IN(pb + 10)) { for (int rep_ = 0; rep_ < 1 + (int)DUP(11); ++rep_) { if (rep_) __syncthreads();
            moe_tables(F, l);
            pg8::Gemm g{(const bf16*)(F.ws + WS_H), (const bf16*)(F.ws + WS_WDN + (size_t)l * NE * 1024 * 1024), MOE_ROWS, NE * 1024, D / 2};
            pg8::MoeOrder<4, false> S{(const LAS int*)(F.LC + LC_TILEE), (const LAS int*)(F.LC + LC_PSTART), __builtin_amdgcn_readfirstlane((int)F.LC[LC_NT]), F.G, F.vcu};
            pg8::EpiYS8 E{F.ws + WS_YS, ap->in[40] + (size_t)l * NE * 1024};
            pg8::gemm_phase<pg8::EpiYS8, pg8::MoeOrder<4, false>, PG8_ALIGN, PG8_SP2, true, 0x79, 0x7d>(ring, g, S, E, F.tid);     }
        } SEAM(pb + 10);
        PHASE_BEGIN(); if (EN(12) && IN(pb + 11)) { phase_combine_ln2(F, ap, l); if (DUP(12)) { __syncthreads(); phase_combine_ln2(F, ap, l); } } SEAM(pb + 11);
    }
#undef IN
#undef SEAM
}

#ifndef MK_ONE_LAUNCH
#define MK_ONE_LAUNCH 1
#endif
extern "C" void kernel_launch(void* const* d_in, const int* in_sizes, int n_in, void* d_out, int out_size, void* d_ws, size_t ws_size, hipStream_t stream) {
    static int grid = 0;
    if (grid == 0) {
        if (n_in != 45 || out_size != M * D || ws_size < WS_END) { fprintf(stderr, "kernel_launch: unexpected problem (n_in %d, out %d, ws %zu)\n", n_in, out_size, ws_size); grid = -1; return; }
        int dev = 0, cus = 0, per_cu = 0;
        if (hipGetDevice(&dev) != hipSuccess || hipDeviceGetAttribute(&cus, hipDeviceAttributeMultiprocessorCount, dev) != hipSuccess) { grid = -1; return; }
        if (hipFuncSetAttribute((const void*)mega_fwd, hipFuncAttributeMaxDynamicSharedMemorySize, LDS_BYTES) != hipSuccess) { fprintf(stderr, "kernel_launch: hipFuncSetAttribute failed\n"); grid = -1; return; }
        if (hipOccupancyMaxActiveBlocksPerMultiprocessor(&per_cu, (const void*)mega_fwd, NTHR, LDS_BYTES) != hipSuccess || per_cu < 1) fprintf(stderr, "kernel_launch: occupancy query says %d\n", per_cu);
        (void)hipGetLastError();
        grid = cus;
    }
    if (grid < 0) return;
    if (hipMemsetAsync((char*)d_ws + WS_CTL, 0, CTL_ZERO_BYTES, stream) != hipSuccess) return;
    Args a{};
    for (int i = 0; i < 45; ++i) a.in[i] = (const float*)d_in[i];
    a.out = (float*)d_out; a.ws = (unsigned char*)d_ws;
#if MK_ONE_LAUNCH
    a.ph_lo = 0; a.ph_hi = N_PHASES;
    hipLaunchKernelGGL(mega_fwd, dim3(grid), dim3(NTHR), LDS_BYTES, stream, a);
#else
    for (int ph = 0; ph < N_PHASES; ++ph) { a.ph_lo = ph; a.ph_hi = ph + 1; hipLaunchKernelGGL(mega_fwd, dim3(grid), dim3(NTHR), LDS_BYTES, stream, a); }
#endif
}
```

```cpp
#include <hip/hip_runtime.h>
#include <cstdio>
#include <cstdint>
namespace pg8 {
#define PG8_LAS __attribute__((address_space(3)))
typedef unsigned short bf16_t;
typedef short bf16x8 __attribute__((ext_vector_type(8)));
typedef float f32x4 __attribute__((ext_vector_type(4)));
typedef unsigned u32x4 __attribute__((ext_vector_type(4)));
constexpr int BM = 256, BK = 64, HALF = 128, HTB = HALF * BK * 2  , STAGE_BYTES = 8 * HTB, NXCD = 8, WGM = 8;

__host__ __device__ __forceinline__ int lds_byte(int r, int c) { const int st = (r >> 4) * 2 + (c >> 5), rr = r & 15, cc = c & 31, ob = rr * 64 + cc * 2; return st * 1024 + (ob ^ (((ob >> 9) & 1) << 5)); }
__host__ __device__ __forceinline__ void stage_rc(int b, int& R, int& C) { const int st = b / 1024, sb = b % 1024, swz = sb ^ (((sb >> 9) & 1) << 5); R = (st >> 1) * 16 + swz / 64; C = (st & 1) * 32 + (swz % 64) / 2; }
__host__ __device__ __forceinline__ int perm32(int rho) { const int n = rho >> 4, i = rho & 15; return 8 * (i >> 2) + 4 * n + (i & 3); }

struct Unit { int pm, pn, po; };
struct Gemm { const bf16_t* A; const bf16_t* Bt; int M, N, K; };

struct StaticOrder {
    int nM, nN, nwg, G, c;
    __host__ __device__ void init(int M, int N, int G_, int c_) { nM = M / BM; nN = N / BM; nwg = nM * nN; G = G_; c = c_; }
    __host__ __device__ bool next(int i, Unit& u) const {
        const long L = (long)i * G + c; if (L >= nwg) return false;
        int wgid = (int)L; { const int q = nwg / NXCD, r = nwg % NXCD, xcd = wgid % NXCD, off = wgid / NXCD; wgid = (xcd < r ? xcd * (q + 1) : r * (q + 1) + (xcd - r) * q) + off; }
        const int nig = WGM * nN, gid = wgid / nig, fm = gid * WGM, gsz = (nM - fm) < WGM ? (nM - fm) : WGM;
        u.pm = fm + ((wgid % nig) % gsz); u.pn = (wgid % nig) / gsz; return true;
    }
    __device__ __forceinline__ void a_ready(const Unit&) const {}
    __device__ __forceinline__ void done(const Unit&) const {}
};

__device__ __forceinline__ unsigned cvt_pk_bf16(float lo, float hi) { unsigned r; asm volatile("v_cvt_pk_bf16_f32 %0, %1, %2" : "=v"(r) : "v"(lo), "v"(hi)); return r; }
typedef float f32x2 __attribute__((ext_vector_type(2)));
__device__ __forceinline__ int lane_id_fresh() { int l; asm volatile("v_mbcnt_lo_u32_b32 %0, -1, 0\n\tv_mbcnt_hi_u32_b32 %0, -1, %0" : "=v"(l)); return l; }
__device__ __forceinline__ f32x2 gelu_pk(f32x2 v) {
    const f32x2 av = __builtin_elementwise_abs(v), d = av * 0.2316418882f + 1.0f;
    f32x2 t; t.x = __builtin_amdgcn_rcpf(d.x); t.y = __builtin_amdgcn_rcpf(d.y);
    f32x2 q = t * 0.5307027145f + (-0.7265760135f); q = q * t + 0.7107068705f; q = q * t + (-0.142248368f); q = q * t + 0.127414796f; q = q * t;
    const f32x2 s = (v * v) * (-0.72134752044f);
    f32x2 e; e.x = __builtin_amdgcn_exp2f(s.x); e.y = __builtin_amdgcn_exp2f(s.y);
    const f32x2 m = v * (q * e), r = v - m;
    f32x2 o; o.x = v.x < 0.f ? m.x : r.x; o.y = v.y < 0.f ? m.y : r.y; return o;
}

template <int ACT  > struct EpiBf16 {
    static constexpr bool PERM = true, AFTER_DRAIN = false; static_assert(ACT == 0 || ACT == 1, "EpiBf16: ACT is 0 (none) or 1 (gelu_pk)");
    bf16_t* O; int ldc; const float* bias; int split_cols; size_t split_stride; float scale0;
    __device__ __forceinline__ void operator()(const f32x4 (&acc)[2][2][4][2], const Unit& u, int wr, int wc, int fr, int fq) const {
        const int row0 = u.pm * BM + wr * 64 + fr; int colt = u.pn * BM; bf16_t* base = O;
        float sc = 1.f; if (split_cols) { const int t = colt / split_cols; base += (size_t)t * split_stride; colt -= t * split_cols; if (t == 0) sc = scale0; }
        const int col0 = colt + wc * 32 + 8 * fq, bcol0 = u.pn * BM + wc * 32 + 8 * fq;
        f32x4 bv[2][2];
#pragma unroll
        for (int bj = 0; bj < 2; ++bj)
#pragma unroll
            for (int n = 0; n < 2; ++n) bv[bj][n] = bias ? *(const f32x4*)(bias + bcol0 + bj * HALF + 4 * n) : (f32x4){0.f, 0.f, 0.f, 0.f};
#pragma unroll
        for (int ai = 0; ai < 2; ++ai)
#pragma unroll
            for (int m = 0; m < 4; ++m) { bf16_t* rowp = base + (size_t)(row0 + ai * HALF + m * 16) * ldc + col0;
#pragma unroll
                for (int bj = 0; bj < 2; ++bj) { f32x4 v0 = acc[ai][bj][m][0] + bv[bj][0], v1 = acc[ai][bj][m][1] + bv[bj][1];
                    if (ACT == 1) { f32x2 a = gelu_pk((f32x2){v0[0], v0[1]}), b = gelu_pk((f32x2){v0[2], v0[3]}), c = gelu_pk((f32x2){v1[0], v1[1]}), d = gelu_pk((f32x2){v1[2], v1[3]});
                        v0 = (f32x4){a.x, a.y, b.x, b.y}; v1 = (f32x4){c.x, c.y, d.x, d.y}; }
                    v0 = v0 * sc; v1 = v1 * sc; u32x4 w; w.x = cvt_pk_bf16(v0[0], v0[1]); w.y = cvt_pk_bf16(v0[2], v0[3]); w.z = cvt_pk_bf16(v1[0], v1[1]); w.w = cvt_pk_bf16(v1[2], v1[3]);
                    *(u32x4*)(rowp + bj * HALF) = w; } }
    }
};


constexpr int ZLD = 11264;
__device__ __forceinline__ float bflo(unsigned w) { return __builtin_bit_cast(float, w << 16); }
__device__ __forceinline__ float bfhi(unsigned w) { return __builtin_bit_cast(float, w & 0xffff0000u); }
__device__ __forceinline__ float sigm(float x) { return __builtin_amdgcn_rcpf(1.0f + __expf(-x)); }
__device__ __forceinline__ float clamp8(float x) { return __builtin_fminf(__builtin_fmaxf(x, -448.0f), 448.0f); }

struct EpiBranch {
    static constexpr bool PERM = true, AFTER_DRAIN = false, KEEP_ACC = true;
    const unsigned char* G8; unsigned char* MB8;
    __device__ __forceinline__ void operator()(f32x4 (&acc)[2][2][4][2], const Unit& u, int wr, int wc, int fr, int fq) const {
        const int n = u.pn >> 2, pn = u.pn & 3, pm = u.pm & 63;
        const int row0 = pm * BM + wr * 64 + fr, col0 = pn * BM + wc * 32 + 8 * fq;
        typedef unsigned u32x2b_ __attribute__((ext_vector_type(2)));
#pragma unroll
        for (int ai = 0; ai < 2; ++ai)
#pragma unroll
            for (int m = 0; m < 4; ++m) { const size_t row = (size_t)(row0 + ai * HALF + m * 16);
#pragma unroll
                for (int bj = 0; bj < 2; ++bj) { const int c = col0 + bj * HALF;
                    const unsigned char* gp = G8 + row * 4096 + n * 1024 + c;
                    const u32x2b_ gq = *(const u32x2b_*)gp;
                    f32x4 s0 = (f32x4){(float)(gq.x & 255u), (float)((gq.x >> 8) & 255u), (float)((gq.x >> 16) & 255u), (float)(gq.x >> 24)}, s1 = (f32x4){(float)(gq.y & 255u), (float)((gq.y >> 8) & 255u), (float)((gq.y >> 16) & 255u), (float)(gq.y >> 24)};
                    if (n < 3) { const u32x2b_ hq = *(const u32x2b_*)(gp + 1024);
                        s0[0] *= __builtin_amdgcn_rcpf((float)(hq.x & 255u)); s0[1] *= __builtin_amdgcn_rcpf((float)((hq.x >> 8) & 255u)); s0[2] *= __builtin_amdgcn_rcpf((float)((hq.x >> 16) & 255u)); s0[3] *= __builtin_amdgcn_rcpf((float)(hq.x >> 24));
                        s1[0] *= __builtin_amdgcn_rcpf((float)(hq.y & 255u)); s1[1] *= __builtin_amdgcn_rcpf((float)((hq.y >> 8) & 255u)); s1[2] *= __builtin_amdgcn_rcpf((float)((hq.y >> 16) & 255u)); s1[3] *= __builtin_amdgcn_rcpf((float)(hq.y >> 24));
                        acc[ai][bj][m][0] = acc[ai][bj][m][0] * s0; acc[ai][bj][m][1] = acc[ai][bj][m][1] * s1; }
                    else { const f32x4 v0 = acc[ai][bj][m][0] * s0 * (16.0f / 255.0f), v1 = acc[ai][bj][m][1] * s1 * (16.0f / 255.0f);
                        unsigned w0 = 0u, w1 = 0u;
                        w0 = __builtin_amdgcn_cvt_pk_fp8_f32(clamp8(v0[0]), clamp8(v0[1]), w0, false); w0 = __builtin_amdgcn_cvt_pk_fp8_f32(clamp8(v0[2]), clamp8(v0[3]), w0, true);
                        w1 = __builtin_amdgcn_cvt_pk_fp8_f32(clamp8(v1[0]), clamp8(v1[1]), w1, false); w1 = __builtin_amdgcn_cvt_pk_fp8_f32(clamp8(v1[2]), clamp8(v1[3]), w1, true);
                        *(u32x2b_*)(MB8 + row * 1024 + c) = (u32x2b_){w0, w1};
                        acc[ai][bj][m][0] = (f32x4){0.f, 0.f, 0.f, 0.f}; acc[ai][bj][m][1] = (f32x4){0.f, 0.f, 0.f, 0.f}; } } }
    }
};
struct EpiGate8 {
    static constexpr bool PERM = true, AFTER_DRAIN = false;
    unsigned char* G8;
    __device__ __forceinline__ void operator()(const f32x4 (&acc)[2][2][4][2], const Unit& u, int wr, int wc, int fr, int fq) const {
        const int row0 = u.pm * BM + wr * 64 + fr, col0 = u.pn * BM + wc * 32 + 8 * fq;
        typedef unsigned u32x2b_ __attribute__((ext_vector_type(2)));
#pragma unroll
        for (int ai = 0; ai < 2; ++ai)
#pragma unroll
            for (int m = 0; m < 4; ++m) { unsigned char* rowp = G8 + (size_t)(row0 + ai * HALF + m * 16) * 4096 + col0;
#pragma unroll
                for (int bj = 0; bj < 2; ++bj) { const f32x4 v0 = acc[ai][bj][m][0], v1 = acc[ai][bj][m][1]; unsigned q[8];
#pragma unroll
                    for (int i = 0; i < 4; ++i) { q[i] = (unsigned)__builtin_fmaxf(255.0f * sigm(v0[i]) + 0.5f, 1.0f); q[4 + i] = (unsigned)__builtin_fmaxf(255.0f * sigm(v1[i]) + 0.5f, 1.0f); }
                    *(u32x2b_*)(rowp + bj * HALF) = (u32x2b_){q[0] | (q[1] << 8) | (q[2] << 16) | (q[3] << 24), q[4] | (q[5] << 8) | (q[6] << 16) | (q[7] << 24)}; } }
    }
};
struct EpiWout {
    static constexpr bool PERM = true, AFTER_DRAIN = false;
    const bf16_t* XB; bf16_t* PRE; float alpha;
    __device__ __forceinline__ void operator()(const f32x4 (&acc)[2][2][4][2], const Unit& u, int wr, int wc, int fr, int fq) const {
        const int row0 = u.pm * BM + wr * 64 + fr, col0 = u.pn * BM + wc * 32 + 8 * fq;
#pragma unroll
        for (int ai = 0; ai < 2; ++ai)
#pragma unroll
            for (int m = 0; m < 4; ++m) { const size_t ro = (size_t)(row0 + ai * HALF + m * 16) * 1024 + col0;
#pragma unroll
                for (int bj = 0; bj < 2; ++bj) { const u32x4 xz = *(const u32x4*)(XB + ro + bj * HALF); const f32x4 v0 = acc[ai][bj][m][0], v1 = acc[ai][bj][m][1];
                    u32x4 w; w.x = cvt_pk_bf16(bflo(xz.x) * alpha + v0[0], bfhi(xz.x) * alpha + v0[1]); w.y = cvt_pk_bf16(bflo(xz.y) * alpha + v0[2], bfhi(xz.y) * alpha + v0[3]);
                    w.z = cvt_pk_bf16(bflo(xz.z) * alpha + v1[0], bfhi(xz.z) * alpha + v1[1]); w.w = cvt_pk_bf16(bflo(xz.w) * alpha + v1[2], bfhi(xz.w) * alpha + v1[3]);
                    *(u32x4*)(PRE + ro + bj * HALF) = w; } }
    }
};
struct EpiGU {
    static constexpr bool PERM = true, AFTER_DRAIN = false;
    bf16_t* H; const float* bgu;
    __device__ __forceinline__ void operator()(const f32x4 (&acc)[2][2][4][2], const Unit& u, int wr, int wc, int fr, int fq) const {
        const int e = u.pn >> 3, j = u.pn & 7;
        const int row0 = u.po * BM + wr * 64 + fr, cl = j * 128 + wc * 32 + 8 * fq;
        const float* bg = bgu + (size_t)e * 2048 + cl; const float* bu = bg + 1024;
        const f32x4 bg0 = *(const f32x4*)bg, bg1 = *(const f32x4*)(bg + 4), bu0 = *(const f32x4*)bu, bu1 = *(const f32x4*)(bu + 4);
#pragma unroll
        for (int ai = 0; ai < 2; ++ai)
#pragma unroll
            for (int m = 0; m < 4; ++m) { const size_t row = (size_t)(row0 + ai * HALF + m * 16);
                f32x4 g0 = acc[ai][0][m][0] + bg0, g1 = acc[ai][0][m][1] + bg1, u0 = acc[ai][1][m][0] + bu0, u1 = acc[ai][1][m][1] + bu1;
                f32x4 h0, h1;
#pragma unroll
                for (int i = 0; i < 4; ++i) {
                    const float ga = fminf(g0[i], 7.0f), ua = fminf(fmaxf(u0[i], -7.0f), 7.0f); h0[i] = (ua + 1.0f) * ga * sigm(1.702f * ga);
                    const float gb = fminf(g1[i], 7.0f), ub = fminf(fmaxf(u1[i], -7.0f), 7.0f); h1[i] = (ub + 1.0f) * gb * sigm(1.702f * gb); }
                unsigned w0 = 0u, w1 = 0u;
                w0 = __builtin_amdgcn_cvt_pk_fp8_f32(h0[0] * 4.f, h0[1] * 4.f, w0, false); w0 = __builtin_amdgcn_cvt_pk_fp8_f32(h0[2] * 4.f, h0[3] * 4.f, w0, true);
                w1 = __builtin_amdgcn_cvt_pk_fp8_f32(h1[0] * 4.f, h1[1] * 4.f, w1, false); w1 = __builtin_amdgcn_cvt_pk_fp8_f32(h1[2] * 4.f, h1[3] * 4.f, w1, true);
                typedef unsigned u32x2_ __attribute__((ext_vector_type(2)));
                *(u32x2_*)((unsigned char*)H + row * 1024 + cl) = (u32x2_){w0, w1}; }
    }
};
struct EpiPle {
    static constexpr bool PERM = true, AFTER_DRAIN = false;
    const bf16_t* PP; bf16_t* PLEG;
    __device__ __forceinline__ void operator()(const f32x4 (&acc)[2][2][4][2], const Unit& u, int wr, int wc, int fr, int fq) const {
        const int row0 = u.pm * BM + wr * 64 + fr, col0 = u.pn * BM + wc * 32 + 8 * fq;
#pragma unroll
        for (int ai = 0; ai < 2; ++ai)
#pragma unroll
            for (int m = 0; m < 4; ++m) { const size_t ro = (size_t)(row0 + ai * HALF + m * 16) * 1024 + col0;
#pragma unroll
                for (int bj = 0; bj < 2; ++bj) { const u32x4 pz = *(const u32x4*)(PP + ro + bj * HALF);
                    const f32x4 v0 = acc[ai][bj][m][0], v1 = acc[ai][bj][m][1];
                    u32x4 w; w.x = cvt_pk_bf16(sigm(v0[0]) * bflo(pz.x), sigm(v0[1]) * bfhi(pz.x)); w.y = cvt_pk_bf16(sigm(v0[2]) * bflo(pz.y), sigm(v0[3]) * bfhi(pz.y));
                    w.z = cvt_pk_bf16(sigm(v1[0]) * bflo(pz.z), sigm(v1[1]) * bfhi(pz.z)); w.w = cvt_pk_bf16(sigm(v1[2]) * bflo(pz.w), sigm(v1[3]) * bfhi(pz.w));
                    *(u32x4*)(PLEG + ro + bj * HALF) = w; } }
    }
};

template <int NTN> struct EpiB16 {
    static constexpr bool PERM = true, AFTER_DRAIN = false;
    bf16_t* O; int ldc; const float* bias; int gate_tile0 = 1 << 30;
    __device__ __forceinline__ void operator()(const f32x4 (&acc)[2][2][4][2], const Unit& u, int wr, int wc, int fr, int fq) const {
        const int row0 = u.pm * BM + wr * 64 + fr, col0 = (NTN ? (u.pn % NTN) : u.pn) * BM + wc * 32 + 8 * fq, bcol0 = u.pn * BM + wc * 32 + 8 * fq;
        f32x4 bv[2][2];
#pragma unroll
        for (int bj = 0; bj < 2; ++bj)
#pragma unroll
            for (int n = 0; n < 2; ++n) bv[bj][n] = bias ? *(const f32x4*)(bias + bcol0 + bj * HALF + 4 * n) : (f32x4){0.f, 0.f, 0.f, 0.f};
#pragma unroll
        for (int ai = 0; ai < 2; ++ai)
#pragma unroll
            for (int m = 0; m < 4; ++m) { bf16_t* rowp = O + (size_t)(row0 + ai * HALF + m * 16) * ldc + col0;
#pragma unroll
                for (int bj = 0; bj < 2; ++bj) { f32x4 v0 = acc[ai][bj][m][0] + bv[bj][0], v1 = acc[ai][bj][m][1] + bv[bj][1];
                    if (u.pn >= gate_tile0) {
#pragma unroll
                        for (int i = 0; i < 4; ++i) { v0[i] = 1.0f + __expf(-v0[i]); v1[i] = 1.0f + __expf(-v1[i]); } }
                    u32x4 w; w.x = cvt_pk_bf16(v0[0], v0[1]); w.y = cvt_pk_bf16(v0[2], v0[3]); w.z = cvt_pk_bf16(v1[0], v1[1]); w.w = cvt_pk_bf16(v1[2], v1[3]);
                    *(u32x4*)(rowp + bj * HALF) = w; } }
    }
};
struct EpiYS8 {
    static constexpr bool PERM = true, AFTER_DRAIN = false;
    unsigned char* O; const float* bias;
    __device__ __forceinline__ void operator()(const f32x4 (&acc)[2][2][4][2], const Unit& u, int wr, int wc, int fr, int fq) const {
        const int row0 = u.pm * BM + wr * 64 + fr, col0 = (u.pn & 3) * BM + wc * 32 + 8 * fq, bcol0 = u.pn * BM + wc * 32 + 8 * fq;
        typedef unsigned u32x2b_ __attribute__((ext_vector_type(2)));
        f32x4 bv[2][2];
#pragma unroll
        for (int bj = 0; bj < 2; ++bj)
#pragma unroll
            for (int n = 0; n < 2; ++n) bv[bj][n] = *(const f32x4*)(bias + bcol0 + bj * HALF + 4 * n);
#pragma unroll
        for (int ai = 0; ai < 2; ++ai)
#pragma unroll
            for (int m = 0; m < 4; ++m) { unsigned char* rowp = O + (size_t)(row0 + ai * HALF + m * 16) * 1024 + col0;
#pragma unroll
                for (int bj = 0; bj < 2; ++bj) { const f32x4 v0 = (acc[ai][bj][m][0] + bv[bj][0]) * 64.0f, v1 = (acc[ai][bj][m][1] + bv[bj][1]) * 64.0f;
                    unsigned w0 = 0u, w1 = 0u;
                    w0 = __builtin_amdgcn_cvt_pk_fp8_f32(clamp8(v0[0]), clamp8(v0[1]), w0, false); w0 = __builtin_amdgcn_cvt_pk_fp8_f32(clamp8(v0[2]), clamp8(v0[3]), w0, true);
                    w1 = __builtin_amdgcn_cvt_pk_fp8_f32(clamp8(v1[0]), clamp8(v1[1]), w1, false); w1 = __builtin_amdgcn_cvt_pk_fp8_f32(clamp8(v1[2]), clamp8(v1[3]), w1, true);
                    *(u32x2b_*)(rowp + bj * HALF) = (u32x2b_){w0, w1}; } }
    }
};
struct LayerGroupOrder {
    int G, c;
    __device__ __forceinline__ bool next(int i, Unit& u) const { const int L = i * G + c; if (L >= 1024) return false; const int l = L >> 8, r = L & 255; u.pm = l * 64 + (r >> 2); u.pn = l * 4 + (r & 3); return true; }
    __device__ __forceinline__ void a_ready(const Unit&) const {}
    __device__ __forceinline__ void done(const Unit&) const {}
};
struct BranchOrder {
    StaticOrder base;
    __device__ __forceinline__ bool next(int i, Unit& u) const { Unit b; if (!base.next(i >> 2, b)) return false; const int n = i & 3; u.pm = b.pm + 64 * n; u.pn = b.pn + 4 * n; return true; }
    __device__ __forceinline__ void a_ready(const Unit&) const {}
    __device__ __forceinline__ void done(const Unit&) const {}
};
template <int NT, bool VIRT> struct MoeOrder {
    const PG8_LAS int* tileE; const PG8_LAS int* pstart; int ntiles, G, c;
    __device__ __forceinline__ bool next(int i, Unit& u) const { const int L = i * G + c; if (L >= ntiles * NT) return false; const int mt = L / NT, j = L % NT; const int e = __builtin_amdgcn_readfirstlane(tileE[mt]);
        u.po = mt; u.pm = VIRT ? 64 * e + (mt - __builtin_amdgcn_readfirstlane(pstart[e])) : mt; u.pn = e * NT + j; return true; }
    __device__ __forceinline__ void a_ready(const Unit&) const {}
    __device__ __forceinline__ void done(const Unit&) const {}
};
template <class E, class = void> struct epi_keeps_acc { static constexpr bool value = false; };
template <class E> struct epi_keeps_acc<E, decltype((void)E::KEEP_ACC)> { static constexpr bool value = E::KEEP_ACC; };
typedef int i32x4 __attribute__((ext_vector_type(4))); typedef int i32x8 __attribute__((ext_vector_type(8)));
__device__ __forceinline__ i32x8 cat8(bf16x8 lo, bf16x8 hi) { return __builtin_shufflevector(__builtin_bit_cast(i32x4, lo), __builtin_bit_cast(i32x4, hi), 0, 1, 2, 3, 4, 5, 6, 7); }
template <class Epi, class Sched, bool ALIGN_EPI = false, bool SP2 = false, bool F8 = false, int F8_SW = 0x7f, int F8_SX = 0x7f>
__device__ __forceinline__ void gemm_phase(PG8_LAS unsigned char* lds, const Gemm g, const Sched& S, const Epi& E, int tid_in) {
    int tid = tid_in; asm volatile("" : "+v"(tid));
    const int wid = __builtin_amdgcn_readfirstlane(tid >> 6), lane = tid & 63, wr = wid >> 2, wc = wid & 3, fr = lane & 15, fq = lane >> 4;
    const int K = g.K, nt = K / BK;
    int f8sw = F8_SW, f8sx = F8_SX; if constexpr (F8) asm volatile("" : "+v"(f8sw), "+v"(f8sx));
    unsigned voffA[2], voffB[2];
#pragma unroll
    for (int i = 0; i < 2; ++i) { int R, C; stage_rc(tid * 16 + i * 8192, R, C); const int Rb = Epi::PERM ? ((R & ~31) + perm32(R & 31)) : R;
        voffA[i] = (unsigned)(R * K + C) * 2u; voffB[i] = (unsigned)(Rb * K + C) * 2u; }
    asm volatile("" : "+v"(voffA[0]), "+v"(voffA[1]), "+v"(voffB[0]), "+v"(voffB[1]));
    const size_t kstep = (size_t)(BK * 2);
    const size_t hstep = (size_t)HALF * K * 2;
    const size_t tstep = 2 * hstep;
    const unsigned ldsw = (unsigned)wid * 1024u;
    const int aoff = lds_byte(wr * 64 + fr, fq * 8), boff = lds_byte(wc * 32 + fr, fq * 8);
#define PG8_SA(b, h) (((b) * 2 + (h)) * HTB)
#define PG8_SB(b, h) ((4 + (b) * 2 + (h)) * HTB)
#define PG8_STAGE(bufoff, gbase, voff) do { _Pragma("unroll") for (int _i = 0; _i < 2; ++_i) \
        __builtin_amdgcn_global_load_lds((const unsigned*)((const char*)(gbase) + (voff)[_i]), (PG8_LAS unsigned*)(lds + (bufoff) + ldsw + _i * 8192), 16, 0, 0); } while (0)
#define PG8_LDA(dst, b, h) do { _Pragma("unroll") for (int m = 0; m < 4; ++m) _Pragma("unroll") for (int k = 0; k < 2; ++k) dst[m][k] = *(const PG8_LAS bf16x8*)(lds + PG8_SA(b, h) + aoff + m * 2048 + k * 1024); } while (0)
#define PG8_LDB(dst, b, h) do { _Pragma("unroll") for (int n = 0; n < 2; ++n) _Pragma("unroll") for (int k = 0; k < 2; ++k) dst[n][k] = *(const PG8_LAS bf16x8*)(lds + PG8_SB(b, h) + boff + n * 2048 + k * 1024); } while (0)
#define PG8_MMA(ai, bj, At, Bt) do { __builtin_amdgcn_s_setprio(1); _Pragma("unroll") for (int m = 0; m < 4; ++m) _Pragma("unroll") for (int n = 0; n < 2; ++n) { \
        if constexpr (F8) { asm volatile("v_mfma_scale_f32_16x16x128_f8f6f4 %0, %1, %2, %0, %3, %4 op_sel_hi:[0,0,0]" : "+v"(acc[ai][bj][m][n]) : "v"(cat8(Bt[n][0], Bt[n][1])), "v"(cat8(At[m][0], At[m][1])), "v"(f8sw), "v"(f8sx)); } \
        else { _Pragma("unroll") for (int k = 0; k < 2; ++k) acc[ai][bj][m][n] = __builtin_amdgcn_mfma_f32_16x16x32_bf16(Bt[n][k], At[m][k], acc[ai][bj][m][n], 0, 0, 0); } } __builtin_amdgcn_s_setprio(0); } while (0)
#define PG8_WAIT_V(n) asm volatile("s_waitcnt vmcnt(" #n ")" ::: "memory")
#define PG8_WAIT_L(n) asm volatile("s_waitcnt lgkmcnt(" #n ")" ::: "memory")
#define PG8_BAR __builtin_amdgcn_s_barrier()
#define PG8_SCHED __builtin_amdgcn_sched_barrier(0)
    Unit cur, nxt; int ui = 0;
    if (!S.next(0, cur)) return;
    f32x4 acc[2][2][4][2];
#pragma unroll
    for (int a = 0; a < 2; ++a)
#pragma unroll
        for (int b = 0; b < 2; ++b)
#pragma unroll
            for (int m = 0; m < 4; ++m)
#pragma unroll
                for (int n = 0; n < 2; ++n) acc[a][b][m][n] = (f32x4){0.f, 0.f, 0.f, 0.f};
    bf16x8 At[4][2], B0[2][2], B1[2][2];
    const char* cA = (const char*)g.A + (size_t)cur.pm * tstep; const char* cB = (const char*)g.Bt + (size_t)cur.pn * tstep;
    S.a_ready(cur);
    if constexpr (SP2) {
        PG8_STAGE(PG8_SB(0, 0), cB, voffB); PG8_STAGE(PG8_SB(0, 1), cB + hstep, voffB); PG8_STAGE(PG8_SA(0, 0), cA, voffA); PG8_STAGE(PG8_SA(0, 1), cA + hstep, voffA);
        if (wr == 1) PG8_BAR;
        PG8_WAIT_V(2); PG8_BAR;
        PG8_STAGE(PG8_SB(1, 0), cB + kstep, voffB); PG8_STAGE(PG8_SA(1, 0), cA + kstep, voffA); PG8_STAGE(PG8_SB(1, 1), cB + hstep + kstep, voffB);
        PG8_WAIT_V(6); PG8_BAR;
    } else {
        PG8_STAGE(PG8_SB(0, 0), cB, voffB); PG8_STAGE(PG8_SA(0, 0), cA, voffA); PG8_STAGE(PG8_SB(0, 1), cB + hstep, voffB); PG8_STAGE(PG8_SA(0, 1), cA + hstep, voffA);
        if (wr == 1) PG8_BAR;
        PG8_WAIT_V(4); PG8_BAR;
        PG8_STAGE(PG8_SB(1, 0), cB + kstep, voffB); PG8_STAGE(PG8_SA(1, 0), cA + kstep, voffA); PG8_STAGE(PG8_SB(1, 1), cB + hstep + kstep, voffB);
        PG8_WAIT_V(6); PG8_BAR;
    }
    for (;;) {
        const bool has_next = S.next(ui + 1, nxt);
        const char* nA = has_next ? (const char*)g.A + (size_t)nxt.pm * tstep : cA; const char* nB = has_next ? (const char*)g.Bt + (size_t)nxt.pn * tstep : cB;
#pragma nounroll
        for (int t = 0; t < nt; t += 2) {
            const bool last = (t == nt - 2);
            const char* a1 = cA + (size_t)(t + 1) * kstep;
            const char* a2 = last ? nA : cA + (size_t)(t + 2) * kstep; const char* b2 = last ? nB : cB + (size_t)(t + 2) * kstep;
            const char* a3 = a2 + kstep; const char* b3 = b2 + kstep;
            if (last && has_next) S.a_ready(nxt);
            if constexpr (SP2) {
            PG8_LDB(B0, 0, 0); PG8_LDB(B1, 0, 1); PG8_SCHED; PG8_LDA(At, 0, 0); PG8_STAGE(PG8_SA(1, 1), a1 + hstep, voffA);
            PG8_WAIT_V(8); PG8_WAIT_L(0); PG8_BAR; PG8_MMA(0, 0, At, B0); PG8_MMA(0, 1, At, B1); PG8_BAR; PG8_SCHED;
            PG8_LDA(At, 0, 1); PG8_STAGE(PG8_SB(0, 0), b2, voffB); PG8_STAGE(PG8_SB(0, 1), b2 + hstep, voffB); PG8_STAGE(PG8_SA(0, 0), a2, voffA);
            PG8_WAIT_V(8); PG8_WAIT_L(0); PG8_BAR; PG8_MMA(1, 0, At, B0); PG8_MMA(1, 1, At, B1); PG8_BAR; PG8_SCHED;
            PG8_LDB(B0, 1, 0); PG8_LDB(B1, 1, 1); PG8_SCHED; PG8_LDA(At, 1, 0); PG8_STAGE(PG8_SA(0, 1), a2 + hstep, voffA);
            PG8_WAIT_V(8); PG8_WAIT_L(0); PG8_BAR; PG8_MMA(0, 0, At, B0); PG8_MMA(0, 1, At, B1); PG8_BAR; PG8_SCHED;
            PG8_LDA(At, 1, 1); PG8_STAGE(PG8_SB(1, 0), b3, voffB); PG8_STAGE(PG8_SB(1, 1), b3 + hstep, voffB); PG8_STAGE(PG8_SA(1, 0), a3, voffA);
            PG8_WAIT_V(8); PG8_WAIT_L(0); PG8_BAR; PG8_MMA(1, 0, At, B0); PG8_MMA(1, 1, At, B1); PG8_BAR; PG8_SCHED;
            } else {
            PG8_LDB(B0, 0, 0); PG8_SCHED; PG8_LDA(At, 0, 0); PG8_STAGE(PG8_SA(1, 1), a1 + hstep, voffA);
            PG8_WAIT_L(8); PG8_BAR; PG8_WAIT_L(0); PG8_MMA(0, 0, At, B0); PG8_BAR; PG8_SCHED;
            PG8_LDB(B1, 0, 1); PG8_STAGE(PG8_SB(0, 0), b2, voffB);
            PG8_BAR; PG8_WAIT_L(0); PG8_MMA(0, 1, At, B1); PG8_BAR;
            PG8_LDA(At, 0, 1); PG8_STAGE(PG8_SA(0, 0), a2, voffA);
            PG8_BAR; PG8_WAIT_L(0); PG8_MMA(1, 0, At, B0); PG8_BAR; PG8_SCHED;
            PG8_STAGE(PG8_SB(0, 1), b2 + hstep, voffB);
            PG8_WAIT_V(6); PG8_BAR; PG8_MMA(1, 1, At, B1); PG8_BAR;
            PG8_LDB(B0, 1, 0); PG8_SCHED; PG8_LDA(At, 1, 0); PG8_STAGE(PG8_SA(0, 1), a2 + hstep, voffA);
            PG8_WAIT_L(8); PG8_BAR; PG8_WAIT_L(0); PG8_MMA(0, 0, At, B0); PG8_BAR; PG8_SCHED;
            PG8_LDB(B1, 1, 1); PG8_STAGE(PG8_SB(1, 0), b3, voffB);
            PG8_BAR; PG8_WAIT_L(0); PG8_MMA(0, 1, At, B1); PG8_BAR;
            PG8_LDA(At, 1, 1); PG8_STAGE(PG8_SA(1, 0), a3, voffA);
            PG8_BAR; PG8_WAIT_L(0); PG8_MMA(1, 0, At, B0); PG8_BAR; PG8_SCHED;
            PG8_STAGE(PG8_SB(1, 1), b3 + hstep, voffB);
            PG8_WAIT_V(6); PG8_BAR; PG8_MMA(1, 1, At, B1); PG8_BAR;
            }
        }
        if constexpr (F8) asm volatile("s_nop 15\n\ts_nop 15" ::: "memory");
        if constexpr (ALIGN_EPI) { if (wr == 0) PG8_BAR; }
        if constexpr (!Epi::AFTER_DRAIN) { const int l2 = lane_id_fresh(); E(acc, cur, wr, wc, l2 & 15, l2 >> 4); S.done(cur); }
        if (!has_next) break;
        if constexpr (!epi_keeps_acc<Epi>::value) {
#pragma unroll
        for (int a = 0; a < 2; ++a)
#pragma unroll
            for (int b = 0; b < 2; ++b)
#pragma unroll
                for (int m = 0; m < 4; ++m)
#pragma unroll
                    for (int n = 0; n < 2; ++n) acc[a][b][m][n] = (f32x4){0.f, 0.f, 0.f, 0.f};
        }
        cur = nxt; cA = nA; cB = nB; ++ui;
        if constexpr (ALIGN_EPI) { if (wr == 1) PG8_BAR; }
    }
    PG8_WAIT_V(0);
    if constexpr (!ALIGN_EPI) { if (wr == 0) PG8_BAR; }
    PG8_BAR;
    if constexpr (Epi::AFTER_DRAIN) { E.fused(acc, cur, wr, wc, fr, fq, lds, wid, lane); S.done(cur); }
#undef PG8_SA
#undef PG8_SB
#undef PG8_STAGE
#undef PG8_LDA
#undef PG8_LDB
#undef PG8_MMA
#undef PG8_WAIT_V
#undef PG8_WAIT_L
#undef PG8_BAR
#undef PG8_SCHED
}
}

#ifndef PG8_SP2
#define PG8_SP2 true
#endif
#ifndef PG8_ALIGN
#define PG8_ALIGN true
#endif

constexpr int NWAVES = 8, NTHR = 512;
constexpr int NL = 4, M = 16384, D = 1024, SEQ = 2048, W = 512, NE = 32, ZLD = 11264, DPLE = 256;
constexpr int NC_BASE = 11016, NC_REST = 11048;
constexpr int ZA = 0, ZB = 1792, ZC = 3840, ZD = 5896, ZX = 6920, ZG = 7168;
constexpr float ALPHA = 1.681792830507429f;
constexpr int MOE_ROWS = 73728;
constexpr size_t MiB = 1u << 20;
constexpr size_t WS_CTL = 0, CTL_ZERO_BYTES = 128 * 1024;
constexpr size_t WS_WIN = 2 * MiB, WS_WBR = 90 * MiB, WS_WOUT = 106 * MiB, WS_WPG = 114 * MiB, WS_WPP = 122 * MiB, WS_WSM = 124 * MiB, WS_WLRU = 126 * MiB;
constexpr size_t WS_WGU = 128 * MiB, WS_WDN = 640 * MiB, WS_PB = 896 * MiB, WS_PP = 928 * MiB, WS_XB = 1056 * MiB, WS_XF = 1088 * MiB, WS_Z = 1152 * MiB;
constexpr size_t WS_RW = 1504 * MiB, WS_BON = 1728 * MiB, WS_VF = 1730 * MiB, WS_LA = 1762 * MiB, WS_LB = 1794 * MiB, WS_YA = 1826 * MiB, WS_OB = 1858 * MiB, WS_HC = 1890 * MiB;
constexpr size_t WS_Y = 1922 * MiB, WS_MF = 1986 * MiB, WS_MB = 2050 * MiB, WS_PRE = 2082 * MiB, WS_X1F = 2146 * MiB, WS_X1B = 2210 * MiB;
constexpr size_t WS_SLOT = 2242 * MiB, WS_TREC = 2244 * MiB, WS_GATE = 2245 * MiB, WS_XS = 2246 * MiB, WS_XB8 = 2246 * MiB, WS_X1B8 = 2262 * MiB, WS_WIN8 = 2278 * MiB, WS_WPG8 = 2294 * MiB, WS_H = 2390 * MiB, WS_YS = 2534 * MiB, WS_PLEG = 2678 * MiB, WS_FR = 2710 * MiB, WS_FRH = 2810 * MiB, WS_FRM = 2890 * MiB, WS_XSV = 2970 * MiB, WS_END = 3994 * MiB;
constexpr size_t RWSZ = 32 * MiB;
constexpr size_t RHSZ = 16 * MiB, WS_LW = WS_RW + 6 * RHSZ;
constexpr int CW_TMO = 0, CW_BAR = 4096, CW_CNT = 16384;
constexpr int RING_BYTES = 131072, LDSCTL_OFF = RING_BYTES, LDSCTL_BYTES = 8192, LDS_USED = RING_BYTES + LDSCTL_BYTES, LDS_BYTES = 147456;
constexpr int LC_BAR = 0  , LC_TILEE = 16  , LC_PSTART = 352  , LC_CNT = 400  , LC_BASE = 432  , LC_NT = 464, LC_REC = 512  ;

#define GAS __attribute__((address_space(1)))
#define LAS __attribute__((address_space(3)))
#define DI __device__ __forceinline__
typedef unsigned short bf16;
typedef unsigned v4u __attribute__((ext_vector_type(4)));
typedef unsigned v2u __attribute__((ext_vector_type(2)));
typedef float f32x4 __attribute__((ext_vector_type(4)));
typedef float f32x2 __attribute__((ext_vector_type(2)));
typedef short bf16x8 __attribute__((ext_vector_type(8)));
typedef GAS unsigned gu32;
#define RLX_AGENT __ATOMIC_RELAXED, __HIP_MEMORY_SCOPE_AGENT
#define LDS_WAIT() asm volatile("s_waitcnt lgkmcnt(0)" ::: "memory")
#define VM_WAIT() asm volatile("s_waitcnt vmcnt(0)" ::: "memory")
DI unsigned f2bf(float f) { unsigned u = __builtin_bit_cast(unsigned, f); return (u + 0x7fffu + ((u >> 16) & 1u)) >> 16; }
typedef __bf16 bf16x2_t __attribute__((ext_vector_type(2)));
DI unsigned pk2(float lo, float hi) { const f32x2 v = {lo, hi}; const bf16x2_t b = __builtin_convertvector(v, bf16x2_t); return __builtin_bit_cast(unsigned, b); }
DI float bf2f(unsigned short b) { return __builtin_bit_cast(float, (unsigned)b << 16); }
DI float blo(unsigned w) { return __builtin_bit_cast(float, w << 16); }
DI float bhi(unsigned w) { return __builtin_bit_cast(float, w & 0xffff0000u); }
DI float sigm(float x) { return __builtin_amdgcn_rcpf(1.0f + __expf(-x)); }
DI float tanh_fast(float x) { return 1.0f - 2.0f * __builtin_amdgcn_rcpf(1.0f + __expf(2.0f * x)); }
DI float siluf(float x) { return x * sigm(x); }
DI float softplusf(float x) { return x > 20.0f ? x : __logf(1.0f + __expf(x)); }
DI float logsigm(float x) { return -softplusf(-x); }
DI unsigned pk4f8(float a, float b, float c, float d) {
    unsigned w = 0u; w = __builtin_amdgcn_cvt_pk_fp8_f32(pg8::clamp8(a * 8.0f), pg8::clamp8(b * 8.0f), w, false); return __builtin_amdgcn_cvt_pk_fp8_f32(pg8::clamp8(c * 8.0f), pg8::clamp8(d * 8.0f), w, true); }
DI float gelu_tanh(float x) { return 0.5f * x * (1.0f + tanh_fast(0.7978845608028654f * (x + 0.044715f * x * x * x))); }

#define XB_TMO      128
#define XB_XCNT(j)  (256  + 64 * (j))
#define XB_XSUB(j)  (1280 + 64 * (j))
#define XB_XGEN(j)  (2304 + 64 * (j))
#define XB_TOP      3328
#define XB_TOPGEN   3392
#define XCD_BAR_WORDS 3456
#define XB_SPIN_CAP (1u << 18)
DI unsigned xb_ld(unsigned* p)              { return __hip_atomic_load(p, __ATOMIC_RELAXED, __HIP_MEMORY_SCOPE_AGENT); }
DI unsigned xb_add(unsigned* p, unsigned v) { return __hip_atomic_fetch_add(p, v, __ATOMIC_RELAXED, __HIP_MEMORY_SCOPE_AGENT); }
DI unsigned xb_xcc_id() { return (unsigned)__builtin_amdgcn_s_getreg((3 << 11) | 20) & 0xFu; }
#define XB_SPIN(cond, bar) do { unsigned _sp = 0; while (cond) { __builtin_amdgcn_s_sleep(1); \
    if ((++_sp & 255u) == 0u) { if (xb_ld(&(bar)[XB_TMO])) break; if (_sp > XB_SPIN_CAP) { atomicAdd(&(bar)[XB_TMO], 1u); break; } } } } while (0)
struct XcdBarrier { unsigned* bar; unsigned x; volatile LAS unsigned* st; };
DI XcdBarrier xcd_barrier_post(unsigned* bar, volatile LAS unsigned* st) {
    XcdBarrier b; b.bar = bar; b.x = xb_xcc_id(); b.st = st;
    if (threadIdx.x == 0) (void)xb_add(&bar[XB_XCNT(b.x)], 1u);
    return b;
}
DI void xcd_barrier_complete(unsigned* bar, unsigned x, unsigned& nloc, unsigned& nx) {
    const unsigned G = gridDim.x * gridDim.y * gridDim.z;
    unsigned sum, cnt, mine, sp = 0u;
    for (;;) {
        sum = 0u; cnt = 0u; mine = 0u;
#pragma unroll
        for (unsigned j = 0; j < 16; ++j) { const unsigned c = xb_ld(&bar[XB_XCNT(j)]); sum += c; cnt += (c > 0u) ? 1u : 0u; mine = (j == x) ? c : mine; }
        if (sum == G) break;
        __builtin_amdgcn_s_sleep(1);
        if ((++sp & 255u) == 0u) { if (xb_ld(&bar[XB_TMO])) break; if (sp > XB_SPIN_CAP) { atomicAdd(&bar[XB_TMO], 1u); break; } }
    }
    nloc = mine > 0u ? mine : 1u; nx = cnt > 0u ? cnt : 1u;
}
DI void xcd_barrier(const XcdBarrier& b) {
    asm volatile("s_waitcnt vmcnt(0)" ::: "memory");
    __syncthreads();
    if (threadIdx.x == 0) {
        unsigned* bar = b.bar;
        __builtin_amdgcn_s_waitcnt(0);
        unsigned nloc = b.st[0], nx = b.st[1];
        if (nloc == 0u) { xcd_barrier_complete(bar, b.x, nloc, nx); b.st[0] = nloc; b.st[1] = nx; }
        const unsigned old = xb_add(&bar[XB_XSUB(b.x)], 1u);
        const unsigned gen = old / nloc;
        if (old + 1u == (gen + 1u) * nloc) {
            __builtin_amdgcn_fence(__ATOMIC_RELEASE, "agent");
            asm volatile("s_waitcnt vmcnt(0)" ::: "memory");
            const unsigned og = xb_add(&bar[XB_TOP], 1u);
            const unsigned tg = og / nx;
            if (og + 1u == (tg + 1u) * nx) xb_add(&bar[XB_TOPGEN], 1u);
            else XB_SPIN(xb_ld(&bar[XB_TOPGEN]) == tg, bar);
            __builtin_amdgcn_fence(__ATOMIC_ACQUIRE, "agent");
            xb_add(&bar[XB_XGEN(b.x)], 1u);
            asm volatile("s_waitcnt vmcnt(0)" ::: "memory");
        } else {
            XB_SPIN(xb_ld(&bar[XB_XGEN(b.x)]) == gen, bar);
            __builtin_amdgcn_fence(__ATOMIC_ACQUIRE, "agent");
            asm volatile("s_waitcnt vmcnt(0)" ::: "memory");
        }
    }
    __syncthreads();
}

struct Args { const float* in[45]; float* out; unsigned char* ws; int ph_lo, ph_hi; };
typedef const __attribute__((address_space(4))) Args* KA;
struct Frame {
    LAS unsigned char* lds; LAS unsigned* LC;
    unsigned char* ws; gu32* ctl;
    int tid, lane, wave, vcu, G, gw, NGW;
};
DI void rebind(Frame& F) {
    int w = F.wave, vc = F.vcu, gg = F.G; asm volatile("" : "+s"(w), "+s"(vc), "+s"(gg)); F.vcu = vc; F.G = gg; F.NGW = gg * NWAVES;
    const int ln = pg8::lane_id_fresh();
    F.wave = w; F.lane = ln; F.tid = w * 64 + ln; F.gw = F.vcu * NWAVES + w;
}

template <int CTRL> DI float dpp_f(float v) { return __builtin_bit_cast(float, __builtin_amdgcn_update_dpp(0, __builtin_bit_cast(int, v), CTRL, 0xf, 0xf, true)); }
template <int MSK> DI int shx_i(int v) {
    if constexpr (MSK < 32) return __builtin_amdgcn_ds_swizzle(v, (MSK << 10) | 0x1f);
    else { const int l = pg8::lane_id_fresh(); return __builtin_amdgcn_ds_bpermute((l ^ MSK) << 2, v); }
}
template <int MSK> DI float shx(float v) { return __builtin_bit_cast(float, shx_i<MSK>(__builtin_bit_cast(int, v))); }
DI float wave_sum(float v) { v += dpp_f<0xB1>(v); v += dpp_f<0x4E>(v); v += dpp_f<0x124>(v); v += dpp_f<0x128>(v); v += shx<16>(v); v += shx<32>(v); return v; }
DI float row16_sum(float v) {
    v += dpp_f<0xB1>(v); v += dpp_f<0x4E>(v); v += dpp_f<0x124>(v); v += dpp_f<0x128>(v); return v;
}

template <int MODE  >
DI void cvt_item(const float* W, int ldw, int N, int K, int kb, int nb, bf16* WT, LAS float* scr, int lane) {
    const int k0 = 64 * kb, n0 = 32 * nb, nl = lane & 31;
    if (MODE == 5 && (n0 + 32 <= 6920 || n0 >= 11016)) return;
    if (MODE == 4 && n0 >= 6920 && n0 + 32 <= 11016) return;
    float v32[32]; const bool okn = (n0 + nl < N); const float* wp = W + (size_t)(k0 + (lane >> 5)) * ldw + n0 + nl;
#pragma unroll
    for (int i = 0; i < 32; ++i) v32[i] = okn ? wp[(size_t)(2 * i) * ldw] : 0.0f;
#pragma unroll
    for (int i = 0; i < 32; ++i) scr[(2 * i + (lane >> 5)) * 33 + nl] = v32[i];
    LDS_WAIT(); asm volatile("" ::: "memory");
    const int c = lane & 7;
#pragma unroll
    for (int j = 0; j < 4; ++j) { const int nn = (lane >> 3) + 8 * j, n = n0 + nn; const LAS float* s = scr + (8 * c) * 33 + nn;
        int ro = n; if (MODE == 1 || MODE == 2) { const int cc = n & 1023; ro = (cc >> 7) * 256 + (n >> 10) * 128 + (cc & 127); }
        if (MODE == 4) ro = (n < 6920) ? n : n - 4096;
        if (MODE == 5) ro = n - 6920;
        const bool gate_col = (n >= 6920 && n < 11016);
        if (MODE == 2 || MODE == 3 || MODE == 5) { unsigned w0 = 0u, w1 = 0u;
            w0 = __builtin_amdgcn_cvt_pk_fp8_f32(s[0 * 33] * 64.0f, s[1 * 33] * 64.0f, w0, false); w0 = __builtin_amdgcn_cvt_pk_fp8_f32(s[2 * 33] * 64.0f, s[3 * 33] * 64.0f, w0, true);
            w1 = __builtin_amdgcn_cvt_pk_fp8_f32(s[4 * 33] * 64.0f, s[5 * 33] * 64.0f, w1, false); w1 = __builtin_amdgcn_cvt_pk_fp8_f32(s[6 * 33] * 64.0f, s[7 * 33] * 64.0f, w1, true);
            if (n < N && (MODE != 5 || gate_col)) *(GAS v2u*)((unsigned char*)WT + (size_t)ro * K + k0 + 8 * c) = (v2u){w0, w1}; }
        else { v4u o; o.x = pk2(s[0 * 33], s[1 * 33]); o.y = pk2(s[2 * 33], s[3 * 33]); o.z = pk2(s[4 * 33], s[5 * 33]); o.w = pk2(s[6 * 33], s[7 * 33]);
            if (n < N && (MODE != 4 || !gate_col)) *(GAS v4u*)(WT + (size_t)ro * K + k0 + 8 * c) = o; } }
    LDS_WAIT(); asm volatile("" ::: "memory");
}
template <int MODE> DI void cvt_item8(const float* W, int ldw, int N, int K, int kb, int nb, unsigned char* WT8, LAS float* scr, int lane) {
    const int k0 = 128 * kb, n0 = 32 * nb, nl = lane & 31, half = lane >> 5;
    if (MODE == 5 && (n0 + 32 <= 6920 || n0 >= 11016)) return;
    float v64[64]; const bool okn = (n0 + nl < N); const float* wp = W + (size_t)(k0 + half) * ldw + n0 + nl;
#pragma unroll
    for (int i = 0; i < 64; ++i) v64[i] = okn ? wp[(size_t)(2 * i) * ldw] : 0.0f;
#pragma unroll
    for (int i = 0; i < 64; ++i) { const int row = 2 * i + half; scr[row * 32 + (nl ^ ((row >> 3) & 31))] = v64[i]; }
    LDS_WAIT(); asm volatile("" ::: "memory");
    const int c = lane & 15, nq = lane >> 4;
#pragma unroll
    for (int j = 0; j < 8; ++j) { const int nn = nq + 4 * j, n = n0 + nn; const LAS float* sp = scr + (8 * c) * 32 + (nn ^ c);
        int ro = n; if (MODE == 2) { const int cc = n & 1023; ro = (cc >> 7) * 256 + (n >> 10) * 128 + (cc & 127); }
        if (MODE == 5) ro = n - 6920;
        const bool ok = (n < N) && (MODE != 5 || (n >= 6920 && n < 11016));
        unsigned w0 = 0u, w1 = 0u;
        w0 = __builtin_amdgcn_cvt_pk_fp8_f32(sp[0 * 32] * 64.0f, sp[1 * 32] * 64.0f, w0, false); w0 = __builtin_amdgcn_cvt_pk_fp8_f32(sp[2 * 32] * 64.0f, sp[3 * 32] * 64.0f, w0, true);
        w1 = __builtin_amdgcn_cvt_pk_fp8_f32(sp[4 * 32] * 64.0f, sp[5 * 32] * 64.0f, w1, false); w1 = __builtin_amdgcn_cvt_pk_fp8_f32(sp[6 * 32] * 64.0f, sp[7 * 32] * 64.0f, w1, true);
        if (ok) *(GAS v2u*)(WT8 + (size_t)ro * K + k0 + 8 * c) = (v2u){w0, w1}; }
    LDS_WAIT(); asm volatile("" ::: "memory");
}
template <int MODE> DI void cvt_class(Frame& F, int& off, const float* W, int K, int N, int ldw, size_t src_stride, bf16* WT, size_t dst_stride, int nmat) {
    LAS float* scr = (LAS float*)(F.lds + F.wave * 16384);
    constexpr bool F8M = (MODE == 2 || MODE == 3 || MODE == 5);
    const int nkb = K / (F8M ? 128 : 64), nnb = (N + 31) / 32, per = nkb * nnb, total = per * nmat;
    int start = (F.gw - off) % F.NGW; if (start < 0) start += F.NGW;
    for (int it = start; it < total; it += F.NGW) { const int mi = it / per, r = it % per;
        if constexpr (F8M) cvt_item8<MODE>(W + (size_t)mi * src_stride, ldw, N, K, r / nnb, r % nnb, (unsigned char*)(WT + (size_t)mi * dst_stride), scr, F.lane);
        else cvt_item<MODE>(W + (size_t)mi * src_stride, ldw, N, K, r / nnb, r % nnb, WT + (size_t)mi * dst_stride, scr, F.lane); }
    off = (off + total) % F.NGW;
}
constexpr int EXP_ITEMS = NE * 512 + NE * 256;
DI void cvt_expert_item(Frame& F, KA a, int l, int it) {
    LAS float* scr = (LAS float*)(F.lds + F.wave * 16384);
    if (it < NE * 512) { const int e = it >> 9, r = it & 511; const size_t mi = (size_t)l * NE + e;
        cvt_item8<2>(a->in[37] + mi * 1024 * 2048, 2048, 2048, 1024, r >> 6, r & 63, F.ws + WS_WGU + mi * 2048 * 1024, scr, F.lane); }
    else { const int i2 = it - NE * 512, e = i2 >> 8, r = i2 & 255; const size_t mi = (size_t)l * NE + e;
        cvt_item8<3>(a->in[39] + mi * 1024 * 1024, 1024, 1024, 1024, r >> 5, r & 31, F.ws + WS_WDN + mi * 1024 * 1024, scr, F.lane); }
}
constexpr int CW_Q = 28672;
DI void cvt_expert_queue(Frame& F, KA a, int l) {
    LAS unsigned* qh = F.LC + 480;
    unsigned nxt = 0u;
    if (F.tid == 0) qh[0] = __hip_atomic_fetch_add((unsigned*)(F.ctl + CW_Q + l * 64), 8u, __ATOMIC_RELAXED, __HIP_MEMORY_SCOPE_AGENT);
    for (int r = 0;; ++r) {
        __syncthreads();
        const int base = (int)qh[r & 1];
        if (base >= EXP_ITEMS) break;
        if (F.tid == 0) nxt = __hip_atomic_fetch_add((unsigned*)(F.ctl + CW_Q + l * 64), 8u, __ATOMIC_RELAXED, __HIP_MEMORY_SCOPE_AGENT);
        if (base + F.wave < EXP_ITEMS) cvt_expert_item(F, a, l, base + F.wave);
        if (F.tid == 0) qh[(r + 1) & 1] = nxt;
    }
}
DI void p0_convert(Frame& F, KA a) {
    int off = 0;
    cvt_class<4>(F, off, a->in[2], 1024, NC_BASE, NC_BASE, 0, (bf16*)(F.ws + WS_WIN), 0, 1);
    cvt_class<4>(F, off, a->in[3], 1024, NC_REST, NC_REST, (size_t)1024 * NC_REST, (bf16*)(F.ws + WS_WIN) + (size_t)ZLD * 1024, (size_t)ZLD * 1024, NL - 1);
    cvt_class<3>(F, off, a->in[31], 512, 1024, 1024, (size_t)512 * 1024, (bf16*)(F.ws + WS_WBR), (size_t)1024 * 512 / 2, NL * 4);
    cvt_class<3>(F, off, a->in[32], 1024, 1024, 1024, (size_t)1024 * 1024, (bf16*)(F.ws + WS_WOUT), (size_t)1024 * 1024 / 2, NL);
    cvt_class<3>(F, off, a->in[41], 1024, 1024, 1024, (size_t)1024 * 1024, (bf16*)(F.ws + WS_WPG8), (size_t)1024 * 1024 / 2, NL);
    cvt_class<5>(F, off, a->in[2], 1024, NC_BASE, NC_BASE, 0, (bf16*)(F.ws + WS_WIN8), 0, 1);
    cvt_class<5>(F, off, a->in[3], 1024, NC_REST, NC_REST, (size_t)1024 * NC_REST, (bf16*)(F.ws + WS_WIN8 + (size_t)4096 * 1024), (size_t)4096 * 1024 / 2, NL - 1);
    cvt_class<0>(F, off, a->in[42], 256, 1024, 1024, (size_t)256 * 1024, (bf16*)(F.ws + WS_WPP), (size_t)1024 * 256, NL);
    const int gt = F.vcu * NTHR + F.tid, NGT = F.G * NTHR;
    for (int l = 0; l < NL; ++l) { const int n0 = (l == 0) ? ZX : ZX + 32; bf16* wt = (bf16*)(F.ws + WS_WIN) + (size_t)l * ZLD * 1024;
        const int nq = (ZG - n0) * 1024 / 8;
        for (int i = gt; i < nq; i += NGT) *(GAS v4u*)(wt + (size_t)n0 * 1024 + (size_t)i * 8) = (v4u){0u, 0u, 0u, 0u}; }
    { bf16* wsm = (bf16*)(F.ws + WS_WSM);
      for (int i = gt; i < NL * 512 * 288; i += NGT) { const int l = i / (512 * 288), r = i % (512 * 288), c = r / 288, k = r % 288; float v;
          if (k < 64) v = a->in[6][((size_t)l * 64 + k) * 512 + c];
          else if (k < 128) v = a->in[8][((size_t)l * 64 + (k - 64)) * 512 + c];
          else if (k < 256) v = a->in[11][((size_t)l * 128 + (k - 128)) * 512 + c];
          else v = (l > 0) ? a->in[10][((size_t)(l - 1) * 32 + (k - 256)) * 512 + c] : 0.0f;
          wsm[i] = (bf16)f2bf(v); }
      bf16* wl = (bf16*)(F.ws + WS_WLRU);
      for (int i = gt; i < NL * 2 * 8 * 64 * 64; i += NGT) { const int l = i >> 16, r = i & 65535, which = r >> 15, g = (r >> 12) & 7, j = (r >> 6) & 63, ii = r & 63;
          const float* src = which ? a->in[28] : a->in[26];
          wl[i] = (bf16)f2bf(src[(((size_t)l * 8 + g) * 64 + ii) * 64 + j]); } }
    { const GAS f32x4* xs = (const GAS f32x4*)a->in[0]; GAS v2u* xb = (GAS v2u*)(F.ws + WS_XB);
      GAS unsigned* xb8 = (GAS unsigned*)(F.ws + WS_XB8);
      for (int i = gt; i < M * D / 4; i += NGT) { const f32x4 v = xs[i]; xb[i] = (v2u){pk2(v.x, v.y), pk2(v.z, v.w)}; unsigned w8 = __builtin_amdgcn_cvt_pk_fp8_f32(v.x * 16.f, v.y * 16.f, 0u, false); xb8[i] = __builtin_amdgcn_cvt_pk_fp8_f32(v.z * 16.f, v.w * 16.f, w8, true); }
      const GAS f32x4* ps = (const GAS f32x4*)a->in[1]; GAS v2u* pb = (GAS v2u*)(F.ws + WS_PB);
      for (int i = gt; i < NL * M * DPLE / 4; i += NGT) { const f32x4 v = ps[i]; pb[i] = (v2u){pk2(v.x, v.y), pk2(v.z, v.w)}; } }
}

DI f32x4 mfma16(bf16x8 a, bf16x8 b, f32x4 c) { return __builtin_amdgcn_mfma_f32_16x16x32_bf16(a, b, c, 0, 0, 0); }
DI f32x4 fresh_zero4() { float z0 = 0.f; asm volatile("" : "+v"(z0)); return (f32x4){z0, z0, z0, z0}; }
constexpr int XS_LD = 296, XCB_LD = 520, XCF_LD = 516;
static_assert(16 * XS_LD * 2 <= 9728 && 9728 + 16 * XCB_LD * 2 <= 26624 && 26624 + 16 * XCF_LD * 4 <= 59904 && 59904 + 18 * 512 * 4 <= RING_BYTES, "prep LDS map");
DI void phase_prep(Frame& F, KA a, int l) {
    LAS bf16* X = (LAS bf16*)F.lds;
    LAS bf16* XCb = (LAS bf16*)(F.lds + 9728);
    LAS float* XCf = (LAS float*)(F.lds + 26624);
    const bf16* z = (const bf16*)(F.ws + WS_Z);
    const bf16* wsm = (const bf16*)(F.ws + WS_WSM) + (size_t)l * 512 * 288;
    const bf16* wlru = (const bf16*)(F.ws + WS_WLRU) + (size_t)l * 65536;
    const float* mu = a->in[4] + l * 1792; const float* w0 = a->in[5] + l * 512; const float* a0 = a->in[7] + l * 512;
    const float* v0 = a->in[9] + (l > 0 ? (l - 1) * 512 : 0); const float* k_k = a->in[12] + l * 512; const float* k_a = a->in[13] + l * 512; const float* r_k = a->in[14] + l * 512;
    const float* cw = a->in[24] + l * 4 * 512; const float* cb = a->in[25] + l * 512; const float* bx = a->in[27] + l * 512; const float* ba = a->in[29] + l * 512; const float* lam = a->in[30] + l * 512;
    bf16* RWH = (bf16*)(F.ws + WS_RW); float* LW = (float*)(F.ws + WS_LW); bf16* VF = (bf16*)(F.ws + WS_VF);     float* BON = (float*)(F.ws + WS_BON);
    float* LA = (float*)(F.ws + WS_LA); bf16* LB = (bf16*)(F.ws + WS_LB);
    const int h = F.wave, lane = F.lane, tok = lane & 15, quad = lane >> 4;
    LAS float* PT = (LAS float*)(F.lds + 59904);
    for (int i = F.tid; i < 18 * 512; i += NTHR) { const int f = i >> 9, c = i & 511; float v;
        if (f < 3) v = mu[f * 512 + c]; else if (f == 3) v = w0[c]; else if (f == 4) v = a0[c]; else if (f == 5) v = (l > 0) ? v0[c] : 0.f; else if (f == 6) v = k_k[c]; else if (f == 7) v = k_a[c]; else if (f == 8) v = r_k[c];
        else if (f == 9) v = bx[c]; else if (f == 10) v = ba[c]; else if (f == 11) v = 8.0f * logsigm(lam[c]); else if (f == 12) v = cb[c]; else if (f < 17) v = cw[(f - 13) * 512 + c]; else v = (c < 256) ? mu[1536 + c] : 0.f;
        PT[i] = v; }
    __syncthreads();
#define PTV(f, c) (*(const LAS f32x4*)(PT + (f) * 512 + (c)))
    for (int item = F.vcu; item < M / 16; item += F.G) {
        const int t0 = item * 16;
        const int t = t0 + tok; const bool first = (t & (SEQ - 1)) == 0;
        v2u kpre[8];
#pragma unroll
        for (int nt = 0; nt < 4; ++nt) { const bf16* zr_ = z + (size_t)t * ZLD + 512 + 64 * h + 16 * quad + 4 * nt; kpre[nt] = *(const v2u*)zr_; kpre[4 + nt] = first ? (v2u){0u, 0u} : *(const v2u*)(zr_ - ZLD); }
        for (int idx = F.tid; idx < 16 * 36; idx += NTHR) {
            const int tk = idx / 36, ch = idx % 36, j0 = 8 * ch, t = t0 + tk; float v8[8];
            if (ch < 32) { const int col = 1536 + j0; const v4u cz = *(const v4u*)(z + (size_t)t * ZLD + col);
                const v4u pz = (t & (SEQ - 1)) ? *(const v4u*)(z + (size_t)(t - 1) * ZLD + col) : (v4u){0u, 0u, 0u, 0u};
                const f32x4 m0 = PTV(17, j0), m1 = PTV(17, j0 + 4);
                const float cu[8] = {blo(cz.x), bhi(cz.x), blo(cz.y), bhi(cz.y), blo(cz.z), bhi(cz.z), blo(cz.w), bhi(cz.w)}, pr[8] = {blo(pz.x), bhi(pz.x), blo(pz.y), bhi(pz.y), blo(pz.z), bhi(pz.z), blo(pz.w), bhi(pz.w)};
                const float mm[8] = {m0[0], m0[1], m0[2], m0[3], m1[0], m1[1], m1[2], m1[3]};
#pragma unroll
                for (int j = 0; j < 8; ++j) { const float xv = cu[j] + (pr[j] - cu[j]) * mm[j]; v8[j] = (ch < 8) ? tanh_fast(xv) : (ch < 16 ? xv : sigm(xv)); } }
            else { const v4u cz = (l > 0) ? *(const v4u*)(z + (size_t)t * ZLD + ZX + (j0 - 256)) : (v4u){0u, 0u, 0u, 0u};
                v8[0] = blo(cz.x); v8[1] = bhi(cz.x); v8[2] = blo(cz.y); v8[3] = bhi(cz.y); v8[4] = blo(cz.z); v8[5] = bhi(cz.z); v8[6] = blo(cz.w); v8[7] = bhi(cz.w); }
            *(LAS v4u*)(X + tk * XS_LD + j0) = (v4u){pk2(v8[0], v8[1]), pk2(v8[2], v8[3]), pk2(v8[4], v8[5]), pk2(v8[6], v8[7])}; }
        for (int idx = F.tid; idx < 16 * 64; idx += NTHR) {
            const int tk = idx >> 6, c = 8 * (idx & 63), t = t0 + tk, tt = t & (SEQ - 1);
            const f32x4 b0 = PTV(12, c), b1 = PTV(12, c + 4); float acc[8] = {b0[0], b0[1], b0[2], b0[3], b1[0], b1[1], b1[2], b1[3]};
#pragma unroll
            for (int j = 0; j < 4; ++j) { if (tt - 3 + j >= 0) { const v4u rz = *(const v4u*)(z + (size_t)(t - 3 + j) * ZLD + ZD + c); const f32x4 w0 = PTV(13 + j, c), w1 = PTV(13 + j, c + 4);
                acc[0] += blo(rz.x) * w0[0]; acc[1] += bhi(rz.x) * w0[1]; acc[2] += blo(rz.y) * w0[2]; acc[3] += bhi(rz.y) * w0[3]; acc[4] += blo(rz.z) * w1[0]; acc[5] += bhi(rz.z) * w1[1]; acc[6] += blo(rz.w) * w1[2]; acc[7] += bhi(rz.w) * w1[3]; } }
            *(LAS f32x4*)(XCf + tk * XCF_LD + c) = (f32x4){acc[0], acc[1], acc[2], acc[3]}; *(LAS f32x4*)(XCf + tk * XCF_LD + c + 4) = (f32x4){acc[4], acc[5], acc[6], acc[7]};
            *(LAS v4u*)(XCb + tk * XCB_LD + c) = (v4u){pk2(acc[0], acc[1]), pk2(acc[2], acc[3]), pk2(acc[4], acc[5]), pk2(acc[6], acc[7])}; }
        __syncthreads();
        {
            float ss = 0.f, bs = 0.f;
#pragma unroll
            for (int nt = 0; nt < 4; ++nt) { const int c = 64 * h + 16 * quad + 4 * nt; const v2u kc_ = kpre[nt], kp_ = kpre[4 + nt];
                const f32x4 mk = PTV(1, c), kkv = PTV(6, c); const f32x4 kc = (f32x4){blo(kc_.x), bhi(kc_.x), blo(kc_.y), bhi(kc_.y)}, kp = (f32x4){blo(kp_.x), bhi(kp_.x), blo(kp_.y), bhi(kp_.y)};
                const f32x4 kk = (kc + (kp - kc) * mk) * kkv; ss += (kk[0] * kk[0] + kk[1] * kk[1]) + (kk[2] * kk[2] + kk[3] * kk[3]); }
            ss += shx<16>(ss); ss += shx<32>(ss);
            const float inv = 1.0f / fmaxf(sqrtf(ss), 1e-12f);
            bf16x8 wf[9]; v2u zc[6]; v2u vfc = (v2u){0u, 0u};
#define PREP_LOAD(NT, WF, ZC, VFC) do { const bf16* wrow_ = wsm + (size_t)(64 * h + 16 * (tok >> 2) + 4 * (NT) + (tok & 3)) * 288 + 8 * quad; \
                _Pragma("unroll") for (int i_ = 0; i_ < 9; ++i_) WF[i_] = *(const bf16x8*)(wrow_ + 32 * i_); \
                const int c_ = 64 * h + 16 * quad + 4 * (NT); const bf16* zr_ = z + (size_t)t * ZLD + c_; const bf16* zp_ = first ? zr_ : zr_ - ZLD; \
                ZC[0] = *(const v2u*)(zr_); ZC[1] = *(const v2u*)(zr_ + 512); ZC[2] = *(const v2u*)(zr_ + 1024); ZC[3] = *(const v2u*)(zp_); ZC[4] = *(const v2u*)(zp_ + 512); ZC[5] = *(const v2u*)(zp_ + 1024); \
                if (l > 0) VFC = *(const v2u*)(VF + (size_t)t * 512 + c_); } while (0)
            v2u oR[4] = {}, oK[4] = {}, oV[4] = {}, oA[4] = {}, oB[4] = {}, oG[4] = {}; f32x4 oW[4] = {};
#define SEL4(O, val) do { _Pragma("unroll") for (int q_ = 0; q_ < 4; ++q_) O[q_] = (nt == q_) ? (val) : O[q_]; } while (0)
#pragma unroll 1
            for (int nt = 0; nt < 4; ++nt) {
                PREP_LOAD(nt, wf, zc, vfc);
                f32x4 aw = (f32x4){0.f, 0.f, 0.f, 0.f}, aa = aw, ag = aw, av = aw;
                bf16x8 xfr[9];
#pragma unroll
                for (int i_ = 0; i_ < 9; ++i_) xfr[i_] = *(const LAS bf16x8*)(X + tok * XS_LD + 8 * quad + 32 * i_);
                __builtin_amdgcn_sched_barrier(0);
#pragma unroll
                for (int ks = 0; ks < 2; ++ks) aw = mfma16(wf[ks], xfr[ks], aw);
#pragma unroll
                for (int ks = 0; ks < 2; ++ks) aa = mfma16(wf[2 + ks], xfr[2 + ks], aa);
#pragma unroll
                for (int ks = 0; ks < 4; ++ks) ag = mfma16(wf[4 + ks], xfr[4 + ks], ag);
                av = mfma16(wf[8], xfr[8], av);
                const int c = 64 * h + 16 * quad + 4 * nt;
                const v2u r_c = zc[0], k_c = zc[1], v_c = zc[2];
                v2u r_p = zc[3], k_p = zc[4], v_p = zc[5];
                if (first) { r_p = (v2u){0u, 0u}; k_p = r_p; v_p = r_p; }
                const f32x4 mr = PTV(0, c), mk = PTV(1, c), mv = PTV(2, c);
                const f32x4 rc = (f32x4){blo(r_c.x), bhi(r_c.x), blo(r_c.y), bhi(r_c.y)}, rp = (f32x4){blo(r_p.x), bhi(r_p.x), blo(r_p.y), bhi(r_p.y)};
                const f32x4 kc = (f32x4){blo(k_c.x), bhi(k_c.x), blo(k_c.y), bhi(k_c.y)}, kp = (f32x4){blo(k_p.x), bhi(k_p.x), blo(k_p.y), bhi(k_p.y)};
                const f32x4 vc = (f32x4){blo(v_c.x), bhi(v_c.x), blo(v_c.y), bhi(v_c.y)}, vp = (f32x4){blo(v_p.x), bhi(v_p.x), blo(v_p.y), bhi(v_p.y)};
                const f32x4 r = rc + (rp - rc) * mr, k = kc + (kp - kc) * mk; f32x4 v = vc + (vp - vc) * mv;
                const f32x4 w0v = PTV(3, c), a0v = PTV(4, c), kkv = PTV(6, c), kav = PTV(7, c), rkv = PTV(8, c);
                f32x4 aval, dc, kkn, k2v;
#pragma unroll
                for (int j = 0; j < 4; ++j) { dc[j] = -0.6065306597126334f * sigm(w0v[j] + aw[j]);     aval[j] = sigm(a0v[j] + aa[j]);
                    kkn[j] = k[j] * kkv[j] * inv; k2v[j] = k[j] * (1.0f + (aval[j] - 1.0f) * kav[j]); bs += r[j] * k2v[j] * rkv[j]; }
                const size_t o = (size_t)t * 512 + c;
                if (l > 0) { const f32x4 v0v = PTV(5, c); const f32x4 vf = (f32x4){blo(vfc.x), bhi(vfc.x), blo(vfc.y), bhi(vfc.y)};
#pragma unroll
                    for (int j = 0; j < 4; ++j) v[j] = v[j] + (vf[j] - v[j]) * sigm(v0v[j] + av[j]); }
#define PK4(val) ((v2u){pk2((val)[0], (val)[1]), pk2((val)[2], (val)[3])})
                { const v2u pr_ = PK4(r), pk_ = PK4(k2v), pv_ = PK4(v), pg_ = PK4(ag); SEL4(oR, pr_); SEL4(oW, dc); SEL4(oK, pk_); SEL4(oV, pv_); SEL4(oG, pg_); }
                { const f32x4 nkn = -kkn, kna = kkn * aval; const v2u pa_ = PK4(nkn), pb_ = PK4(kna); SEL4(oA, pa_); SEL4(oB, pb_); }
            }
#undef PREP_LOAD
            bs += shx<16>(bs); bs += shx<32>(bs);
            if (quad == 0) BON[(size_t)t * 8 + h] = bs;
            { const size_t o = (size_t)t * 512 + 64 * h + 16 * quad;
#define ST16H(arr, O) do { bf16* d_ = RWH + (size_t)(arr) * (RHSZ / 2) + o; *(v4u*)d_ = (v4u){O[0].x, O[0].y, O[1].x, O[1].y}; *(v4u*)(d_ + 8) = (v4u){O[2].x, O[2].y, O[3].x, O[3].y}; } while (0)
              ST16H(0, oR); ST16H(1, oK); ST16H(2, oV); ST16H(3, oA); ST16H(4, oB); ST16H(5, oG);
#pragma unroll
              for (int nt = 0; nt < 4; ++nt) *(f32x4*)(LW + o + 4 * nt) = oW[nt];
              if (l == 0) { bf16* d_ = VF + o; *(v4u*)d_ = (v4u){oV[0].x, oV[0].y, oV[1].x, oV[1].y}; *(v4u*)(d_ + 8) = (v4u){oV[2].x, oV[2].y, oV[3].x, oV[3].y}; } }
#undef ST16H
#undef PK4
#undef SEL4
        }
        {
            bf16x8 lf[4], ln[4];
#define LRU_LOAD(NT, LF) do { const bf16* wxr_ = wlru + ((size_t)h * 64 + 16 * (NT) + tok) * 64 + 8 * quad; LF[0] = *(const bf16x8*)(wxr_); LF[1] = *(const bf16x8*)(wxr_ + 32); LF[2] = *(const bf16x8*)(wxr_ + 8 * 64 * 64); LF[3] = *(const bf16x8*)(wxr_ + 8 * 64 * 64 + 32); } while (0)
            LRU_LOAD(0, lf);
#pragma unroll 1
            for (int nt = 0; nt < 4; ++nt) { f32x4 gx = (f32x4){0.f, 0.f, 0.f, 0.f}, ga = gx;
                if (nt < 3) LRU_LOAD(nt + 1, ln);
                const LAS bf16* xrow = XCb + tok * XCB_LD + 64 * h + 8 * quad;
#pragma unroll
                for (int ks = 0; ks < 2; ++ks) { const bf16x8 xf = *(const LAS bf16x8*)(xrow + 32 * ks); gx = mfma16(lf[ks], xf, gx); ga = mfma16(lf[2 + ks], xf, ga); }
                const int c = 64 * h + 16 * nt + 4 * quad;
                const f32x4 bxv = PTV(9, c), bav = PTV(10, c), lmv = PTV(11, c);
                const f32x4 xc = *(const LAS f32x4*)(XCf + tok * XCF_LD + c);
                f32x4 oa, ob;
#pragma unroll
                for (int j = 0; j < 4; ++j) { const float gxs = sigm(gx[j] + bxv[j]), gas = sigm(ga[j] + bav[j]); const float la = gas * lmv[j];
                    oa[j] = __expf(la); const float mult = first ? 1.0f : sqrtf(1.0f - __expf(2.0f * la)); ob[j] = mult * gxs * xc[j]; }
                *(f32x4*)(LA + (size_t)t * 512 + c) = oa; *(v2u*)(LB + (size_t)t * 512 + c) = (v2u){pk2(ob[0], ob[1]), pk2(ob[2], ob[3])};
#pragma unroll
                for (int i_ = 0; i_ < 4; ++i_) lf[i_] = ln[i_]; }
#undef LRU_LOAD
        }
        __syncthreads();
    }
#undef PTV
}

DI void scan_rwkv_item(Frame& F, int item) {
    constexpr int T = 32, BUF = 5 * T * 64 + T * 32;
    LAS float* stg = (LAS float*)F.lds;
    LAS float* yout = (LAS float*)(F.lds + 2 * BUF * 4);
    const int half = item & 1, h = (item >> 1) & 7, b = item >> 4;
    const float* RWb = (const float*)(F.ws + WS_RW); float* YA = (float*)(F.ws + WS_YA);
    const int rl = F.tid >> 4, kq = F.tid & 15;
    const size_t tb0 = (size_t)b * SEQ;
    f32x4 pre[6];
    auto issue = [&](int blk) {
#pragma unroll
        for (int i = 0; i < 6; ++i) { const int idx = F.tid + i * NTHR; if (idx < BUF / 4) {
            const float* src;
            if (idx < 2560) { const int arr = idx >> 9, rem = idx & 511, st = rem >> 4, c4 = rem & 15; const int ga = (arr == 3) ? 4 : (arr == 4 ? 5 : arr);
                src = RWb + (size_t)ga * (RWSZ / 4) + (tb0 + blk * T + st) * 512 + 64 * h + 4 * c4; }
            else { const int rem = idx - 2560, st = rem >> 3, c4 = rem & 7; src = RWb + (size_t)3 * (RWSZ / 4) + (tb0 + blk * T + st) * 512 + 64 * h + 32 * half + 4 * c4; }
            pre[i] = *(const f32x4*)src; } }
    };
    auto commit = [&](int buf) {
#pragma unroll
        for (int i = 0; i < 6; ++i) { const int idx = F.tid + i * NTHR; if (idx < BUF / 4) *(LAS f32x4*)(stg + buf * BUF + idx * 4) = pre[i]; }
    };
    issue(0); commit(0); __syncthreads();
    f32x4 S = (f32x4){0.f, 0.f, 0.f, 0.f};
    for (int blk = 0; blk < SEQ / T; ++blk) {
        const int buf = blk & 1;
        if (blk + 1 < SEQ / T) issue(blk + 1);
        const LAS float* sb = stg + buf * BUF;
#pragma unroll 4
        for (int s = 0; s < T; ++s) {
            const f32x4 r4 = *(const LAS f32x4*)(sb + 0 * T * 64 + s * 64 + 4 * kq), w4 = *(const LAS f32x4*)(sb + 1 * T * 64 + s * 64 + 4 * kq), k4 = *(const LAS f32x4*)(sb + 2 * T * 64 + s * 64 + 4 * kq);
            const f32x4 a4 = *(const LAS f32x4*)(sb + 3 * T * 64 + s * 64 + 4 * kq), b4 = *(const LAS f32x4*)(sb + 4 * T * 64 + s * 64 + 4 * kq);
            const float v = sb[5 * T * 64 + s * 32 + rl];
            const float sa = row16_sum((S[0] * a4[0] + S[1] * a4[1]) + (S[2] * a4[2] + S[3] * a4[3]));
            S = S * w4 + b4 * sa + k4 * v;
            const float y = row16_sum((S[0] * r4[0] + S[1] * r4[1]) + (S[2] * r4[2] + S[3] * r4[3]));
            if (kq == 0) yout[s * 32 + rl] = y;
        }
        __syncthreads();
        for (int i = F.tid; i < T * 32; i += NTHR) { const int st = i >> 5, r = i & 31; YA[(tb0 + blk * T + st) * 512 + 64 * h + 32 * half + r] = yout[i]; }
        if (blk + 1 < SEQ / T) commit(buf ^ 1);
        __syncthreads();
    }
}
DI void scan_hgrn_item(Frame& F, KA a, int l, int item) {
    constexpr int T = 32;
    LAS float* Fd = (LAS float*)F.lds; LAS float* Kk = Fd + T * 128; LAS float* Qs = Kk + T * 128; LAS float* Is = Qs + T * 128; LAS float* Oo = Is + T * 16; LAS float* lbs = Oo + T * 16;
    const int vs = item & 7, h = (item >> 3) & 3, b = item >> 5;
    const bf16* z = (const bf16*)(F.ws + WS_Z); float* OB = (float*)(F.ws + WS_OB);
    const size_t tb0 = (size_t)b * SEQ;
    if (F.tid < 128) { const int c = 128 * h + F.tid; const float* hb = a->in[17];
        const float x0 = hb[c], x1 = hb[512 + c], x2 = hb[1024 + c], x3 = hb[1536 + c]; const float mx = fmaxf(fmaxf(x0, x1), fmaxf(x2, x3));
        const float e0 = __expf(x0 - mx), e1 = __expf(x1 - mx), e2 = __expf(x2 - mx), e3 = __expf(x3 - mx); const float inv = 1.0f / (e0 + e1 + e2 + e3);
        lbs[F.tid] = (l == 0) ? 0.0f : (l == 1 ? e1 * inv : (l == 2 ? (e1 + e2) * inv : (e1 + e2 + e3) * inv)); }
    v4u pre[3];
    auto issue = [&](int blk) {
#pragma unroll
        for (int i = 0; i < 3; ++i) { const int idx = F.tid + i * NTHR; if (idx < 1088) { const bf16* src;
            if (idx < 1024) { const int arr = idx >> 9, rem = idx & 511, st = rem >> 4, ch = rem & 15; src = z + (tb0 + blk * T + st) * ZLD + ZB + arr * 512 + 128 * h + 8 * ch; }
            else { const int rem = idx - 1024, st = rem >> 1, ch = rem & 1; src = z + (tb0 + blk * T + st) * ZLD + ZB + 1024 + 128 * h + 16 * vs + 8 * ch; }
            pre[i] = *(const v4u*)src; } }
    };
    auto commit = [&]() {
#pragma unroll
        for (int i = 0; i < 3; ++i) { const int idx = F.tid + i * NTHR; if (idx < 1088) { float v[8]; v[0] = blo(pre[i].x); v[1] = bhi(pre[i].x); v[2] = blo(pre[i].y); v[3] = bhi(pre[i].y); v[4] = blo(pre[i].z); v[5] = bhi(pre[i].z); v[6] = blo(pre[i].w); v[7] = bhi(pre[i].w);
            if (idx < 512) { const int st = idx >> 4, ch = idx & 15;
#pragma unroll
                for (int j = 0; j < 8; ++j) Qs[st * 128 + 8 * ch + j] = siluf(v[j]); }
            else if (idx < 1024) { const int rem = idx & 511, st = rem >> 4, ch = rem & 15;
#pragma unroll
                for (int j = 0; j < 8; ++j) { const float lb = lbs[8 * ch + j], sg = sigm(v[j]); Fd[st * 128 + 8 * ch + j] = lb + (1.0f - lb) * sg; Kk[st * 128 + 8 * ch + j] = (1.0f - lb) * (1.0f - sg); } }
            else { const int rem = idx - 1024, st = rem >> 1, ch = rem & 1;
#pragma unroll
                for (int j = 0; j < 8; ++j) Is[st * 16 + 8 * ch + j] = v[j]; } } }
    };
    __syncthreads();
    issue(0); commit(); __syncthreads();
    const int vl = 2 * F.wave + (F.lane >> 5), kg = F.lane & 31;
    f32x4 S = (f32x4){0.f, 0.f, 0.f, 0.f};
    for (int blk = 0; blk < SEQ / T; ++blk) {
        if (blk + 1 < SEQ / T) issue(blk + 1);
#pragma unroll 4
        for (int s = 0; s < T; ++s) {
            const f32x4 f4 = *(const LAS f32x4*)(Fd + s * 128 + 4 * kg), k4 = *(const LAS f32x4*)(Kk + s * 128 + 4 * kg), q4 = *(const LAS f32x4*)(Qs + s * 128 + 4 * kg);
            const float iv = Is[s * 16 + vl];
            S = S * f4 + k4 * iv;
            float o = row16_sum((S[0] * q4[0] + S[1] * q4[1]) + (S[2] * q4[2] + S[3] * q4[3]));
            o += shx<16>(o);
            if (kg == 0) Oo[s * 16 + vl] = o;
        }
        __syncthreads();
        { const int st = F.tid >> 4, r = F.tid & 15; OB[(tb0 + blk * T + st) * 512 + 128 * h + 16 * vs + r] = Oo[F.tid]; }
        if (blk + 1 < SEQ / T) commit();
        __syncthreads();
    }
}
DI void scan_mlstm_item(Frame& F, KA a, int l, int item) {
    constexpr int T = 32;
    LAS float* Qs = (LAS float*)F.lds; LAS float* Ks = Qs + T * 128; LAS float* Vs = Ks + T * 128; LAS float* Ho = Vs + T * 16;
    LAS float* FD = Ho + T * 16; LAS float* IW = FD + T; LAS float* EM = IW + T; LAS float* IG = EM + T; LAS float* FG = IG + T; LAS float* mst = FG + T;
    LAS float* raw = mst + 32;
    const int vs = item & 7, h = (item >> 3) & 3, b = item >> 5;
    const bf16* z = (const bf16*)(F.ws + WS_Z); float* HC = (float*)(F.ws + WS_HC);
    const float* cw = a->in[19] + l * 4 * 1024; const float* cb = a->in[20] + l * 1024; const float ib = a->in[21][l * 4 + h], fb = a->in[22][l * 4 + h];
    const size_t tb0 = (size_t)b * SEQ;
    v4u pre[3]; v4u prev_; float pig = 0.f, pfg = 0.f;
    auto issue = [&](int blk) {
#pragma unroll
        for (int i = 0; i < 3; ++i) { const int idx = F.tid + i * NTHR; if (idx < 1120) { const int row = idx >> 5, rem = idx & 31, arr = rem >> 4, ch = rem & 15; const int tt = blk * T - 3 + row;
            pre[i] = (tt >= 0) ? *(const v4u*)(z + (tb0 + tt) * ZLD + ZC + arr * 512 + 128 * h + 8 * ch) : (v4u){0u, 0u, 0u, 0u}; } }
        if (F.tid < 64) { const int st = F.tid >> 1, ch = F.tid & 1; prev_ = *(const v4u*)(z + (tb0 + blk * T + st) * ZLD + ZC + 1024 + 128 * h + 16 * vs + 8 * ch); }
        if (F.tid >= 64 && F.tid < 96) { const int st = F.tid - 64; const bf16* zr = z + (tb0 + blk * T + st) * ZLD + ZC + 2048; pig = bf2f(zr[h]); pfg = bf2f(zr[4 + h]); }
    };
    auto commit = [&]() {
#pragma unroll
        for (int i = 0; i < 3; ++i) { const int idx = F.tid + i * NTHR; if (idx < 1120) { const int row = idx >> 5, rem = idx & 31;
            LAS float* d = raw + row * 256 + 8 * rem; d[0] = blo(pre[i].x); d[1] = bhi(pre[i].x); d[2] = blo(pre[i].y); d[3] = bhi(pre[i].y); d[4] = blo(pre[i].z); d[5] = bhi(pre[i].z); d[6] = blo(pre[i].w); d[7] = bhi(pre[i].w); } }
        if (F.tid < 64) { const int st = F.tid >> 1, ch = F.tid & 1; LAS float* d = Vs + st * 16 + 8 * ch; d[0] = blo(prev_.x); d[1] = bhi(prev_.x); d[2] = blo(prev_.y); d[3] = bhi(prev_.y); d[4] = blo(prev_.z); d[5] = bhi(prev_.z); d[6] = blo(prev_.w); d[7] = bhi(prev_.w); }
        if (F.tid >= 64 && F.tid < 96) { IG[F.tid - 64] = pig + ib; FG[F.tid - 64] = logsigm(pfg + fb); }
        __syncthreads();
        for (int idx = F.tid; idx < T * 256; idx += NTHR) { const int st = idx >> 8, cc = idx & 255, arr = cc >> 7, k = cc & 127; const int wc_ = arr * 512 + 128 * h + k;
            float acc = cb[wc_];
#pragma unroll
            for (int j = 0; j < 4; ++j) acc += raw[(st + j) * 256 + cc] * cw[j * 1024 + wc_];
            acc = siluf(acc);
            if (arr == 0) Qs[st * 128 + k] = acc; else Ks[st * 128 + k] = acc * 0.08838834764831845f; }
        if (F.tid == 0) { float m = mst[0];
            for (int s = 0; s < T; ++s) { const float lf = FG[s], ip = IG[s]; const float mn = fmaxf(lf + m, ip); FD[s] = __expf(lf + m - mn); IW[s] = __expf(ip - mn); EM[s] = __expf(-mn); m = mn; }
            mst[0] = m; }
    };
    if (F.tid == 0) mst[0] = -1e30f;
    __syncthreads();
    issue(0); commit(); __syncthreads();
    const int vl = 2 * F.wave + (F.lane >> 5), kg = F.lane & 31;
    f32x4 C = (f32x4){0.f, 0.f, 0.f, 0.f}, n = C;
    for (int blk = 0; blk < SEQ / T; ++blk) {
        if (blk + 1 < SEQ / T) issue(blk + 1);
#pragma unroll 4
        for (int s = 0; s < T; ++s) {
            const f32x4 k4 = *(const LAS f32x4*)(Ks + s * 128 + 4 * kg), q4 = *(const LAS f32x4*)(Qs + s * 128 + 4 * kg);
            const float fd = FD[s], iw = IW[s], vv = Vs[s * 16 + vl];
            C = C * fd + k4 * (iw * vv); n = n * fd + k4 * iw;
            float num = row16_sum((C[0] * q4[0] + C[1] * q4[1]) + (C[2] * q4[2] + C[3] * q4[3]));
            float den = row16_sum((n[0] * q4[0] + n[1] * q4[1]) + (n[2] * q4[2] + n[3] * q4[3]));
            num += shx<16>(num); den += shx<16>(den);
            if (kg == 0) Ho[s * 16 + vl] = num / fmaxf(fabsf(den), EM[s]);
        }
        __syncthreads();
        { const int st = F.tid >> 4, r = F.tid & 15; HC[(tb0 + blk * T + st) * 512 + 128 * h + 16 * vs + r] = Ho[F.tid]; }
        if (blk + 1 < SEQ / T) commit();
        __syncthreads();
    }
}
DI void scan_lru_item(Frame& F, int item) {
    LAS float* SA = (LAS float*)F.lds; LAS float* SB = SA + 512;
    const int cg = item & 31, b = item >> 5, ch = F.tid & 15, seg = F.tid >> 4, c = 16 * cg + ch;
    const float* LA = (const float*)(F.ws + WS_LA); const float* LB = (const float*)(F.ws + WS_LB); const bf16* z = (const bf16*)(F.ws + WS_Z);
    bf16* Y3 = (bf16*)(F.ws + WS_Y) + (size_t)3 * M * 512;
    const size_t t0 = (size_t)b * SEQ + seg * 64;
    float A = 1.0f, Bv = 0.0f;
    for (int s = 0; s < 64; ++s) { const float av = LA[(t0 + s) * 512 + c], bv = LB[(t0 + s) * 512 + c]; A *= av; Bv = av * Bv + bv; }
    SA[seg * 16 + ch] = A; SB[seg * 16 + ch] = Bv;
    __syncthreads();
    float hh = 0.0f;
    for (int s2 = 0; s2 < seg; ++s2) hh = SA[s2 * 16 + ch] * hh + SB[s2 * 16 + ch];
    for (int s = 0; s < 64; ++s) { const float av = LA[(t0 + s) * 512 + c], bv = LB[(t0 + s) * 512 + c]; hh = av * hh + bv;
        const float g = bf2f(z[(t0 + s) * ZLD + ZD + 512 + c]); Y3[(t0 + s) * 512 + c] = (bf16)f2bf(hh * gelu_tanh(g)); }
    __syncthreads();
}
DI bf16x8 pack8(f32x4 lo, f32x4 hi) { v4u w; w.x = pk2(lo[0], lo[1]); w.y = pk2(lo[2], lo[3]); w.z = pk2(hi[0], hi[1]); w.w = pk2(hi[2], hi[3]); return __builtin_bit_cast(bf16x8, w); }
DI bf16x8 ld_perm(const LAS bf16* row, int kbase, int quad) {
    const v2u a = *(const LAS v2u*)(row + kbase + 4 * quad), b = *(const LAS v2u*)(row + kbase + 16 + 4 * quad); v4u w; w.x = a.x; w.y = a.y; w.z = b.x; w.w = b.y; return __builtin_bit_cast(bf16x8, w); }
constexpr int CQ_LD = 136, CT_LD = 40;
constexpr int FH_STRIDE = 34 * 1024 + 512;
DI void st_frag(unsigned char* base, int f, int lane, bf16x8 v) { *(bf16x8*)(base + f * 1024 + lane * 16) = v; }
DI bf16x8 ld_vperm(const unsigned char* natfrag, int fr, int quad) { const unsigned char* p = natfrag + (fr + 16 * (quad >> 1)) * 16 + 8 * (quad & 1);
    const v2u a = *(const v2u*)p, b = *(const v2u*)(p + 512); return __builtin_bit_cast(bf16x8, (v4u){a.x, a.y, b.x, b.y}); }
DI void hgrn_raw_load(Frame& F, int prob, v4u& pq, v4u& pf, v4u& pi) {
    const int bh = prob >> 6, c = prob & 63, h = bh & 3, b = bh >> 2; const bf16* z = (const bf16*)(F.ws + WS_Z);
    const bf16* src = z + ((size_t)b * SEQ + c * 32 + (F.tid >> 4)) * ZLD + ZB + 128 * h + 8 * (F.tid & 15); pq = *(const v4u*)src; pf = *(const v4u*)(src + 512); pi = *(const v4u*)(src + 1024);
}
DI void hgrn_lower_bounds(Frame& F, KA a, int l) {
    constexpr int C = 32;
    LAS float* lbs = (LAS float*)((LAS bf16*)F.lds + 2 * C * CQ_LD + 2 * 128 * CT_LD) + C * 128 + 4 * 128;
    { const int cc = F.tid; const float* hb = a->in[17];
      const float x0 = hb[cc], x1 = hb[512 + cc], x2 = hb[1024 + cc], x3 = hb[1536 + cc]; const float mx = fmaxf(fmaxf(x0, x1), fmaxf(x2, x3));
      const float e0 = __expf(x0 - mx), e1 = __expf(x1 - mx), e2 = __expf(x2 - mx), e3 = __expf(x3 - mx); const float inv = 1.0f / (e0 + e1 + e2 + e3);
      lbs[cc] = (l == 0) ? 0.0f : (l == 1 ? e1 * inv : (l == 2 ? (e1 + e2) * inv : (e1 + e2 + e3) * inv)); }
    __syncthreads();
}
DI void prep_hgrn_item(Frame& F, KA a, int l, int prob, int nprob, v4u& pq, v4u& pf, v4u& pi) {
    constexpr int C = 32;
    LAS bf16* Qt = (LAS bf16*)F.lds; LAS bf16* Kt = Qt + C * CQ_LD; LAS bf16* KhT = Kt + C * CQ_LD; LAS bf16* VT = KhT + 128 * CT_LD;
    LAS float* bc = (LAS float*)(VT + 128 * CT_LD); LAS float* PS = bc + C * 128; LAS float* lbs = PS + 4 * 128;
    const int bh = prob >> 6, c = prob & 63, h = bh & 3, b = bh >> 2, w = F.wave, lane = F.lane, fr = lane & 15, quad = lane >> 4;
    const bf16* z = (const bf16*)(F.ws + WS_Z);
    unsigned char* fo = F.ws + WS_FRH + (size_t)prob * FH_STRIDE;
    const size_t row0 = (size_t)b * SEQ + c * C;
    const int tr = F.tid >> 4, k0 = 8 * (F.tid & 15);
    float qv[8], kv[8];
    { const float fr_[8] = {blo(pf.x), bhi(pf.x), blo(pf.y), bhi(pf.y), blo(pf.z), bhi(pf.z), blo(pf.w), bhi(pf.w)};
      const float qr[8] = {blo(pq.x), bhi(pq.x), blo(pq.y), bhi(pq.y), blo(pq.z), bhi(pq.z), blo(pq.w), bhi(pq.w)};
      float lf[8];
#pragma unroll
      for (int j = 0; j < 8; ++j) { const float lb = lbs[128 * h + k0 + j], sg = sigm(fr_[j]); const float f = lb + (1.0f - lb) * sg; lf[j] = __logf(fmaxf(f, 1e-37f)); kv[j] = (1.0f - lb) * (1.0f - sg); qv[j] = siluf(qr[j]); }
      *(LAS f32x4*)(bc + tr * 128 + k0) = (f32x4){lf[0], lf[1], lf[2], lf[3]}; *(LAS f32x4*)(bc + tr * 128 + k0 + 4) = (f32x4){lf[4], lf[5], lf[6], lf[7]};
      const unsigned iv[4] = {pi.x, pi.y, pi.z, pi.w};
#pragma unroll
      for (int j = 0; j < 4; ++j) { VT[(k0 + 2 * j) * CT_LD + tr] = (bf16)(iv[j] & 0xffffu); VT[(k0 + 2 * j + 1) * CT_LD + tr] = (bf16)(iv[j] >> 16); } }
    if (nprob >= 0) hgrn_raw_load(F, nprob, pq, pf, pi);
    __syncthreads();
    { const int k = F.tid & 127, part = F.tid >> 7; float v8[8], run = 0.f;
#pragma unroll
      for (int j = 0; j < 8; ++j) v8[j] = bc[(8 * part + j) * 128 + k];
#pragma unroll
      for (int j = 0; j < 8; ++j) { run += v8[j]; bc[(8 * part + j) * 128 + k] = run; }
      PS[part * 128 + k] = run; }
    __syncthreads();
    { float q8[8], k8[8]; const int part = tr >> 3;
#pragma unroll
      for (int j = 0; j < 8; ++j) { const int k = k0 + j; const float p0 = PS[k], p1 = PS[128 + k], p2 = PS[256 + k], p3 = PS[384 + k];
          const float off = (part > 0 ? p0 : 0.f) + (part > 1 ? p1 : 0.f) + (part > 2 ? p2 : 0.f); const float blast = (p0 + p1) + (p2 + p3);
          const float bcu = bc[tr * 128 + k] + off; q8[j] = qv[j] * __expf(bcu); k8[j] = kv[j] * __expf(-bcu);
          KhT[k * CT_LD + tr] = (bf16)f2bf(kv[j] * __expf(blast - bcu));
          if (tr == 0) ((float*)(fo + 34 * 1024))[k] = __expf(blast); }
      *(LAS v4u*)(Qt + tr * CQ_LD + k0) = (v4u){pk2(q8[0], q8[1]), pk2(q8[2], q8[3]), pk2(q8[4], q8[5]), pk2(q8[6], q8[7])};
      *(LAS v4u*)(Kt + tr * CQ_LD + k0) = (v4u){pk2(k8[0], k8[1]), pk2(k8[2], k8[3]), pk2(k8[4], k8[5]), pk2(k8[6], k8[7])}; }
    __syncthreads();
    st_frag(fo, w, lane, ld_perm(Qt + (16 * (w >> 2) + fr) * CQ_LD, 32 * (w & 3), quad));
    st_frag(fo, 8 + w, lane, *(const LAS bf16x8*)(KhT + (16 * w + fr) * CT_LD + 8 * quad));
    st_frag(fo, 19 + 2 * w, lane, *(const LAS bf16x8*)(VT + (16 * w + fr) * CT_LD + 8 * quad));
    if (w < 2) {
        const f32x4 zero4 = fresh_zero4(); f32x4 pa = zero4, pb = zero4;
#pragma unroll
        for (int ks = 0; ks < 4; ++ks) { const bf16x8 qb = *(const LAS bf16x8*)(Qt + (16 * w + fr) * CQ_LD + 32 * ks + 8 * quad);
            pa = mfma16(*(const LAS bf16x8*)(Kt + fr * CQ_LD + 32 * ks + 8 * quad), qb, pa);
            if (w == 1) pb = mfma16(*(const LAS bf16x8*)(Kt + (16 + fr) * CQ_LD + 32 * ks + 8 * quad), qb, pb); }
#pragma unroll
        for (int j = 0; j < 4; ++j) { if (4 * quad + j > fr) { if (w == 0) pa[j] = 0.f; else pb[j] = 0.f; } }
        st_frag(fo, 16 + w, lane, pack8(pa, pb));
    }
    __syncthreads();
}
template <int NF, int NW, int SB> struct ChainStage {
    static constexpr int MAXF = (NF + NW - 1) / NW, SLOT = NF * 1024 + 512;
    bf16x8 r[MAXF]; f32x4 sc;
    DI void load(const unsigned char* p, int wsub, int lane) {
#pragma unroll
        for (int i = 0; i < MAXF; ++i) { const int f = wsub + NW * i; if (f < NF) r[i] = *(const bf16x8*)(p + f * 1024 + lane * 16); }
        if (wsub == NW - 1 && lane < SB / 16) sc = *(const f32x4*)(p + NF * 1024 + lane * 16);
    }
    DI void store(LAS unsigned char* slot, int wsub, int lane) const {
#pragma unroll
        for (int i = 0; i < MAXF; ++i) { const int f = wsub + NW * i; if (f < NF) *(LAS bf16x8*)(slot + f * 1024 + lane * 16) = r[i]; }
        if (wsub == NW - 1 && lane < SB / 16) *(LAS f32x4*)(slot + NF * 1024 + lane * 16) = sc;
    }
};
#define LQ(slot, f) (*(const LAS bf16x8*)((slot) + (f) * 1024 + lane * 16))
DI void chain_hgrn(Frame& F, int item) {
    typedef ChainStage<18, 8, 512> St;
    const int bh = item, h = bh & 3, b = bh >> 2, w = F.wave, lane = F.lane, fr = lane & 15, quad = lane >> 4;
    const bool act = true; const int vs = w;
    const unsigned char* fb = F.ws + WS_FRH + (size_t)bh * 64 * FH_STRIDE;
    bf16* OB = (bf16*)(F.ws + WS_OB);
    LAS unsigned char* L = F.lds;
    f32x4 S[8];
#pragma unroll
    for (int i = 0; i < 8; ++i) S[i] = (f32x4){0.f, 0.f, 0.f, 0.f};
    St sa, sb, sc;
    auto ld = [&](St& s, int c) { const unsigned char* p = fb + (size_t)c * FH_STRIDE;
#pragma unroll
        for (int i = 0; i < St::MAXF; ++i) { const int f = w + 8 * i; if (f < 18) s.r[i] = *(const bf16x8*)(p + f * 1024 + lane * 16); }
        if (w == 7 && lane < 32) s.sc = *(const f32x4*)(p + 34 * 1024 + lane * 16); };
    ld(sa, 0); sa.store(L, w, lane); ld(sa, 1); ld(sb, 2);
    bf16x8 vp = ld_vperm(fb + (19 + 2 * vs) * 1024, fr, quad), vn = *(const bf16x8*)(fb + (19 + 2 * vs) * 1024 + lane * 16);
    bf16x8 vp1 = ld_vperm(fb + FH_STRIDE + (19 + 2 * vs) * 1024, fr, quad), vn1 = *(const bf16x8*)(fb + FH_STRIDE + (19 + 2 * vs) * 1024 + lane * 16);
    __syncthreads();
    const f32x4 zero4 = fresh_zero4();
#pragma unroll 1
    for (int c = 0; c < 64; ++c) {
        ld(sc, c + 3 < 64 ? c + 3 : 63);
        const unsigned char* pn = fb + (size_t)(c + 2 < 64 ? c + 2 : 63) * FH_STRIDE;
        const LAS unsigned char* sl = L + (c & 1) * St::SLOT;
        if (act) {
        bf16x8 q[18]; f32x4 gl[8];
#pragma unroll
        for (int i = 0; i < 18; ++i) q[i] = LQ(sl, i);
#pragma unroll
        for (int kk = 0; kk < 8; ++kk) gl[kk] = *(const LAS f32x4*)(sl + 18 * 1024 + (16 * kk + 4 * quad) * 4);
        __builtin_amdgcn_sched_barrier(0);
        f32x4 o0 = mfma16(q[16], vp, zero4), o1 = mfma16(q[17], vp, zero4); vp = vp1; vp1 = ld_vperm(pn + (19 + 2 * vs) * 1024, fr, quad);
#pragma unroll
        for (int kt = 0; kt < 4; ++kt) { const bf16x8 sf = pack8(S[2 * kt], S[2 * kt + 1]); o0 = mfma16(q[kt], sf, o0); o1 = mfma16(q[4 + kt], sf, o1); }
#pragma unroll
        for (int kk = 0; kk < 8; ++kk) S[kk] = mfma16(q[8 + kk], vn, S[kk] * gl[kk]);
        vn = vn1; vn1 = *(const bf16x8*)(pn + (19 + 2 * vs) * 1024 + lane * 16);
        bf16* ob = OB + ((size_t)b * SEQ + c * 32) * 512 + 128 * h + 16 * vs; const unsigned lo = 4u * quad * 512u + fr;
#pragma unroll
        for (int j = 0; j < 4; ++j) { ob[lo + j * 512] = (bf16)f2bf(o0[j]); ob[lo + (16 + j) * 512] = (bf16)f2bf(o1[j]); }
        }
        sa.store(L + ((c + 1) & 1) * St::SLOT, w, lane);
        __syncthreads();
        sa = sb; sb = sc;
    }
}
template <int CTRL, int RM> DI float dpp_rm(float old, float v) { return __builtin_bit_cast(float, __builtin_amdgcn_update_dpp(__builtin_bit_cast(int, old), __builtin_bit_cast(int, v), CTRL, RM, 0xf, false)); }
DI float scan32_add(float v) {
    v += dpp_rm<0x111, 0xf>(0.f, v); v += dpp_rm<0x112, 0xf>(0.f, v); v += dpp_rm<0x114, 0xf>(0.f, v); v += dpp_rm<0x118, 0xf>(0.f, v); v += dpp_rm<0x142, 0xa>(0.f, v); return v; }
DI float scan32_max(float v) {
    const float ninf = -3.0e38f;
    v = fmaxf(v, dpp_rm<0x111, 0xf>(ninf, v)); v = fmaxf(v, dpp_rm<0x112, 0xf>(ninf, v)); v = fmaxf(v, dpp_rm<0x114, 0xf>(ninf, v)); v = fmaxf(v, dpp_rm<0x118, 0xf>(ninf, v)); v = fmaxf(v, dpp_rm<0x142, 0xa>(ninf, v)); return v; }
struct MRaw { v4u r[3], v; float ig, fg; };
DI void mlstm_raw_load(Frame& F, int prob, MRaw& R) {
    const int bh = prob >> 6, c = prob & 63, h = bh & 3, b = bh >> 2; const bf16* z = (const bf16*)(F.ws + WS_Z);
#pragma unroll
    for (int i = 0; i < 3; ++i) { const int idx = F.tid + i * NTHR; if (idx < 1120) { const int row = idx >> 5, pc = idx & 31; const int tt = c * 32 - 3 + row;
        R.r[i] = (tt >= 0) ? *(const v4u*)(z + ((size_t)b * SEQ + tt) * ZLD + ZC + (pc >> 4) * 512 + 128 * h + 8 * (pc & 15)) : (v4u){0u, 0u, 0u, 0u}; } }
    R.v = *(const v4u*)(z + ((size_t)b * SEQ + c * 32 + (F.tid >> 4)) * ZLD + ZC + 1024 + 128 * h + 8 * (F.tid & 15));
    if (F.wave == 0) { const bf16* zr = z + ((size_t)b * SEQ + c * 32 + (F.lane & 31)) * ZLD + ZC + 2048; R.ig = bf2f(zr[h]); R.fg = bf2f(zr[4 + h]); }
}
DI void prep_mlstm_item(Frame& F, KA a, int l, int prob, int nprob, MRaw& R) {
    constexpr int C = 32;
    LAS bf16* Qs = (LAS bf16*)F.lds; LAS bf16* Ks = Qs + C * CQ_LD; LAS bf16* KhT = Ks + C * CQ_LD; LAS bf16* VT = KhT + 128 * CT_LD;
    LAS float* raw = (LAS float*)(VT + 128 * CT_LD);
    LAS float* WT = raw + 35 * 256;
    LAS float* sc = WT + 32 * 32;
    const int bh = prob >> 6, c = prob & 63, h = bh & 3, b = bh >> 2, w = F.wave, lane = F.lane, fr = lane & 15, quad = lane >> 4;
    const bf16* z = (const bf16*)(F.ws + WS_Z);
    unsigned char* fo = F.ws + WS_FRM + (size_t)prob * FH_STRIDE; float* fsc = (float*)(fo + 34 * 1024);
    const float* cw = a->in[19] + l * 4 * 1024; const float* cb = a->in[20] + l * 1024; const float ib = a->in[21][l * 4 + h], fb = a->in[22][l * 4 + h];
    const size_t row0 = (size_t)b * SEQ + c * C;
    const int tr = F.tid >> 4, k0 = 8 * (F.tid & 15);
    const int wc_ = ((F.tid & 255) >> 7) * 512 + 128 * h + (F.tid & 127);
    const float cw0_ = cw[wc_], cw1_ = cw[1024 + wc_], cw2_ = cw[2048 + wc_], cw3_ = cw[3072 + wc_], cbb_ = cb[wc_];
#pragma unroll
    for (int i = 0; i < 3; ++i) { const int idx = F.tid + i * NTHR; if (idx < 1120) { const int row = idx >> 5, pc = idx & 31;
        const v4u r = R.r[i];
        LAS float* d = raw + row * 256 + 8 * pc; *(LAS f32x4*)d = (f32x4){blo(r.x), bhi(r.x), blo(r.y), bhi(r.y)}; *(LAS f32x4*)(d + 4) = (f32x4){blo(r.z), bhi(r.z), blo(r.w), bhi(r.w)}; } }
    { const v4u pv = R.v; const unsigned iv[4] = {pv.x, pv.y, pv.z, pv.w};
#pragma unroll
      for (int j = 0; j < 4; ++j) { VT[(k0 + 2 * j) * CT_LD + tr] = (bf16)(iv[j] & 0xffffu); VT[(k0 + 2 * j + 1) * CT_LD + tr] = (bf16)(iv[j] >> 16); } }
    if (w == 0) {
        const int t = lane & 31;
        const float lf = logsigm(R.fg + fb), ip = R.ig + ib;
        const float fc = scan32_add(lf), g = ip - fc, lm = scan32_max(g);
        const float lml = __builtin_bit_cast(float, __builtin_amdgcn_readlane(__builtin_bit_cast(int, lm), 31));
        if (lane < 32) { sc[t] = g; sc[32 + t] = lm; sc[64 + t] = __expf(g - lml); fsc[t] = lm; fsc[32 + t] = fc; }
    }
    if (nprob >= 0) mlstm_raw_load(F, nprob, R);
    __syncthreads();
    { const int cc = F.tid & 255, tg = F.tid >> 8, arr = cc >> 7, k = cc & 127;
      const float w0 = cw0_, w1 = cw1_, w2 = cw2_, w3 = cw3_, bb = cbb_;
      float x0 = raw[(16 * tg + 0) * 256 + cc], x1 = raw[(16 * tg + 1) * 256 + cc], x2 = raw[(16 * tg + 2) * 256 + cc];
      float o16[16];
#pragma unroll
      for (int j = 0; j < 16; ++j) { const float x3 = raw[(16 * tg + 3 + j) * 256 + cc]; o16[j] = siluf(bb + x0 * w0 + x1 * w1 + x2 * w2 + x3 * w3); x0 = x1; x1 = x2; x2 = x3; }
      if (arr == 0) {
#pragma unroll
          for (int j = 0; j < 16; ++j) Qs[(16 * tg + j) * CQ_LD + k] = (bf16)f2bf(o16[j]);
      } else { unsigned pw[8];
#pragma unroll
          for (int j = 0; j < 16; ++j) { o16[j] *= 0.08838834764831845f; Ks[(16 * tg + j) * CQ_LD + k] = (bf16)f2bf(o16[j]); o16[j] *= sc[64 + 16 * tg + j]; }
#pragma unroll
          for (int j = 0; j < 8; ++j) pw[j] = pk2(o16[2 * j], o16[2 * j + 1]);
          *(LAS v4u*)(KhT + k * CT_LD + 16 * tg) = (v4u){pw[0], pw[1], pw[2], pw[3]}; *(LAS v4u*)(KhT + k * CT_LD + 16 * tg + 8) = (v4u){pw[4], pw[5], pw[6], pw[7]}; } }
    { const int t = F.tid >> 4, s0 = 2 * (F.tid & 15); const float lmt = sc[32 + t];
      WT[t * 32 + s0] = (s0 <= t) ? __expf(sc[s0] - lmt) : 0.f; WT[t * 32 + s0 + 1] = (s0 + 1 <= t) ? __expf(sc[s0 + 1] - lmt) : 0.f; }
    __syncthreads();
    st_frag(fo, w, lane, ld_perm(Qs + (16 * (w >> 2) + fr) * CQ_LD, 32 * (w & 3), quad));
    st_frag(fo, 8 + w, lane, *(const LAS bf16x8*)(KhT + (16 * w + fr) * CT_LD + 8 * quad));
    st_frag(fo, 19 + 2 * w, lane, *(const LAS bf16x8*)(VT + (16 * w + fr) * CT_LD + 8 * quad));
    if (w < 2) {
        const f32x4 zero4 = fresh_zero4(); f32x4 pa = zero4, pb = zero4;
#pragma unroll
        for (int ks = 0; ks < 4; ++ks) { const bf16x8 qb = *(const LAS bf16x8*)(Qs + (16 * w + fr) * CQ_LD + 32 * ks + 8 * quad);
            pa = mfma16(*(const LAS bf16x8*)(Ks + fr * CQ_LD + 32 * ks + 8 * quad), qb, pa);
            if (w == 1) pb = mfma16(*(const LAS bf16x8*)(Ks + (16 + fr) * CQ_LD + 32 * ks + 8 * quad), qb, pb); }
        pa = pa * *(const LAS f32x4*)(WT + (16 * w + fr) * 32 + 4 * quad);
        if (w == 1) pb = pb * *(const LAS f32x4*)(WT + (16 + fr) * 32 + 16 + 4 * quad);
        float d = ((pa[0] + pa[1]) + (pa[2] + pa[3])) + ((pb[0] + pb[1]) + (pb[2] + pb[3]));
        d += shx<16>(d); d += shx<32>(d);
        if (quad == 0) fsc[64 + 16 * w + fr] = d;
        st_frag(fo, 16 + w, lane, pack8(pa, pb));
    }
    __syncthreads();
}
DI void chain_mlstm(Frame& F, int item) {
    typedef ChainStage<18, 8, 384> St;
    const int bh = item >> 1, half = item & 1, h = bh & 3, b = bh >> 2, w = F.wave, lane = F.lane, fr = lane & 15, quad = lane >> 4;
    const bool act = w < 4, nrm = (w == 4); const int vs = 4 * half + (w & 3);
    const unsigned char* fb = F.ws + WS_FRM + (size_t)bh * 64 * FH_STRIDE;
    bf16* HC = (bf16*)(F.ws + WS_HC);
    LAS unsigned char* L = F.lds;
    LAS float* DN = (LAS float*)(F.lds + 2 * St::SLOT);
    f32x4 S[8];
#pragma unroll
    for (int i = 0; i < 8; ++i) S[i] = (f32x4){0.f, 0.f, 0.f, 0.f};
    St sa, sb, sc;
    auto ld = [&](St& s, int c) { const unsigned char* p = fb + (size_t)c * FH_STRIDE;
#pragma unroll
        for (int i = 0; i < St::MAXF; ++i) { const int f = w + 8 * i; if (f < 18) s.r[i] = *(const bf16x8*)(p + f * 1024 + lane * 16); }
        if (w == 7 && lane < 24) s.sc = *(const f32x4*)(p + 34 * 1024 + lane * 16); };
    ld(sa, 0); sa.store(L, w, lane); ld(sa, 1); ld(sb, 2);
    bf16x8 vp = ld_vperm(fb + (19 + 2 * vs) * 1024, fr, quad), vn = *(const bf16x8*)(fb + (19 + 2 * vs) * 1024 + lane * 16);
    bf16x8 vp1 = ld_vperm(fb + FH_STRIDE + (19 + 2 * vs) * 1024, fr, quad), vn1 = *(const bf16x8*)(fb + FH_STRIDE + (19 + 2 * vs) * 1024 + lane * 16);
    __syncthreads();
    const f32x4 zero4 = fresh_zero4();
    unsigned o1_ = 0x3f803f80u; asm volatile("" : "+v"(o1_)); const bf16x8 ones = __builtin_bit_cast(bf16x8, (v4u){o1_, o1_, o1_, o1_});
    float mprev = -1e30f;
    f32x4 iqp[2], op[2];
    iqp[0] = iqp[1] = op[0] = op[1] = zero4;
    const unsigned lo = 4u * quad * 512u + fr;
#pragma unroll 1
    for (int c = 0; c < 64; ++c) {
        ld(sc, c + 3 < 64 ? c + 3 : 63);
        const unsigned char* pn = fb + (size_t)(c + 2 < 64 ? c + 2 : 63) * FH_STRIDE;
        const LAS unsigned char* sl = L + (c & 1) * St::SLOT; const LAS float* ss = (const LAS float*)(sl + 18 * 1024);
        const float lml = ss[31], fcl = ss[63];
        const float cml = fmaxf(lml, mprev), rhol = __expf(lml - cml), cd = __expf(mprev - cml);
        if (act) {
            if (c > 0) {
                const LAS float* dn = DN + ((c - 1) & 1) * 64; bf16* hb = HC + ((size_t)b * SEQ + (c - 1) * 32) * 512 + 128 * h + 16 * vs;
#pragma unroll
                for (int tb = 0; tb < 2; ++tb) { const f32x4 wr = *(const LAS f32x4*)(dn + 16 * tb + 4 * quad), rr = *(const LAS f32x4*)(dn + 32 + 16 * tb + 4 * quad);
#pragma unroll
                    for (int j = 0; j < 4; ++j) hb[lo + (16 * tb + j) * 512] = (bf16)f2bf(wr[j] * iqp[tb][j] + rr[j] * op[tb][j]); }
            }
            bf16x8 sf[4];
#pragma unroll
            for (int kt = 0; kt < 4; ++kt) sf[kt] = pack8(S[2 * kt], S[2 * kt + 1]);
            { bf16x8 q[8]; const bf16x8 ap0 = LQ(sl, 16), ap1 = LQ(sl, 17);
#pragma unroll
              for (int i = 0; i < 8; ++i) q[i] = LQ(sl, i);
              __builtin_amdgcn_sched_barrier(0);
              f32x4 o0 = mfma16(ap0, vp, zero4), o1 = mfma16(ap1, vp, zero4), i0 = zero4, i1 = zero4;
#pragma unroll
              for (int kt = 0; kt < 4; ++kt) { i0 = mfma16(q[kt], sf[kt], i0); i1 = mfma16(q[4 + kt], sf[kt], i1); }
              op[0] = o0; op[1] = o1; iqp[0] = i0; iqp[1] = i1; }
            vp = vp1; vp1 = ld_vperm(pn + (19 + 2 * vs) * 1024, fr, quad);
            { bf16x8 kf[8];
#pragma unroll
              for (int kk = 0; kk < 8; ++kk) kf[kk] = LQ(sl, 8 + kk);
              __builtin_amdgcn_sched_barrier(0);
#pragma unroll
              for (int kk = 0; kk < 8; ++kk) { const f32x4 us = mfma16(kf[kk], vn, zero4); S[kk] = S[kk] * cd + us * rhol; } }
            vn = vn1; vn1 = *(const bf16x8*)(pn + (19 + 2 * vs) * 1024 + lane * 16);
        } else if (nrm) {
            bf16x8 nf[4];
#pragma unroll
            for (int kt = 0; kt < 4; ++kt) nf[kt] = pack8(S[2 * kt], S[2 * kt + 1]);
            LAS float* dn = DN + (c & 1) * 64;
#pragma unroll
            for (int tb = 0; tb < 2; ++tb) {
                bf16x8 q[4];
#pragma unroll
                for (int kt = 0; kt < 4; ++kt) q[kt] = LQ(sl, 4 * tb + kt);
                const f32x4 slm = *(const LAS f32x4*)(ss + 16 * tb + 4 * quad), sfc = *(const LAS f32x4*)(ss + 32 + 16 * tb + 4 * quad), srs = *(const LAS f32x4*)(ss + 64 + 16 * tb + 4 * quad);
                __builtin_amdgcn_sched_barrier(0);
                f32x4 nq = zero4;
#pragma unroll
                for (int kt = 0; kt < 4; ++kt) nq = mfma16(q[kt], nf[kt], nq);
                f32x4 wr, rr;
#pragma unroll
                for (int j = 0; j < 4; ++j) { const float cm = fmaxf(slm[j], mprev), rho = __expf(slm[j] - cm), wi = __expf(mprev - cm), em = __expf(-(sfc[j] + cm));
                    const float rd = __builtin_amdgcn_rcpf(fmaxf(fabsf(wi * nq[j] + rho * srs[j]), em)); wr[j] = wi * rd; rr[j] = rho * rd; }
                if (fr == 0) { *(LAS f32x4*)(dn + 16 * tb + 4 * quad) = wr; *(LAS f32x4*)(dn + 32 + 16 * tb + 4 * quad) = rr; }
            }
            { bf16x8 kf[8];
#pragma unroll
              for (int kk = 0; kk < 8; ++kk) kf[kk] = LQ(sl, 8 + kk);
              __builtin_amdgcn_sched_barrier(0);
#pragma unroll
              for (int kk = 0; kk < 8; ++kk) { const f32x4 un = mfma16(kf[kk], ones, zero4); S[kk] = S[kk] * cd + un * rhol; } }
        }
        mprev = fcl + cml;
        sa.store(L + ((c + 1) & 1) * St::SLOT, w, lane);
        __syncthreads();
        sa = sb; sb = sc;
    }
    if (act) {
        const LAS float* dn = DN + 64; bf16* hb = HC + ((size_t)b * SEQ + 63 * 32) * 512 + 128 * h + 16 * vs;
#pragma unroll
        for (int tb = 0; tb < 2; ++tb) { const f32x4 wr = *(const LAS f32x4*)(dn + 16 * tb + 4 * quad), rr = *(const LAS f32x4*)(dn + 32 + 16 * tb + 4 * quad);
#pragma unroll
            for (int j = 0; j < 4; ++j) hb[lo + (16 * tb + j) * 512] = (bf16)f2bf(wr[j] * iqp[tb][j] + rr[j] * op[tb][j]); }
    }
}
constexpr int FR_STRIDE = 22 * 1024 + 256;
constexpr int RK_LD = 72, RT_LD = 40, RAAB_LD = 36;
struct RRaw { float lw[8]; unsigned r[8], k[8], a[8], b[8], v[8]; };
DI void rwkv_raw_load(Frame& F, int prob, RRaw& R) {
    const bf16* RWH = (const bf16*)(F.ws + WS_RW); const float* LW = (const float*)(F.ws + WS_LW);
    const int tq = F.tid & 255, k = tq & 63, part = tq >> 6, wq = F.wave & 3, fr = F.lane & 15, quad = F.lane >> 4;
    const int bh = prob >> 6, c = prob & 63, b = bh >> 3, h = bh & 7; const size_t row0 = (size_t)b * SEQ + c * 32; const size_t o = (row0 + 8 * part) * 512 + 64 * h + k;
#pragma unroll
    for (int j = 0; j < 8; ++j) { R.lw[j] = LW[o + (size_t)j * 512]; R.r[j] = RWH[0 * (RHSZ / 2) + o + (size_t)j * 512]; R.k[j] = RWH[1 * (RHSZ / 2) + o + (size_t)j * 512]; R.a[j] = RWH[3 * (RHSZ / 2) + o + (size_t)j * 512]; R.b[j] = RWH[4 * (RHSZ / 2) + o + (size_t)j * 512]; }
    const bf16* vsrc = RWH + 2 * (RHSZ / 2) + row0 * 512 + 64 * h + 16 * wq + fr;
#pragma unroll
    for (int j = 0; j < 4; ++j) { R.v[j] = vsrc[(size_t)(4 * quad + j) * 512]; R.v[4 + j] = vsrc[(size_t)(16 + 4 * quad + j) * 512]; }
}
DI void phase_rwkv_chunkprep(Frame& F) {
    const int grp = F.wave >> 2, wq = F.wave & 3, lane = F.lane, fr = lane & 15, quad = lane >> 4, tq = F.tid & 255;
    LAS unsigned char* L = F.lds + grp * 65536;
    LAS bf16* At = (LAS bf16*)L;
    LAS bf16* Bt = At + 32 * RK_LD;
    LAS bf16* Kt = Bt + 32 * RK_LD;
    LAS bf16* Rt = Kt + 32 * RK_LD;
    LAS bf16* AT = Rt + 32 * RK_LD;
    LAS bf16* BhT = AT + 64 * RT_LD;
    LAS bf16* KhT = BhT + 64 * RT_LD;
    LAS bf16* Tm = KhT + 64 * RT_LD;
    LAS bf16* AakT = Tm + 32 * RT_LD;
    LAS bf16* Arb = AakT + 32 * RT_LD;
    LAS bf16* TaT = Arb + 32 * RT_LD;
    LAS bf16* TAkT = TaT + 64 * RT_LD;
    LAS float* Aab = (LAS float*)(TAkT + 32 * RT_LD);
    LAS float* PS = Aab + 32 * RAAB_LD;
    const bf16* RWH = (const bf16*)(F.ws + WS_RW); const float* LW = (const float*)(F.ws + WS_LW);
    unsigned char* FRb = F.ws + WS_FR;
    const f32x4 zero4 = fresh_zero4();
    RRaw RR; if (F.vcu < 2048) rwkv_raw_load(F, F.vcu * 2 + grp, RR);
    for (int it = F.vcu; it < 2048; it += F.G) {
        const int prob = it * 2 + grp;
        const int bh = prob >> 6, c = prob & 63, b = bh >> 3, h = bh & 7;
        const size_t row0 = (size_t)b * SEQ + c * 32;
        unsigned char* fr_out = FRb + (size_t)prob * FR_STRIDE;
        {
            const int k = tq & 63, part = tq >> 6; const size_t o = (row0 + 8 * part) * 512 + 64 * h + k;
            float lw[8], g[8]; float run = 0.f;
#pragma unroll
            for (int j = 0; j < 8; ++j) { lw[j] = RR.lw[j]; run += lw[j]; g[j] = run; }
            PS[part * 64 + k] = run;
            __syncthreads();
            float off = 0.f, tot = 0.f;
#pragma unroll
            for (int p = 0; p < 4; ++p) { const float v = PS[p * 64 + k]; tot += v; if (p < part) off += v; }
            unsigned pa[4], pb[4], pk[4];
            float av8[8], bv8[8], kv8[8];
#pragma unroll
            for (int j = 0; j < 8; ++j) { const float G = g[j] + off; const float r = bf2f((unsigned short)RR.r[j]), k2 = bf2f((unsigned short)RR.k[j]), a_ = bf2f((unsigned short)RR.a[j]), b_ = bf2f((unsigned short)RR.b[j]);
                const float eG = __expf(G), enG = __expf(-G), eGm1 = __expf(G - lw[j]), eh = __expf(tot - G);
                const int t = 8 * part + j;
                At[t * RK_LD + k] = (bf16)f2bf(a_ * eGm1); Bt[t * RK_LD + k] = (bf16)f2bf(b_ * enG); Kt[t * RK_LD + k] = (bf16)f2bf(k2 * enG); Rt[t * RK_LD + k] = (bf16)f2bf(r * eG);
                av8[j] = a_ * eGm1; bv8[j] = b_ * eh; kv8[j] = k2 * eh; }
#pragma unroll
            for (int j = 0; j < 4; ++j) { pa[j] = pk2(av8[2 * j], av8[2 * j + 1]); pb[j] = pk2(bv8[2 * j], bv8[2 * j + 1]); pk[j] = pk2(kv8[2 * j], kv8[2 * j + 1]); }
            *(LAS v4u*)(AT + k * RT_LD + 8 * part) = (v4u){pa[0], pa[1], pa[2], pa[3]};
            *(LAS v4u*)(BhT + k * RT_LD + 8 * part) = (v4u){pb[0], pb[1], pb[2], pb[3]};
            *(LAS v4u*)(KhT + k * RT_LD + 8 * part) = (v4u){pk[0], pk[1], pk[2], pk[3]};
            if (part == 0) ((float*)(fr_out + 22 * 1024))[k] = __expf(tot);
            { const unsigned (&vv)[8] = RR.v;
              *(v4u*)(fr_out + (18 + wq) * 1024 + lane * 16) = (v4u){vv[0] | (vv[1] << 16), vv[2] | (vv[3] << 16), vv[4] | (vv[5] << 16), vv[6] | (vv[7] << 16)}; }
            if (it + F.G < 2048) rwkv_raw_load(F, (it + F.G) * 2 + grp, RR);
        }
        __syncthreads();
        f32x4 ark[2][2];
        {
            const LAS bf16* Am = (wq == 0) ? At : (wq == 2 ? Rt : Kt);
            const LAS bf16* Bm = (wq == 0 || wq == 2) ? Bt : (wq == 1 ? At : Rt);
            f32x4 acc[2][2];
#pragma unroll
            for (int rb = 0; rb < 2; ++rb)
#pragma unroll
                for (int cbk = 0; cbk < 2; ++cbk) { f32x4 x = zero4;
#pragma unroll
                    for (int ks = 0; ks < 2; ++ks) x = mfma16(*(const LAS bf16x8*)(Am + (16 * rb + fr) * RK_LD + 32 * ks + 8 * quad), *(const LAS bf16x8*)(Bm + (16 * cbk + fr) * RK_LD + 32 * ks + 8 * quad), x);
                    acc[rb][cbk] = x; }
#pragma unroll
            for (int rb = 0; rb < 2; ++rb)
#pragma unroll
                for (int cbk = 0; cbk < 2; ++cbk)
#pragma unroll
                    for (int j = 0; j < 4; ++j) { const int row = 16 * rb + 4 * quad + j, col = 16 * cbk + fr; const int t = (wq == 0 || wq == 2) ? row : col, s = (wq == 0 || wq == 2) ? col : row;
                        const bool keep = (wq < 2) ? (s < t) : (s <= t); const float v = keep ? acc[rb][cbk][j] : 0.f; acc[rb][cbk][j] = v;
                        if (wq == 0) Aab[row * RAAB_LD + col] = v; else if (wq == 1) AakT[row * RT_LD + col] = (bf16)f2bf(v); else if (wq == 2) Arb[row * RT_LD + col] = (bf16)f2bf(v); }
#pragma unroll
            for (int rb = 0; rb < 2; ++rb)
#pragma unroll
                for (int cbk = 0; cbk < 2; ++cbk) ark[rb][cbk] = acc[rb][cbk];
        }
        __syncthreads();
        if (wq == 0) {
            float Tc[32]; const int cidx = lane & 31;
#pragma unroll
            for (int t = 0; t < 32; ++t) { float acc = (t == cidx) ? 1.0f : 0.0f;
#pragma unroll
                for (int s = 0; s < t; ++s) acc += Aab[t * RAAB_LD + s] * Tc[s];
                Tc[t] = acc; if (lane < 32) Tm[t * RT_LD + cidx] = (bf16)f2bf(acc); }
        }
        __syncthreads();
        {
            const bf16x8 aT = *(const LAS bf16x8*)(AT + (16 * wq + fr) * RT_LD + 8 * quad);
#pragma unroll
            for (int st = 0; st < 2; ++st) { const f32x4 x = mfma16(aT, *(const LAS bf16x8*)(Tm + (16 * st + fr) * RT_LD + 8 * quad), zero4);
#pragma unroll
                for (int j = 0; j < 4; ++j) TaT[(16 * wq + 4 * quad + j) * RT_LD + 16 * st + fr] = (bf16)f2bf(x[j]); }
            const int st = wq >> 1, ut = wq & 1;
            const f32x4 y = mfma16(*(const LAS bf16x8*)(AakT + (16 * st + fr) * RT_LD + 8 * quad), *(const LAS bf16x8*)(Tm + (16 * ut + fr) * RT_LD + 8 * quad), zero4);
#pragma unroll
            for (int j = 0; j < 4; ++j) TAkT[(16 * st + 4 * quad + j) * RT_LD + 16 * ut + fr] = (bf16)f2bf(y[j]);
        }
        __syncthreads();
        {
            { const int tb = wq & 1, i = wq >> 1; const bf16x8 bop = *(const LAS bf16x8*)(Arb + (16 * tb + fr) * RT_LD + 8 * quad); f32x4 x[2];
#pragma unroll
              for (int u = 0; u < 2; ++u) { const int kt = 2 * i + u; const v2u rz = *(const LAS v2u*)(Rt + (16 * tb + fr) * RK_LD + 16 * kt + 4 * quad);
                  x[u] = mfma16(*(const LAS bf16x8*)(TaT + (16 * kt + fr) * RT_LD + 8 * quad), bop, (f32x4){blo(rz.x), bhi(rz.x), blo(rz.y), bhi(rz.y)}); }
              *(bf16x8*)(fr_out + (tb * 2 + i) * 1024 + lane * 16) = pack8(x[0], x[1]); }
            { const bf16x8 bop = *(const LAS bf16x8*)(BhT + (16 * wq + fr) * RT_LD + 8 * quad); f32x4 x[4];
#pragma unroll
              for (int kt = 0; kt < 4; ++kt) x[kt] = mfma16(*(const LAS bf16x8*)(TaT + (16 * kt + fr) * RT_LD + 8 * quad), bop, zero4);
              *(bf16x8*)(fr_out + (6 + wq * 2 + 0) * 1024 + lane * 16) = pack8(x[0], x[1]); *(bf16x8*)(fr_out + (6 + wq * 2 + 1) * 1024 + lane * 16) = pack8(x[2], x[3]);
              f32x4 q[2];
#pragma unroll
              for (int sb = 0; sb < 2; ++sb) { const v2u kz = *(const LAS v2u*)(KhT + (16 * wq + fr) * RT_LD + 16 * sb + 4 * quad);
                  q[sb] = mfma16(*(const LAS bf16x8*)(TAkT + (16 * sb + fr) * RT_LD + 8 * quad), bop, (f32x4){blo(kz.x), bhi(kz.x), blo(kz.y), bhi(kz.y)}); }
              *(bf16x8*)(fr_out + (14 + wq) * 1024 + lane * 16) = pack8(q[0], q[1]); }
            if (wq == 3) {
#pragma unroll
                for (int tb = 0; tb < 2; ++tb) { const bf16x8 bop = *(const LAS bf16x8*)(Arb + (16 * tb + fr) * RT_LD + 8 * quad); f32x4 x[2];
#pragma unroll
                    for (int sb = 0; sb < 2; ++sb) x[sb] = mfma16(*(const LAS bf16x8*)(TAkT + (16 * sb + fr) * RT_LD + 8 * quad), bop, ark[sb][tb]);
                    *(bf16x8*)(fr_out + (4 + tb) * 1024 + lane * 16) = pack8(x[0], x[1]); } }
        }
        __syncthreads();
    }
}
DI void chunk_rwkv_chain(Frame& F, int item) {
    typedef ChainStage<18, 4, 256> St;
    const int grp = F.wave >> 2, w = F.wave & 3, lane = F.lane, fr = lane & 15, quad = lane >> 4;
    const int bh = item * 2 + grp, b = bh >> 3, h = bh & 7;
    const unsigned char* fb = F.ws + WS_FR + (size_t)bh * 64 * FR_STRIDE;
    bf16* YA = (bf16*)(F.ws + WS_YA);
    LAS unsigned char* L = F.lds + grp * (2 * St::SLOT);
    f32x4 H[4];
#pragma unroll
    for (int i = 0; i < 4; ++i) H[i] = (f32x4){0.f, 0.f, 0.f, 0.f};
    St sa, sb, sc;
    auto ld = [&](St& s, int c) { const unsigned char* p = fb + (size_t)c * FR_STRIDE;
#pragma unroll
        for (int i = 0; i < St::MAXF; ++i) { const int f = w + 4 * i; if (f < 18) s.r[i] = *(const bf16x8*)(p + f * 1024 + lane * 16); }
        if (w == 3 && lane < 16) s.sc = *(const f32x4*)(p + 22 * 1024 + lane * 16); };
    ld(sa, 0); sa.store(L, w, lane); ld(sa, 1); ld(sb, 2);
    bf16x8 vf = *(const bf16x8*)(fb + (18 + w) * 1024 + lane * 16), vf1 = *(const bf16x8*)(fb + FR_STRIDE + (18 + w) * 1024 + lane * 16);
    __syncthreads();
    const f32x4 zero4 = fresh_zero4();
#pragma unroll 1
    for (int c = 0; c < 64; ++c) {
        ld(sc, c + 3 < 64 ? c + 3 : 63);
        const unsigned char* pn = fb + (size_t)(c + 2 < 64 ? c + 2 : 63) * FR_STRIDE;
        const LAS unsigned char* sl = L + (c & 1) * St::SLOT;
        bf16x8 q[18]; f32x4 gl[4];
#pragma unroll
        for (int i = 0; i < 18; ++i) q[i] = LQ(sl, i);
#pragma unroll
        for (int kt = 0; kt < 4; ++kt) gl[kt] = *(const LAS f32x4*)(sl + 18 * 1024 + (16 * kt + 4 * quad) * 4);
        __builtin_amdgcn_sched_barrier(0);
        const bf16x8 hb0 = pack8(H[0], H[1]), hb1 = pack8(H[2], H[3]);
        f32x4 y0 = mfma16(q[4], vf, zero4), y1 = mfma16(q[5], vf, zero4);
        y0 = mfma16(q[0], hb0, y0); y0 = mfma16(q[1], hb1, y0); y1 = mfma16(q[2], hb0, y1); y1 = mfma16(q[3], hb1, y1);
#pragma unroll
        for (int kt = 0; kt < 4; ++kt) { f32x4 x = mfma16(q[14 + kt], vf, H[kt] * gl[kt]); x = mfma16(q[6 + 2 * kt], hb0, x); H[kt] = mfma16(q[7 + 2 * kt], hb1, x); }
        vf = vf1; vf1 = *(const bf16x8*)(pn + (18 + w) * 1024 + lane * 16);
        bf16* yb = YA + ((size_t)b * SEQ + c * 32) * 512 + 64 * h + 16 * w; const unsigned lo = 4u * quad * 512u + fr;
#pragma unroll
        for (int j = 0; j < 4; ++j) { yb[lo + j * 512] = (bf16)f2bf(y0[j]); yb[lo + (16 + j) * 512] = (bf16)f2bf(y1[j]); }
        sa.store(L + ((c + 1) & 1) * St::SLOT, w, lane);
        __syncthreads();
        sa = sb; sb = sc;
    }
}
#undef LQ
DI void scan_lru_item4(Frame& F, int item) {
    LAS f32x4* SA = (LAS f32x4*)F.lds; LAS f32x4* SB = SA + 512;
    const int cg = item & 7, b = item >> 3, cq = F.tid & 15, seg = F.tid >> 4, c = 64 * cg + 4 * cq;
    const float* LA = (const float*)(F.ws + WS_LA); const bf16* LB = (const bf16*)(F.ws + WS_LB); const bf16* z = (const bf16*)(F.ws + WS_Z);
    unsigned char* Y3 = F.ws + WS_Y + (size_t)3 * M * 512;
    const size_t t0 = (size_t)b * SEQ + seg * 64;
    const float* la = LA + t0 * 512 + c; const bf16* lb = LB + t0 * 512 + c; const bf16* gzp = z + t0 * ZLD + ZD + 512 + c; unsigned char* yp = Y3 + t0 * 512 + c;
    f32x4 A = (f32x4){1.f, 1.f, 1.f, 1.f}, Bv = (f32x4){0.f, 0.f, 0.f, 0.f};
    f32x4 av0[8], av1[8]; v2u bq0[8], bq1[8], gz0[8], gz1[8];
#define LRU_LD(AV, BQ, S0) do { _Pragma("unroll") for (int i_ = 0; i_ < 8; ++i_) { AV[i_] = *(const f32x4*)(la + (size_t)((S0) + i_) * 512); BQ[i_] = *(const v2u*)(lb + (size_t)((S0) + i_) * 512); } } while (0)
#define LRU_LDG(GZ, S0) do { _Pragma("unroll") for (int i_ = 0; i_ < 8; ++i_) GZ[i_] = *(const v2u*)(gzp + (size_t)((S0) + i_) * ZLD); } while (0)
#define LRU_C1(AV, BQ) do { _Pragma("unroll") for (int i_ = 0; i_ < 8; ++i_) { const f32x4 bv_ = (f32x4){blo(BQ[i_].x), bhi(BQ[i_].x), blo(BQ[i_].y), bhi(BQ[i_].y)}; A = A * AV[i_]; Bv = AV[i_] * Bv + bv_; } } while (0)
#define LRU_C2(AV, BQ, GZ, S0) do { _Pragma("unroll") for (int i_ = 0; i_ < 8; ++i_) { const f32x4 bv_ = (f32x4){blo(BQ[i_].x), bhi(BQ[i_].x), blo(BQ[i_].y), bhi(BQ[i_].y)}; hh = AV[i_] * hh + bv_; \
        *(unsigned*)(yp + (size_t)((S0) + i_) * 512) = pk4f8(hh[0] * gelu_tanh(blo(GZ[i_].x)), hh[1] * gelu_tanh(bhi(GZ[i_].x)), hh[2] * gelu_tanh(blo(GZ[i_].y)), hh[3] * gelu_tanh(bhi(GZ[i_].y))); } } while (0)
    LRU_LD(av0, bq0, 0);
#pragma unroll 1
    for (int k = 0; k < 64; k += 16) { LRU_LD(av1, bq1, k + 8); LRU_C1(av0, bq0); if (k + 16 < 64) LRU_LD(av0, bq0, k + 16); LRU_C1(av1, bq1); }
    LRU_LD(av0, bq0, 0); LRU_LDG(gz0, 0);
    SA[seg * 16 + cq] = A; SB[seg * 16 + cq] = Bv;
    __syncthreads();
    f32x4 hh = (f32x4){0.f, 0.f, 0.f, 0.f};
    for (int s2 = 0; s2 < seg; ++s2) hh = SA[s2 * 16 + cq] * hh + SB[s2 * 16 + cq];
#pragma unroll 1
    for (int k = 0; k < 64; k += 16) { LRU_LD(av1, bq1, k + 8); LRU_LDG(gz1, k + 8); LRU_C2(av0, bq0, gz0, k); if (k + 16 < 64) { LRU_LD(av0, bq0, k + 16); LRU_LDG(gz0, k + 16); } LRU_C2(av1, bq1, gz1, k + 8); }
#undef LRU_LD
#undef LRU_LDG
#undef LRU_C1
#undef LRU_C2
    __syncthreads();
}
DI void phase_chunkprep(Frame& F, KA a, int l) {
#ifndef DUPCP
#define DUPCP 0
#endif
    for (int rep = 0; rep < 1 + ((DUPCP >> 0) & 1); ++rep) { phase_rwkv_chunkprep(F); __syncthreads(); }
    for (int rep = 0; rep < 1 + ((DUPCP >> 1) & 1); ++rep) { v4u pq, pf, pi; if (F.vcu < 2048) hgrn_raw_load(F, F.vcu, pq, pf, pi); hgrn_lower_bounds(F, a, l);
      for (int it = F.vcu; it < 2048; it += F.G) prep_hgrn_item(F, a, l, it, (it + F.G < 2048) ? it + F.G : -1, pq, pf, pi); }
    for (int rep = 0; rep < 1 + ((DUPCP >> 2) & 1); ++rep) { MRaw R; if (F.vcu < 2048) mlstm_raw_load(F, F.vcu, R);
      for (int it = F.vcu; it < 2048; it += F.G) prep_mlstm_item(F, a, l, it, (it + F.G < 2048) ? it + F.G : -1, R); }
}
DI void phase_scan(Frame& F, KA a, int l) {
    int v = __builtin_amdgcn_readfirstlane((int)blockIdx.x); asm volatile("" : "+s"(v));
    if (F.G >= 160) {
#ifndef DUPSCAN
#define DUPSCAN 0
#endif
        if (v < 32) { for (int rep = 0; rep < 1 + ((DUPSCAN >> 0) & 1); ++rep) { chain_hgrn(F, v); __syncthreads(); } }
        else if (v < 96) { for (int rep = 0; rep < 1 + ((DUPSCAN >> 1) & 1); ++rep) { int mi_ = 2 * ((((v - 32) >> 4) << 3) + ((v - 32) & 7)) + (((v - 32) >> 3) & 1); asm volatile("" : "+s"(mi_)); chain_mlstm(F, mi_); __syncthreads(); } }
        else if (v < 128) { for (int rep = 0; rep < 1 + ((DUPSCAN >> 2) & 1); ++rep) { chunk_rwkv_chain(F, v - 96); __syncthreads(); } }
        else if (v < 192) { for (int rep = 0; rep < 1 + ((DUPSCAN >> 3) & 1); ++rep) { scan_lru_item4(F, v - 128); __syncthreads(); } }
    }
    __syncthreads(); cvt_expert_queue(F, a, l);
}

DI float xsum8(float v) { v += dpp_f<0xB1>(v); v += dpp_f<0x4E>(v); v += dpp_f<0x141>(v); return v; }
DI void phase_post(Frame& F, KA a, int l) {
    const bf16* z = (const bf16*)(F.ws + WS_Z); const bf16* RWH = (const bf16*)(F.ws + WS_RW); const float* BON = (const float*)(F.ws + WS_BON);
    const bf16* YA = (const bf16*)(F.ws + WS_YA); const bf16* OB = (const bf16*)(F.ws + WS_OB); const bf16* HC = (const bf16*)(F.ws + WS_HC);
    unsigned char* Y = F.ws + WS_Y;
    const float* lng = a->in[15] + l * 512; const float* lnb = a->in[16] + l * 512; const float* hnw = a->in[18] + l * 512; const float* mnw = a->in[23] + l * 512;
    const int c = 8 * F.lane;
    struct PTok { v4u ya, ob, hc; v4u gq, vq, gzb, gzc; float bon; };
    auto issue = [&](PTok& T, int t) { const size_t o = (size_t)t * 512 + c;
        T.ya = *(const v4u*)(YA + o); T.ob = *(const v4u*)(OB + o); T.hc = *(const v4u*)(HC + o);
        T.gq = *(const v4u*)(RWH + 5 * (RHSZ / 2) + o); T.vq = *(const v4u*)(RWH + 2 * (RHSZ / 2) + o); T.gzb = *(const v4u*)(z + (size_t)t * ZLD + ZB + 1536 + c); T.gzc = *(const v4u*)(z + (size_t)t * ZLD + ZC + 1536 + c);
        T.bon = BON[(size_t)t * 8 + (F.lane >> 3)]; };
    float lg[8], lb[8], nwh[8], nwm[8];
    *(f32x4*)&lg[0] = *(const f32x4*)(lng + c); *(f32x4*)&lg[4] = *(const f32x4*)(lng + c + 4); *(f32x4*)&lb[0] = *(const f32x4*)(lnb + c); *(f32x4*)&lb[4] = *(const f32x4*)(lnb + c + 4);
    *(f32x4*)&nwh[0] = *(const f32x4*)(hnw + c); *(f32x4*)&nwh[4] = *(const f32x4*)(hnw + c + 4); *(f32x4*)&nwm[0] = *(const f32x4*)(mnw + c); *(f32x4*)&nwm[4] = *(const f32x4*)(mnw + c + 4);
    const int t0 = F.gw, nt = (M - t0 + F.NGW - 1) / F.NGW;
    PTok cur, nxt;
    issue(cur, t0);
#pragma unroll 1
    for (int i = 0; i < nt; ++i) {
        const int t = t0 + i * F.NGW;
        if (i + 1 < nt) issue(nxt, t + F.NGW);
        const size_t o = (size_t)t * 512 + c;
        { const v4u yq_ = cur.ya; float y[8] = {blo(yq_.x), bhi(yq_.x), blo(yq_.y), bhi(yq_.y), blo(yq_.z), bhi(yq_.z), blo(yq_.w), bhi(yq_.w)};
          float s_ = 0.f; for (int j = 0; j < 8; ++j) s_ += y[j]; const float mean = xsum8(s_) * (1.0f / 64.0f);
          float q = 0.f; for (int j = 0; j < 8; ++j) { y[j] -= mean; q += y[j] * y[j]; } const float rstd = rsqrtf(xsum8(q) * (1.0f / 64.0f) + 64e-5f);
          const v4u gq = cur.gq, vq = cur.vq;
          const float g[8] = {blo(gq.x), bhi(gq.x), blo(gq.y), bhi(gq.y), blo(gq.z), bhi(gq.z), blo(gq.w), bhi(gq.w)}, v[8] = {blo(vq.x), bhi(vq.x), blo(vq.y), bhi(vq.y), blo(vq.z), bhi(vq.z), blo(vq.w), bhi(vq.w)};
          float r[8]; for (int j = 0; j < 8; ++j) r[j] = (y[j] * rstd * lg[j] + lb[j] + cur.bon * v[j]) * g[j];
          *(v2u*)(Y + o) = (v2u){pk4f8(r[0], r[1], r[2], r[3]), pk4f8(r[4], r[5], r[6], r[7])}; }
        { const v4u yq_ = cur.ob; float y[8] = {blo(yq_.x), bhi(yq_.x), blo(yq_.y), bhi(yq_.y), blo(yq_.z), bhi(yq_.z), blo(yq_.w), bhi(yq_.w)};
          float q = 0.f; for (int j = 0; j < 8; ++j) q += y[j] * y[j]; q = xsum8(q); q += dpp_f<0x128>(q); const float rstd = rsqrtf(q * (1.0f / 128.0f) + 1e-6f);
          const v4u gz = cur.gzb; const float g[8] = {blo(gz.x), bhi(gz.x), blo(gz.y), bhi(gz.y), blo(gz.z), bhi(gz.z), blo(gz.w), bhi(gz.w)};
          float r[8]; for (int j = 0; j < 8; ++j) r[j] = y[j] * rstd * nwh[j] * siluf(g[j]);
          *(v2u*)(Y + (size_t)M * 512 + o) = (v2u){pk4f8(r[0], r[1], r[2], r[3]), pk4f8(r[4], r[5], r[6], r[7])}; }
        { const v4u yq_ = cur.hc; float y[8] = {blo(yq_.x), bhi(yq_.x), blo(yq_.y), bhi(yq_.y), blo(yq_.z), bhi(yq_.z), blo(yq_.w), bhi(yq_.w)};
          float s_ = 0.f; for (int j = 0; j < 8; ++j) s_ += y[j]; s_ = xsum8(s_); s_ += dpp_f<0x128>(s_); const float mean = s_ * (1.0f / 128.0f);
          float q = 0.f; for (int j = 0; j < 8; ++j) { y[j] -= mean; q += y[j] * y[j]; } q = xsum8(q); q += dpp_f<0x128>(q); const float rstd = rsqrtf(q * (1.0f / 128.0f) + 1e-6f);
          const v4u gz = cur.gzc; const float g[8] = {blo(gz.x), bhi(gz.x), blo(gz.y), bhi(gz.y), blo(gz.z), bhi(gz.z), blo(gz.w), bhi(gz.w)};
          float r[8]; for (int j = 0; j < 8; ++j) r[j] = y[j] * rstd * nwm[j] * sigm(g[j]);
          *(v2u*)(Y + (size_t)2 * M * 512 + o) = (v2u){pk4f8(r[0], r[1], r[2], r[3]), pk4f8(r[4], r[5], r[6], r[7])}; }
        cur = nxt;
    }
}

DI void ln_row(const f32x4 (&v)[4], f32x4 (&o)[4], const float* g, const float* b, int lane) {
    float s = 0.f;
#pragma unroll
    for (int j = 0; j < 4; ++j) s += (v[j].x + v[j].y) + (v[j].z + v[j].w);
    const float mean = wave_sum(s) * (1.0f / D); float q = 0.f;
#pragma unroll
    for (int j = 0; j < 4; ++j) { o[j] = v[j] - mean; q += (o[j].x * o[j].x + o[j].y * o[j].y) + (o[j].z * o[j].z + o[j].w * o[j].w); }
    const float rstd = rsqrtf(wave_sum(q) * (1.0f / D) + 1e-5f);
#pragma unroll
    for (int j = 0; j < 4; ++j) { const f32x4 gg = *(const f32x4*)(g + 4 * lane + 256 * j), bb = *(const f32x4*)(b + 4 * lane + 256 * j); o[j] = o[j] * rstd * gg + bb; }
}
DI void phase_ln1_router(Frame& F, KA a, int l) {
    constexpr int WLD = 1032, LGLD = 33;
    LAS bf16* WrB = (LAS bf16*)F.lds;
    LAS float* LG = (LAS float*)(F.lds + 66560);
    LAS unsigned* cntL = F.LC + LC_CNT; LAS unsigned* baseL = F.LC + LC_BASE; LAS unsigned* rec = F.LC + LC_REC;
    const float* Wr = a->in[35] + (size_t)l * 1024 * 32; const float* rb = a->in[36] + l * 32;
    const float* g1 = a->in[33] + l * 1024; const float* b1 = a->in[34] + l * 1024;
    const bf16* PRE = (const bf16*)(F.ws + WS_PRE); bf16* X1B = (bf16*)(F.ws + WS_X1B);
    bf16* XSV = (bf16*)(F.ws + WS_XSV); unsigned* TREC = (unsigned*)(F.ws + WS_TREC); float* GATE = (float*)(F.ws + WS_GATE);
    for (int i4 = F.tid; i4 < 1024 * 8; i4 += NTHR) { const int c = i4 & 1023, e4 = i4 >> 10; const f32x4 w4 = *(const f32x4*)(Wr + c * 32 + 4 * e4);
        WrB[(4 * e4 + 0) * WLD + c] = (bf16)f2bf(w4[0]); WrB[(4 * e4 + 1) * WLD + c] = (bf16)f2bf(w4[1]); WrB[(4 * e4 + 2) * WLD + c] = (bf16)f2bf(w4[2]); WrB[(4 * e4 + 3) * WLD + c] = (bf16)f2bf(w4[3]); }
    const int lane = F.lane;
    for (int item = F.vcu; item < M / 64; item += F.G) {
        if (F.tid < 32) cntL[F.tid] = 0u;
        __syncthreads();
        v2u pzn[4];
#pragma unroll
        for (int j = 0; j < 4; ++j) pzn[j] = *(const v2u*)(PRE + (size_t)(item * 64 + F.wave) * D + 4 * lane + 256 * j);
        for (int tl = F.wave; tl < 64; tl += NWAVES) {
            const int t = item * 64 + tl;
            f32x4 v[4], x[4];
#pragma unroll
            for (int j = 0; j < 4; ++j) v[j] = (f32x4){blo(pzn[j].x), bhi(pzn[j].x), blo(pzn[j].y), bhi(pzn[j].y)};
            { const int tn = item * 64 + (tl + NWAVES < 64 ? tl + NWAVES : tl);
#pragma unroll
              for (int j = 0; j < 4; ++j) pzn[j] = *(const v2u*)(PRE + (size_t)tn * D + 4 * lane + 256 * j); }
            ln_row(v, x, g1, b1, lane);
#pragma unroll
            for (int j = 0; j < 4; ++j) { *(v2u*)(X1B + (size_t)t * D + 4 * lane + 256 * j) = (v2u){pk2(x[j].x, x[j].y), pk2(x[j].z, x[j].w)};
                unsigned w8 = __builtin_amdgcn_cvt_pk_fp8_f32(x[j].x * 16.f, x[j].y * 16.f, 0u, false); *(unsigned*)(F.ws + WS_X1B8 + (size_t)t * D + 4 * lane + 256 * j) = __builtin_amdgcn_cvt_pk_fp8_f32(x[j].z * 16.f, x[j].w * 16.f, w8, true); }
        }
        VM_WAIT(); __syncthreads();
        { const int tt = F.wave >> 1, eh = F.wave & 1, tok = lane & 15, quad = lane >> 4;
          const bf16* xr = X1B + (size_t)(item * 64 + 16 * tt + tok) * D + 8 * quad; const LAS bf16* wr_ = WrB + (16 * eh + tok) * WLD + 8 * quad;
          f32x4 acc = (f32x4){0.f, 0.f, 0.f, 0.f};
#pragma unroll
          for (int kb = 0; kb < 4; ++kb) { bf16x8 xf[8];
#pragma unroll
              for (int i = 0; i < 8; ++i) xf[i] = *(const bf16x8*)(xr + 32 * (8 * kb + i));
#pragma unroll
              for (int i = 0; i < 8; ++i) acc = mfma16(*(const LAS bf16x8*)(wr_ + 32 * (8 * kb + i)), xf[i], acc); }
          const f32x4 bb = *(const f32x4*)(rb + 16 * eh + 4 * quad);
#pragma unroll
          for (int j = 0; j < 4; ++j) LG[(16 * tt + tok) * LGLD + 16 * eh + 4 * quad + j] = acc[j] + bb[j]; }
        __syncthreads();
        for (int i2 = 0; i2 < 4; ++i2) {
            const int tl = F.wave * 8 + 2 * i2 + (lane >> 5), myE = lane & 31;
            float logit = LG[tl * LGLD + myE];
            float tv[4]; int ti[4];
#pragma unroll
            for (int k = 0; k < 4; ++k) { float bv = logit; int bi = myE;
#define AMXD(ctrl) { const float ov = dpp_f<ctrl>(bv); const int oi = __builtin_amdgcn_update_dpp(0, bi, ctrl, 0xf, 0xf, true); if (ov > bv || (ov == bv && oi < bi)) { bv = ov; bi = oi; } }
#define AMX(o) { const float ov = shx<o>(bv); const int oi = shx_i<o>(bi); if (ov > bv || (ov == bv && oi < bi)) { bv = ov; bi = oi; } }
                AMXD(0xB1) AMXD(0x4E) AMXD(0x124) AMXD(0x128) AMX(16)
#undef AMX
#undef AMXD
                tv[k] = bv; ti[k] = bi; if (myE == bi) logit = -3.0e38f; }
            const float e1 = __expf(tv[1] - tv[0]), e2 = __expf(tv[2] - tv[0]), e3 = __expf(tv[3] - tv[0]); const float inv = 1.0f / (1.0f + e1 + e2 + e3);
            if (myE < 4) { const int e = (myE == 0) ? ti[0] : (myE == 1 ? ti[1] : (myE == 2 ? ti[2] : ti[3]));
                const float gt = ((myE == 0) ? 1.0f : (myE == 1 ? e1 : (myE == 2 ? e2 : e3))) * inv;
                const unsigned pos = __hip_atomic_fetch_add(&cntL[e], 1u, __ATOMIC_RELAXED, __HIP_MEMORY_SCOPE_WORKGROUP);
                rec[(tl * 4 + myE) * 3 + 0] = (unsigned)e; rec[(tl * 4 + myE) * 3 + 1] = pos; rec[(tl * 4 + myE) * 3 + 2] = __builtin_bit_cast(unsigned, gt); }
        }
        __syncthreads();
        if (F.tid < 32) baseL[F.tid] = __hip_atomic_fetch_add((unsigned*)(F.ctl + CW_CNT + l * 2048 + F.tid * 64), cntL[F.tid], __ATOMIC_RELAXED, __HIP_MEMORY_SCOPE_AGENT);
        __syncthreads();
        if (F.tid < 256) { const int tl = F.tid >> 2, k = F.tid & 3, t = item * 64 + tl; const unsigned e = rec[F.tid * 3], pos = rec[F.tid * 3 + 1] + baseL[rec[F.tid * 3]];
            TREC[(size_t)t * 4 + k] = (e << 20) | pos; GATE[(size_t)t * 4 + k] = __builtin_bit_cast(float, rec[F.tid * 3 + 2]); }
        __syncthreads();
        for (int r0 = F.wave * 4; r0 < 256; r0 += NWAVES * 4) {
            const int t = item * 64 + (r0 >> 2); const GAS v4u* srow = (const GAS v4u*)(X1B + (size_t)t * D); const v4u q0 = srow[lane], q1 = srow[lane + 64];
            v2u f0, f1;
            f0.x = __builtin_amdgcn_cvt_pk_fp8_f32(blo(q0.x) * 16.f, bhi(q0.x) * 16.f, 0u, false); f0.x = __builtin_amdgcn_cvt_pk_fp8_f32(blo(q0.y) * 16.f, bhi(q0.y) * 16.f, f0.x, true);
            f0.y = __builtin_amdgcn_cvt_pk_fp8_f32(blo(q0.z) * 16.f, bhi(q0.z) * 16.f, 0u, false); f0.y = __builtin_amdgcn_cvt_pk_fp8_f32(blo(q0.w) * 16.f, bhi(q0.w) * 16.f, f0.y, true);
            f1.x = __builtin_amdgcn_cvt_pk_fp8_f32(blo(q1.x) * 16.f, bhi(q1.x) * 16.f, 0u, false); f1.x = __builtin_amdgcn_cvt_pk_fp8_f32(blo(q1.y) * 16.f, bhi(q1.y) * 16.f, f1.x, true);
            f1.y = __builtin_amdgcn_cvt_pk_fp8_f32(blo(q1.z) * 16.f, bhi(q1.z) * 16.f, 0u, false); f1.y = __builtin_amdgcn_cvt_pk_fp8_f32(blo(q1.w) * 16.f, bhi(q1.w) * 16.f, f1.y, true);
#pragma unroll
            for (int k = 0; k < 4; ++k) { const unsigned e = rec[(r0 + k) * 3]; const unsigned pos = rec[(r0 + k) * 3 + 1] + baseL[e]; GAS v2u* drow = (GAS v2u*)((unsigned char*)XSV + ((size_t)e * M + pos) * D); drow[lane] = f0; drow[lane + 64] = f1; } }
        __syncthreads();
    }
}
DI void moe_tables(Frame& F, int l) {
    if (F.tid < 64) {
        const int e = F.lane & 31;
        const unsigned cnt = __hip_atomic_load((unsigned*)(F.ctl + CW_CNT + l * 2048 + e * 64), __ATOMIC_RELAXED, __HIP_MEMORY_SCOPE_AGENT);
        const unsigned nt = (cnt + 255u) >> 8;
        const unsigned inc = (unsigned)scan32_add((float)nt);
        const unsigned start = inc - nt;
        if (F.lane < 32) { F.LC[LC_CNT + e] = cnt; F.LC[LC_PSTART + e] = start;
#pragma clang loop vectorize(disable) unroll(disable)
            for (unsigned i = 0; i < nt; ++i) F.LC[LC_TILEE + start + i] = (unsigned)e; }
        if (F.lane == 31) { F.LC[LC_PSTART + 32] = inc; F.LC[LC_NT] = inc; }
    }
    __syncthreads();
}
DI void phase_gather(Frame& F, int l) {
    moe_tables(F, l);
    const unsigned* SLOT = (const unsigned*)(F.ws + WS_SLOT); const bf16* X1B = (const bf16*)(F.ws + WS_X1B); bf16* XS = (bf16*)(F.ws + WS_XS);
    const int nrows = (int)F.LC[LC_NT] * 256;
    for (int row = F.gw; row < nrows; row += F.NGW) {
        const int mt = row >> 8; const int e = (int)F.LC[LC_TILEE + mt]; const int pos = row - (int)F.LC[LC_PSTART + e] * 256;
        if (pos < (int)F.LC[LC_CNT + e]) { const unsigned t = SLOT[(size_t)e * M + pos];
            const GAS v4u* s = (const GAS v4u*)(X1B + (size_t)t * D); GAS v4u* d = (GAS v4u*)(XS + (size_t)row * D);
            d[F.lane] = s[F.lane]; d[F.lane + 64] = s[F.lane + 64]; }
    }
}
DI void phase_combine_ln2(Frame& F, KA a, int l) {
    moe_tables(F, l);
    const bf16* X1B = (const bf16*)(F.ws + WS_X1B); const unsigned* TREC = (const unsigned*)(F.ws + WS_TREC); const float* GATE = (const float*)(F.ws + WS_GATE);
    const unsigned char* YS = F.ws + WS_YS;     const bf16* PLEG = (const bf16*)(F.ws + WS_PLEG);
    bf16* XB = (bf16*)(F.ws + WS_XB);
    const float* g2 = a->in[43] + l * 1024; const float* b2 = a->in[44] + l * 1024; const int lane = F.lane;
    struct Tok { v2u xz[4], pz[4]; unsigned yz[4][4]; float gt[4]; };
    auto issue = [&](Tok& T, int t, const unsigned (&rr)[4], const float (&gg)[4]) {
#pragma unroll
        for (int j = 0; j < 4; ++j) { T.xz[j] = *(const v2u*)(X1B + (size_t)t * D + 4 * lane + 256 * j); T.pz[j] = *(const v2u*)(PLEG + (size_t)t * D + 4 * lane + 256 * j); }
#pragma unroll
        for (int k = 0; k < 4; ++k) { const size_t row = (size_t)F.LC[LC_PSTART + (rr[k] >> 20)] * 256 + (rr[k] & 0xfffffu); T.gt[k] = gg[k];
#pragma unroll
            for (int j = 0; j < 4; ++j) T.yz[k][j] = *(const unsigned*)(YS + row * D + 4 * lane + 256 * j); } };
    const int t0 = F.gw, nt = (M - t0 + F.NGW - 1) / F.NGW;
    unsigned r1[4], r2[4]; float g1_[4], g2_[4];
#pragma unroll
    for (int k = 0; k < 4; ++k) { r1[k] = TREC[(size_t)t0 * 4 + k]; g1_[k] = GATE[(size_t)t0 * 4 + k]; const int tb = (nt > 1) ? t0 + F.NGW : t0; r2[k] = TREC[(size_t)tb * 4 + k]; g2_[k] = GATE[(size_t)tb * 4 + k]; }
    Tok cur, nxt;
    issue(cur, t0, r1, g1_);
#pragma unroll 1
    for (int i = 0; i < nt; ++i) {
        const int t = t0 + i * F.NGW;
        if (i + 1 < nt) issue(nxt, t + F.NGW, r2, g2_);
        { const int tc = (i + 2 < nt) ? t + 2 * F.NGW : t;
#pragma unroll
          for (int k = 0; k < 4; ++k) { r2[k] = TREC[(size_t)tc * 4 + k]; g2_[k] = GATE[(size_t)tc * 4 + k]; } }
        f32x4 v[4], x[4];
#pragma unroll
        for (int j = 0; j < 4; ++j) v[j] = (f32x4){blo(cur.xz[j].x), bhi(cur.xz[j].x), blo(cur.xz[j].y), bhi(cur.xz[j].y)} * ALPHA + (f32x4){blo(cur.pz[j].x), bhi(cur.pz[j].x), blo(cur.pz[j].y), bhi(cur.pz[j].y)};
#pragma unroll
        for (int k = 0; k < 4; ++k)
#pragma unroll
            for (int j = 0; j < 4; ++j) { const unsigned yw = cur.yz[k][j]; const f32x2 ylo = __builtin_amdgcn_cvt_pk_f32_fp8(yw, false), yhi = __builtin_amdgcn_cvt_pk_f32_fp8(yw, true);
                v[j] = v[j] + (f32x4){ylo[0], ylo[1], yhi[0], yhi[1]} * (cur.gt[k] * (1.0f / 64.0f)); }
        ln_row(v, x, g2, b2, lane);
        if (l == NL - 1) {
#pragma unroll
            for (int j = 0; j < 4; ++j) *(f32x4*)(a->out + (size_t)t * D + 4 * lane + 256 * j) = x[j];
        } else {
#pragma unroll
            for (int j = 0; j < 4; ++j) { *(v2u*)(XB + (size_t)t * D + 4 * lane + 256 * j) = (v2u){pk2(x[j].x, x[j].y), pk2(x[j].z, x[j].w)};
                unsigned w8 = __builtin_amdgcn_cvt_pk_fp8_f32(x[j].x * 16.f, x[j].y * 16.f, 0u, false); *(unsigned*)(F.ws + WS_XB8 + (size_t)t * D + 4 * lane + 256 * j) = __builtin_amdgcn_cvt_pk_fp8_f32(x[j].z * 16.f, x[j].w * 16.f, w8, true); }
        }
        cur = nxt;
    }
}

constexpr int PH_PER_LAYER = 12, N_PHASES = 2 + NL * PH_PER_LAYER;
__global__ void __launch_bounds__(NTHR, 2) mega_fwd(Args args) {
    extern __shared__ __attribute__((aligned(16))) unsigned char lds_raw[];
    Frame F;
    F.lds = (LAS unsigned char*)lds_raw; F.LC = (LAS unsigned*)(F.lds + LDSCTL_OFF);
    F.G = gridDim.x; { const int bx = blockIdx.x; F.vcu = (F.G % 8 == 0) ? (bx % 8) * (F.G / 8) + bx / 8 : bx; }
    F.NGW = F.G * NWAVES; F.wave = __builtin_amdgcn_readfirstlane((int)threadIdx.x >> 6); rebind(F);
    F.ws = args.ws; F.ctl = (gu32*)(args.ws + WS_CTL);
    KA ap = (KA)__builtin_amdgcn_kernarg_segment_ptr();
#define PHASE_BEGIN() do { ap = (KA)__builtin_amdgcn_kernarg_segment_ptr(); asm volatile("" : "+s"(ap)); F.ws = ap->ws; F.ctl = (gu32*)(F.ws + WS_CTL); rebind(F); } while (0)
#pragma clang loop vectorize(disable) unroll(disable)
    for (int u = F.tid; u < LDSCTL_BYTES / 4; u += NTHR) F.LC[u] = 0u;
    __syncthreads();
    const int lo = args.ph_lo, hi = args.ph_hi;
    const bool multi = (hi - lo) > 1;
    XcdBarrier bar; bar.bar = (unsigned*)(F.ctl + CW_BAR); bar.x = 0; bar.st = nullptr;
    if (multi) bar = xcd_barrier_post((unsigned*)(F.ctl + CW_BAR), (volatile LAS unsigned*)(F.LC + LC_BAR));
#ifndef PHMASK
#define PHMASK 0xffffffffu
#endif
#ifndef DUPMASK
#define DUPMASK 0x0u
#endif
#define EN(j) ((PHMASK >> (j)) & 1u)
#define DUP(j) ((DUPMASK >> (j)) & 1u)
#define IN(k) (lo <= (k) && (k) < hi)
#define SEAM(k) do { if (IN(k) && IN((k) + 1)) xcd_barrier(bar); } while (0)
    LAS unsigned char* ring = F.lds;

    PHASE_BEGIN(); if (EN(0) && IN(0)) { p0_convert(F, ap); if (DUP(0)) { __syncthreads(); p0_convert(F, ap); } } SEAM(0);
    PHASE_BEGIN(); if (EN(1) && IN(1)) { for (int rep_ = 0; rep_ < 1 + (int)DUP(1); ++rep_) { if (rep_) __syncthreads();
        pg8::Gemm g{(const bf16*)(F.ws + WS_PB), (const bf16*)(F.ws + WS_WPP), NL * M, NL * 1024, DPLE};
        pg8::LayerGroupOrder S{F.G, (int)blockIdx.x};
        pg8::EpiB16<4> E{(bf16*)(F.ws + WS_PP), 1024, nullptr};
        pg8::gemm_phase<pg8::EpiB16<4>, pg8::LayerGroupOrder, PG8_ALIGN, PG8_SP2>(ring, g, S, E, F.tid); }
    } SEAM(1);

    for (int l = 0; l < NL; ++l) {
        const int pb = 2 + l * PH_PER_LAYER;
        PHASE_BEGIN(); if (EN(2) && IN(pb + 0)) { for (int rep_ = 0; rep_ < 1 + (int)DUP(2); ++rep_) { if (rep_) __syncthreads();
            { pg8::Gemm g{(const bf16*)(F.ws + WS_XB8), (const bf16*)(F.ws + WS_WIN8 + (size_t)l * 4096 * 1024), M, 4096, D / 2};
              pg8::StaticOrder S; S.init(M, 4096, F.G, (int)blockIdx.x);
              pg8::EpiGate8 E{F.ws + WS_MF};
              pg8::gemm_phase<pg8::EpiGate8, pg8::StaticOrder, PG8_ALIGN, PG8_SP2, true, 0x79, 0x7b>(ring, g, S, E, F.tid); }
            { pg8::Gemm g{(const bf16*)(F.ws + WS_XB), (const bf16*)(F.ws + WS_WIN) + (size_t)l * ZLD * 1024, M, ZG, D};
              pg8::StaticOrder S; S.init(M, ZG, F.G, (int)blockIdx.x);
              pg8::EpiB16<0> E{(bf16*)(F.ws + WS_Z), ZLD, nullptr};
              pg8::gemm_phase<pg8::EpiB16<0>, pg8::StaticOrder, PG8_ALIGN, PG8_SP2>(ring, g, S, E, F.tid); } }
        } SEAM(pb + 0);
        PHASE_BEGIN(); if (EN(3) && IN(pb + 1)) { phase_prep(F, ap, l); if (DUP(3)) { __syncthreads(); phase_prep(F, ap, l); } } SEAM(pb + 1);
        PHASE_BEGIN(); if (EN(14) && IN(pb + 2)) { phase_chunkprep(F, ap, l); if (DUP(14)) { __syncthreads(); phase_chunkprep(F, ap, l); } } SEAM(pb + 2);
        PHASE_BEGIN(); if (EN(4) && IN(pb + 3)) { phase_scan(F, ap, l); if (DUP(4)) { __syncthreads(); phase_scan(F, ap, l); } } SEAM(pb + 3);
        PHASE_BEGIN(); if (EN(5) && IN(pb + 4)) { phase_post(F, ap, l); if (DUP(5)) { __syncthreads(); phase_post(F, ap, l); } } SEAM(pb + 4);
        PHASE_BEGIN(); if (EN(6) && IN(pb + 5)) { for (int rep_ = 0; rep_ < 1 + (int)DUP(6); ++rep_) { if (rep_) __syncthreads();
            pg8::Gemm g{(const bf16*)(F.ws + WS_Y), (const bf16*)(F.ws + WS_WBR + (size_t)l * 4 * 1024 * 512), 4 * M, 4 * 1024, W / 2};
            pg8::BranchOrder S; S.base.init(M, D, F.G, (int)blockIdx.x);
            pg8::EpiBranch E{F.ws + WS_MF, F.ws + WS_MB};
            pg8::gemm_phase<pg8::EpiBranch, pg8::BranchOrder, PG8_ALIGN, PG8_SP2, true, 0x79, 0x7c>(ring, g, S, E, F.tid); }
        } SEAM(pb + 5);
        PHASE_BEGIN(); if (EN(7) && IN(pb + 6)) { for (int rep_ = 0; rep_ < 1 + (int)DUP(7); ++rep_) { if (rep_) __syncthreads();
            pg8::Gemm g{(const bf16*)(F.ws + WS_MB), (const bf16*)(F.ws + WS_WOUT + (size_t)l * 1024 * 1024), M, D, D / 2};
            pg8::StaticOrder S; S.init(M, D, F.G, (int)blockIdx.x);
            pg8::EpiWout E{(const bf16*)(F.ws + WS_XB), (bf16*)(F.ws + WS_PRE), ALPHA};
            pg8::gemm_phase<pg8::EpiWout, pg8::StaticOrder, PG8_ALIGN, PG8_SP2, true, 0x79, 0x7b>(ring, g, S, E, F.tid); }
        } SEAM(pb + 6);
        PHASE_BEGIN(); if (EN(8) && IN(pb + 7)) { phase_ln1_router(F, ap, l); } SEAM(pb + 7);
        PHASE_BEGIN(); if (EN(10) && IN(pb + 8)) { for (int rep_ = 0; rep_ < 1 + (int)DUP(10); ++rep_) { if (rep_) __syncthreads();
            moe_tables(F, l);
            { pg8::Gemm g{(const bf16*)(F.ws + WS_XSV), (const bf16*)(F.ws + WS_WGU + (size_t)l * NE * 2048 * 1024), NE * M, NE * 2048, D / 2};
              pg8::MoeOrder<8, true> S{(const LAS int*)(F.LC + LC_TILEE), (const LAS int*)(F.LC + LC_PSTART), __builtin_amdgcn_readfirstlane((int)F.LC[LC_NT]), F.G, F.vcu};
              pg8::EpiGU E{(bf16*)(F.ws + WS_H), ap->in[38] + (size_t)l * NE * 2048};
              pg8::gemm_phase<pg8::EpiGU, pg8::MoeOrder<8, true>, PG8_ALIGN, PG8_SP2, true, 0x79, 0x7b>(ring, g, S, E, F.tid);     } }
        }
        PHASE_BEGIN(); if (EN(13) && IN(pb + 9)) { for (int rep_ = 0; rep_ < 1 + (int)DUP(13); ++rep_) { if (rep_) __syncthreads();
            { pg8::Gemm g{(const bf16*)(F.ws + WS_X1B8), (const bf16*)(F.ws + WS_WPG8 + (size_t)l * 1024 * 1024), M, D, D / 2};
              pg8::StaticOrder S; S.init(M, D, F.G, (int)blockIdx.x);
              pg8::EpiPle E{(const bf16*)(F.ws + WS_PP) + (size_t)l * M * 1024, (bf16*)(F.ws + WS_PLEG)};
              pg8::gemm_phase<pg8::EpiPle, pg8::StaticOrder, PG8_ALIGN, PG8_SP2, true, 0x79, 0x7b>(ring, g, S, E, F.tid); } }
        } SEAM(pb + 9);
        PHASE_BEGIN(); if (EN(11) && IN(pb + 10)) { for (int rep_ = 0; rep_ < 1 + (int)DUP(11); ++rep_) { if (rep_) __syncthreads();
            moe_tables(F, l);
            pg8::Gemm g{(const bf16*)(F.ws + WS_H), (const bf16*)(F.ws + WS_WDN + (size_t)l * NE * 1024 * 1024), MOE_ROWS, NE * 1024, D / 2};
            pg8::MoeOrder<4, false> S{(const LAS int*)(F.LC + LC_TILEE), (const LAS int*)(F.LC + LC_PSTART), __builtin_amdgcn_readfirstlane((int)F.LC[LC_NT]), F.G, F.vcu};
            pg8::EpiYS8 E{F.ws + WS_YS, ap->in[40] + (size_t)l * NE * 1024};
            pg8::gemm_phase<pg8::EpiYS8, pg8::MoeOrder<4, false>, PG8_ALIGN, PG8_SP2, true, 0x79, 0x7d>(ring, g, S, E, F.tid);     }
        } SEAM(pb + 10);
        PHASE_BEGIN(); if (EN(12) && IN(pb + 11)) { phase_combine_ln2(F, ap, l); if (DUP(12)) { __syncthreads(); phase_combine_ln2(F, ap, l); } } SEAM(pb + 11);
    }
#undef IN
#undef SEAM
}

#ifndef MK_ONE_LAUNCH
#define MK_ONE_LAUNCH 1
#endif
extern "C" void kernel_launch(void* const* d_in, const int* in_sizes, int n_in, void* d_out, int out_size, void* d_ws, size_t ws_size, hipStream_t stream) {
    static int grid = 0;
    if (grid == 0) {
        if (n_in != 45 || out_size != M * D || ws_size < WS_END) { fprintf(stderr, "kernel_launch: unexpected problem (n_in %d, out %d, ws %zu)\n", n_in, out_size, ws_size); grid = -1; return; }
        int dev = 0, cus = 0, per_cu = 0;
        if (hipGetDevice(&dev) != hipSuccess || hipDeviceGetAttribute(&cus, hipDeviceAttributeMultiprocessorCount, dev) != hipSuccess) { grid = -1; return; }
        if (hipFuncSetAttribute((const void*)mega_fwd, hipFuncAttributeMaxDynamicSharedMemorySize, LDS_BYTES) != hipSuccess) { fprintf(stderr, "kernel_launch: hipFuncSetAttribute failed\n"); grid = -1; return; }
        if (hipOccupancyMaxActiveBlocksPerMultiprocessor(&per_cu, (const void*)mega_fwd, NTHR, LDS_BYTES) != hipSuccess || per_cu < 1) fprintf(stderr, "kernel_launch: occupancy query says %d\n", per_cu);
        (void)hipGetLastError();
        grid = cus;
    }
    if (grid < 0) return;
    if (hipMemsetAsync((char*)d_ws + WS_CTL, 0, CTL_ZERO_BYTES, stream) != hipSuccess) return;
    Args a{};
    for (int i = 0; i < 45; ++i) a.in[i] = (const float*)d_in[i];
    a.out = (float*)d_out; a.ws = (unsigned char*)d_ws;
#if MK_ONE_LAUNCH
    a.ph_lo = 0; a.ph_hi = N_PHASES;
    hipLaunchKernelGGL(mega_fwd, dim3(grid), dim3(NTHR), LDS_BYTES, stream, a);
#else
    for (int ph = 0; ph < N_PHASES; ++ph) { a.ph_lo = ph; a.ph_hi = ph + 1; hipLaunchKernelGGL(mega_fwd, dim3(grid), dim3(NTHR), LDS_BYTES, stream, a); }
#endif
}
```

```cpp
#include <hip/hip_runtime.h>
#include <cstdio>
#include <cstdint>
namespace pg8 {
#define PG8_LAS __attribute__((address_space(3)))
typedef unsigned short bf16_t;
typedef short bf16x8 __attribute__((ext_vector_type(8)));
typedef float f32x4 __attribute__((ext_vector_type(4)));
typedef unsigned u32x4 __attribute__((ext_vector_type(4)));
constexpr int BM = 256, BK = 64, HALF = 128, HTB = HALF * BK * 2  , STAGE_BYTES = 8 * HTB, NXCD = 8, WGM = 8;

__host__ __device__ __forceinline__ int lds_byte(int r, int c) { const int st = (r >> 4) * 2 + (c >> 5), rr = r & 15, cc = c & 31, ob = rr * 64 + cc * 2; return st * 1024 + (ob ^ (((ob >> 9) & 1) << 5)); }
__host__ __device__ __forceinline__ void stage_rc(int b, int& R, int& C) { const int st = b / 1024, sb = b % 1024, swz = sb ^ (((sb >> 9) & 1) << 5); R = (st >> 1) * 16 + swz / 64; C = (st & 1) * 32 + (swz % 64) / 2; }
__host__ __device__ __forceinline__ int perm32(int rho) { const int n = rho >> 4, i = rho & 15; return 8 * (i >> 2) + 4 * n + (i & 3); }

struct Unit { int pm, pn, po; };
struct Gemm { const bf16_t* A; const bf16_t* Bt; int M, N, K; };

struct StaticOrder {
    int nM, nN, nwg, G, c;
    __host__ __device__ void init(int M, int N, int G_, int c_) { nM = M / BM; nN = N / BM; nwg = nM * nN; G = G_; c = c_; }
    __host__ __device__ bool next(int i, Unit& u) const {
        const long L = (long)i * G + c; if (L >= nwg) return false;
        int wgid = (int)L; { const int q = nwg / NXCD, r = nwg % NXCD, xcd = wgid % NXCD, off = wgid / NXCD; wgid = (xcd < r ? xcd * (q + 1) : r * (q + 1) + (xcd - r) * q) + off; }
        const int nig = WGM * nN, gid = wgid / nig, fm = gid * WGM, gsz = (nM - fm) < WGM ? (nM - fm) : WGM;
        u.pm = fm + ((wgid % nig) % gsz); u.pn = (wgid % nig) / gsz; return true;
    }
    __device__ __forceinline__ void a_ready(const Unit&) const {}
    __device__ __forceinline__ void done(const Unit&) const {}
};

__device__ __forceinline__ unsigned cvt_pk_bf16(float lo, float hi) { unsigned r; asm volatile("v_cvt_pk_bf16_f32 %0, %1, %2" : "=v"(r) : "v"(lo), "v"(hi)); return r; }
typedef float f32x2 __attribute__((ext_vector_type(2)));
__device__ __forceinline__ int lane_id_fresh() { int l; asm volatile("v_mbcnt_lo_u32_b32 %0, -1, 0\n\tv_mbcnt_hi_u32_b32 %0, -1, %0" : "=v"(l)); return l; }
__device__ __forceinline__ f32x2 gelu_pk(f32x2 v) {
    const f32x2 av = __builtin_elementwise_abs(v), d = av * 0.2316418882f + 1.0f;
    f32x2 t; t.x = __builtin_amdgcn_rcpf(d.x); t.y = __builtin_amdgcn_rcpf(d.y);
    f32x2 q = t * 0.5307027145f + (-0.7265760135f); q = q * t + 0.7107068705f; q = q * t + (-0.142248368f); q = q * t + 0.127414796f; q = q * t;
    const f32x2 s = (v * v) * (-0.72134752044f);
    f32x2 e; e.x = __builtin_amdgcn_exp2f(s.x); e.y = __builtin_amdgcn_exp2f(s.y);
    const f32x2 m = v * (q * e), r = v - m;
    f32x2 o; o.x = v.x < 0.f ? m.x : r.x; o.y = v.y < 0.f ? m.y : r.y; return o;
}

template <int ACT  > struct EpiBf16 {
    static constexpr bool PERM = true, AFTER_DRAIN = false; static_assert(ACT == 0 || ACT == 1, "EpiBf16: ACT is 0 (none) or 1 (gelu_pk)");
    bf16_t* O; int ldc; const float* bias; int split_cols; size_t split_stride; float scale0;
    __device__ __forceinline__ void operator()(const f32x4 (&acc)[2][2][4][2], const Unit& u, int wr, int wc, int fr, int fq) const {
        const int row0 = u.pm * BM + wr * 64 + fr; int colt = u.pn * BM; bf16_t* base = O;
        float sc = 1.f; if (split_cols) { const int t = colt / split_cols; base += (size_t)t * split_stride; colt -= t * split_cols; if (t == 0) sc = scale0; }
        const int col0 = colt + wc * 32 + 8 * fq, bcol0 = u.pn * BM + wc * 32 + 8 * fq;
        f32x4 bv[2][2];
#pragma unroll
        for (int bj = 0; bj < 2; ++bj)
#pragma unroll
            for (int n = 0; n < 2; ++n) bv[bj][n] = bias ? *(const f32x4*)(bias + bcol0 + bj * HALF + 4 * n) : (f32x4){0.f, 0.f, 0.f, 0.f};
#pragma unroll
        for (int ai = 0; ai < 2; ++ai)
#pragma unroll
            for (int m = 0; m < 4; ++m) { bf16_t* rowp = base + (size_t)(row0 + ai * HALF + m * 16) * ldc + col0;
#pragma unroll
                for (int bj = 0; bj < 2; ++bj) { f32x4 v0 = acc[ai][bj][m][0] + bv[bj][0], v1 = acc[ai][bj][m][1] + bv[bj][1];
                    if (ACT == 1) { f32x2 a = gelu_pk((f32x2){v0[0], v0[1]}), b = gelu_pk((f32x2){v0[2], v0[3]}), c = gelu_pk((f32x2){v1[0], v1[1]}), d = gelu_pk((f32x2){v1[2], v1[3]});
                        v0 = (f32x4){a.x, a.y, b.x, b.y}; v1 = (f32x4){c.x, c.y, d.x, d.y}; }
                    v0 = v0 * sc; v1 = v1 * sc; u32x4 w; w.x = cvt_pk_bf16(v0[0], v0[1]); w.y = cvt_pk_bf16(v0[2], v0[3]); w.z = cvt_pk_bf16(v1[0], v1[1]); w.w = cvt_pk_bf16(v1[2], v1[3]);
                    *(u32x4*)(rowp + bj * HALF) = w; } }
    }
};


constexpr int ZLD = 11264;
__device__ __forceinline__ float bflo(unsigned w) { return __builtin_bit_cast(float, w << 16); }
__device__ __forceinline__ float bfhi(unsigned w) { return __builtin_bit_cast(float, w & 0xffff0000u); }
__device__ __forceinline__ float sigm(float x) { return __builtin_amdgcn_rcpf(1.0f + __expf(-x)); }
__device__ __forceinline__ float clamp8(float x) { return __builtin_fminf(__builtin_fmaxf(x, -448.0f), 448.0f); }

struct EpiBranch {
    static constexpr bool PERM = true, AFTER_DRAIN = false, KEEP_ACC = true;
    const unsigned char* G8; unsigned char* MB8;
    __device__ __forceinline__ void operator()(f32x4 (&acc)[2][2][4][2], const Unit& u, int wr, int wc, int fr, int fq) const {
        const int n = u.pn >> 2, pn = u.pn & 3, pm = u.pm & 63;
        const int row0 = pm * BM + wr * 64 + fr, col0 = pn * BM + wc * 32 + 8 * fq;
        typedef unsigned u32x2b_ __attribute__((ext_vector_type(2)));
#pragma unroll
        for (int ai = 0; ai < 2; ++ai)
#pragma unroll
            for (int m = 0; m < 4; ++m) { const size_t row = (size_t)(row0 + ai * HALF + m * 16);
#pragma unroll
                for (int bj = 0; bj < 2; ++bj) { const int c = col0 + bj * HALF;
                    const unsigned char* gp = G8 + row * 4096 + n * 1024 + c;
                    const u32x2b_ gq = *(const u32x2b_*)gp;
                    f32x4 s0 = (f32x4){(float)(gq.x & 255u), (float)((gq.x >> 8) & 255u), (float)((gq.x >> 16) & 255u), (float)(gq.x >> 24)}, s1 = (f32x4){(float)(gq.y & 255u), (float)((gq.y >> 8) & 255u), (float)((gq.y >> 16) & 255u), (float)(gq.y >> 24)};
                    if (n < 3) { const u32x2b_ hq = *(const u32x2b_*)(gp + 1024);
                        s0[0] *= __builtin_amdgcn_rcpf((float)(hq.x & 255u)); s0[1] *= __builtin_amdgcn_rcpf((float)((hq.x >> 8) & 255u)); s0[2] *= __builtin_amdgcn_rcpf((float)((hq.x >> 16) & 255u)); s0[3] *= __builtin_amdgcn_rcpf((float)(hq.x >> 24));
                        s1[0] *= __builtin_amdgcn_rcpf((float)(hq.y & 255u)); s1[1] *= __builtin_amdgcn_rcpf((float)((hq.y >> 8) & 255u)); s1[2] *= __builtin_amdgcn_rcpf((float)((hq.y >> 16) & 255u)); s1[3] *= __builtin_amdgcn_rcpf((float)(hq.y >> 24));
                        acc[ai][bj][m][0] = acc[ai][bj][m][0] * s0; acc[ai][bj][m][1] = acc[ai][bj][m][1] * s1; }
                    else { const f32x4 v0 = acc[ai][bj][m][0] * s0 * (16.0f / 255.0f), v1 = acc[ai][bj][m][1] * s1 * (16.0f / 255.0f);
                        unsigned w0 = 0u, w1 = 0u;
                        w0 = __builtin_amdgcn_cvt_pk_fp8_f32(clamp8(v0[0]), clamp8(v0[1]), w0, false); w0 = __builtin_amdgcn_cvt_pk_fp8_f32(clamp8(v0[2]), clamp8(v0[3]), w0, true);
                        w1 = __builtin_amdgcn_cvt_pk_fp8_f32(clamp8(v1[0]), clamp8(v1[1]), w1, false); w1 = __builtin_amdgcn_cvt_pk_fp8_f32(clamp8(v1[2]), clamp8(v1[3]), w1, true);
                        *(u32x2b_*)(MB8 + row * 1024 + c) = (u32x2b_){w0, w1};
                        acc[ai][bj][m][0] = (f32x4){0.f, 0.f, 0.f, 0.f}; acc[ai][bj][m][1] = (f32x4){0.f, 0.f, 0.f, 0.f}; } } }
    }
};
struct EpiGate8 {
    static constexpr bool PERM = true, AFTER_DRAIN = false;
    unsigned char* G8;
    __device__ __forceinline__ void operator()(const f32x4 (&acc)[2][2][4][2], const Unit& u, int wr, int wc, int fr, int fq) const {
        const int row0 = u.pm * BM + wr * 64 + fr, col0 = u.pn * BM + wc * 32 + 8 * fq;
        typedef unsigned u32x2b_ __attribute__((ext_vector_type(2)));
#pragma unroll
        for (int ai = 0; ai < 2; ++ai)
#pragma unroll
            for (int m = 0; m < 4; ++m) { unsigned char* rowp = G8 + (size_t)(row0 + ai * HALF + m * 16) * 4096 + col0;
#pragma unroll
                for (int bj = 0; bj < 2; ++bj) { const f32x4 v0 = acc[ai][bj][m][0], v1 = acc[ai][bj][m][1]; unsigned q[8];
#pragma unroll
                    for (int i = 0; i < 4; ++i) { q[i] = (unsigned)__builtin_fmaxf(255.0f * sigm(v0[i]) + 0.5f, 1.0f); q[4 + i] = (unsigned)__builtin_fmaxf(255.0f * sigm(v1[i]) + 0.5f, 1.0f); }
                    *(u32x2b_*)(rowp + bj * HALF) = (u32x2b_){q[0] | (q[1] << 8) | (q[2] << 16) | (q[3] << 24), q[4] | (q[5] << 8) | (q[6] << 16) | (q[7] << 24)}; } }
    }
};
struct EpiWout {
    static constexpr bool PERM = true, AFTER_DRAIN = false;
    const bf16_t* XB; bf16_t* PRE; float alpha;
    __device__ __forceinline__ void operator()(const f32x4 (&acc)[2][2][4][2], const Unit& u, int wr, int wc, int fr, int fq) const {
        const int row0 = u.pm * BM + wr * 64 + fr, col0 = u.pn * BM + wc * 32 + 8 * fq;
#pragma unroll
        for (int ai = 0; ai < 2; ++ai)
#pragma unroll
            for (int m = 0; m < 4; ++m) { const size_t ro = (size_t)(row0 + ai * HALF + m * 16) * 1024 + col0;
#pragma unroll
                for (int bj = 0; bj < 2; ++bj) { const u32x4 xz = *(const u32x4*)(XB + ro + bj * HALF); const f32x4 v0 = acc[ai][bj][m][0], v1 = acc[ai][bj][m][1];
                    u32x4 w; w.x = cvt_pk_bf16(bflo(xz.x) * alpha + v0[0], bfhi(xz.x) * alpha + v0[1]); w.y = cvt_pk_bf16(bflo(xz.y) * alpha + v0[2], bfhi(xz.y) * alpha + v0[3]);
                    w.z = cvt_pk_bf16(bflo(xz.z) * alpha + v1[0], bfhi(xz.z) * alpha + v1[1]); w.w = cvt_pk_bf16(bflo(xz.w) * alpha + v1[2], bfhi(xz.w) * alpha + v1[3]);
                    *(u32x4*)(PRE + ro + bj * HALF) = w; } }
    }
};
struct EpiGU {
    static constexpr bool PERM = true, AFTER_DRAIN = false;
    bf16_t* H; const float* bgu;
    __device__ __forceinline__ void operator()(const f32x4 (&acc)[2][2][4][2], const Unit& u, int wr, int wc, int fr, int fq) const {
        const int e = u.pn >> 3, j = u.pn & 7;
        const int row0 = u.po * BM + wr * 64 + fr, cl = j * 128 + wc * 32 + 8 * fq;
        const float* bg = bgu + (size_t)e * 2048 + cl; const float* bu = bg + 1024;
        const f32x4 bg0 = *(const f32x4*)bg, bg1 = *(const f32x4*)(bg + 4), bu0 = *(const f32x4*)bu, bu1 = *(const f32x4*)(bu + 4);
#pragma unroll
        for (int ai = 0; ai < 2; ++ai)
#pragma unroll
            for (int m = 0; m < 4; ++m) { const size_t row = (size_t)(row0 + ai * HALF + m * 16);
                f32x4 g0 = acc[ai][0][m][0] + bg0, g1 = acc[ai][0][m][1] + bg1, u0 = acc[ai][1][m][0] + bu0, u1 = acc[ai][1][m][1] + bu1;
                f32x4 h0, h1;
#pragma unroll
                for (int i = 0; i < 4; ++i) {
                    const float ga = fminf(g0[i], 7.0f), ua = fminf(fmaxf(u0[i], -7.0f), 7.0f); h0[i] = (ua + 1.0f) * ga * sigm(1.702f * ga);
                    const float gb = fminf(g1[i], 7.0f), ub = fminf(fmaxf(u1[i], -7.0f), 7.0f); h1[i] = (ub + 1.0f) * gb * sigm(1.702f * gb); }
                unsigned w0 = 0u, w1 = 0u;
                w0 = __builtin_amdgcn_cvt_pk_fp8_f32(h0[0] * 4.f, h0[1] * 4.f, w0, false); w0 = __builtin_amdgcn_cvt_pk_fp8_f32(h0[2] * 4.f, h0[3] * 4.f, w0, true);
                w1 = __builtin_amdgcn_cvt_pk_fp8_f32(h1[0] * 4.f, h1[1] * 4.f, w1, false); w1 = __builtin_amdgcn_cvt_pk_fp8_f32(h1[2] * 4.f, h1[3] * 4.f, w1, true);
                typedef unsigned u32x2_ __attribute__((ext_vector_type(2)));
                *(u32x2_*)((unsigned char*)H + row * 1024 + cl) = (u32x2_){w0, w1}; }
    }
};
struct EpiPle {
    static constexpr bool PERM = true, AFTER_DRAIN = false;
    const bf16_t* PP; bf16_t* PLEG;
    __device__ __forceinline__ void operator()(const f32x4 (&acc)[2][2][4][2], const Unit& u, int wr, int wc, int fr, int fq) const {
        const int row0 = u.pm * BM + wr * 64 + fr, col0 = u.pn * BM + wc * 32 + 8 * fq;
#pragma unroll
        for (int ai = 0; ai < 2; ++ai)
#pragma unroll
            for (int m = 0; m < 4; ++m) { const size_t ro = (size_t)(row0 + ai * HALF + m * 16) * 1024 + col0;
#pragma unroll
                for (int bj = 0; bj < 2; ++bj) { const u32x4 pz = *(const u32x4*)(PP + ro + bj * HALF);
                    const f32x4 v0 = acc[ai][bj][m][0], v1 = acc[ai][bj][m][1];
                    u32x4 w; w.x = cvt_pk_bf16(sigm(v0[0]) * bflo(pz.x), sigm(v0[1]) * bfhi(pz.x)); w.y = cvt_pk_bf16(sigm(v0[2]) * bflo(pz.y), sigm(v0[3]) * bfhi(pz.y));
                    w.z = cvt_pk_bf16(sigm(v1[0]) * bflo(pz.z), sigm(v1[1]) * bfhi(pz.z)); w.w = cvt_pk_bf16(sigm(v1[2]) * bflo(pz.w), sigm(v1[3]) * bfhi(pz.w));
                    *(u32x4*)(PLEG + ro + bj * HALF) = w; } }
    }
};

template <int NTN> struct EpiB16 {
    static constexpr bool PERM = true, AFTER_DRAIN = false;
    bf16_t* O; int ldc; const float* bias; int gate_tile0 = 1 << 30;
    __device__ __forceinline__ void operator()(const f32x4 (&acc)[2][2][4][2], const Unit& u, int wr, int wc, int fr, int fq) const {
        const int row0 = u.pm * BM + wr * 64 + fr, col0 = (NTN ? (u.pn % NTN) : u.pn) * BM + wc * 32 + 8 * fq, bcol0 = u.pn * BM + wc * 32 + 8 * fq;
        f32x4 bv[2][2];
#pragma unroll
        for (int bj = 0; bj < 2; ++bj)
#pragma unroll
            for (int n = 0; n < 2; ++n) bv[bj][n] = bias ? *(const f32x4*)(bias + bcol0 + bj * HALF + 4 * n) : (f32x4){0.f, 0.f, 0.f, 0.f};
#pragma unroll
        for (int ai = 0; ai < 2; ++ai)
#pragma unroll
            for (int m = 0; m < 4; ++m) { bf16_t* rowp = O + (size_t)(row0 + ai * HALF + m * 16) * ldc + col0;
#pragma unroll
                for (int bj = 0; bj < 2; ++bj) { f32x4 v0 = acc[ai][bj][m][0] + bv[bj][0], v1 = acc[ai][bj][m][1] + bv[bj][1];
                    if (u.pn >= gate_tile0) {
#pragma unroll
                        for (int i = 0; i < 4; ++i) { v0[i] = 1.0f + __expf(-v0[i]); v1[i] = 1.0f + __expf(-v1[i]); } }
                    u32x4 w; w.x = cvt_pk_bf16(v0[0], v0[1]); w.y = cvt_pk_bf16(v0[2], v0[3]); w.z = cvt_pk_bf16(v1[0], v1[1]); w.w = cvt_pk_bf16(v1[2], v1[3]);
                    *(u32x4*)(rowp + bj * HALF) = w; } }
    }
};
struct EpiYS8 {
    static constexpr bool PERM = true, AFTER_DRAIN = false;
    unsigned char* O; const float* bias;
    __device__ __forceinline__ void operator()(const f32x4 (&acc)[2][2][4][2], const Unit& u, int wr, int wc, int fr, int fq) const {
        const int row0 = u.pm * BM + wr * 64 + fr, col0 = (u.pn & 3) * BM + wc * 32 + 8 * fq, bcol0 = u.pn * BM + wc * 32 + 8 * fq;
        typedef unsigned u32x2b_ __attribute__((ext_vector_type(2)));
        f32x4 bv[2][2];
#pragma unroll
        for (int bj = 0; bj < 2; ++bj)
#pragma unroll
            for (int n = 0; n < 2; ++n) bv[bj][n] = *(const f32x4*)(bias + bcol0 + bj * HALF + 4 * n);
#pragma unroll
        for (int ai = 0; ai < 2; ++ai)
#pragma unroll
            for (int m = 0; m < 4; ++m) { unsigned char* rowp = O + (size_t)(row0 + ai * HALF + m * 16) * 1024 + col0;
#pragma unroll
                for (int bj = 0; bj < 2; ++bj) { const f32x4 v0 = (acc[ai][bj][m][0] + bv[bj][0]) * 64.0f, v1 = (acc[ai][bj][m][1] + bv[bj][1]) * 64.0f;
                    unsigned w0 = 0u, w1 = 0u;
                    w0 = __builtin_amdgcn_cvt_pk_fp8_f32(clamp8(v0[0]), clamp8(v0[1]), w0, false); w0 = __builtin_amdgcn_cvt_pk_fp8_f32(clamp8(v0[2]), clamp8(v0[3]), w0, true);
                    w1 = __builtin_amdgcn_cvt_pk_fp8_f32(clamp8(v1[0]), clamp8(v1[1]), w1, false); w1 = __builtin_amdgcn_cvt_pk_fp8_f32(clamp8(v1[2]), clamp8(v1[3]), w1, true);
                    *(u32x2b_*)(rowp + bj * HALF) = (u32x2b_){w0, w1}; } }
    }
};
struct LayerGroupOrder {
    int G, c;
    __device__ __forceinline__ bool next(int i, Unit& u) const { const int L = i * G + c; if (L >= 1024) return false; const int l = L >> 8, r = L & 255; u.pm = l * 64 + (r >> 2); u.pn = l * 4 + (r & 3); return true; }
    __device__ __forceinline__ void a_ready(const Unit&) const {}
    __device__ __forceinline__ void done(const Unit&) const {}
};
struct BranchOrder {
    StaticOrder base;
    __device__ __forceinline__ bool next(int i, Unit& u) const { Unit b; if (!base.next(i >> 2, b)) return false; const int n = i & 3; u.pm = b.pm + 64 * n; u.pn = b.pn + 4 * n; return true; }
    __device__ __forceinline__ void a_ready(const Unit&) const {}
    __device__ __forceinline__ void done(const Unit&) const {}
};
template <int NT, bool VIRT> struct MoeOrder {
    const PG8_LAS int* tileE; const PG8_LAS int* pstart; int ntiles, G, c;
    __device__ __forceinline__ bool next(int i, Unit& u) const { const int L = i * G + c; if (L >= ntiles * NT) return false; const int mt = L / NT, j = L % NT; const int e = __builtin_amdgcn_readfirstlane(tileE[mt]);
        u.po = mt; u.pm = VIRT ? 64 * e + (mt - __builtin_amdgcn_readfirstlane(pstart[e])) : mt; u.pn = e * NT + j; return true; }
    __device__ __forceinline__ void a_ready(const Unit&) const {}
    __device__ __forceinline__ void done(const Unit&) const {}
};
template <class E, class = void> struct epi_keeps_acc { static constexpr bool value = false; };
template <class E> struct epi_keeps_acc<E, decltype((void)E::KEEP_ACC)> { static constexpr bool value = E::KEEP_ACC; };
typedef int i32x4 __attribute__((ext_vector_type(4))); typedef int i32x8 __attribute__((ext_vector_type(8)));
__device__ __forceinline__ i32x8 cat8(bf16x8 lo, bf16x8 hi) { return __builtin_shufflevector(__builtin_bit_cast(i32x4, lo), __builtin_bit_cast(i32x4, hi), 0, 1, 2, 3, 4, 5, 6, 7); }
template <class Epi, class Sched, bool ALIGN_EPI = false, bool SP2 = false, bool F8 = false, int F8_SW = 0x7f, int F8_SX = 0x7f>
__device__ __forceinline__ void gemm_phase(PG8_LAS unsigned char* lds, const Gemm g, const Sched& S, const Epi& E, int tid_in) {
    int tid = tid_in; asm volatile("" : "+v"(tid));
    const int wid = __builtin_amdgcn_readfirstlane(tid >> 6), lane = tid & 63, wr = wid >> 2, wc = wid & 3, fr = lane & 15, fq = lane >> 4;
    const int K = g.K, nt = K / BK;
    int f8sw = F8_SW, f8sx = F8_SX; if constexpr (F8) asm volatile("" : "+v"(f8sw), "+v"(f8sx));
    unsigned voffA[2], voffB[2];
#pragma unroll
    for (int i = 0; i < 2; ++i) { int R, C; stage_rc(tid * 16 + i * 8192, R, C); const int Rb = Epi::PERM ? ((R & ~31) + perm32(R & 31)) : R;
        voffA[i] = (unsigned)(R * K + C) * 2u; voffB[i] = (unsigned)(Rb * K + C) * 2u; }
    asm volatile("" : "+v"(voffA[0]), "+v"(voffA[1]), "+v"(voffB[0]), "+v"(voffB[1]));
    const size_t kstep = (size_t)(BK * 2);
    const size_t hstep = (size_t)HALF * K * 2;
    const size_t tstep = 2 * hstep;
    const unsigned ldsw = (unsigned)wid * 1024u;
    const int aoff = lds_byte(wr * 64 + fr, fq * 8), boff = lds_byte(wc * 32 + fr, fq * 8);
#define PG8_SA(b, h) (((b) * 2 + (h)) * HTB)
#define PG8_SB(b, h) ((4 + (b) * 2 + (h)) * HTB)
#define PG8_STAGE(bufoff, gbase, voff) do { _Pragma("unroll") for (int _i = 0; _i < 2; ++_i) \
        __builtin_amdgcn_global_load_lds((const unsigned*)((const char*)(gbase) + (voff)[_i]), (PG8_LAS unsigned*)(lds + (bufoff) + ldsw + _i * 8192), 16, 0, 0); } while (0)
#define PG8_LDA(dst, b, h) do { _Pragma("unroll") for (int m = 0; m < 4; ++m) _Pragma("unroll") for (int k = 0; k < 2; ++k) dst[m][k] = *(const PG8_LAS bf16x8*)(lds + PG8_SA(b, h) + aoff + m * 2048 + k * 1024); } while (0)
#define PG8_LDB(dst, b, h) do { _Pragma("unroll") for (int n = 0; n < 2; ++n) _Pragma("unroll") for (int k = 0; k < 2; ++k) dst[n][k] = *(const PG8_LAS bf16x8*)(lds + PG8_SB(b, h) + boff + n * 2048 + k * 1024); } while (0)
#define PG8_MMA(ai, bj, At, Bt) do { __builtin_amdgcn_s_setprio(1); _Pragma("unroll") for (int m = 0; m < 4; ++m) _Pragma("unroll") for (int n = 0; n < 2; ++n) { \
        if constexpr (F8) { asm volatile("v_mfma_scale_f32_16x16x128_f8f6f4 %0, %1, %2, %0, %3, %4 op_sel_hi:[0,0,0]" : "+v"(acc[ai][bj][m][n]) : "v"(cat8(Bt[n][0], Bt[n][1])), "v"(cat8(At[m][0], At[m][1])), "v"(f8sw), "v"(f8sx)); } \
        else { _Pragma("unroll") for (int k = 0; k < 2; ++k) acc[ai][bj][m][n] = __builtin_amdgcn_mfma_f32_16x16x32_bf16(Bt[n][k], At[m][k], acc[ai][bj][m][n], 0, 0, 0); } } __builtin_amdgcn_s_setprio(0); } while (0)
#define PG8_WAIT_V(n) asm volatile("s_waitcnt vmcnt(" #n ")" ::: "memory")
#define PG8_WAIT_L(n) asm volatile("s_waitcnt lgkmcnt(" #n ")" ::: "memory")
#define PG8_BAR __builtin_amdgcn_s_barrier()
#define PG8_SCHED __builtin_amdgcn_sched_barrier(0)
    Unit cur, nxt; int ui = 0;
    if (!S.next(0, cur)) return;
    f32x4 acc[2][2][4][2];
#pragma unroll
    for (int a = 0; a < 2; ++a)
#pragma unroll
        for (int b = 0; b < 2; ++b)
#pragma unroll
            for (int m = 0; m < 4; ++m)
#pragma unroll
                for (int n = 0; n < 2; ++n) acc[a][b][m][n] = (f32x4){0.f, 0.f, 0.f, 0.f};
    bf16x8 At[4][2], B0[2][2], B1[2][2];
    const char* cA = (const char*)g.A + (size_t)cur.pm * tstep; const char* cB = (const char*)g.Bt + (size_t)cur.pn * tstep;
    S.a_ready(cur);
    if constexpr (SP2) {
        PG8_STAGE(PG8_SB(0, 0), cB, voffB); PG8_STAGE(PG8_SB(0, 1), cB + hstep, voffB); PG8_STAGE(PG8_SA(0, 0), cA, voffA); PG8_STAGE(PG8_SA(0, 1), cA + hstep, voffA);
        if (wr == 1) PG8_BAR;
        PG8_WAIT_V(2); PG8_BAR;
        PG8_STAGE(PG8_SB(1, 0), cB + kstep, voffB); PG8_STAGE(PG8_SA(1, 0), cA + kstep, voffA); PG8_STAGE(PG8_SB(1, 1), cB + hstep + kstep, voffB);
        PG8_WAIT_V(6); PG8_BAR;
    } else {
        PG8_STAGE(PG8_SB(0, 0), cB, voffB); PG8_STAGE(PG8_SA(0, 0), cA, voffA); PG8_STAGE(PG8_SB(0, 1), cB + hstep, voffB); PG8_STAGE(PG8_SA(0, 1), cA + hstep, voffA);
        if (wr == 1) PG8_BAR;
        PG8_WAIT_V(4); PG8_BAR;
        PG8_STAGE(PG8_SB(1, 0), cB + kstep, voffB); PG8_STAGE(PG8_SA(1, 0), cA + kstep, voffA); PG8_STAGE(PG8_SB(1, 1), cB + hstep + kstep, voffB);
        PG8_WAIT_V(6); PG8_BAR;
    }
    for (;;) {
        const bool has_next = S.next(ui + 1, nxt);
        const char* nA = has_next ? (const char*)g.A + (size_t)nxt.pm * tstep : cA; const char* nB = has_next ? (const char*)g.Bt + (size_t)nxt.pn * tstep : cB;
#pragma nounroll
        for (int t = 0; t < nt; t += 2) {
            const bool last = (t == nt - 2);
            const char* a1 = cA + (size_t)(t + 1) * kstep;
            const char* a2 = last ? nA : cA + (size_t)(t + 2) * kstep; const char* b2 = last ? nB : cB + (size_t)(t + 2) * kstep;
            const char* a3 = a2 + kstep; const char* b3 = b2 + kstep;
            if (last && has_next) S.a_ready(nxt);
            if constexpr (SP2) {
            PG8_LDB(B0, 0, 0); PG8_LDB(B1, 0, 1); PG8_SCHED; PG8_LDA(At, 0, 0); PG8_STAGE(PG8_SA(1, 1), a1 + hstep, voffA);
            PG8_WAIT_V(8); PG8_WAIT_L(0); PG8_BAR; PG8_MMA(0, 0, At, B0); PG8_MMA(0, 1, At, B1); PG8_BAR; PG8_SCHED;
            PG8_LDA(At, 0, 1); PG8_STAGE(PG8_SB(0, 0), b2, voffB); PG8_STAGE(PG8_SB(0, 1), b2 + hstep, voffB); PG8_STAGE(PG8_SA(0, 0), a2, voffA);
            PG8_WAIT_V(8); PG8_WAIT_L(0); PG8_BAR; PG8_MMA(1, 0, At, B0); PG8_MMA(1, 1, At, B1); PG8_BAR; PG8_SCHED;
            PG8_LDB(B0, 1, 0); PG8_LDB(B1, 1, 1); PG8_SCHED; PG8_LDA(At, 1, 0); PG8_STAGE(PG8_SA(0, 1), a2 + hstep, voffA);
            PG8_WAIT_V(8); PG8_WAIT_L(0); PG8_BAR; PG8_MMA(0, 0, At, B0); PG8_MMA(0, 1, At, B1); PG8_BAR; PG8_SCHED;
            PG8_LDA(At, 1, 1); PG8_STAGE(PG8_SB(1, 0), b3, voffB); PG8_STAGE(PG8_SB(1, 1), b3 + hstep, voffB); PG8_STAGE(PG8_SA(1, 0), a3, voffA);
            PG8_WAIT_V(8); PG8_WAIT_L(0); PG8_BAR; PG8_MMA(1, 0, At, B0); PG8_MMA(1, 1, At, B1); PG8_BAR; PG8_SCHED;
            } else {
            PG8_LDB(B0, 0, 0); PG8_SCHED; PG8_LDA(At, 0, 0); PG8_STAGE(PG8_SA(1, 1), a1 + hstep, voffA);
            PG8_WAIT_L(8); PG8_BAR; PG8_WAIT_L(0); PG8_MMA(0, 0, At, B0); PG8_BAR; PG8_SCHED;
            PG8_LDB(B1, 0, 1); PG8_STAGE(PG8_SB(0, 0), b2, voffB);
            PG8_BAR; PG8_WAIT_L(0); PG8_MMA(0, 1, At, B1); PG8_BAR;
            PG8_LDA(At, 0, 1); PG8_STAGE(PG8_SA(0, 0), a2, voffA);
            PG8_BAR; PG8_WAIT_L(0); PG8_MMA(1, 0, At, B0); PG8_BAR; PG8_SCHED;
            PG8_STAGE(PG8_SB(0, 1), b2 + hstep, voffB);
            PG8_WAIT_V(6); PG8_BAR; PG8_MMA(1, 1, At, B1); PG8_BAR;
            PG8_LDB(B0, 1, 0); PG8_SCHED; PG8_LDA(At, 1, 0); PG8_STAGE(PG8_SA(0, 1), a2 + hstep, voffA);
            PG8_WAIT_L(8); PG8_BAR; PG8_WAIT_L(0); PG8_MMA(0, 0, At, B0); PG8_BAR; PG8_SCHED;
            PG8_LDB(B1, 1, 1); PG8_STAGE(PG8_SB(1, 0), b3, voffB);
            PG8_BAR; PG8_WAIT_L(0); PG8_MMA(0, 1, At, B1); PG8_BAR;
            PG8_LDA(At, 1, 1); PG8_STAGE(PG8_SA(1, 0), a3, voffA);
            PG8_BAR; PG8_WAIT_L(0); PG8_MMA(1, 0, At, B0); PG8_BAR; PG8_SCHED;
            PG8_STAGE(PG8_SB(1, 1), b3 + hstep, voffB);
            PG8_WAIT_V(6); PG8_BAR; PG8_MMA(1, 1, At, B1); PG8_BAR;
            }
        }
        if constexpr (F8) asm volatile("s_nop 15\n\ts_nop 15" ::: "memory");
        if constexpr (ALIGN_EPI) { if (wr == 0) PG8_BAR; }
        if constexpr (!Epi::AFTER_DRAIN) { const int l2 = lane_id_fresh(); E(acc, cur, wr, wc, l2 & 15, l2 >> 4); S.done(cur); }
        if (!has_next) break;
        if constexpr (!epi_keeps_acc<Epi>::value) {
#pragma unroll
        for (int a = 0; a < 2; ++a)
#pragma unroll
            for (int b = 0; b < 2; ++b)
#pragma unroll
                for (int m = 0; m < 4; ++m)
#pragma unroll
                    for (int n = 0; n < 2; ++n) acc[a][b][m][n] = (f32x4){0.f, 0.f, 0.f, 0.f};
        }
        cur = nxt; cA = nA; cB = nB; ++ui;
        if constexpr (ALIGN_EPI) { if (wr == 1) PG8_BAR; }
    }
    PG8_WAIT_V(0);
    if constexpr (!ALIGN_EPI) { if (wr == 0) PG8_BAR; }
    PG8_BAR;
    if constexpr (Epi::AFTER_DRAIN) { E.fused(acc, cur, wr, wc, fr, fq, lds, wid, lane); S.done(cur); }
#undef PG8_SA
#undef PG8_SB
#undef PG8_STAGE
#undef PG8_LDA
#undef PG8_LDB
#undef PG8_MMA
#undef PG8_WAIT_V
#undef PG8_WAIT_L
#undef PG8_BAR
#undef PG8_SCHED
}
}

#ifndef PG8_SP2
#define PG8_SP2 true
#endif
#ifndef PG8_ALIGN
#define PG8_ALIGN true
#endif

constexpr int NWAVES = 8, NTHR = 512;
constexpr int NL = 4, M = 16384, D = 1024, SEQ = 2048, W = 512, NE = 32, ZLD = 11264, DPLE = 256;
constexpr int NC_BASE = 11016, NC_REST = 11048;
constexpr int ZA = 0, ZB = 1792, ZC = 3840, ZD = 5896, ZX = 6920, ZG = 7168;
constexpr float ALPHA = 1.681792830507429f;
constexpr int MOE_ROWS = 73728;
constexpr size_t MiB = 1u << 20;
constexpr size_t WS_CTL = 0, CTL_ZERO_BYTES = 128 * 1024;
constexpr size_t WS_WIN = 2 * MiB, WS_WBR = 90 * MiB, WS_WOUT = 106 * MiB, WS_WPG = 114 * MiB, WS_WPP = 122 * MiB, WS_WSM = 124 * MiB, WS_WLRU = 126 * MiB;
constexpr size_t WS_WGU = 128 * MiB, WS_WDN = 640 * MiB, WS_PB = 896 * MiB, WS_PP = 928 * MiB, WS_XB = 1056 * MiB, WS_XF = 1088 * MiB, WS_Z = 1152 * MiB;
constexpr size_t WS_RW = 1504 * MiB, WS_BON = 1728 * MiB, WS_VF = 1730 * MiB, WS_LA = 1762 * MiB, WS_LB = 1794 * MiB, WS_YA = 1826 * MiB, WS_OB = 1858 * MiB, WS_HC = 1890 * MiB;
constexpr size_t WS_Y = 1922 * MiB, WS_MF = 1986 * MiB, WS_MB = 2050 * MiB, WS_PRE = 2082 * MiB, WS_X1F = 2146 * MiB, WS_X1B = 2210 * MiB;
constexpr size_t WS_SLOT = 2242 * MiB, WS_TREC = 2244 * MiB, WS_GATE = 2245 * MiB, WS_XS = 2246 * MiB, WS_XB8 = 2246 * MiB, WS_X1B8 = 2262 * MiB, WS_WIN8 = 2278 * MiB, WS_WPG8 = 2294 * MiB, WS_H = 2390 * MiB, WS_YS = 2534 * MiB, WS_PLEG = 2678 * MiB, WS_FR = 2710 * MiB, WS_FRH = 2810 * MiB, WS_FRM = 2890 * MiB, WS_XSV = 2970 * MiB, WS_END = 3994 * MiB;
constexpr size_t RWSZ = 32 * MiB;
constexpr size_t RHSZ = 16 * MiB, WS_LW = WS_RW + 6 * RHSZ;
constexpr int CW_TMO = 0, CW_BAR = 4096, CW_CNT = 16384;
constexpr int RING_BYTES = 131072, LDSCTL_OFF = RING_BYTES, LDSCTL_BYTES = 8192, LDS_USED = RING_BYTES + LDSCTL_BYTES, LDS_BYTES = 147456;
constexpr int LC_BAR = 0  , LC_TILEE = 16  , LC_PSTART = 352  , LC_CNT = 400  , LC_BASE = 432  , LC_NT = 464, LC_REC = 512  ;

#define GAS __attribute__((address_space(1)))
#define LAS __attribute__((address_space(3)))
#define DI __device__ __forceinline__
typedef unsigned short bf16;
typedef unsigned v4u __attribute__((ext_vector_type(4)));
typedef unsigned v2u __attribute__((ext_vector_type(2)));
typedef float f32x4 __attribute__((ext_vector_type(4)));
typedef float f32x2 __attribute__((ext_vector_type(2)));
typedef short bf16x8 __attribute__((ext_vector_type(8)));
typedef GAS unsigned gu32;
#define RLX_AGENT __ATOMIC_RELAXED, __HIP_MEMORY_SCOPE_AGENT
#define LDS_WAIT() asm volatile("s_waitcnt lgkmcnt(0)" ::: "memory")
#define VM_WAIT() asm volatile("s_waitcnt vmcnt(0)" ::: "memory")
DI unsigned f2bf(float f) { unsigned u = __builtin_bit_cast(unsigned, f); return (u + 0x7fffu + ((u >> 16) & 1u)) >> 16; }
typedef __bf16 bf16x2_t __attribute__((ext_vector_type(2)));
DI unsigned pk2(float lo, float hi) { const f32x2 v = {lo, hi}; const bf16x2_t b = __builtin_convertvector(v, bf16x2_t); return __builtin_bit_cast(unsigned, b); }
DI float bf2f(unsigned short b) { return __builtin_bit_cast(float, (unsigned)b << 16); }
DI float blo(unsigned w) { return __builtin_bit_cast(float, w << 16); }
DI float bhi(unsigned w) { return __builtin_bit_cast(float, w & 0xffff0000u); }
DI float sigm(float x) { return __builtin_amdgcn_rcpf(1.0f + __expf(-x)); }
DI float tanh_fast(float x) { return 1.0f - 2.0f * __builtin_amdgcn_rcpf(1.0f + __expf(2.0f * x)); }
DI float siluf(float x) { return x * sigm(x); }
DI float softplusf(float x) { return x > 20.0f ? x : __logf(1.0f + __expf(x)); }
DI float logsigm(float x) { return -softplusf(-x); }
DI unsigned pk4f8(float a, float b, float c, float d) {
    unsigned w = 0u; w = __builtin_amdgcn_cvt_pk_fp8_f32(pg8::clamp8(a * 8.0f), pg8::clamp8(b * 8.0f), w, false); return __builtin_amdgcn_cvt_pk_fp8_f32(pg8::clamp8(c * 8.0f), pg8::clamp8(d * 8.0f), w, true); }
DI float gelu_tanh(float x) { return 0.5f * x * (1.0f + tanh_fast(0.7978845608028654f * (x + 0.044715f * x * x * x))); }

#define XB_TMO      128
#define XB_XCNT(j)  (256  + 64 * (j))
#define XB_XSUB(j)  (1280 + 64 * (j))
#define XB_XGEN(j)  (2304 + 64 * (j))
#define XB_TOP      3328
#define XB_TOPGEN   3392
#define XCD_BAR_WORDS 3456
#define XB_SPIN_CAP (1u << 18)
DI unsigned xb_ld(unsigned* p)              { return __hip_atomic_load(p, __ATOMIC_RELAXED, __HIP_MEMORY_SCOPE_AGENT); }
DI unsigned xb_add(unsigned* p, unsigned v) { return __hip_atomic_fetch_add(p, v, __ATOMIC_RELAXED, __HIP_MEMORY_SCOPE_AGENT); }
DI unsigned xb_xcc_id() { return (unsigned)__builtin_amdgcn_s_getreg((3 << 11) | 20) & 0xFu; }
#define XB_SPIN(cond, bar) do { unsigned _sp = 0; while (cond) { __builtin_amdgcn_s_sleep(1); \
    if ((++_sp & 255u) == 0u) { if (xb_ld(&(bar)[XB_TMO])) break; if (_sp > XB_SPIN_CAP) { atomicAdd(&(bar)[XB_TMO], 1u); break; } } } } while (0)
struct XcdBarrier { unsigned* bar; unsigned x; volatile LAS unsigned* st; };
DI XcdBarrier xcd_barrier_post(unsigned* bar, volatile LAS unsigned* st) {
    XcdBarrier b; b.bar = bar; b.x = xb_xcc_id(); b.st = st;
    if (threadIdx.x == 0) (void)xb_add(&bar[XB_XCNT(b.x)], 1u);
    return b;
}
DI void xcd_barrier_complete(unsigned* bar, unsigned x, unsigned& nloc, unsigned& nx) {
    const unsigned G = gridDim.x * gridDim.y * gridDim.z;
    unsigned sum, cnt, mine, sp = 0u;
    for (;;) {
        sum = 0u; cnt = 0u; mine = 0u;
#pragma unroll
        for (unsigned j = 0; j < 16; ++j) { const unsigned c = xb_ld(&bar[XB_XCNT(j)]); sum += c; cnt += (c > 0u) ? 1u : 0u; mine = (j == x) ? c : mine; }
        if (sum == G) break;
        __builtin_amdgcn_s_sleep(1);
        if ((++sp & 255u) == 0u) { if (xb_ld(&bar[XB_TMO])) break; if (sp > XB_SPIN_CAP) { atomicAdd(&bar[XB_TMO], 1u); break; } }
    }
    nloc = mine > 0u ? mine : 1u; nx = cnt > 0u ? cnt : 1u;
}
DI void xcd_barrier(const XcdBarrier& b) {
    asm volatile("s_waitcnt vmcnt(0)" ::: "memory");
    __syncthreads();
    if (threadIdx.x == 0) {
        unsigned* bar = b.bar;
        __builtin_amdgcn_s_waitcnt(0);
        unsigned nloc = b.st[0], nx = b.st[1];
        if (nloc == 0u) { xcd_barrier_complete(bar, b.x, nloc, nx); b.st[0] = nloc; b.st[1] = nx; }
        const unsigned old = xb_add(&bar[XB_XSUB(b.x)], 1u);
        const unsigned gen = old / nloc;
        if (old + 1u == (gen + 1u) * nloc) {
            __builtin_amdgcn_fence(__ATOMIC_RELEASE, "agent");
            asm volatile("s_waitcnt vmcnt(0)" ::: "memory");
            const unsigned og = xb_add(&bar[XB_TOP], 1u);
            const unsigned tg = og / nx;
            if (og + 1u == (tg + 1u) * nx) xb_add(&bar[XB_TOPGEN], 1u);
            else XB_SPIN(xb_ld(&bar[XB_TOPGEN]) == tg, bar);
            __builtin_amdgcn_fence(__ATOMIC_ACQUIRE, "agent");
            xb_add(&bar[XB_XGEN(b.x)], 1u);
            asm volatile("s_waitcnt vmcnt(0)" ::: "memory");
        } else {
            XB_SPIN(xb_ld(&bar[XB_XGEN(b.x)]) == gen, bar);
            __builtin_amdgcn_fence(__ATOMIC_ACQUIRE, "agent");
            asm volatile("s_waitcnt vmcnt(0)" ::: "memory");
        }
    }
    __syncthreads();
}

struct Args { const float* in[45]; float* out; unsigned char* ws; int ph_lo, ph_hi; };
typedef const __attribute__((address_space(4))) Args* KA;
struct Frame {
    LAS unsigned char* lds; LAS unsigned* LC;
    unsigned char* ws; gu32* ctl;
    int tid, lane, wave, vcu, G, gw, NGW;
};
DI void rebind(Frame& F) {
    int w = F.wave, vc = F.vcu, gg = F.G; asm volatile("" : "+s"(w), "+s"(vc), "+s"(gg)); F.vcu = vc; F.G = gg; F.NGW = gg * NWAVES;
    const int ln = pg8::lane_id_fresh();
    F.wave = w; F.lane = ln; F.tid = w * 64 + ln; F.gw = F.vcu * NWAVES + w;
}

template <int CTRL> DI float dpp_f(float v) { return __builtin_bit_cast(float, __builtin_amdgcn_update_dpp(0, __builtin_bit_cast(int, v), CTRL, 0xf, 0xf, true)); }
template <int MSK> DI int shx_i(int v) {
    if constexpr (MSK < 32) return __builtin_amdgcn_ds_swizzle(v, (MSK << 10) | 0x1f);
    else { const int l = pg8::lane_id_fresh(); return __builtin_amdgcn_ds_bpermute((l ^ MSK) << 2, v); }
}
template <int MSK> DI float shx(float v) { return __builtin_bit_cast(float, shx_i<MSK>(__builtin_bit_cast(int, v))); }
DI float wave_sum(float v) { v += dpp_f<0xB1>(v); v += dpp_f<0x4E>(v); v += dpp_f<0x124>(v); v += dpp_f<0x128>(v); v += shx<16>(v); v += shx<32>(v); return v; }
DI float row16_sum(float v) {
    v += dpp_f<0xB1>(v); v += dpp_f<0x4E>(v); v += dpp_f<0x124>(v); v += dpp_f<0x128>(v); return v;
}

template <int MODE  >
DI void cvt_item(const float* W, int ldw, int N, int K, int kb, int nb, bf16* WT, LAS float* scr, int lane) {
    const int k0 = 64 * kb, n0 = 32 * nb, nl = lane & 31;
    if (MODE == 5 && (n0 + 32 <= 6920 || n0 >= 11016)) return;
    if (MODE == 4 && n0 >= 6920 && n0 + 32 <= 11016) return;
    float v32[32]; const bool okn = (n0 + nl < N); const float* wp = W + (size_t)(k0 + (lane >> 5)) * ldw + n0 + nl;
#pragma unroll
    for (int i = 0; i < 32; ++i) v32[i] = okn ? wp[(size_t)(2 * i) * ldw] : 0.0f;
#pragma unroll
    for (int i = 0; i < 32; ++i) scr[(2 * i + (lane >> 5)) * 33 + nl] = v32[i];
    LDS_WAIT(); asm volatile("" ::: "memory");
    const int c = lane & 7;
#pragma unroll
    for (int j = 0; j < 4; ++j) { const int nn = (lane >> 3) + 8 * j, n = n0 + nn; const LAS float* s = scr + (8 * c) * 33 + nn;
        int ro = n; if (MODE == 1 || MODE == 2) { const int cc = n & 1023; ro = (cc >> 7) * 256 + (n >> 10) * 128 + (cc & 127); }
        if (MODE == 4) ro = (n < 6920) ? n : n - 4096;
        if (MODE == 5) ro = n - 6920;
        const bool gate_col = (n >= 6920 && n < 11016);
        if (MODE == 2 || MODE == 3 || MODE == 5) { unsigned w0 = 0u, w1 = 0u;
            w0 = __builtin_amdgcn_cvt_pk_fp8_f32(s[0 * 33] * 64.0f, s[1 * 33] * 64.0f, w0, false); w0 = __builtin_amdgcn_cvt_pk_fp8_f32(s[2 * 33] * 64.0f, s[3 * 33] * 64.0f, w0, true);
            w1 = __builtin_amdgcn_cvt_pk_fp8_f32(s[4 * 33] * 64.0f, s[5 * 33] * 64.0f, w1, false); w1 = __builtin_amdgcn_cvt_pk_fp8_f32(s[6 * 33] * 64.0f, s[7 * 33] * 64.0f, w1, true);
            if (n < N && (MODE != 5 || gate_col)) *(GAS v2u*)((unsigned char*)WT + (size_t)ro * K + k0 + 8 * c) = (v2u){w0, w1}; }
        else { v4u o; o.x = pk2(s[0 * 33], s[1 * 33]); o.y = pk2(s[2 * 33], s[3 * 33]); o.z = pk2(s[4 * 33], s[5 * 33]); o.w = pk2(s[6 * 33], s[7 * 33]);
            if (n < N && (MODE != 4 || !gate_col)) *(GAS v4u*)(WT + (size_t)ro * K + k0 + 8 * c) = o; } }
    LDS_WAIT(); asm volatile("" ::: "memory");
}
template <int MODE> DI void cvt_item8(const float* W, int ldw, int N, int K, int kb, int nb, unsigned char* WT8, LAS float* scr, int lane) {
    const int k0 = 128 * kb, n0 = 32 * nb, nl = lane & 31, half = lane >> 5;
    if (MODE == 5 && (n0 + 32 <= 6920 || n0 >= 11016)) return;
    float v64[64]; const bool okn = (n0 + nl < N); const float* wp = W + (size_t)(k0 + half) * ldw + n0 + nl;
#pragma unroll
    for (int i = 0; i < 64; ++i) v64[i] = okn ? __builtin_nontemporal_load(wp + (size_t)(2 * i) * ldw) : 0.0f;
#pragma unroll
    for (int i = 0; i < 64; ++i) { const int row = 2 * i + half; scr[row * 32 + (nl ^ ((row >> 3) & 31))] = v64[i]; }
    LDS_WAIT(); asm volatile("" ::: "memory");
    const int c = lane & 15, nq = lane >> 4;
#pragma unroll
    for (int j = 0; j < 8; ++j) { const int nn = nq + 4 * j, n = n0 + nn; const LAS float* sp = scr + (8 * c) * 32 + (nn ^ c);
        int ro = n; if (MODE == 2) { const int cc = n & 1023; ro = (cc >> 7) * 256 + (n >> 10) * 128 + (cc & 127); }
        if (MODE == 5) ro = n - 6920;
        const bool ok = (n < N) && (MODE != 5 || (n >= 6920 && n < 11016));
        unsigned w0 = 0u, w1 = 0u;
        w0 = __builtin_amdgcn_cvt_pk_fp8_f32(sp[0 * 32] * 64.0f, sp[1 * 32] * 64.0f, w0, false); w0 = __builtin_amdgcn_cvt_pk_fp8_f32(sp[2 * 32] * 64.0f, sp[3 * 32] * 64.0f, w0, true);
        w1 = __builtin_amdgcn_cvt_pk_fp8_f32(sp[4 * 32] * 64.0f, sp[5 * 32] * 64.0f, w1, false); w1 = __builtin_amdgcn_cvt_pk_fp8_f32(sp[6 * 32] * 64.0f, sp[7 * 32] * 64.0f, w1, true);
        if (ok) __builtin_nontemporal_store((v2u){w0, w1}, (v2u*)(WT8 + (size_t)ro * K + k0 + 8 * c)); }
    LDS_WAIT(); asm volatile("" ::: "memory");
}
template <int MODE> DI void cvt_class(Frame& F, int& off, const float* W, int K, int N, int ldw, size_t src_stride, bf16* WT, size_t dst_stride, int nmat) {
    LAS float* scr = (LAS float*)(F.lds + F.wave * 16384);
    constexpr bool F8M = (MODE == 2 || MODE == 3 || MODE == 5);
    const int nkb = K / (F8M ? 128 : 64), nnb = (N + 31) / 32, per = nkb * nnb, total = per * nmat;
    int start = (F.gw - off) % F.NGW; if (start < 0) start += F.NGW;
    for (int it = start; it < total; it += F.NGW) { const int mi = it / per, r = it % per;
        if constexpr (F8M) cvt_item8<MODE>(W + (size_t)mi * src_stride, ldw, N, K, r / nnb, r % nnb, (unsigned char*)(WT + (size_t)mi * dst_stride), scr, F.lane);
        else cvt_item<MODE>(W + (size_t)mi * src_stride, ldw, N, K, r / nnb, r % nnb, WT + (size_t)mi * dst_stride, scr, F.lane); }
    off = (off + total) % F.NGW;
}
constexpr int EXP_ITEMS = NE * 512 + NE * 256;
DI void cvt_expert_item(Frame& F, KA a, int l, int it) {
    LAS float* scr = (LAS float*)(F.lds + F.wave * 16384);
    if (it < NE * 512) { const int e = it >> 9, r = it & 511; const size_t mi = (size_t)l * NE + e;
        cvt_item8<2>(a->in[37] + mi * 1024 * 2048, 2048, 2048, 1024, r >> 6, r & 63, F.ws + WS_WGU + mi * 2048 * 1024, scr, F.lane); }
    else { const int i2 = it - NE * 512, e = i2 >> 8, r = i2 & 255; const size_t mi = (size_t)l * NE + e;
        cvt_item8<3>(a->in[39] + mi * 1024 * 1024, 1024, 1024, 1024, r >> 5, r & 31, F.ws + WS_WDN + mi * 1024 * 1024, scr, F.lane); }
}
constexpr int CW_Q = 28672;
DI void cvt_expert_queue(Frame& F, KA a, int l) {
    LAS unsigned* qh = F.LC + 480;
    unsigned nxt = 0u;
    if (F.tid == 0) qh[0] = __hip_atomic_fetch_add((unsigned*)(F.ctl + CW_Q + l * 64), 8u, __ATOMIC_RELAXED, __HIP_MEMORY_SCOPE_AGENT);
    for (int r = 0;; ++r) {
        __syncthreads();
        const int base = (int)qh[r & 1];
        if (base >= EXP_ITEMS) break;
        if (F.tid == 0) nxt = __hip_atomic_fetch_add((unsigned*)(F.ctl + CW_Q + l * 64), 8u, __ATOMIC_RELAXED, __HIP_MEMORY_SCOPE_AGENT);
        if (base + F.wave < EXP_ITEMS) cvt_expert_item(F, a, l, base + F.wave);
        if (F.tid == 0) qh[(r + 1) & 1] = nxt;
    }
}
DI void p0_convert(Frame& F, KA a) {
    int off = 0;
    cvt_class<4>(F, off, a->in[2], 1024, NC_BASE, NC_BASE, 0, (bf16*)(F.ws + WS_WIN), 0, 1);
    cvt_class<4>(F, off, a->in[3], 1024, NC_REST, NC_REST, (size_t)1024 * NC_REST, (bf16*)(F.ws + WS_WIN) + (size_t)ZLD * 1024, (size_t)ZLD * 1024, NL - 1);
    cvt_class<3>(F, off, a->in[31], 512, 1024, 1024, (size_t)512 * 1024, (bf16*)(F.ws + WS_WBR), (size_t)1024 * 512 / 2, NL * 4);
    cvt_class<3>(F, off, a->in[32], 1024, 1024, 1024, (size_t)1024 * 1024, (bf16*)(F.ws + WS_WOUT), (size_t)1024 * 1024 / 2, NL);
    cvt_class<3>(F, off, a->in[41], 1024, 1024, 1024, (size_t)1024 * 1024, (bf16*)(F.ws + WS_WPG8), (size_t)1024 * 1024 / 2, NL);
    cvt_class<5>(F, off, a->in[2], 1024, NC_BASE, NC_BASE, 0, (bf16*)(F.ws + WS_WIN8), 0, 1);
    cvt_class<5>(F, off, a->in[3], 1024, NC_REST, NC_REST, (size_t)1024 * NC_REST, (bf16*)(F.ws + WS_WIN8 + (size_t)4096 * 1024), (size_t)4096 * 1024 / 2, NL - 1);
    cvt_class<0>(F, off, a->in[42], 256, 1024, 1024, (size_t)256 * 1024, (bf16*)(F.ws + WS_WPP), (size_t)1024 * 256, NL);
    const int gt = F.vcu * NTHR + F.tid, NGT = F.G * NTHR;
    for (int l = 0; l < NL; ++l) { const int n0 = (l == 0) ? ZX : ZX + 32; bf16* wt = (bf16*)(F.ws + WS_WIN) + (size_t)l * ZLD * 1024;
        const int nq = (ZG - n0) * 1024 / 8;
        for (int i = gt; i < nq; i += NGT) *(GAS v4u*)(wt + (size_t)n0 * 1024 + (size_t)i * 8) = (v4u){0u, 0u, 0u, 0u}; }
    { bf16* wsm = (bf16*)(F.ws + WS_WSM);
      for (int i = gt; i < NL * 512 * 288; i += NGT) { const int l = i / (512 * 288), r = i % (512 * 288), c = r / 288, k = r % 288; float v;
          if (k < 64) v = a->in[6][((size_t)l * 64 + k) * 512 + c];
          else if (k < 128) v = a->in[8][((size_t)l * 64 + (k - 64)) * 512 + c];
          else if (k < 256) v = a->in[11][((size_t)l * 128 + (k - 128)) * 512 + c];
          else v = (l > 0) ? a->in[10][((size_t)(l - 1) * 32 + (k - 256)) * 512 + c] : 0.0f;
          wsm[i] = (bf16)f2bf(v); }
      bf16* wl = (bf16*)(F.ws + WS_WLRU);
      for (int i = gt; i < NL * 2 * 8 * 64 * 64; i += NGT) { const int l = i >> 16, r = i & 65535, which = r >> 15, g = (r >> 12) & 7, j = (r >> 6) & 63, ii = r & 63;
          const float* src = which ? a->in[28] : a->in[26];
          wl[i] = (bf16)f2bf(src[(((size_t)l * 8 + g) * 64 + ii) * 64 + j]); } }
    { const GAS f32x4* xs = (const GAS f32x4*)a->in[0]; GAS v2u* xb = (GAS v2u*)(F.ws + WS_XB);
      GAS unsigned* xb8 = (GAS unsigned*)(F.ws + WS_XB8);
      for (int i = gt; i < M * D / 4; i += NGT) { const f32x4 v = xs[i]; xb[i] = (v2u){pk2(v.x, v.y), pk2(v.z, v.w)}; unsigned w8 = __builtin_amdgcn_cvt_pk_fp8_f32(v.x * 16.f, v.y * 16.f, 0u, false); xb8[i] = __builtin_amdgcn_cvt_pk_fp8_f32(v.z * 16.f, v.w * 16.f, w8, true); }
      const GAS f32x4* ps = (const GAS f32x4*)a->in[1]; GAS v2u* pb = (GAS v2u*)(F.ws + WS_PB);
      for (int i = gt; i < NL * M * DPLE / 4; i += NGT) { const f32x4 v = ps[i]; pb[i] = (v2u){pk2(v.x, v.y), pk2(v.z, v.w)}; } }
}

DI f32x4 mfma16(bf16x8 a, bf16x8 b, f32x4 c) { return __builtin_amdgcn_mfma_f32_16x16x32_bf16(a, b, c, 0, 0, 0); }
DI f32x4 fresh_zero4() { float z0 = 0.f; asm volatile("" : "+v"(z0)); return (f32x4){z0, z0, z0, z0}; }
constexpr int XS_LD = 296, XCB_LD = 520, XCF_LD = 516;
static_assert(16 * XS_LD * 2 <= 9728 && 9728 + 16 * XCB_LD * 2 <= 26624 && 26624 + 16 * XCF_LD * 4 <= 59904 && 59904 + 18 * 512 * 4 <= RING_BYTES, "prep LDS map");
DI void phase_prep(Frame& F, KA a, int l) {
    LAS bf16* X = (LAS bf16*)F.lds;
    LAS bf16* XCb = (LAS bf16*)(F.lds + 9728);
    LAS float* XCf = (LAS float*)(F.lds + 26624);
    const bf16* z = (const bf16*)(F.ws + WS_Z);
    const bf16* wsm = (const bf16*)(F.ws + WS_WSM) + (size_t)l * 512 * 288;
    const bf16* wlru = (const bf16*)(F.ws + WS_WLRU) + (size_t)l * 65536;
    const float* mu = a->in[4] + l * 1792; const float* w0 = a->in[5] + l * 512; const float* a0 = a->in[7] + l * 512;
    const float* v0 = a->in[9] + (l > 0 ? (l - 1) * 512 : 0); const float* k_k = a->in[12] + l * 512; const float* k_a = a->in[13] + l * 512; const float* r_k = a->in[14] + l * 512;
    const float* cw = a->in[24] + l * 4 * 512; const float* cb = a->in[25] + l * 512; const float* bx = a->in[27] + l * 512; const float* ba = a->in[29] + l * 512; const float* lam = a->in[30] + l * 512;
    bf16* RWH = (bf16*)(F.ws + WS_RW); float* LW = (float*)(F.ws + WS_LW); bf16* VF = (bf16*)(F.ws + WS_VF);     float* BON = (float*)(F.ws + WS_BON);
    float* LA = (float*)(F.ws + WS_LA); bf16* LB = (bf16*)(F.ws + WS_LB);
    const int h = F.wave, lane = F.lane, tok = lane & 15, quad = lane >> 4;
    LAS float* PT = (LAS float*)(F.lds + 59904);
#pragma unroll
    for (int f = 0; f < 18; ++f) { const int c = F.tid, i = f * 512 + c; float v;
        if (f < 3) v = mu[f * 512 + c]; else if (f == 3) v = w0[c]; else if (f == 4) v = a0[c]; else if (f == 5) v = (l > 0) ? v0[c] : 0.f; else if (f == 6) v = k_k[c]; else if (f == 7) v = k_a[c]; else if (f == 8) v = r_k[c];
        else if (f == 9) v = bx[c]; else if (f == 10) v = ba[c]; else if (f == 11) v = 8.0f * logsigm(lam[c]); else if (f == 12) v = cb[c]; else if (f < 17) v = cw[(f - 13) * 512 + c]; else v = (c < 256) ? mu[1536 + c] : 0.f;
        PT[i] = v; }
    __syncthreads();
#define PTV(f, c) (*(const LAS f32x4*)(PT + (f) * 512 + (c)))
    for (int item = F.vcu; item < M / 16; item += F.G) {
        const int t0 = item * 16;
        const int t = t0 + tok; const bool first = (t & (SEQ - 1)) == 0;
        v2u kpre[8];
#pragma unroll
        for (int nt = 0; nt < 4; ++nt) { const bf16* zr_ = z + (size_t)t * ZLD + 512 + 64 * h + 16 * quad + 4 * nt; kpre[nt] = *(const v2u*)zr_; kpre[4 + nt] = first ? (v2u){0u, 0u} : *(const v2u*)(zr_ - ZLD); }
        for (int idx = F.tid; idx < 16 * 36; idx += NTHR) {
            const int tk = idx / 36, ch = idx % 36, j0 = 8 * ch, t = t0 + tk; float v8[8];
            if (ch < 32) { const int col = 1536 + j0; const v4u cz = *(const v4u*)(z + (size_t)t * ZLD + col);
                const v4u pz = (t & (SEQ - 1)) ? *(const v4u*)(z + (size_t)(t - 1) * ZLD + col) : (v4u){0u, 0u, 0u, 0u};
                const f32x4 m0 = PTV(17, j0), m1 = PTV(17, j0 + 4);
                const float cu[8] = {blo(cz.x), bhi(cz.x), blo(cz.y), bhi(cz.y), blo(cz.z), bhi(cz.z), blo(cz.w), bhi(cz.w)}, pr[8] = {blo(pz.x), bhi(pz.x), blo(pz.y), bhi(pz.y), blo(pz.z), bhi(pz.z), blo(pz.w), bhi(pz.w)};
                const float mm[8] = {m0[0], m0[1], m0[2], m0[3], m1[0], m1[1], m1[2], m1[3]};
#pragma unroll
                for (int j = 0; j < 8; ++j) { const float xv = cu[j] + (pr[j] - cu[j]) * mm[j]; v8[j] = (ch < 8) ? tanh_fast(xv) : (ch < 16 ? xv : sigm(xv)); } }
            else { const v4u cz = (l > 0) ? *(const v4u*)(z + (size_t)t * ZLD + ZX + (j0 - 256)) : (v4u){0u, 0u, 0u, 0u};
                v8[0] = blo(cz.x); v8[1] = bhi(cz.x); v8[2] = blo(cz.y); v8[3] = bhi(cz.y); v8[4] = blo(cz.z); v8[5] = bhi(cz.z); v8[6] = blo(cz.w); v8[7] = bhi(cz.w); }
            *(LAS v4u*)(X + tk * XS_LD + j0) = (v4u){pk2(v8[0], v8[1]), pk2(v8[2], v8[3]), pk2(v8[4], v8[5]), pk2(v8[6], v8[7])}; }
        for (int idx = F.tid; idx < 16 * 64; idx += NTHR) {
            const int tk = idx >> 6, c = 8 * (idx & 63), t = t0 + tk, tt = t & (SEQ - 1);
            const f32x4 b0 = PTV(12, c), b1 = PTV(12, c + 4); float acc[8] = {b0[0], b0[1], b0[2], b0[3], b1[0], b1[1], b1[2], b1[3]};
#pragma unroll
            for (int j = 0; j < 4; ++j) { if (tt - 3 + j >= 0) { const v4u rz = *(const v4u*)(z + (size_t)(t - 3 + j) * ZLD + ZD + c); const f32x4 w0 = PTV(13 + j, c), w1 = PTV(13 + j, c + 4);
                acc[0] += blo(rz.x) * w0[0]; acc[1] += bhi(rz.x) * w0[1]; acc[2] += blo(rz.y) * w0[2]; acc[3] += bhi(rz.y) * w0[3]; acc[4] += blo(rz.z) * w1[0]; acc[5] += bhi(rz.z) * w1[1]; acc[6] += blo(rz.w) * w1[2]; acc[7] += bhi(rz.w) * w1[3]; } }
            *(LAS f32x4*)(XCf + tk * XCF_LD + c) = (f32x4){acc[0], acc[1], acc[2], acc[3]}; *(LAS f32x4*)(XCf + tk * XCF_LD + c + 4) = (f32x4){acc[4], acc[5], acc[6], acc[7]};
            *(LAS v4u*)(XCb + tk * XCB_LD + c) = (v4u){pk2(acc[0], acc[1]), pk2(acc[2], acc[3]), pk2(acc[4], acc[5]), pk2(acc[6], acc[7])}; }
        __syncthreads();
        {
            float ss = 0.f, bs = 0.f;
#pragma unroll
            for (int nt = 0; nt < 4; ++nt) { const int c = 64 * h + 16 * quad + 4 * nt; const v2u kc_ = kpre[nt], kp_ = kpre[4 + nt];
                const f32x4 mk = PTV(1, c), kkv = PTV(6, c); const f32x4 kc = (f32x4){blo(kc_.x), bhi(kc_.x), blo(kc_.y), bhi(kc_.y)}, kp = (f32x4){blo(kp_.x), bhi(kp_.x), blo(kp_.y), bhi(kp_.y)};
                const f32x4 kk = (kc + (kp - kc) * mk) * kkv; ss += (kk[0] * kk[0] + kk[1] * kk[1]) + (kk[2] * kk[2] + kk[3] * kk[3]); }
            ss += shx<16>(ss); ss += shx<32>(ss);
            const float inv = 1.0f / fmaxf(sqrtf(ss), 1e-12f);
            bf16x8 wf[9]; v2u zc[6]; v2u vfc = (v2u){0u, 0u};
#define PREP_LOAD(NT, WF, ZC, VFC) do { const bf16* wrow_ = wsm + (size_t)(64 * h + 16 * (tok >> 2) + 4 * (NT) + (tok & 3)) * 288 + 8 * quad; \
                _Pragma("unroll") for (int i_ = 0; i_ < 9; ++i_) WF[i_] = *(const bf16x8*)(wrow_ + 32 * i_); \
                const int c_ = 64 * h + 16 * quad + 4 * (NT); const bf16* zr_ = z + (size_t)t * ZLD + c_; const bf16* zp_ = first ? zr_ : zr_ - ZLD; \
                ZC[0] = *(const v2u*)(zr_); ZC[1] = *(const v2u*)(zr_ + 512); ZC[2] = *(const v2u*)(zr_ + 1024); ZC[3] = *(const v2u*)(zp_); ZC[4] = *(const v2u*)(zp_ + 512); ZC[5] = *(const v2u*)(zp_ + 1024); \
                if (l > 0) VFC = *(const v2u*)(VF + (size_t)t * 512 + c_); } while (0)
            v2u oR[4] = {}, oK[4] = {}, oV[4] = {}, oA[4] = {}, oB[4] = {}, oG[4] = {}; f32x4 oW[4] = {};
#define SEL4(O, val) do { _Pragma("unroll") for (int q_ = 0; q_ < 4; ++q_) O[q_] = (nt == q_) ? (val) : O[q_]; } while (0)
#pragma unroll 1
            for (int nt = 0; nt < 4; ++nt) {
                PREP_LOAD(nt, wf, zc, vfc);
                f32x4 aw = (f32x4){0.f, 0.f, 0.f, 0.f}, aa = aw, ag = aw, av = aw;
                bf16x8 xfr[9];
#pragma unroll
                for (int i_ = 0; i_ < 9; ++i_) xfr[i_] = *(const LAS bf16x8*)(X + tok * XS_LD + 8 * quad + 32 * i_);
                __builtin_amdgcn_sched_barrier(0);
#pragma unroll
                for (int ks = 0; ks < 2; ++ks) aw = mfma16(wf[ks], xfr[ks], aw);
#pragma unroll
                for (int ks = 0; ks < 2; ++ks) aa = mfma16(wf[2 + ks], xfr[2 + ks], aa);
#pragma unroll
                for (int ks = 0; ks < 4; ++ks) ag = mfma16(wf[4 + ks], xfr[4 + ks], ag);
                av = mfma16(wf[8], xfr[8], av);
                const int c = 64 * h + 16 * quad + 4 * nt;
                const v2u r_c = zc[0], k_c = zc[1], v_c = zc[2];
                v2u r_p = zc[3], k_p = zc[4], v_p = zc[5];
                if (first) { r_p = (v2u){0u, 0u}; k_p = r_p; v_p = r_p; }
                const f32x4 mr = PTV(0, c), mk = PTV(1, c), mv = PTV(2, c);
                const f32x4 rc = (f32x4){blo(r_c.x), bhi(r_c.x), blo(r_c.y), bhi(r_c.y)}, rp = (f32x4){blo(r_p.x), bhi(r_p.x), blo(r_p.y), bhi(r_p.y)};
                const f32x4 kc = (f32x4){blo(k_c.x), bhi(k_c.x), blo(k_c.y), bhi(k_c.y)}, kp = (f32x4){blo(k_p.x), bhi(k_p.x), blo(k_p.y), bhi(k_p.y)};
                const f32x4 vc = (f32x4){blo(v_c.x), bhi(v_c.x), blo(v_c.y), bhi(v_c.y)}, vp = (f32x4){blo(v_p.x), bhi(v_p.x), blo(v_p.y), bhi(v_p.y)};
                const f32x4 r = rc + (rp - rc) * mr, k = kc + (kp - kc) * mk; f32x4 v = vc + (vp - vc) * mv;
                const f32x4 w0v = PTV(3, c), a0v = PTV(4, c), kkv = PTV(6, c), kav = PTV(7, c), rkv = PTV(8, c);
                f32x4 aval, dc, kkn, k2v;
#pragma unroll
                for (int j = 0; j < 4; ++j) { dc[j] = -0.6065306597126334f * sigm(w0v[j] + aw[j]);     aval[j] = sigm(a0v[j] + aa[j]);
                    kkn[j] = k[j] * kkv[j] * inv; k2v[j] = k[j] * (1.0f + (aval[j] - 1.0f) * kav[j]); bs += r[j] * k2v[j] * rkv[j]; }
                const size_t o = (size_t)t * 512 + c;
                if (l > 0) { const f32x4 v0v = PTV(5, c); const f32x4 vf = (f32x4){blo(vfc.x), bhi(vfc.x), blo(vfc.y), bhi(vfc.y)};
#pragma unroll
                    for (int j = 0; j < 4; ++j) v[j] = v[j] + (vf[j] - v[j]) * sigm(v0v[j] + av[j]); }
#define PK4(val) ((v2u){pk2((val)[0], (val)[1]), pk2((val)[2], (val)[3])})
                { const v2u pr_ = PK4(r), pk_ = PK4(k2v), pv_ = PK4(v), pg_ = PK4(ag); SEL4(oR, pr_); SEL4(oW, dc); SEL4(oK, pk_); SEL4(oV, pv_); SEL4(oG, pg_); }
                { const f32x4 nkn = -kkn, kna = kkn * aval; const v2u pa_ = PK4(nkn), pb_ = PK4(kna); SEL4(oA, pa_); SEL4(oB, pb_); }
            }
#undef PREP_LOAD
            bs += shx<16>(bs); bs += shx<32>(bs);
            if (quad == 0) BON[(size_t)t * 8 + h] = bs;
            { const size_t o = (size_t)t * 512 + 64 * h + 16 * quad;
#define ST16H(arr, O) do { bf16* d_ = RWH + (size_t)(arr) * (RHSZ / 2) + o; *(v4u*)d_ = (v4u){O[0].x, O[0].y, O[1].x, O[1].y}; *(v4u*)(d_ + 8) = (v4u){O[2].x, O[2].y, O[3].x, O[3].y}; } while (0)
              ST16H(0, oR); ST16H(1, oK); ST16H(2, oV); ST16H(3, oA); ST16H(4, oB); ST16H(5, oG);
#pragma unroll
              for (int nt = 0; nt < 4; ++nt) *(f32x4*)(LW + o + 4 * nt) = oW[nt];
              if (l == 0) { bf16* d_ = VF + o; *(v4u*)d_ = (v4u){oV[0].x, oV[0].y, oV[1].x, oV[1].y}; *(v4u*)(d_ + 8) = (v4u){oV[2].x, oV[2].y, oV[3].x, oV[3].y}; } }
#undef ST16H
#undef PK4
#undef SEL4
        }
        {
            bf16x8 lf[4], ln[4];
#define LRU_LOAD(NT, LF) do { const bf16* wxr_ = wlru + ((size_t)h * 64 + 16 * (NT) + tok) * 64 + 8 * quad; LF[0] = *(const bf16x8*)(wxr_); LF[1] = *(const bf16x8*)(wxr_ + 32); LF[2] = *(const bf16x8*)(wxr_ + 8 * 64 * 64); LF[3] = *(const bf16x8*)(wxr_ + 8 * 64 * 64 + 32); } while (0)
            LRU_LOAD(0, lf);
#pragma unroll 1
            for (int nt = 0; nt < 4; ++nt) { f32x4 gx = (f32x4){0.f, 0.f, 0.f, 0.f}, ga = gx;
                if (nt < 3) LRU_LOAD(nt + 1, ln);
                const LAS bf16* xrow = XCb + tok * XCB_LD + 64 * h + 8 * quad;
#pragma unroll
                for (int ks = 0; ks < 2; ++ks) { const bf16x8 xf = *(const LAS bf16x8*)(xrow + 32 * ks); gx = mfma16(lf[ks], xf, gx); ga = mfma16(lf[2 + ks], xf, ga); }
                const int c = 64 * h + 16 * nt + 4 * quad;
                const f32x4 bxv = PTV(9, c), bav = PTV(10, c), lmv = PTV(11, c);
                const f32x4 xc = *(const LAS f32x4*)(XCf + tok * XCF_LD + c);
                f32x4 oa, ob;
#pragma unroll
                for (int j = 0; j < 4; ++j) { const float gxs = sigm(gx[j] + bxv[j]), gas = sigm(ga[j] + bav[j]); const float la = gas * lmv[j];
                    oa[j] = __expf(la); const float mult = first ? 1.0f : sqrtf(1.0f - __expf(2.0f * la)); ob[j] = mult * gxs * xc[j]; }
                *(f32x4*)(LA + (size_t)t * 512 + c) = oa; *(v2u*)(LB + (size_t)t * 512 + c) = (v2u){pk2(ob[0], ob[1]), pk2(ob[2], ob[3])};
#pragma unroll
                for (int i_ = 0; i_ < 4; ++i_) lf[i_] = ln[i_]; }
#undef LRU_LOAD
        }
        __syncthreads();
    }
#undef PTV
}

DI void scan_rwkv_item(Frame& F, int item) {
    constexpr int T = 32, BUF = 5 * T * 64 + T * 32;
    LAS float* stg = (LAS float*)F.lds;
    LAS float* yout = (LAS float*)(F.lds + 2 * BUF * 4);
    const int half = item & 1, h = (item >> 1) & 7, b = item >> 4;
    const float* RWb = (const float*)(F.ws + WS_RW); float* YA = (float*)(F.ws + WS_YA);
    const int rl = F.tid >> 4, kq = F.tid & 15;
    const size_t tb0 = (size_t)b * SEQ;
    f32x4 pre[6];
    auto issue = [&](int blk) {
#pragma unroll
        for (int i = 0; i < 6; ++i) { const int idx = F.tid + i * NTHR; if (idx < BUF / 4) {
            const float* src;
            if (idx < 2560) { const int arr = idx >> 9, rem = idx & 511, st = rem >> 4, c4 = rem & 15; const int ga = (arr == 3) ? 4 : (arr == 4 ? 5 : arr);
                src = RWb + (size_t)ga * (RWSZ / 4) + (tb0 + blk * T + st) * 512 + 64 * h + 4 * c4; }
            else { const int rem = idx - 2560, st = rem >> 3, c4 = rem & 7; src = RWb + (size_t)3 * (RWSZ / 4) + (tb0 + blk * T + st) * 512 + 64 * h + 32 * half + 4 * c4; }
            pre[i] = *(const f32x4*)src; } }
    };
    auto commit = [&](int buf) {
#pragma unroll
        for (int i = 0; i < 6; ++i) { const int idx = F.tid + i * NTHR; if (idx < BUF / 4) *(LAS f32x4*)(stg + buf * BUF + idx * 4) = pre[i]; }
    };
    issue(0); commit(0); __syncthreads();
    f32x4 S = (f32x4){0.f, 0.f, 0.f, 0.f};
    for (int blk = 0; blk < SEQ / T; ++blk) {
        const int buf = blk & 1;
        if (blk + 1 < SEQ / T) issue(blk + 1);
        const LAS float* sb = stg + buf * BUF;
#pragma unroll 4
        for (int s = 0; s < T; ++s) {
            const f32x4 r4 = *(const LAS f32x4*)(sb + 0 * T * 64 + s * 64 + 4 * kq), w4 = *(const LAS f32x4*)(sb + 1 * T * 64 + s * 64 + 4 * kq), k4 = *(const LAS f32x4*)(sb + 2 * T * 64 + s * 64 + 4 * kq);
            const f32x4 a4 = *(const LAS f32x4*)(sb + 3 * T * 64 + s * 64 + 4 * kq), b4 = *(const LAS f32x4*)(sb + 4 * T * 64 + s * 64 + 4 * kq);
            const float v = sb[5 * T * 64 + s * 32 + rl];
            const float sa = row16_sum((S[0] * a4[0] + S[1] * a4[1]) + (S[2] * a4[2] + S[3] * a4[3]));
            S = S * w4 + b4 * sa + k4 * v;
            const float y = row16_sum((S[0] * r4[0] + S[1] * r4[1]) + (S[2] * r4[2] + S[3] * r4[3]));
            if (kq == 0) yout[s * 32 + rl] = y;
        }
        __syncthreads();
        for (int i = F.tid; i < T * 32; i += NTHR) { const int st = i >> 5, r = i & 31; YA[(tb0 + blk * T + st) * 512 + 64 * h + 32 * half + r] = yout[i]; }
        if (blk + 1 < SEQ / T) commit(buf ^ 1);
        __syncthreads();
    }
}
DI void scan_hgrn_item(Frame& F, KA a, int l, int item) {
    constexpr int T = 32;
    LAS float* Fd = (LAS float*)F.lds; LAS float* Kk = Fd + T * 128; LAS float* Qs = Kk + T * 128; LAS float* Is = Qs + T * 128; LAS float* Oo = Is + T * 16; LAS float* lbs = Oo + T * 16;
    const int vs = item & 7, h = (item >> 3) & 3, b = item >> 5;
    const bf16* z = (const bf16*)(F.ws + WS_Z); float* OB = (float*)(F.ws + WS_OB);
    const size_t tb0 = (size_t)b * SEQ;
    if (F.tid < 128) { const int c = 128 * h + F.tid; const float* hb = a->in[17];
        const float x0 = hb[c], x1 = hb[512 + c], x2 = hb[1024 + c], x3 = hb[1536 + c]; const float mx = fmaxf(fmaxf(x0, x1), fmaxf(x2, x3));
        const float e0 = __expf(x0 - mx), e1 = __expf(x1 - mx), e2 = __expf(x2 - mx), e3 = __expf(x3 - mx); const float inv = 1.0f / (e0 + e1 + e2 + e3);
        lbs[F.tid] = (l == 0) ? 0.0f : (l == 1 ? e1 * inv : (l == 2 ? (e1 + e2) * inv : (e1 + e2 + e3) * inv)); }
    v4u pre[3];
    auto issue = [&](int blk) {
#pragma unroll
        for (int i = 0; i < 3; ++i) { const int idx = F.tid + i * NTHR; if (idx < 1088) { const bf16* src;
            if (idx < 1024) { const int arr = idx >> 9, rem = idx & 511, st = rem >> 4, ch = rem & 15; src = z + (tb0 + blk * T + st) * ZLD + ZB + arr * 512 + 128 * h + 8 * ch; }
            else { const int rem = idx - 1024, st = rem >> 1, ch = rem & 1; src = z + (tb0 + blk * T + st) * ZLD + ZB + 1024 + 128 * h + 16 * vs + 8 * ch; }
            pre[i] = *(const v4u*)src; } }
    };
    auto commit = [&]() {
#pragma unroll
        for (int i = 0; i < 3; ++i) { const int idx = F.tid + i * NTHR; if (idx < 1088) { float v[8]; v[0] = blo(pre[i].x); v[1] = bhi(pre[i].x); v[2] = blo(pre[i].y); v[3] = bhi(pre[i].y); v[4] = blo(pre[i].z); v[5] = bhi(pre[i].z); v[6] = blo(pre[i].w); v[7] = bhi(pre[i].w);
            if (idx < 512) { const int st = idx >> 4, ch = idx & 15;
#pragma unroll
                for (int j = 0; j < 8; ++j) Qs[st * 128 + 8 * ch + j] = siluf(v[j]); }
            else if (idx < 1024) { const int rem = idx & 511, st = rem >> 4, ch = rem & 15;
#pragma unroll
                for (int j = 0; j < 8; ++j) { const float lb = lbs[8 * ch + j], sg = sigm(v[j]); Fd[st * 128 + 8 * ch + j] = lb + (1.0f - lb) * sg; Kk[st * 128 + 8 * ch + j] = (1.0f - lb) * (1.0f - sg); } }
            else { const int rem = idx - 1024, st = rem >> 1, ch = rem & 1;
#pragma unroll
                for (int j = 0; j < 8; ++j) Is[st * 16 + 8 * ch + j] = v[j]; } } }
    };
    __syncthreads();
    issue(0); commit(); __syncthreads();
    const int vl = 2 * F.wave + (F.lane >> 5), kg = F.lane & 31;
    f32x4 S = (f32x4){0.f, 0.f, 0.f, 0.f};
    for (int blk = 0; blk < SEQ / T; ++blk) {
        if (blk + 1 < SEQ / T) issue(blk + 1);
#pragma unroll 4
        for (int s = 0; s < T; ++s) {
            const f32x4 f4 = *(const LAS f32x4*)(Fd + s * 128 + 4 * kg), k4 = *(const LAS f32x4*)(Kk + s * 128 + 4 * kg), q4 = *(const LAS f32x4*)(Qs + s * 128 + 4 * kg);
            const float iv = Is[s * 16 + vl];
            S = S * f4 + k4 * iv;
            float o = row16_sum((S[0] * q4[0] + S[1] * q4[1]) + (S[2] * q4[2] + S[3] * q4[3]));
            o += shx<16>(o);
            if (kg == 0) Oo[s * 16 + vl] = o;
        }
        __syncthreads();
        { const int st = F.tid >> 4, r = F.tid & 15; OB[(tb0 + blk * T + st) * 512 + 128 * h + 16 * vs + r] = Oo[F.tid]; }
        if (blk + 1 < SEQ / T) commit();
        __syncthreads();
    }
}
DI void scan_mlstm_item(Frame& F, KA a, int l, int item) {
    constexpr int T = 32;
    LAS float* Qs = (LAS float*)F.lds; LAS float* Ks = Qs + T * 128; LAS float* Vs = Ks + T * 128; LAS float* Ho = Vs + T * 16;
    LAS float* FD = Ho + T * 16; LAS float* IW = FD + T; LAS float* EM = IW + T; LAS float* IG = EM + T; LAS float* FG = IG + T; LAS float* mst = FG + T;
    LAS float* raw = mst + 32;
    const int vs = item & 7, h = (item >> 3) & 3, b = item >> 5;
    const bf16* z = (const bf16*)(F.ws + WS_Z); float* HC = (float*)(F.ws + WS_HC);
    const float* cw = a->in[19] + l * 4 * 1024; const float* cb = a->in[20] + l * 1024; const float ib = a->in[21][l * 4 + h], fb = a->in[22][l * 4 + h];
    const size_t tb0 = (size_t)b * SEQ;
    v4u pre[3]; v4u prev_; float pig = 0.f, pfg = 0.f;
    auto issue = [&](int blk) {
#pragma unroll
        for (int i = 0; i < 3; ++i) { const int idx = F.tid + i * NTHR; if (idx < 1120) { const int row = idx >> 5, rem = idx & 31, arr = rem >> 4, ch = rem & 15; const int tt = blk * T - 3 + row;
            pre[i] = (tt >= 0) ? *(const v4u*)(z + (tb0 + tt) * ZLD + ZC + arr * 512 + 128 * h + 8 * ch) : (v4u){0u, 0u, 0u, 0u}; } }
        if (F.tid < 64) { const int st = F.tid >> 1, ch = F.tid & 1; prev_ = *(const v4u*)(z + (tb0 + blk * T + st) * ZLD + ZC + 1024 + 128 * h + 16 * vs + 8 * ch); }
        if (F.tid >= 64 && F.tid < 96) { const int st = F.tid - 64; const bf16* zr = z + (tb0 + blk * T + st) * ZLD + ZC + 2048; pig = bf2f(zr[h]); pfg = bf2f(zr[4 + h]); }
    };
    auto commit = [&]() {
#pragma unroll
        for (int i = 0; i < 3; ++i) { const int idx = F.tid + i * NTHR; if (idx < 1120) { const int row = idx >> 5, rem = idx & 31;
            LAS float* d = raw + row * 256 + 8 * rem; d[0] = blo(pre[i].x); d[1] = bhi(pre[i].x); d[2] = blo(pre[i].y); d[3] = bhi(pre[i].y); d[4] = blo(pre[i].z); d[5] = bhi(pre[i].z); d[6] = blo(pre[i].w); d[7] = bhi(pre[i].w); } }
        if (F.tid < 64) { const int st = F.tid >> 1, ch = F.tid & 1; LAS float* d = Vs + st * 16 + 8 * ch; d[0] = blo(prev_.x); d[1] = bhi(prev_.x); d[2] = blo(prev_.y); d[3] = bhi(prev_.y); d[4] = blo(prev_.z); d[5] = bhi(prev_.z); d[6] = blo(prev_.w); d[7] = bhi(prev_.w); }
        if (F.tid >= 64 && F.tid < 96) { IG[F.tid - 64] = pig + ib; FG[F.tid - 64] = logsigm(pfg + fb); }
        __syncthreads();
        for (int idx = F.tid; idx < T * 256; idx += NTHR) { const int st = idx >> 8, cc = idx & 255, arr = cc >> 7, k = cc & 127; const int wc_ = arr * 512 + 128 * h + k;
            float acc = cb[wc_];
#pragma unroll
            for (int j = 0; j < 4; ++j) acc += raw[(st + j) * 256 + cc] * cw[j * 1024 + wc_];
            acc = siluf(acc);
            if (arr == 0) Qs[st * 128 + k] = acc; else Ks[st * 128 + k] = acc * 0.08838834764831845f; }
        if (F.tid == 0) { float m = mst[0];
            for (int s = 0; s < T; ++s) { const float lf = FG[s], ip = IG[s]; const float mn = fmaxf(lf + m, ip); FD[s] = __expf(lf + m - mn); IW[s] = __expf(ip - mn); EM[s] = __expf(-mn); m = mn; }
            mst[0] = m; }
    };
    if (F.tid == 0) mst[0] = -1e30f;
    __syncthreads();
    issue(0); commit(); __syncthreads();
    const int vl = 2 * F.wave + (F.lane >> 5), kg = F.lane & 31;
    f32x4 C = (f32x4){0.f, 0.f, 0.f, 0.f}, n = C;
    for (int blk = 0; blk < SEQ / T; ++blk) {
        if (blk + 1 < SEQ / T) issue(blk + 1);
#pragma unroll 4
        for (int s = 0; s < T; ++s) {
            const f32x4 k4 = *(const LAS f32x4*)(Ks + s * 128 + 4 * kg), q4 = *(const LAS f32x4*)(Qs + s * 128 + 4 * kg);
            const float fd = FD[s], iw = IW[s], vv = Vs[s * 16 + vl];
            C = C * fd + k4 * (iw * vv); n = n * fd + k4 * iw;
            float num = row16_sum((C[0] * q4[0] + C[1] * q4[1]) + (C[2] * q4[2] + C[3] * q4[3]));
            float den = row16_sum((n[0] * q4[0] + n[1] * q4[1]) + (n[2] * q4[2] + n[3] * q4[3]));
            num += shx<16>(num); den += shx<16>(den);
            if (kg == 0) Ho[s * 16 + vl] = num / fmaxf(fabsf(den), EM[s]);
        }
        __syncthreads();
        { const int st = F.tid >> 4, r = F.tid & 15; HC[(tb0 + blk * T + st) * 512 + 128 * h + 16 * vs + r] = Ho[F.tid]; }
        if (blk + 1 < SEQ / T) commit();
        __syncthreads();
    }
}
DI void scan_lru_item(Frame& F, int item) {
    LAS float* SA = (LAS float*)F.lds; LAS float* SB = SA + 512;
    const int cg = item & 31, b = item >> 5, ch = F.tid & 15, seg = F.tid >> 4, c = 16 * cg + ch;
    const float* LA = (const float*)(F.ws + WS_LA); const float* LB = (const float*)(F.ws + WS_LB); const bf16* z = (const bf16*)(F.ws + WS_Z);
    bf16* Y3 = (bf16*)(F.ws + WS_Y) + (size_t)3 * M * 512;
    const size_t t0 = (size_t)b * SEQ + seg * 64;
    float A = 1.0f, Bv = 0.0f;
    for (int s = 0; s < 64; ++s) { const float av = LA[(t0 + s) * 512 + c], bv = LB[(t0 + s) * 512 + c]; A *= av; Bv = av * Bv + bv; }
    SA[seg * 16 + ch] = A; SB[seg * 16 + ch] = Bv;
    __syncthreads();
    float hh = 0.0f;
    for (int s2 = 0; s2 < seg; ++s2) hh = SA[s2 * 16 + ch] * hh + SB[s2 * 16 + ch];
    for (int s = 0; s < 64; ++s) { const float av = LA[(t0 + s) * 512 + c], bv = LB[(t0 + s) * 512 + c]; hh = av * hh + bv;
        const float g = bf2f(z[(t0 + s) * ZLD + ZD + 512 + c]); Y3[(t0 + s) * 512 + c] = (bf16)f2bf(hh * gelu_tanh(g)); }
    __syncthreads();
}
DI bf16x8 pack8(f32x4 lo, f32x4 hi) { v4u w; w.x = pk2(lo[0], lo[1]); w.y = pk2(lo[2], lo[3]); w.z = pk2(hi[0], hi[1]); w.w = pk2(hi[2], hi[3]); return __builtin_bit_cast(bf16x8, w); }
DI bf16x8 ld_perm(const LAS bf16* row, int kbase, int quad) {
    const v2u a = *(const LAS v2u*)(row + kbase + 4 * quad), b = *(const LAS v2u*)(row + kbase + 16 + 4 * quad); v4u w; w.x = a.x; w.y = a.y; w.z = b.x; w.w = b.y; return __builtin_bit_cast(bf16x8, w); }
constexpr int CQ_LD = 136, CT_LD = 40;
constexpr int FH_STRIDE = 34 * 1024 + 512;
DI void st_frag(unsigned char* base, int f, int lane, bf16x8 v) { *(bf16x8*)(base + f * 1024 + lane * 16) = v; }
DI bf16x8 ld_vperm(const unsigned char* natfrag, int fr, int quad) { const unsigned char* p = natfrag + (fr + 16 * (quad >> 1)) * 16 + 8 * (quad & 1);
    const v2u a = *(const v2u*)p, b = *(const v2u*)(p + 512); return __builtin_bit_cast(bf16x8, (v4u){a.x, a.y, b.x, b.y}); }
DI void hgrn_raw_load(Frame& F, int prob, v4u& pq, v4u& pf, v4u& pi) {
    const int bh = prob >> 6, c = prob & 63, h = bh & 3, b = bh >> 2; const bf16* z = (const bf16*)(F.ws + WS_Z);
    const bf16* src = z + ((size_t)b * SEQ + c * 32 + (F.tid >> 4)) * ZLD + ZB + 128 * h + 8 * (F.tid & 15); pq = *(const v4u*)src; pf = *(const v4u*)(src + 512); pi = *(const v4u*)(src + 1024);
}
DI void hgrn_lower_bounds(Frame& F, KA a, int l) {
    constexpr int C = 32;
    LAS float* lbs = (LAS float*)((LAS bf16*)F.lds + 2 * C * CQ_LD + 2 * 128 * CT_LD) + C * 128 + 4 * 128;
    { const int cc = F.tid; const float* hb = a->in[17];
      const float x0 = hb[cc], x1 = hb[512 + cc], x2 = hb[1024 + cc], x3 = hb[1536 + cc]; const float mx = fmaxf(fmaxf(x0, x1), fmaxf(x2, x3));
      const float e0 = __expf(x0 - mx), e1 = __expf(x1 - mx), e2 = __expf(x2 - mx), e3 = __expf(x3 - mx); const float inv = 1.0f / (e0 + e1 + e2 + e3);
      lbs[cc] = (l == 0) ? 0.0f : (l == 1 ? e1 * inv : (l == 2 ? (e1 + e2) * inv : (e1 + e2 + e3) * inv)); }
    __syncthreads();
}
DI void prep_hgrn_item(Frame& F, KA a, int l, int prob, int nprob, v4u& pq, v4u& pf, v4u& pi) {
    constexpr int C = 32;
    LAS bf16* Qt = (LAS bf16*)F.lds; LAS bf16* Kt = Qt + C * CQ_LD; LAS bf16* KhT = Kt + C * CQ_LD; LAS bf16* VT = KhT + 128 * CT_LD;
    LAS float* bc = (LAS float*)(VT + 128 * CT_LD); LAS float* PS = bc + C * 128; LAS float* lbs = PS + 4 * 128;
    const int bh = prob >> 6, c = prob & 63, h = bh & 3, b = bh >> 2, w = F.wave, lane = F.lane, fr = lane & 15, quad = lane >> 4;
    const bf16* z = (const bf16*)(F.ws + WS_Z);
    unsigned char* fo = F.ws + WS_FRH + (size_t)prob * FH_STRIDE;
    const size_t row0 = (size_t)b * SEQ + c * C;
    const int tr = F.tid >> 4, k0 = 8 * (F.tid & 15);
    float qv[8], kv[8];
    { const float fr_[8] = {blo(pf.x), bhi(pf.x), blo(pf.y), bhi(pf.y), blo(pf.z), bhi(pf.z), blo(pf.w), bhi(pf.w)};
      const float qr[8] = {blo(pq.x), bhi(pq.x), blo(pq.y), bhi(pq.y), blo(pq.z), bhi(pq.z), blo(pq.w), bhi(pq.w)};
      float lf[8];
#pragma unroll
      for (int j = 0; j < 8; ++j) { const float lb = lbs[128 * h + k0 + j], sg = sigm(fr_[j]); const float f = lb + (1.0f - lb) * sg; lf[j] = __logf(fmaxf(f, 1e-37f)); kv[j] = (1.0f - lb) * (1.0f - sg); qv[j] = siluf(qr[j]); }
      *(LAS f32x4*)(bc + tr * 128 + k0) = (f32x4){lf[0], lf[1], lf[2], lf[3]}; *(LAS f32x4*)(bc + tr * 128 + k0 + 4) = (f32x4){lf[4], lf[5], lf[6], lf[7]};
      const unsigned iv[4] = {pi.x, pi.y, pi.z, pi.w};
#pragma unroll
      for (int j = 0; j < 4; ++j) { VT[(k0 + 2 * j) * CT_LD + tr] = (bf16)(iv[j] & 0xffffu); VT[(k0 + 2 * j + 1) * CT_LD + tr] = (bf16)(iv[j] >> 16); } }
    if (nprob >= 0) hgrn_raw_load(F, nprob, pq, pf, pi);
    __syncthreads();
    { const int k = F.tid & 127, part = F.tid >> 7; float v8[8], run = 0.f;
#pragma unroll
      for (int j = 0; j < 8; ++j) v8[j] = bc[(8 * part + j) * 128 + k];
#pragma unroll
      for (int j = 0; j < 8; ++j) { run += v8[j]; bc[(8 * part + j) * 128 + k] = run; }
      PS[part * 128 + k] = run; }
    __syncthreads();
    { float q8[8], k8[8]; const int part = tr >> 3;
#pragma unroll
      for (int j = 0; j < 8; ++j) { const int k = k0 + j; const float p0 = PS[k], p1 = PS[128 + k], p2 = PS[256 + k], p3 = PS[384 + k];
          const float off = (part > 0 ? p0 : 0.f) + (part > 1 ? p1 : 0.f) + (part > 2 ? p2 : 0.f); const float blast = (p0 + p1) + (p2 + p3);
          const float bcu = bc[tr * 128 + k] + off; q8[j] = qv[j] * __expf(bcu); k8[j] = kv[j] * __expf(-bcu);
          KhT[k * CT_LD + tr] = (bf16)f2bf(kv[j] * __expf(blast - bcu));
          if (tr == 0) ((float*)(fo + 34 * 1024))[k] = __expf(blast); }
      *(LAS v4u*)(Qt + tr * CQ_LD + k0) = (v4u){pk2(q8[0], q8[1]), pk2(q8[2], q8[3]), pk2(q8[4], q8[5]), pk2(q8[6], q8[7])};
      *(LAS v4u*)(Kt + tr * CQ_LD + k0) = (v4u){pk2(k8[0], k8[1]), pk2(k8[2], k8[3]), pk2(k8[4], k8[5]), pk2(k8[6], k8[7])}; }
    __syncthreads();
    st_frag(fo, w, lane, ld_perm(Qt + (16 * (w >> 2) + fr) * CQ_LD, 32 * (w & 3), quad));
    st_frag(fo, 8 + w, lane, *(const LAS bf16x8*)(KhT + (16 * w + fr) * CT_LD + 8 * quad));
    st_frag(fo, 19 + 2 * w, lane, *(const LAS bf16x8*)(VT + (16 * w + fr) * CT_LD + 8 * quad));
    if (w < 2) {
        const f32x4 zero4 = fresh_zero4(); f32x4 pa = zero4, pb = zero4;
#pragma unroll
        for (int ks = 0; ks < 4; ++ks) { const bf16x8 qb = *(const LAS bf16x8*)(Qt + (16 * w + fr) * CQ_LD + 32 * ks + 8 * quad);
            pa = mfma16(*(const LAS bf16x8*)(Kt + fr * CQ_LD + 32 * ks + 8 * quad), qb, pa);
            if (w == 1) pb = mfma16(*(const LAS bf16x8*)(Kt + (16 + fr) * CQ_LD + 32 * ks + 8 * quad), qb, pb); }
#pragma unroll
        for (int j = 0; j < 4; ++j) { if (4 * quad + j > fr) { if (w == 0) pa[j] = 0.f; else pb[j] = 0.f; } }
        st_frag(fo, 16 + w, lane, pack8(pa, pb));
    }
    __syncthreads();
}
template <int NF, int NW, int SB> struct ChainStage {
    static constexpr int MAXF = (NF + NW - 1) / NW, SLOT = NF * 1024 + 512;
    bf16x8 r[MAXF]; f32x4 sc;
    DI void load(const unsigned char* p, int wsub, int lane) {
#pragma unroll
        for (int i = 0; i < MAXF; ++i) { const int f = wsub + NW * i; if (f < NF) r[i] = *(const bf16x8*)(p + f * 1024 + lane * 16); }
        if (wsub == NW - 1 && lane < SB / 16) sc = *(const f32x4*)(p + NF * 1024 + lane * 16);
    }
    DI void store(LAS unsigned char* slot, int wsub, int lane) const {
#pragma unroll
        for (int i = 0; i < MAXF; ++i) { const int f = wsub + NW * i; if (f < NF) *(LAS bf16x8*)(slot + f * 1024 + lane * 16) = r[i]; }
        if (wsub == NW - 1 && lane < SB / 16) *(LAS f32x4*)(slot + NF * 1024 + lane * 16) = sc;
    }
};
#define LQ(slot, f) (*(const LAS bf16x8*)((slot) + (f) * 1024 + lane * 16))
DI void chain_hgrn(Frame& F, int item) {
    typedef ChainStage<18, 8, 512> St;
    const int bh = item, h = bh & 3, b = bh >> 2, w = F.wave, lane = F.lane, fr = lane & 15, quad = lane >> 4;
    const bool act = true; const int vs = w;
    const unsigned char* fb = F.ws + WS_FRH + (size_t)bh * 64 * FH_STRIDE;
    bf16* OB = (bf16*)(F.ws + WS_OB);
    LAS unsigned char* L = F.lds;
    f32x4 S[8];
#pragma unroll
    for (int i = 0; i < 8; ++i) S[i] = (f32x4){0.f, 0.f, 0.f, 0.f};
    St sa, sb, sc;
    auto ld = [&](St& s, int c) { const unsigned char* p = fb + (size_t)c * FH_STRIDE;
#pragma unroll
        for (int i = 0; i < St::MAXF; ++i) { const int f = w + 8 * i; if (f < 18) s.r[i] = *(const bf16x8*)(p + f * 1024 + lane * 16); }
        if (w == 7 && lane < 32) s.sc = *(const f32x4*)(p + 34 * 1024 + lane * 16); };
    ld(sa, 0); sa.store(L, w, lane); ld(sa, 1); ld(sb, 2);
    bf16x8 vp = ld_vperm(fb + (19 + 2 * vs) * 1024, fr, quad), vn = *(const bf16x8*)(fb + (19 + 2 * vs) * 1024 + lane * 16);
    bf16x8 vp1 = ld_vperm(fb + FH_STRIDE + (19 + 2 * vs) * 1024, fr, quad), vn1 = *(const bf16x8*)(fb + FH_STRIDE + (19 + 2 * vs) * 1024 + lane * 16);
    __syncthreads();
    const f32x4 zero4 = fresh_zero4();
#pragma unroll 1
    for (int c = 0; c < 64; ++c) {
        ld(sc, c + 3 < 64 ? c + 3 : 63);
        const unsigned char* pn = fb + (size_t)(c + 2 < 64 ? c + 2 : 63) * FH_STRIDE;
        const LAS unsigned char* sl = L + (c & 1) * St::SLOT;
        if (act) {
        bf16x8 q[18]; f32x4 gl[8];
#pragma unroll
        for (int i = 0; i < 18; ++i) q[i] = LQ(sl, i);
#pragma unroll
        for (int kk = 0; kk < 8; ++kk) gl[kk] = *(const LAS f32x4*)(sl + 18 * 1024 + (16 * kk + 4 * quad) * 4);
        __builtin_amdgcn_sched_barrier(0);
        f32x4 o0 = mfma16(q[16], vp, zero4), o1 = mfma16(q[17], vp, zero4); vp = vp1; vp1 = ld_vperm(pn + (19 + 2 * vs) * 1024, fr, quad);
#pragma unroll
        for (int kt = 0; kt < 4; ++kt) { const bf16x8 sf = pack8(S[2 * kt], S[2 * kt + 1]); o0 = mfma16(q[kt], sf, o0); o1 = mfma16(q[4 + kt], sf, o1); }
#pragma unroll
        for (int kk = 0; kk < 8; ++kk) S[kk] = mfma16(q[8 + kk], vn, S[kk] * gl[kk]);
        vn = vn1; vn1 = *(const bf16x8*)(pn + (19 + 2 * vs) * 1024 + lane * 16);
        bf16* ob = OB + ((size_t)b * SEQ + c * 32) * 512 + 128 * h + 16 * vs; const unsigned lo = 4u * quad * 512u + fr;
#pragma unroll
        for (int j = 0; j < 4; ++j) { ob[lo + j * 512] = (bf16)f2bf(o0[j]); ob[lo + (16 + j) * 512] = (bf16)f2bf(o1[j]); }
        }
        sa.store(L + ((c + 1) & 1) * St::SLOT, w, lane);
        __syncthreads();
        sa = sb; sb = sc;
    }
}
template <int CTRL, int RM> DI float dpp_rm(float old, float v) { return __builtin_bit_cast(float, __builtin_amdgcn_update_dpp(__builtin_bit_cast(int, old), __builtin_bit_cast(int, v), CTRL, RM, 0xf, false)); }
DI float scan32_add(float v) {
    v += dpp_rm<0x111, 0xf>(0.f, v); v += dpp_rm<0x112, 0xf>(0.f, v); v += dpp_rm<0x114, 0xf>(0.f, v); v += dpp_rm<0x118, 0xf>(0.f, v); v += dpp_rm<0x142, 0xa>(0.f, v); return v; }
DI float scan32_max(float v) {
    const float ninf = -3.0e38f;
    v = fmaxf(v, dpp_rm<0x111, 0xf>(ninf, v)); v = fmaxf(v, dpp_rm<0x112, 0xf>(ninf, v)); v = fmaxf(v, dpp_rm<0x114, 0xf>(ninf, v)); v = fmaxf(v, dpp_rm<0x118, 0xf>(ninf, v)); v = fmaxf(v, dpp_rm<0x142, 0xa>(ninf, v)); return v; }
struct MRaw { v4u r[3], v; float ig, fg; };
DI void mlstm_raw_load(Frame& F, int prob, MRaw& R) {
    const int bh = prob >> 6, c = prob & 63, h = bh & 3, b = bh >> 2; const bf16* z = (const bf16*)(F.ws + WS_Z);
#pragma unroll
    for (int i = 0; i < 3; ++i) { const int idx = F.tid + i * NTHR; if (idx < 1120) { const int row = idx >> 5, pc = idx & 31; const int tt = c * 32 - 3 + row;
        R.r[i] = (tt >= 0) ? *(const v4u*)(z + ((size_t)b * SEQ + tt) * ZLD + ZC + (pc >> 4) * 512 + 128 * h + 8 * (pc & 15)) : (v4u){0u, 0u, 0u, 0u}; } }
    R.v = *(const v4u*)(z + ((size_t)b * SEQ + c * 32 + (F.tid >> 4)) * ZLD + ZC + 1024 + 128 * h + 8 * (F.tid & 15));
    if (F.wave == 0) { const bf16* zr = z + ((size_t)b * SEQ + c * 32 + (F.lane & 31)) * ZLD + ZC + 2048; R.ig = bf2f(zr[h]); R.fg = bf2f(zr[4 + h]); }
}
DI void prep_mlstm_item(Frame& F, KA a, int l, int prob, int nprob, MRaw& R) {
    constexpr int C = 32;
    LAS bf16* Qs = (LAS bf16*)F.lds; LAS bf16* Ks = Qs + C * CQ_LD; LAS bf16* KhT = Ks + C * CQ_LD; LAS bf16* VT = KhT + 128 * CT_LD;
    LAS float* raw = (LAS float*)(VT + 128 * CT_LD);
    LAS float* WT = raw + 35 * 256;
    LAS float* sc = WT + 32 * 32;
    const int bh = prob >> 6, c = prob & 63, h = bh & 3, b = bh >> 2, w = F.wave, lane = F.lane, fr = lane & 15, quad = lane >> 4;
    const bf16* z = (const bf16*)(F.ws + WS_Z);
    unsigned char* fo = F.ws + WS_FRM + (size_t)prob * FH_STRIDE; float* fsc = (float*)(fo + 34 * 1024);
    const float* cw = a->in[19] + l * 4 * 1024; const float* cb = a->in[20] + l * 1024; const float ib = a->in[21][l * 4 + h], fb = a->in[22][l * 4 + h];
    const size_t row0 = (size_t)b * SEQ + c * C;
    const int tr = F.tid >> 4, k0 = 8 * (F.tid & 15);
    const int wc_ = ((F.tid & 255) >> 7) * 512 + 128 * h + (F.tid & 127);
    const float cw0_ = cw[wc_], cw1_ = cw[1024 + wc_], cw2_ = cw[2048 + wc_], cw3_ = cw[3072 + wc_], cbb_ = cb[wc_];
#pragma unroll
    for (int i = 0; i < 3; ++i) { const int idx = F.tid + i * NTHR; if (idx < 1120) { const int row = idx >> 5, pc = idx & 31;
        const v4u r = R.r[i];
        LAS float* d = raw + row * 256 + 8 * pc; *(LAS f32x4*)d = (f32x4){blo(r.x), bhi(r.x), blo(r.y), bhi(r.y)}; *(LAS f32x4*)(d + 4) = (f32x4){blo(r.z), bhi(r.z), blo(r.w), bhi(r.w)}; } }
    { const v4u pv = R.v; const unsigned iv[4] = {pv.x, pv.y, pv.z, pv.w};
#pragma unroll
      for (int j = 0; j < 4; ++j) { VT[(k0 + 2 * j) * CT_LD + tr] = (bf16)(iv[j] & 0xffffu); VT[(k0 + 2 * j + 1) * CT_LD + tr] = (bf16)(iv[j] >> 16); } }
    if (w == 0) {
        const int t = lane & 31;
        const float lf = logsigm(R.fg + fb), ip = R.ig + ib;
        const float fc = scan32_add(lf), g = ip - fc, lm = scan32_max(g);
        const float lml = __builtin_bit_cast(float, __builtin_amdgcn_readlane(__builtin_bit_cast(int, lm), 31));
        if (lane < 32) { sc[t] = g; sc[32 + t] = lm; sc[64 + t] = __expf(g - lml); fsc[t] = lm; fsc[32 + t] = fc; }
    }
    if (nprob >= 0) mlstm_raw_load(F, nprob, R);
    __syncthreads();
    { const int cc = F.tid & 255, tg = F.tid >> 8, arr = cc >> 7, k = cc & 127;
      const float w0 = cw0_, w1 = cw1_, w2 = cw2_, w3 = cw3_, bb = cbb_;
      float x0 = raw[(16 * tg + 0) * 256 + cc], x1 = raw[(16 * tg + 1) * 256 + cc], x2 = raw[(16 * tg + 2) * 256 + cc];
      float o16[16];
#pragma unroll
      for (int j = 0; j < 16; ++j) { const float x3 = raw[(16 * tg + 3 + j) * 256 + cc]; o16[j] = siluf(bb + x0 * w0 + x1 * w1 + x2 * w2 + x3 * w3); x0 = x1; x1 = x2; x2 = x3; }
      if (arr == 0) {
#pragma unroll
          for (int j = 0; j < 16; ++j) Qs[(16 * tg + j) * CQ_LD + k] = (bf16)f2bf(o16[j]);
      } else { unsigned pw[8];
#pragma unroll
          for (int j = 0; j < 16; ++j) { o16[j] *= 0.08838834764831845f; Ks[(16 * tg + j) * CQ_LD + k] = (bf16)f2bf(o16[j]); o16[j] *= sc[64 + 16 * tg + j]; }
#pragma unroll
          for (int j = 0; j < 8; ++j) pw[j] = pk2(o16[2 * j], o16[2 * j + 1]);
          *(LAS v4u*)(KhT + k * CT_LD + 16 * tg) = (v4u){pw[0], pw[1], pw[2], pw[3]}; *(LAS v4u*)(KhT + k * CT_LD + 16 * tg + 8) = (v4u){pw[4], pw[5], pw[6], pw[7]}; } }
    { const int t = F.tid >> 4, s0 = 2 * (F.tid & 15); const float lmt = sc[32 + t];
      WT[t * 32 + s0] = (s0 <= t) ? __expf(sc[s0] - lmt) : 0.f; WT[t * 32 + s0 + 1] = (s0 + 1 <= t) ? __expf(sc[s0 + 1] - lmt) : 0.f; }
    __syncthreads();
    st_frag(fo, w, lane, ld_perm(Qs + (16 * (w >> 2) + fr) * CQ_LD, 32 * (w & 3), quad));
    st_frag(fo, 8 + w, lane, *(const LAS bf16x8*)(KhT + (16 * w + fr) * CT_LD + 8 * quad));
    st_frag(fo, 19 + 2 * w, lane, *(const LAS bf16x8*)(VT + (16 * w + fr) * CT_LD + 8 * quad));
    if (w < 2) {
        const f32x4 zero4 = fresh_zero4(); f32x4 pa = zero4, pb = zero4;
#pragma unroll
        for (int ks = 0; ks < 4; ++ks) { const bf16x8 qb = *(const LAS bf16x8*)(Qs + (16 * w + fr) * CQ_LD + 32 * ks + 8 * quad);
            pa = mfma16(*(const LAS bf16x8*)(Ks + fr * CQ_LD + 32 * ks + 8 * quad), qb, pa);
            if (w == 1) pb = mfma16(*(const LAS bf16x8*)(Ks + (16 + fr) * CQ_LD + 32 * ks + 8 * quad), qb, pb); }
        pa = pa * *(const LAS f32x4*)(WT + (16 * w + fr) * 32 + 4 * quad);
        if (w == 1) pb = pb * *(const LAS f32x4*)(WT + (16 + fr) * 32 + 16 + 4 * quad);
        float d = ((pa[0] + pa[1]) + (pa[2] + pa[3])) + ((pb[0] + pb[1]) + (pb[2] + pb[3]));
        d += shx<16>(d); d += shx<32>(d);
        if (quad == 0) fsc[64 + 16 * w + fr] = d;
        st_frag(fo, 16 + w, lane, pack8(pa, pb));
    }
    __syncthreads();
}
DI void chain_mlstm(Frame& F, int item) {
    typedef ChainStage<18, 8, 384> St;
    const int bh = item >> 1, half = item & 1, h = bh & 3, b = bh >> 2, w = F.wave, lane = F.lane, fr = lane & 15, quad = lane >> 4;
    const bool act = w < 4, nrm = (w == 4); const int vs = 4 * half + (w & 3);
    const unsigned char* fb = F.ws + WS_FRM + (size_t)bh * 64 * FH_STRIDE;
    bf16* HC = (bf16*)(F.ws + WS_HC);
    LAS unsigned char* L = F.lds;
    LAS float* DN = (LAS float*)(F.lds + 2 * St::SLOT);
    f32x4 S[8];
#pragma unroll
    for (int i = 0; i < 8; ++i) S[i] = (f32x4){0.f, 0.f, 0.f, 0.f};
    St sa, sb, sc;
    auto ld = [&](St& s, int c) { const unsigned char* p = fb + (size_t)c * FH_STRIDE;
#pragma unroll
        for (int i = 0; i < St::MAXF; ++i) { const int f = w + 8 * i; if (f < 18) s.r[i] = *(const bf16x8*)(p + f * 1024 + lane * 16); }
        if (w == 7 && lane < 24) s.sc = *(const f32x4*)(p + 34 * 1024 + lane * 16); };
    ld(sa, 0); sa.store(L, w, lane); ld(sa, 1); ld(sb, 2);
    bf16x8 vp = ld_vperm(fb + (19 + 2 * vs) * 1024, fr, quad), vn = *(const bf16x8*)(fb + (19 + 2 * vs) * 1024 + lane * 16);
    bf16x8 vp1 = ld_vperm(fb + FH_STRIDE + (19 + 2 * vs) * 1024, fr, quad), vn1 = *(const bf16x8*)(fb + FH_STRIDE + (19 + 2 * vs) * 1024 + lane * 16);
    __syncthreads();
    const f32x4 zero4 = fresh_zero4();
    unsigned o1_ = 0x3f803f80u; asm volatile("" : "+v"(o1_)); const bf16x8 ones = __builtin_bit_cast(bf16x8, (v4u){o1_, o1_, o1_, o1_});
    float mprev = -1e30f;
    f32x4 iqp[2], op[2];
    iqp[0] = iqp[1] = op[0] = op[1] = zero4;
    const unsigned lo = 4u * quad * 512u + fr;
#pragma unroll 1
    for (int c = 0; c < 64; ++c) {
        ld(sc, c + 3 < 64 ? c + 3 : 63);
        const unsigned char* pn = fb + (size_t)(c + 2 < 64 ? c + 2 : 63) * FH_STRIDE;
        const LAS unsigned char* sl = L + (c & 1) * St::SLOT; const LAS float* ss = (const LAS float*)(sl + 18 * 1024);
        const float lml = ss[31], fcl = ss[63];
        const float cml = fmaxf(lml, mprev), rhol = __expf(lml - cml), cd = __expf(mprev - cml);
        if (act) {
            if (c > 0) {
                const LAS float* dn = DN + ((c - 1) & 1) * 64; bf16* hb = HC + ((size_t)b * SEQ + (c - 1) * 32) * 512 + 128 * h + 16 * vs;
#pragma unroll
                for (int tb = 0; tb < 2; ++tb) { const f32x4 wr = *(const LAS f32x4*)(dn + 16 * tb + 4 * quad), rr = *(const LAS f32x4*)(dn + 32 + 16 * tb + 4 * quad);
#pragma unroll
                    for (int j = 0; j < 4; ++j) hb[lo + (16 * tb + j) * 512] = (bf16)f2bf(wr[j] * iqp[tb][j] + rr[j] * op[tb][j]); }
            }
            bf16x8 sf[4];
#pragma unroll
            for (int kt = 0; kt < 4; ++kt) sf[kt] = pack8(S[2 * kt], S[2 * kt + 1]);
            { bf16x8 q[8]; const bf16x8 ap0 = LQ(sl, 16), ap1 = LQ(sl, 17);
#pragma unroll
              for (int i = 0; i < 8; ++i) q[i] = LQ(sl, i);
              __builtin_amdgcn_sched_barrier(0);
              f32x4 o0 = mfma16(ap0, vp, zero4), o1 = mfma16(ap1, vp, zero4), i0 = zero4, i1 = zero4;
#pragma unroll
              for (int kt = 0; kt < 4; ++kt) { i0 = mfma16(q[kt], sf[kt], i0); i1 = mfma16(q[4 + kt], sf[kt], i1); }
              op[0] = o0; op[1] = o1; iqp[0] = i0; iqp[1] = i1; }
            vp = vp1; vp1 = ld_vperm(pn + (19 + 2 * vs) * 1024, fr, quad);
            { bf16x8 kf[8];
#pragma unroll
              for (int kk = 0; kk < 8; ++kk) kf[kk] = LQ(sl, 8 + kk);
              __builtin_amdgcn_sched_barrier(0);
#pragma unroll
              for (int kk = 0; kk < 8; ++kk) { const f32x4 us = mfma16(kf[kk], vn, zero4); S[kk] = S[kk] * cd + us * rhol; } }
            vn = vn1; vn1 = *(const bf16x8*)(pn + (19 + 2 * vs) * 1024 + lane * 16);
        } else if (nrm) {
            bf16x8 nf[4];
#pragma unroll
            for (int kt = 0; kt < 4; ++kt) nf[kt] = pack8(S[2 * kt], S[2 * kt + 1]);
            LAS float* dn = DN + (c & 1) * 64;
#pragma unroll
            for (int tb = 0; tb < 2; ++tb) {
                bf16x8 q[4];
#pragma unroll
                for (int kt = 0; kt < 4; ++kt) q[kt] = LQ(sl, 4 * tb + kt);
                const f32x4 slm = *(const LAS f32x4*)(ss + 16 * tb + 4 * quad), sfc = *(const LAS f32x4*)(ss + 32 + 16 * tb + 4 * quad), srs = *(const LAS f32x4*)(ss + 64 + 16 * tb + 4 * quad);
                __builtin_amdgcn_sched_barrier(0);
                f32x4 nq = zero4;
#pragma unroll
                for (int kt = 0; kt < 4; ++kt) nq = mfma16(q[kt], nf[kt], nq);
                f32x4 wr, rr;
#pragma unroll
                for (int j = 0; j < 4; ++j) { const float cm = fmaxf(slm[j], mprev), rho = __expf(slm[j] - cm), wi = __expf(mprev - cm), em = __expf(-(sfc[j] + cm));
                    const float rd = __builtin_amdgcn_rcpf(fmaxf(fabsf(wi * nq[j] + rho * srs[j]), em)); wr[j] = wi * rd; rr[j] = rho * rd; }
                if (fr == 0) { *(LAS f32x4*)(dn + 16 * tb + 4 * quad) = wr; *(LAS f32x4*)(dn + 32 + 16 * tb + 4 * quad) = rr; }
            }
            { bf16x8 kf[8];
#pragma unroll
              for (int kk = 0; kk < 8; ++kk) kf[kk] = LQ(sl, 8 + kk);
              __builtin_amdgcn_sched_barrier(0);
#pragma unroll
              for (int kk = 0; kk < 8; ++kk) { const f32x4 un = mfma16(kf[kk], ones, zero4); S[kk] = S[kk] * cd + un * rhol; } }
        }
        mprev = fcl + cml;
        sa.store(L + ((c + 1) & 1) * St::SLOT, w, lane);
        __syncthreads();
        sa = sb; sb = sc;
    }
    if (act) {
        const LAS float* dn = DN + 64; bf16* hb = HC + ((size_t)b * SEQ + 63 * 32) * 512 + 128 * h + 16 * vs;
#pragma unroll
        for (int tb = 0; tb < 2; ++tb) { const f32x4 wr = *(const LAS f32x4*)(dn + 16 * tb + 4 * quad), rr = *(const LAS f32x4*)(dn + 32 + 16 * tb + 4 * quad);
#pragma unroll
            for (int j = 0; j < 4; ++j) hb[lo + (16 * tb + j) * 512] = (bf16)f2bf(wr[j] * iqp[tb][j] + rr[j] * op[tb][j]); }
    }
}
constexpr int FR_STRIDE = 22 * 1024 + 256;
constexpr int RK_LD = 72, RT_LD = 40, RAAB_LD = 36;
struct RRaw { float lw[8]; unsigned r[8], k[8], a[8], b[8], v[8]; };
DI void rwkv_raw_load(Frame& F, int prob, RRaw& R) {
    const bf16* RWH = (const bf16*)(F.ws + WS_RW); const float* LW = (const float*)(F.ws + WS_LW);
    const int tq = F.tid & 255, k = tq & 63, part = tq >> 6, wq = F.wave & 3, fr = F.lane & 15, quad = F.lane >> 4;
    const int bh = prob >> 6, c = prob & 63, b = bh >> 3, h = bh & 7; const size_t row0 = (size_t)b * SEQ + c * 32; const size_t o = (row0 + 8 * part) * 512 + 64 * h + k;
#pragma unroll
    for (int j = 0; j < 8; ++j) { R.lw[j] = __builtin_nontemporal_load(LW + o + (size_t)j * 512); R.r[j] = __builtin_nontemporal_load(RWH + 0 * (RHSZ / 2) + o + (size_t)j * 512); R.k[j] = __builtin_nontemporal_load(RWH + 1 * (RHSZ / 2) + o + (size_t)j * 512); R.a[j] = __builtin_nontemporal_load(RWH + 3 * (RHSZ / 2) + o + (size_t)j * 512); R.b[j] = __builtin_nontemporal_load(RWH + 4 * (RHSZ / 2) + o + (size_t)j * 512); }
    const bf16* vsrc = RWH + 2 * (RHSZ / 2) + row0 * 512 + 64 * h + 16 * wq + fr;
#pragma unroll
    for (int j = 0; j < 4; ++j) { R.v[j] = vsrc[(size_t)(4 * quad + j) * 512]; R.v[4 + j] = vsrc[(size_t)(16 + 4 * quad + j) * 512]; }
}
DI void phase_rwkv_chunkprep(Frame& F) {
    const int grp = F.wave >> 2, wq = F.wave & 3, lane = F.lane, fr = lane & 15, quad = lane >> 4, tq = F.tid & 255;
    LAS unsigned char* L = F.lds + grp * 65536;
    LAS bf16* At = (LAS bf16*)L;
    LAS bf16* Bt = At + 32 * RK_LD;
    LAS bf16* Kt = Bt + 32 * RK_LD;
    LAS bf16* Rt = Kt + 32 * RK_LD;
    LAS bf16* AT = Rt + 32 * RK_LD;
    LAS bf16* BhT = AT + 64 * RT_LD;
    LAS bf16* KhT = BhT + 64 * RT_LD;
    LAS bf16* Tm = KhT + 64 * RT_LD;
    LAS bf16* AakT = Tm + 32 * RT_LD;
    LAS bf16* Arb = AakT + 32 * RT_LD;
    LAS bf16* TaT = Arb + 32 * RT_LD;
    LAS bf16* TAkT = TaT + 64 * RT_LD;
    LAS float* Aab = (LAS float*)(TAkT + 32 * RT_LD);
    LAS float* PS = Aab + 32 * RAAB_LD;
    const bf16* RWH = (const bf16*)(F.ws + WS_RW); const float* LW = (const float*)(F.ws + WS_LW);
    unsigned char* FRb = F.ws + WS_FR;
    const f32x4 zero4 = fresh_zero4();
    RRaw RR; if (F.vcu < 2048) rwkv_raw_load(F, F.vcu * 2 + grp, RR);
    for (int it = F.vcu; it < 2048; it += F.G) {
        const int prob = it * 2 + grp;
        const int bh = prob >> 6, c = prob & 63, b = bh >> 3, h = bh & 7;
        const size_t row0 = (size_t)b * SEQ + c * 32;
        unsigned char* fr_out = FRb + (size_t)prob * FR_STRIDE;
        {
            const int k = tq & 63, part = tq >> 6; const size_t o = (row0 + 8 * part) * 512 + 64 * h + k;
            float lw[8], g[8]; float run = 0.f;
#pragma unroll
            for (int j = 0; j < 8; ++j) { lw[j] = RR.lw[j]; run += lw[j]; g[j] = run; }
            PS[part * 64 + k] = run;
            __syncthreads();
            float off = 0.f, tot = 0.f;
#pragma unroll
            for (int p = 0; p < 4; ++p) { const float v = PS[p * 64 + k]; tot += v; if (p < part) off += v; }
            unsigned pa[4], pb[4], pk[4];
            float av8[8], bv8[8], kv8[8];
#pragma unroll
            for (int j = 0; j < 8; ++j) { const float G = g[j] + off; const float r = bf2f((unsigned short)RR.r[j]), k2 = bf2f((unsigned short)RR.k[j]), a_ = bf2f((unsigned short)RR.a[j]), b_ = bf2f((unsigned short)RR.b[j]);
                const float eG = __expf(G), enG = __expf(-G), eGm1 = __expf(G - lw[j]), eh = __expf(tot - G);
                const int t = 8 * part + j;
                At[t * RK_LD + k] = (bf16)f2bf(a_ * eGm1); Bt[t * RK_LD + k] = (bf16)f2bf(b_ * enG); Kt[t * RK_LD + k] = (bf16)f2bf(k2 * enG); Rt[t * RK_LD + k] = (bf16)f2bf(r * eG);
                av8[j] = a_ * eGm1; bv8[j] = b_ * eh; kv8[j] = k2 * eh; }
#pragma unroll
            for (int j = 0; j < 4; ++j) { pa[j] = pk2(av8[2 * j], av8[2 * j + 1]); pb[j] = pk2(bv8[2 * j], bv8[2 * j + 1]); pk[j] = pk2(kv8[2 * j], kv8[2 * j + 1]); }
            *(LAS v4u*)(AT + k * RT_LD + 8 * part) = (v4u){pa[0], pa[1], pa[2], pa[3]};
            *(LAS v4u*)(BhT + k * RT_LD + 8 * part) = (v4u){pb[0], pb[1], pb[2], pb[3]};
            *(LAS v4u*)(KhT + k * RT_LD + 8 * part) = (v4u){pk[0], pk[1], pk[2], pk[3]};
            if (part == 0) ((float*)(fr_out + 22 * 1024))[k] = __expf(tot);
            { const unsigned (&vv)[8] = RR.v;
              *(v4u*)(fr_out + (18 + wq) * 1024 + lane * 16) = (v4u){vv[0] | (vv[1] << 16), vv[2] | (vv[3] << 16), vv[4] | (vv[5] << 16), vv[6] | (vv[7] << 16)}; }
            if (it + F.G < 2048) rwkv_raw_load(F, (it + F.G) * 2 + grp, RR);
        }
        __syncthreads();
        f32x4 ark[2][2];
        {
            const LAS bf16* Am = (wq == 0) ? At : (wq == 2 ? Rt : Kt);
            const LAS bf16* Bm = (wq == 0 || wq == 2) ? Bt : (wq == 1 ? At : Rt);
            f32x4 acc[2][2];
#pragma unroll
            for (int rb = 0; rb < 2; ++rb)
#pragma unroll
                for (int cbk = 0; cbk < 2; ++cbk) { f32x4 x = zero4;
#pragma unroll
                    for (int ks = 0; ks < 2; ++ks) x = mfma16(*(const LAS bf16x8*)(Am + (16 * rb + fr) * RK_LD + 32 * ks + 8 * quad), *(const LAS bf16x8*)(Bm + (16 * cbk + fr) * RK_LD + 32 * ks + 8 * quad), x);
                    acc[rb][cbk] = x; }
#pragma unroll
            for (int rb = 0; rb < 2; ++rb)
#pragma unroll
                for (int cbk = 0; cbk < 2; ++cbk)
#pragma unroll
                    for (int j = 0; j < 4; ++j) { const int row = 16 * rb + 4 * quad + j, col = 16 * cbk + fr; const int t = (wq == 0 || wq == 2) ? row : col, s = (wq == 0 || wq == 2) ? col : row;
                        const bool keep = (wq < 2) ? (s < t) : (s <= t); const float v = keep ? acc[rb][cbk][j] : 0.f; acc[rb][cbk][j] = v;
                        if (wq == 0) Aab[row * RAAB_LD + col] = v; else if (wq == 1) AakT[row * RT_LD + col] = (bf16)f2bf(v); else if (wq == 2) Arb[row * RT_LD + col] = (bf16)f2bf(v); }
#pragma unroll
            for (int rb = 0; rb < 2; ++rb)
#pragma unroll
                for (int cbk = 0; cbk < 2; ++cbk) ark[rb][cbk] = acc[rb][cbk];
        }
        __syncthreads();
        if (wq == 0) {
            float Tc[32]; const int cidx = lane & 31;
#pragma unroll
            for (int t = 0; t < 32; ++t) { float acc = (t == cidx) ? 1.0f : 0.0f;
#pragma unroll
                for (int s = 0; s < t; ++s) acc += Aab[t * RAAB_LD + s] * Tc[s];
                Tc[t] = acc; if (lane < 32) Tm[t * RT_LD + cidx] = (bf16)f2bf(acc); }
        }
        __syncthreads();
        {
            const bf16x8 aT = *(const LAS bf16x8*)(AT + (16 * wq + fr) * RT_LD + 8 * quad);
#pragma unroll
            for (int st = 0; st < 2; ++st) { const f32x4 x = mfma16(aT, *(const LAS bf16x8*)(Tm + (16 * st + fr) * RT_LD + 8 * quad), zero4);
#pragma unroll
                for (int j = 0; j < 4; ++j) TaT[(16 * wq + 4 * quad + j) * RT_LD + 16 * st + fr] = (bf16)f2bf(x[j]); }
            const int st = wq >> 1, ut = wq & 1;
            const f32x4 y = mfma16(*(const LAS bf16x8*)(AakT + (16 * st + fr) * RT_LD + 8 * quad), *(const LAS bf16x8*)(Tm + (16 * ut + fr) * RT_LD + 8 * quad), zero4);
#pragma unroll
            for (int j = 0; j < 4; ++j) TAkT[(16 * st + 4 * quad + j) * RT_LD + 16 * ut + fr] = (bf16)f2bf(y[j]);
        }
        __syncthreads();
        {
            { const int tb = wq & 1, i = wq >> 1; const bf16x8 bop = *(const LAS bf16x8*)(Arb + (16 * tb + fr) * RT_LD + 8 * quad); f32x4 x[2];
#pragma unroll
              for (int u = 0; u < 2; ++u) { const int kt = 2 * i + u; const v2u rz = *(const LAS v2u*)(Rt + (16 * tb + fr) * RK_LD + 16 * kt + 4 * quad);
                  x[u] = mfma16(*(const LAS bf16x8*)(TaT + (16 * kt + fr) * RT_LD + 8 * quad), bop, (f32x4){blo(rz.x), bhi(rz.x), blo(rz.y), bhi(rz.y)}); }
              *(bf16x8*)(fr_out + (tb * 2 + i) * 1024 + lane * 16) = pack8(x[0], x[1]); }
            { const bf16x8 bop = *(const LAS bf16x8*)(BhT + (16 * wq + fr) * RT_LD + 8 * quad); f32x4 x[4];
#pragma unroll
              for (int kt = 0; kt < 4; ++kt) x[kt] = mfma16(*(const LAS bf16x8*)(TaT + (16 * kt + fr) * RT_LD + 8 * quad), bop, zero4);
              *(bf16x8*)(fr_out + (6 + wq * 2 + 0) * 1024 + lane * 16) = pack8(x[0], x[1]); *(bf16x8*)(fr_out + (6 + wq * 2 + 1) * 1024 + lane * 16) = pack8(x[2], x[3]);
              f32x4 q[2];
#pragma unroll
              for (int sb = 0; sb < 2; ++sb) { const v2u kz = *(const LAS v2u*)(KhT + (16 * wq + fr) * RT_LD + 16 * sb + 4 * quad);
                  q[sb] = mfma16(*(const LAS bf16x8*)(TAkT + (16 * sb + fr) * RT_LD + 8 * quad), bop, (f32x4){blo(kz.x), bhi(kz.x), blo(kz.y), bhi(kz.y)}); }
              *(bf16x8*)(fr_out + (14 + wq) * 1024 + lane * 16) = pack8(q[0], q[1]); }
            if (wq == 3) {
#pragma unroll
                for (int tb = 0; tb < 2; ++tb) { const bf16x8 bop = *(const LAS bf16x8*)(Arb + (16 * tb + fr) * RT_LD + 8 * quad); f32x4 x[2];
#pragma unroll
                    for (int sb = 0; sb < 2; ++sb) x[sb] = mfma16(*(const LAS bf16x8*)(TAkT + (16 * sb + fr) * RT_LD + 8 * quad), bop, ark[sb][tb]);
                    *(bf16x8*)(fr_out + (4 + tb) * 1024 + lane * 16) = pack8(x[0], x[1]); } }
        }
        __syncthreads();
    }
}
DI void chunk_rwkv_chain(Frame& F, int item) {
    typedef ChainStage<18, 4, 256> St;
    const int grp = F.wave >> 2, w = F.wave & 3, lane = F.lane, fr = lane & 15, quad = lane >> 4;
    const int bh = item * 2 + grp, b = bh >> 3, h = bh & 7;
    const unsigned char* fb = F.ws + WS_FR + (size_t)bh * 64 * FR_STRIDE;
    bf16* YA = (bf16*)(F.ws + WS_YA);
    LAS unsigned char* L = F.lds + grp * (2 * St::SLOT);
    f32x4 H[4];
#pragma unroll
    for (int i = 0; i < 4; ++i) H[i] = (f32x4){0.f, 0.f, 0.f, 0.f};
    St sa, sb, sc;
    auto ld = [&](St& s, int c) { const unsigned char* p = fb + (size_t)c * FR_STRIDE;
#pragma unroll
        for (int i = 0; i < St::MAXF; ++i) { const int f = w + 4 * i; if (f < 18) s.r[i] = *(const bf16x8*)(p + f * 1024 + lane * 16); }
        if (w == 3 && lane < 16) s.sc = *(const f32x4*)(p + 22 * 1024 + lane * 16); };
    ld(sa, 0); sa.store(L, w, lane); ld(sa, 1); ld(sb, 2);
    bf16x8 vf = *(const bf16x8*)(fb + (18 + w) * 1024 + lane * 16), vf1 = *(const bf16x8*)(fb + FR_STRIDE + (18 + w) * 1024 + lane * 16);
    __syncthreads();
    const f32x4 zero4 = fresh_zero4();
#pragma unroll 1
    for (int c = 0; c < 64; ++c) {
        ld(sc, c + 3 < 64 ? c + 3 : 63);
        const unsigned char* pn = fb + (size_t)(c + 2 < 64 ? c + 2 : 63) * FR_STRIDE;
        const LAS unsigned char* sl = L + (c & 1) * St::SLOT;
        bf16x8 q[18]; f32x4 gl[4];
#pragma unroll
        for (int i = 0; i < 18; ++i) q[i] = LQ(sl, i);
#pragma unroll
        for (int kt = 0; kt < 4; ++kt) gl[kt] = *(const LAS f32x4*)(sl + 18 * 1024 + (16 * kt + 4 * quad) * 4);
        __builtin_amdgcn_sched_barrier(0);
        const bf16x8 hb0 = pack8(H[0], H[1]), hb1 = pack8(H[2], H[3]);
        f32x4 y0 = mfma16(q[4], vf, zero4), y1 = mfma16(q[5], vf, zero4);
        y0 = mfma16(q[0], hb0, y0); y0 = mfma16(q[1], hb1, y0); y1 = mfma16(q[2], hb0, y1); y1 = mfma16(q[3], hb1, y1);
#pragma unroll
        for (int kt = 0; kt < 4; ++kt) { f32x4 x = mfma16(q[14 + kt], vf, H[kt] * gl[kt]); x = mfma16(q[6 + 2 * kt], hb0, x); H[kt] = mfma16(q[7 + 2 * kt], hb1, x); }
        vf = vf1; vf1 = *(const bf16x8*)(pn + (18 + w) * 1024 + lane * 16);
        bf16* yb = YA + ((size_t)b * SEQ + c * 32) * 512 + 64 * h + 16 * w; const unsigned lo = 4u * quad * 512u + fr;
#pragma unroll
        for (int j = 0; j < 4; ++j) { yb[lo + j * 512] = (bf16)f2bf(y0[j]); yb[lo + (16 + j) * 512] = (bf16)f2bf(y1[j]); }
        sa.store(L + ((c + 1) & 1) * St::SLOT, w, lane);
        __syncthreads();
        sa = sb; sb = sc;
    }
}
#undef LQ
DI void scan_lru_item4(Frame& F, int item) {
    LAS f32x4* SA = (LAS f32x4*)F.lds; LAS f32x4* SB = SA + 512;
    const int cg = item & 7, b = item >> 3, cq = F.tid & 15, seg = F.tid >> 4, c = 64 * cg + 4 * cq;
    const float* LA = (const float*)(F.ws + WS_LA); const bf16* LB = (const bf16*)(F.ws + WS_LB); const bf16* z = (const bf16*)(F.ws + WS_Z);
    unsigned char* Y3 = F.ws + WS_Y + (size_t)3 * M * 512;
    const size_t t0 = (size_t)b * SEQ + seg * 64;
    const float* la = LA + t0 * 512 + c; const bf16* lb = LB + t0 * 512 + c; const bf16* gzp = z + t0 * ZLD + ZD + 512 + c; unsigned char* yp = Y3 + t0 * 512 + c;
    f32x4 A = (f32x4){1.f, 1.f, 1.f, 1.f}, Bv = (f32x4){0.f, 0.f, 0.f, 0.f};
    f32x4 av0[8], av1[8]; v2u bq0[8], bq1[8], gz0[8], gz1[8];
#define LRU_LD(AV, BQ, S0) do { _Pragma("unroll") for (int i_ = 0; i_ < 8; ++i_) { AV[i_] = *(const f32x4*)(la + (size_t)((S0) + i_) * 512); BQ[i_] = *(const v2u*)(lb + (size_t)((S0) + i_) * 512); } } while (0)
#define LRU_LDG(GZ, S0) do { _Pragma("unroll") for (int i_ = 0; i_ < 8; ++i_) GZ[i_] = *(const v2u*)(gzp + (size_t)((S0) + i_) * ZLD); } while (0)
#define LRU_C1(AV, BQ) do { _Pragma("unroll") for (int i_ = 0; i_ < 8; ++i_) { const f32x4 bv_ = (f32x4){blo(BQ[i_].x), bhi(BQ[i_].x), blo(BQ[i_].y), bhi(BQ[i_].y)}; A = A * AV[i_]; Bv = AV[i_] * Bv + bv_; } } while (0)
#define LRU_C2(AV, BQ, GZ, S0) do { _Pragma("unroll") for (int i_ = 0; i_ < 8; ++i_) { const f32x4 bv_ = (f32x4){blo(BQ[i_].x), bhi(BQ[i_].x), blo(BQ[i_].y), bhi(BQ[i_].y)}; hh = AV[i_] * hh + bv_; \
        *(unsigned*)(yp + (size_t)((S0) + i_) * 512) = pk4f8(hh[0] * gelu_tanh(blo(GZ[i_].x)), hh[1] * gelu_tanh(bhi(GZ[i_].x)), hh[2] * gelu_tanh(blo(GZ[i_].y)), hh[3] * gelu_tanh(bhi(GZ[i_].y))); } } while (0)
    LRU_LD(av0, bq0, 0);
#pragma unroll 1
    for (int k = 0; k < 64; k += 16) { LRU_LD(av1, bq1, k + 8); LRU_C1(av0, bq0); if (k + 16 < 64) LRU_LD(av0, bq0, k + 16); LRU_C1(av1, bq1); }
    LRU_LD(av0, bq0, 0); LRU_LDG(gz0, 0);
    SA[seg * 16 + cq] = A; SB[seg * 16 + cq] = Bv;
    __syncthreads();
    f32x4 hh = (f32x4){0.f, 0.f, 0.f, 0.f};
    for (int s2 = 0; s2 < seg; ++s2) hh = SA[s2 * 16 + cq] * hh + SB[s2 * 16 + cq];
#pragma unroll 1
    for (int k = 0; k < 64; k += 16) { LRU_LD(av1, bq1, k + 8); LRU_LDG(gz1, k + 8); LRU_C2(av0, bq0, gz0, k); if (k + 16 < 64) { LRU_LD(av0, bq0, k + 16); LRU_LDG(gz0, k + 16); } LRU_C2(av1, bq1, gz1, k + 8); }
#undef LRU_LD
#undef LRU_LDG
#undef LRU_C1
#undef LRU_C2
    __syncthreads();
}
DI void phase_chunkprep(Frame& F, KA a, int l) {
#ifndef DUPCP
#define DUPCP 0
#endif
    for (int rep = 0; rep < 1 + ((DUPCP >> 0) & 1); ++rep) { phase_rwkv_chunkprep(F); __syncthreads(); }
    for (int rep = 0; rep < 1 + ((DUPCP >> 1) & 1); ++rep) { v4u pq, pf, pi; if (F.vcu < 2048) hgrn_raw_load(F, F.vcu, pq, pf, pi); hgrn_lower_bounds(F, a, l);
      for (int it = F.vcu; it < 2048; it += F.G) prep_hgrn_item(F, a, l, it, (it + F.G < 2048) ? it + F.G : -1, pq, pf, pi); }
    for (int rep = 0; rep < 1 + ((DUPCP >> 2) & 1); ++rep) { MRaw R; if (F.vcu < 2048) mlstm_raw_load(F, F.vcu, R);
      for (int it = F.vcu; it < 2048; it += F.G) prep_mlstm_item(F, a, l, it, (it + F.G < 2048) ? it + F.G : -1, R); }
}
DI void phase_scan(Frame& F, KA a, int l) {
    int v = __builtin_amdgcn_readfirstlane((int)blockIdx.x); asm volatile("" : "+s"(v));
    if (F.G >= 160) {
#ifndef DUPSCAN
#define DUPSCAN 0
#endif
        if (v < 32) { for (int rep = 0; rep < 1 + ((DUPSCAN >> 0) & 1); ++rep) { chain_hgrn(F, v); __syncthreads(); } }
        else if (v < 96) { for (int rep = 0; rep < 1 + ((DUPSCAN >> 1) & 1); ++rep) { int mi_ = 2 * ((((v - 32) >> 4) << 3) + ((v - 32) & 7)) + (((v - 32) >> 3) & 1); asm volatile("" : "+s"(mi_)); chain_mlstm(F, mi_); __syncthreads(); } }
        else if (v < 128) { for (int rep = 0; rep < 1 + ((DUPSCAN >> 2) & 1); ++rep) { chunk_rwkv_chain(F, v - 96); __syncthreads(); } }
        else if (v < 192) { for (int rep = 0; rep < 1 + ((DUPSCAN >> 3) & 1); ++rep) { scan_lru_item4(F, v - 128); __syncthreads(); } }
    }
    __syncthreads(); cvt_expert_queue(F, a, l);
}

DI float xsum8(float v) { v += dpp_f<0xB1>(v); v += dpp_f<0x4E>(v); v += dpp_f<0x141>(v); return v; }
DI void phase_post(Frame& F, KA a, int l) {
    const bf16* z = (const bf16*)(F.ws + WS_Z); const bf16* RWH = (const bf16*)(F.ws + WS_RW); const float* BON = (const float*)(F.ws + WS_BON);
    const bf16* YA = (const bf16*)(F.ws + WS_YA); const bf16* OB = (const bf16*)(F.ws + WS_OB); const bf16* HC = (const bf16*)(F.ws + WS_HC);
    unsigned char* Y = F.ws + WS_Y;
    const float* lng = a->in[15] + l * 512; const float* lnb = a->in[16] + l * 512; const float* hnw = a->in[18] + l * 512; const float* mnw = a->in[23] + l * 512;
    const int c = 8 * F.lane;
    struct PTok { v4u ya, ob, hc; v4u gq, vq, gzb, gzc; float bon; };
    auto issue = [&](PTok& T, int t) { const size_t o = (size_t)t * 512 + c;
        T.ya = __builtin_nontemporal_load((const v4u*)(YA + o)); T.ob = __builtin_nontemporal_load((const v4u*)(OB + o)); T.hc = __builtin_nontemporal_load((const v4u*)(HC + o));
        T.gq = *(const v4u*)(RWH + 5 * (RHSZ / 2) + o); T.vq = *(const v4u*)(RWH + 2 * (RHSZ / 2) + o); T.gzb = *(const v4u*)(z + (size_t)t * ZLD + ZB + 1536 + c); T.gzc = *(const v4u*)(z + (size_t)t * ZLD + ZC + 1536 + c);
        T.bon = BON[(size_t)t * 8 + (F.lane >> 3)]; };
    float lg[8], lb[8], nwh[8], nwm[8];
    *(f32x4*)&lg[0] = *(const f32x4*)(lng + c); *(f32x4*)&lg[4] = *(const f32x4*)(lng + c + 4); *(f32x4*)&lb[0] = *(const f32x4*)(lnb + c); *(f32x4*)&lb[4] = *(const f32x4*)(lnb + c + 4);
    *(f32x4*)&nwh[0] = *(const f32x4*)(hnw + c); *(f32x4*)&nwh[4] = *(const f32x4*)(hnw + c + 4); *(f32x4*)&nwm[0] = *(const f32x4*)(mnw + c); *(f32x4*)&nwm[4] = *(const f32x4*)(mnw + c + 4);
    const int t0 = F.gw, nt = (M - t0 + F.NGW - 1) / F.NGW;
    PTok cur, nxt;
    issue(cur, t0);
#pragma unroll 1
    for (int i = 0; i < nt; ++i) {
        const int t = t0 + i * F.NGW;
        if (i + 1 < nt) issue(nxt, t + F.NGW);
        const size_t o = (size_t)t * 512 + c;
        { const v4u yq_ = cur.ya; float y[8] = {blo(yq_.x), bhi(yq_.x), blo(yq_.y), bhi(yq_.y), blo(yq_.z), bhi(yq_.z), blo(yq_.w), bhi(yq_.w)};
          float s_ = 0.f; for (int j = 0; j < 8; ++j) s_ += y[j]; const float mean = xsum8(s_) * (1.0f / 64.0f);
          float q = 0.f; for (int j = 0; j < 8; ++j) { y[j] -= mean; q += y[j] * y[j]; } const float rstd = rsqrtf(xsum8(q) * (1.0f / 64.0f) + 64e-5f);
          const v4u gq = cur.gq, vq = cur.vq;
          const float g[8] = {blo(gq.x), bhi(gq.x), blo(gq.y), bhi(gq.y), blo(gq.z), bhi(gq.z), blo(gq.w), bhi(gq.w)}, v[8] = {blo(vq.x), bhi(vq.x), blo(vq.y), bhi(vq.y), blo(vq.z), bhi(vq.z), blo(vq.w), bhi(vq.w)};
          float r[8]; for (int j = 0; j < 8; ++j) r[j] = (y[j] * rstd * lg[j] + lb[j] + cur.bon * v[j]) * g[j];
          *(v2u*)(Y + o) = (v2u){pk4f8(r[0], r[1], r[2], r[3]), pk4f8(r[4], r[5], r[6], r[7])}; }
        { const v4u yq_ = cur.ob; float y[8] = {blo(yq_.x), bhi(yq_.x), blo(yq_.y), bhi(yq_.y), blo(yq_.z), bhi(yq_.z), blo(yq_.w), bhi(yq_.w)};
          float q = 0.f; for (int j = 0; j < 8; ++j) q += y[j] * y[j]; q = xsum8(q); q += dpp_f<0x128>(q); const float rstd = rsqrtf(q * (1.0f / 128.0f) + 1e-6f);
          const v4u gz = cur.gzb; const float g[8] = {blo(gz.x), bhi(gz.x), blo(gz.y), bhi(gz.y), blo(gz.z), bhi(gz.z), blo(gz.w), bhi(gz.w)};
          float r[8]; for (int j = 0; j < 8; ++j) r[j] = y[j] * rstd * nwh[j] * siluf(g[j]);
          *(v2u*)(Y + (size_t)M * 512 + o) = (v2u){pk4f8(r[0], r[1], r[2], r[3]), pk4f8(r[4], r[5], r[6], r[7])}; }
        { const v4u yq_ = cur.hc; float y[8] = {blo(yq_.x), bhi(yq_.x), blo(yq_.y), bhi(yq_.y), blo(yq_.z), bhi(yq_.z), blo(yq_.w), bhi(yq_.w)};
          float s_ = 0.f; for (int j = 0; j < 8; ++j) s_ += y[j]; s_ = xsum8(s_); s_ += dpp_f<0x128>(s_); const float mean = s_ * (1.0f / 128.0f);
          float q = 0.f; for (int j = 0; j < 8; ++j) { y[j] -= mean; q += y[j] * y[j]; } q = xsum8(q); q += dpp_f<0x128>(q); const float rstd = rsqrtf(q * (1.0f / 128.0f) + 1e-6f);
          const v4u gz = cur.gzc; const float g[8] = {blo(gz.x), bhi(gz.x), blo(gz.y), bhi(gz.y), blo(gz.z), bhi(gz.z), blo(gz.w), bhi(gz.w)};
          float r[8]; for (int j = 0; j < 8; ++j) r[j] = y[j] * rstd * nwm[j] * sigm(g[j]);
          *(v2u*)(Y + (size_t)2 * M * 512 + o) = (v2u){pk4f8(r[0], r[1], r[2], r[3]), pk4f8(r[4], r[5], r[6], r[7])}; }
        cur = nxt;
    }
}

DI void ln_row(const f32x4 (&v)[4], f32x4 (&o)[4], const float* g, const float* b, int lane) {
    float s = 0.f;
#pragma unroll
    for (int j = 0; j < 4; ++j) s += (v[j].x + v[j].y) + (v[j].z + v[j].w);
    const float mean = wave_sum(s) * (1.0f / D); float q = 0.f;
#pragma unroll
    for (int j = 0; j < 4; ++j) { o[j] = v[j] - mean; q += (o[j].x * o[j].x + o[j].y * o[j].y) + (o[j].z * o[j].z + o[j].w * o[j].w); }
    const float rstd = rsqrtf(wave_sum(q) * (1.0f / D) + 1e-5f);
#pragma unroll
    for (int j = 0; j < 4; ++j) { const f32x4 gg = *(const f32x4*)(g + 4 * lane + 256 * j), bb = *(const f32x4*)(b + 4 * lane + 256 * j); o[j] = o[j] * rstd * gg + bb; }
}
DI void ln_row_r(const f32x4 (&v)[4], f32x4 (&o)[4], const f32x4 (&gq)[4], const f32x4 (&bq)[4]) {
    float s = 0.f;
#pragma unroll
    for (int j = 0; j < 4; ++j) s += (v[j].x + v[j].y) + (v[j].z + v[j].w);
    const float mean = wave_sum(s) * (1.0f / D); float q = 0.f;
#pragma unroll
    for (int j = 0; j < 4; ++j) { o[j] = v[j] - mean; q += (o[j].x * o[j].x + o[j].y * o[j].y) + (o[j].z * o[j].z + o[j].w * o[j].w); }
    const float rstd = rsqrtf(wave_sum(q) * (1.0f / D) + 1e-5f);
#pragma unroll
    for (int j = 0; j < 4; ++j) o[j] = o[j] * rstd * gq[j] + bq[j];
}
DI void phase_ln1_router(Frame& F, KA a, int l) {
    constexpr int WLD = 1032, LGLD = 33;
    LAS bf16* WrB = (LAS bf16*)F.lds;
    LAS float* LG = (LAS float*)(F.lds + 66560);
    LAS unsigned* cntL = F.LC + LC_CNT; LAS unsigned* baseL = F.LC + LC_BASE; LAS unsigned* rec = F.LC + LC_REC;
    const float* Wr = a->in[35] + (size_t)l * 1024 * 32; const float* rb = a->in[36] + l * 32;
    const float* g1 = a->in[33] + l * 1024; const float* b1 = a->in[34] + l * 1024;
    const bf16* PRE = (const bf16*)(F.ws + WS_PRE); bf16* X1B = (bf16*)(F.ws + WS_X1B);
    bf16* XSV = (bf16*)(F.ws + WS_XSV); unsigned* TREC = (unsigned*)(F.ws + WS_TREC); float* GATE = (float*)(F.ws + WS_GATE);
    f32x4 wq_[16];
#pragma unroll
    for (int k_ = 0; k_ < 16; ++k_) { const int i4 = F.tid + k_ * NTHR; wq_[k_] = *(const f32x4*)(Wr + (i4 & 1023) * 32 + 4 * (i4 >> 10)); }
#pragma unroll
    for (int k_ = 0; k_ < 16; ++k_) { const int i4 = F.tid + k_ * NTHR; const int c = i4 & 1023, e4 = i4 >> 10; const f32x4 w4 = wq_[k_];
        WrB[(4 * e4 + 0) * WLD + c] = (bf16)f2bf(w4[0]); WrB[(4 * e4 + 1) * WLD + c] = (bf16)f2bf(w4[1]); WrB[(4 * e4 + 2) * WLD + c] = (bf16)f2bf(w4[2]); WrB[(4 * e4 + 3) * WLD + c] = (bf16)f2bf(w4[3]); }
    const int lane = F.lane;
    f32x4 gq1[4], bq1[4];
#pragma unroll
    for (int j = 0; j < 4; ++j) { gq1[j] = *(const f32x4*)(g1 + 4 * lane + 256 * j); bq1[j] = *(const f32x4*)(b1 + 4 * lane + 256 * j); }
    for (int item = F.vcu; item < M / 64; item += F.G) {
        if (F.tid < 32) cntL[F.tid] = 0u;
        __syncthreads();
        v2u pzn[4];
#pragma unroll
        for (int j = 0; j < 4; ++j) pzn[j] = *(const v2u*)(PRE + (size_t)(item * 64 + F.wave) * D + 4 * lane + 256 * j);
        for (int tl = F.wave; tl < 64; tl += NWAVES) {
            const int t = item * 64 + tl;
            f32x4 v[4], x[4];
#pragma unroll
            for (int j = 0; j < 4; ++j) v[j] = (f32x4){blo(pzn[j].x), bhi(pzn[j].x), blo(pzn[j].y), bhi(pzn[j].y)};
            { const int tn = item * 64 + (tl + NWAVES < 64 ? tl + NWAVES : tl);
#pragma unroll
              for (int j = 0; j < 4; ++j) pzn[j] = *(const v2u*)(PRE + (size_t)tn * D + 4 * lane + 256 * j); }
            ln_row_r(v, x, gq1, bq1);
#pragma unroll
            for (int j = 0; j < 4; ++j) { *(v2u*)(X1B + (size_t)t * D + 4 * lane + 256 * j) = (v2u){pk2(x[j].x, x[j].y), pk2(x[j].z, x[j].w)};
                unsigned w8 = __builtin_amdgcn_cvt_pk_fp8_f32(x[j].x * 16.f, x[j].y * 16.f, 0u, false); *(unsigned*)(F.ws + WS_X1B8 + (size_t)t * D + 4 * lane + 256 * j) = __builtin_amdgcn_cvt_pk_fp8_f32(x[j].z * 16.f, x[j].w * 16.f, w8, true); }
        }
        VM_WAIT(); __syncthreads();
        { const int tt = F.wave >> 1, eh = F.wave & 1, tok = lane & 15, quad = lane >> 4;
          const bf16* xr = X1B + (size_t)(item * 64 + 16 * tt + tok) * D + 8 * quad; const LAS bf16* wr_ = WrB + (16 * eh + tok) * WLD + 8 * quad;
          f32x4 acc = (f32x4){0.f, 0.f, 0.f, 0.f};
#pragma unroll
          for (int kb = 0; kb < 4; ++kb) { bf16x8 xf[8];
#pragma unroll
              for (int i = 0; i < 8; ++i) xf[i] = *(const bf16x8*)(xr + 32 * (8 * kb + i));
#pragma unroll
              for (int i = 0; i < 8; ++i) acc = mfma16(*(const LAS bf16x8*)(wr_ + 32 * (8 * kb + i)), xf[i], acc); }
          const f32x4 bb = *(const f32x4*)(rb + 16 * eh + 4 * quad);
#pragma unroll
          for (int j = 0; j < 4; ++j) LG[(16 * tt + tok) * LGLD + 16 * eh + 4 * quad + j] = acc[j] + bb[j]; }
        __syncthreads();
        for (int i2 = 0; i2 < 4; ++i2) {
            const int tl = F.wave * 8 + 2 * i2 + (lane >> 5), myE = lane & 31;
            float logit = LG[tl * LGLD + myE];
            float tv[4]; int ti[4];
#pragma unroll
            for (int k = 0; k < 4; ++k) { float bv = logit; int bi = myE;
#define AMXD(ctrl) { const float ov = dpp_f<ctrl>(bv); const int oi = __builtin_amdgcn_update_dpp(0, bi, ctrl, 0xf, 0xf, true); if (ov > bv || (ov == bv && oi < bi)) { bv = ov; bi = oi; } }
#define AMX(o) { const float ov = shx<o>(bv); const int oi = shx_i<o>(bi); if (ov > bv || (ov == bv && oi < bi)) { bv = ov; bi = oi; } }
                AMXD(0xB1) AMXD(0x4E) AMXD(0x124) AMXD(0x128) AMX(16)
#undef AMX
#undef AMXD
                tv[k] = bv; ti[k] = bi; if (myE == bi) logit = -3.0e38f; }
            const float e1 = __expf(tv[1] - tv[0]), e2 = __expf(tv[2] - tv[0]), e3 = __expf(tv[3] - tv[0]); const float inv = 1.0f / (1.0f + e1 + e2 + e3);
            if (myE < 4) { const int e = (myE == 0) ? ti[0] : (myE == 1 ? ti[1] : (myE == 2 ? ti[2] : ti[3]));
                const float gt = ((myE == 0) ? 1.0f : (myE == 1 ? e1 : (myE == 2 ? e2 : e3))) * inv;
                const unsigned pos = __hip_atomic_fetch_add(&cntL[e], 1u, __ATOMIC_RELAXED, __HIP_MEMORY_SCOPE_WORKGROUP);
                rec[(tl * 4 + myE) * 3 + 0] = (unsigned)e; rec[(tl * 4 + myE) * 3 + 1] = pos; rec[(tl * 4 + myE) * 3 + 2] = __builtin_bit_cast(unsigned, gt); }
        }
        __syncthreads();
        if (F.tid < 32) baseL[F.tid] = __hip_atomic_fetch_add((unsigned*)(F.ctl + CW_CNT + l * 2048 + F.tid * 64), cntL[F.tid], __ATOMIC_RELAXED, __HIP_MEMORY_SCOPE_AGENT);
        __syncthreads();
        if (F.tid < 256) { const int tl = F.tid >> 2, k = F.tid & 3, t = item * 64 + tl; const unsigned e = rec[F.tid * 3], pos = rec[F.tid * 3 + 1] + baseL[rec[F.tid * 3]];
            TREC[(size_t)t * 4 + k] = (e << 20) | pos; GATE[(size_t)t * 4 + k] = __builtin_bit_cast(float, rec[F.tid * 3 + 2]); }
        __syncthreads();
        for (int r0 = F.wave * 4; r0 < 256; r0 += NWAVES * 4) {
            const int t = item * 64 + (r0 >> 2); const GAS v4u* srow = (const GAS v4u*)(X1B + (size_t)t * D); const v4u q0 = srow[lane], q1 = srow[lane + 64];
            v2u f0, f1;
            f0.x = __builtin_amdgcn_cvt_pk_fp8_f32(blo(q0.x) * 16.f, bhi(q0.x) * 16.f, 0u, false); f0.x = __builtin_amdgcn_cvt_pk_fp8_f32(blo(q0.y) * 16.f, bhi(q0.y) * 16.f, f0.x, true);
            f0.y = __builtin_amdgcn_cvt_pk_fp8_f32(blo(q0.z) * 16.f, bhi(q0.z) * 16.f, 0u, false); f0.y = __builtin_amdgcn_cvt_pk_fp8_f32(blo(q0.w) * 16.f, bhi(q0.w) * 16.f, f0.y, true);
            f1.x = __builtin_amdgcn_cvt_pk_fp8_f32(blo(q1.x) * 16.f, bhi(q1.x) * 16.f, 0u, false); f1.x = __builtin_amdgcn_cvt_pk_fp8_f32(blo(q1.y) * 16.f, bhi(q1.y) * 16.f, f1.x, true);
            f1.y = __builtin_amdgcn_cvt_pk_fp8_f32(blo(q1.z) * 16.f, bhi(q1.z) * 16.f, 0u, false); f1.y = __builtin_amdgcn_cvt_pk_fp8_f32(blo(q1.w) * 16.f, bhi(q1.w) * 16.f, f1.y, true);
#pragma unroll
            for (int k = 0; k < 4; ++k) { const unsigned e = rec[(r0 + k) * 3]; const unsigned pos = rec[(r0 + k) * 3 + 1] + baseL[e]; GAS v2u* drow = (GAS v2u*)((unsigned char*)XSV + ((size_t)e * M + pos) * D); drow[lane] = f0; drow[lane + 64] = f1; } }
        __syncthreads();
    }
}
DI void moe_tables(Frame& F, int l) {
    if (F.tid < 64) {
        const int e = F.lane & 31;
        const unsigned cnt = __hip_atomic_load((unsigned*)(F.ctl + CW_CNT + l * 2048 + e * 64), __ATOMIC_RELAXED, __HIP_MEMORY_SCOPE_AGENT);
        const unsigned nt = (cnt + 255u) >> 8;
        const unsigned inc = (unsigned)scan32_add((float)nt);
        const unsigned start = inc - nt;
        if (F.lane < 32) { F.LC[LC_CNT + e] = cnt; F.LC[LC_PSTART + e] = start;
#pragma clang loop vectorize(disable) unroll(disable)
            for (unsigned i = 0; i < nt; ++i) F.LC[LC_TILEE + start + i] = (unsigned)e; }
        if (F.lane == 31) { F.LC[LC_PSTART + 32] = inc; F.LC[LC_NT] = inc; }
    }
    __syncthreads();
}
DI void phase_gather(Frame& F, int l) {
    moe_tables(F, l);
    const unsigned* SLOT = (const unsigned*)(F.ws + WS_SLOT); const bf16* X1B = (const bf16*)(F.ws + WS_X1B); bf16* XS = (bf16*)(F.ws + WS_XS);
    const int nrows = (int)F.LC[LC_NT] * 256;
    for (int row = F.gw; row < nrows; row += F.NGW) {
        const int mt = row >> 8; const int e = (int)F.LC[LC_TILEE + mt]; const int pos = row - (int)F.LC[LC_PSTART + e] * 256;
        if (pos < (int)F.LC[LC_CNT + e]) { const unsigned t = SLOT[(size_t)e * M + pos];
            const GAS v4u* s = (const GAS v4u*)(X1B + (size_t)t * D); GAS v4u* d = (GAS v4u*)(XS + (size_t)row * D);
            d[F.lane] = s[F.lane]; d[F.lane + 64] = s[F.lane + 64]; }
    }
}
DI void phase_combine_ln2(Frame& F, KA a, int l, bool build_tables) {
    if (build_tables) moe_tables(F, l);
    const bf16* X1B = (const bf16*)(F.ws + WS_X1B); const unsigned* TREC = (const unsigned*)(F.ws + WS_TREC); const float* GATE = (const float*)(F.ws + WS_GATE);
    const unsigned char* YS = F.ws + WS_YS;     const bf16* PLEG = (const bf16*)(F.ws + WS_PLEG);
    bf16* XB = (bf16*)(F.ws + WS_XB);
    const float* g2 = a->in[43] + l * 1024; const float* b2 = a->in[44] + l * 1024; const int lane = F.lane;
    struct Tok { v2u xz[4], pz[4]; unsigned yz[4][4]; float gt[4]; };
    auto issue = [&](Tok& T, int t, const unsigned (&rr)[4], const float (&gg)[4]) {
#pragma unroll
        for (int j = 0; j < 4; ++j) { T.xz[j] = __builtin_nontemporal_load((const v2u*)(X1B + (size_t)t * D + 4 * lane + 256 * j)); T.pz[j] = __builtin_nontemporal_load((const v2u*)(PLEG + (size_t)t * D + 4 * lane + 256 * j)); }
#pragma unroll
        for (int k = 0; k < 4; ++k) { const size_t row = (size_t)F.LC[LC_PSTART + (rr[k] >> 20)] * 256 + (rr[k] & 0xfffffu); T.gt[k] = gg[k];
#pragma unroll
            for (int j = 0; j < 4; ++j) T.yz[k][j] = __builtin_nontemporal_load((const unsigned*)(YS + row * D + 4 * lane + 256 * j)); } };
    const int t0 = F.gw, nt = (M - t0 + F.NGW - 1) / F.NGW;
    f32x4 gq2[4], bq2[4];
#pragma unroll
    for (int j = 0; j < 4; ++j) { gq2[j] = *(const f32x4*)(g2 + 4 * lane + 256 * j); bq2[j] = *(const f32x4*)(b2 + 4 * lane + 256 * j); }
    unsigned r1[4], r2[4]; float g1_[4], g2_[4];
#pragma unroll
    for (int k = 0; k < 4; ++k) { r1[k] = TREC[(size_t)t0 * 4 + k]; g1_[k] = GATE[(size_t)t0 * 4 + k]; const int tb = (nt > 1) ? t0 + F.NGW : t0; r2[k] = TREC[(size_t)tb * 4 + k]; g2_[k] = GATE[(size_t)tb * 4 + k]; }
    Tok cur, nxt;
    issue(cur, t0, r1, g1_);
#pragma unroll 1
    for (int i = 0; i < nt; ++i) {
        const int t = t0 + i * F.NGW;
        if (i + 1 < nt) issue(nxt, t + F.NGW, r2, g2_);
        { const int tc = (i + 2 < nt) ? t + 2 * F.NGW : t;
#pragma unroll
          for (int k = 0; k < 4; ++k) { r2[k] = TREC[(size_t)tc * 4 + k]; g2_[k] = GATE[(size_t)tc * 4 + k]; } }
        f32x4 v[4], x[4];
#pragma unroll
        for (int j = 0; j < 4; ++j) v[j] = (f32x4){blo(cur.xz[j].x), bhi(cur.xz[j].x), blo(cur.xz[j].y), bhi(cur.xz[j].y)} * ALPHA + (f32x4){blo(cur.pz[j].x), bhi(cur.pz[j].x), blo(cur.pz[j].y), bhi(cur.pz[j].y)};
#pragma unroll
        for (int k = 0; k < 4; ++k)
#pragma unroll
            for (int j = 0; j < 4; ++j) { const unsigned yw = cur.yz[k][j]; const f32x2 ylo = __builtin_amdgcn_cvt_pk_f32_fp8(yw, false), yhi = __builtin_amdgcn_cvt_pk_f32_fp8(yw, true);
                v[j] = v[j] + (f32x4){ylo[0], ylo[1], yhi[0], yhi[1]} * (cur.gt[k] * (1.0f / 64.0f)); }
        ln_row_r(v, x, gq2, bq2);
        if (l == NL - 1) {
#pragma unroll
            for (int j = 0; j < 4; ++j) *(f32x4*)(a->out + (size_t)t * D + 4 * lane + 256 * j) = x[j];
        } else {
#pragma unroll
            for (int j = 0; j < 4; ++j) { *(v2u*)(XB + (size_t)t * D + 4 * lane + 256 * j) = (v2u){pk2(x[j].x, x[j].y), pk2(x[j].z, x[j].w)};
                unsigned w8 = __builtin_amdgcn_cvt_pk_fp8_f32(x[j].x * 16.f, x[j].y * 16.f, 0u, false); *(unsigned*)(F.ws + WS_XB8 + (size_t)t * D + 4 * lane + 256 * j) = __builtin_amdgcn_cvt_pk_fp8_f32(x[j].z * 16.f, x[j].w * 16.f, w8, true); }
        }
        cur = nxt;
    }
}

constexpr int PH_PER_LAYER = 12, N_PHASES = 2 + NL * PH_PER_LAYER;
__global__ void __launch_bounds__(NTHR, 2) mega_fwd(Args args) {
    extern __shared__ __attribute__((aligned(16))) unsigned char lds_raw[];
    Frame F;
    F.lds = (LAS unsigned char*)lds_raw; F.LC = (LAS unsigned*)(F.lds + LDSCTL_OFF);
    F.G = gridDim.x; { const int bx = blockIdx.x; F.vcu = (F.G % 8 == 0) ? (bx % 8) * (F.G / 8) + bx / 8 : bx; }
    F.NGW = F.G * NWAVES; F.wave = __builtin_amdgcn_readfirstlane((int)threadIdx.x >> 6); rebind(F);
    F.ws = args.ws; F.ctl = (gu32*)(args.ws + WS_CTL);
    KA ap = (KA)__builtin_amdgcn_kernarg_segment_ptr();
#define PHASE_BEGIN() do { ap = (KA)__builtin_amdgcn_kernarg_segment_ptr(); asm volatile("" : "+s"(ap)); F.ws = ap->ws; F.ctl = (gu32*)(F.ws + WS_CTL); rebind(F); } while (0)
#pragma clang loop vectorize(disable) unroll(disable)
    for (int u = F.tid; u < LDSCTL_BYTES / 4; u += NTHR) F.LC[u] = 0u;
    __syncthreads();
    const int lo = args.ph_lo, hi = args.ph_hi;
    const bool multi = (hi - lo) > 1;
    XcdBarrier bar; bar.bar = (unsigned*)(F.ctl + CW_BAR); bar.x = 0; bar.st = nullptr;
    if (multi) bar = xcd_barrier_post((unsigned*)(F.ctl + CW_BAR), (volatile LAS unsigned*)(F.LC + LC_BAR));
#ifndef PHMASK
#define PHMASK 0xffffffffu
#endif
#ifndef DUPMASK
#define DUPMASK 0x0u
#endif
#define EN(j) ((PHMASK >> (j)) & 1u)
#define DUP(j) ((DUPMASK >> (j)) & 1u)
#define IN(k) (lo <= (k) && (k) < hi)
#define SEAM(k) do { if (IN(k) && IN((k) + 1)) xcd_barrier(bar); } while (0)
    LAS unsigned char* ring = F.lds;

    PHASE_BEGIN(); if (EN(0) && IN(0)) { p0_convert(F, ap); if (DUP(0)) { __syncthreads(); p0_convert(F, ap); } } SEAM(0);
    PHASE_BEGIN(); if (EN(1) && IN(1)) { for (int rep_ = 0; rep_ < 1 + (int)DUP(1); ++rep_) { if (rep_) __syncthreads();
        pg8::Gemm g{(const bf16*)(F.ws + WS_PB), (const bf16*)(F.ws + WS_WPP), NL * M, NL * 1024, DPLE};
        pg8::LayerGroupOrder S{F.G, (int)blockIdx.x};
        pg8::EpiB16<4> E{(bf16*)(F.ws + WS_PP), 1024, nullptr};
        pg8::gemm_phase<pg8::EpiB16<4>, pg8::LayerGroupOrder, PG8_ALIGN, PG8_SP2>(ring, g, S, E, F.tid); }
    } SEAM(1);

    for (int l = 0; l < NL; ++l) {
        const int pb = 2 + l * PH_PER_LAYER;
        PHASE_BEGIN(); if (EN(2) && IN(pb + 0)) { for (int rep_ = 0; rep_ < 1 + (int)DUP(2); ++rep_) { if (rep_) __syncthreads();
            { pg8::Gemm g{(const bf16*)(F.ws + WS_XB8), (const bf16*)(F.ws + WS_WIN8 + (size_t)l * 4096 * 1024), M, 4096, D / 2};
              pg8::StaticOrder S; S.init(M, 4096, F.G, (int)blockIdx.x);
              pg8::EpiGate8 E{F.ws + WS_MF};
              pg8::gemm_phase<pg8::EpiGate8, pg8::StaticOrder, PG8_ALIGN, PG8_SP2, true, 0x79, 0x7b>(ring, g, S, E, F.tid); }
            { pg8::Gemm g{(const bf16*)(F.ws + WS_XB), (const bf16*)(F.ws + WS_WIN) + (size_t)l * ZLD * 1024, M, ZG, D};
              pg8::StaticOrder S; S.init(M, ZG, F.G, (int)blockIdx.x);
              pg8::EpiB16<0> E{(bf16*)(F.ws + WS_Z), ZLD, nullptr};
              pg8::gemm_phase<pg8::EpiB16<0>, pg8::StaticOrder, PG8_ALIGN, PG8_SP2>(ring, g, S, E, F.tid); } }
        } SEAM(pb + 0);
        PHASE_BEGIN(); if (EN(3) && IN(pb + 1)) { phase_prep(F, ap, l); if (DUP(3)) { __syncthreads(); phase_prep(F, ap, l); } } SEAM(pb + 1);
        PHASE_BEGIN(); if (EN(14) && IN(pb + 2)) { phase_chunkprep(F, ap, l); if (DUP(14)) { __syncthreads(); phase_chunkprep(F, ap, l); } } SEAM(pb + 2);
        PHASE_BEGIN(); if (EN(4) && IN(pb + 3)) { phase_scan(F, ap, l); if (DUP(4)) { __syncthreads(); phase_scan(F, ap, l); } } SEAM(pb + 3);
        PHASE_BEGIN(); if (EN(5) && IN(pb + 4)) { phase_post(F, ap, l); if (DUP(5)) { __syncthreads(); phase_post(F, ap, l); } } SEAM(pb + 4);
        PHASE_BEGIN(); if (EN(6) && IN(pb + 5)) { for (int rep_ = 0; rep_ < 1 + (int)DUP(6); ++rep_) { if (rep_) __syncthreads();
            pg8::Gemm g{(const bf16*)(F.ws + WS_Y), (const bf16*)(F.ws + WS_WBR + (size_t)l * 4 * 1024 * 512), 4 * M, 4 * 1024, W / 2};
            pg8::BranchOrder S; S.base.init(M, D, F.G, (int)blockIdx.x);
            pg8::EpiBranch E{F.ws + WS_MF, F.ws + WS_MB};
            pg8::gemm_phase<pg8::EpiBranch, pg8::BranchOrder, PG8_ALIGN, PG8_SP2, true, 0x79, 0x7c>(ring, g, S, E, F.tid); }
        } SEAM(pb + 5);
        PHASE_BEGIN(); if (EN(7) && IN(pb + 6)) { for (int rep_ = 0; rep_ < 1 + (int)DUP(7); ++rep_) { if (rep_) __syncthreads();
            pg8::Gemm g{(const bf16*)(F.ws + WS_MB), (const bf16*)(F.ws + WS_WOUT + (size_t)l * 1024 * 1024), M, D, D / 2};
            pg8::StaticOrder S; S.init(M, D, F.G, (int)blockIdx.x);
            pg8::EpiWout E{(const bf16*)(F.ws + WS_XB), (bf16*)(F.ws + WS_PRE), ALPHA};
            pg8::gemm_phase<pg8::EpiWout, pg8::StaticOrder, PG8_ALIGN, PG8_SP2, true, 0x79, 0x7b>(ring, g, S, E, F.tid); }
        } SEAM(pb + 6);
        PHASE_BEGIN(); if (EN(8) && IN(pb + 7)) { phase_ln1_router(F, ap, l); } SEAM(pb + 7);
        PHASE_BEGIN(); if (EN(10) && IN(pb + 8)) { for (int rep_ = 0; rep_ < 1 + (int)DUP(10); ++rep_) { if (rep_) __syncthreads();
            moe_tables(F, l);
            { pg8::Gemm g{(const bf16*)(F.ws + WS_XSV), (const bf16*)(F.ws + WS_WGU + (size_t)l * NE * 2048 * 1024), NE * M, NE * 2048, D / 2};
              pg8::MoeOrder<8, true> S{(const LAS int*)(F.LC + LC_TILEE), (const LAS int*)(F.LC + LC_PSTART), __builtin_amdgcn_readfirstlane((int)F.LC[LC_NT]), F.G, F.vcu};
              pg8::EpiGU E{(bf16*)(F.ws + WS_H), ap->in[38] + (size_t)l * NE * 2048};
              pg8::gemm_phase<pg8::EpiGU, pg8::MoeOrder<8, true>, PG8_ALIGN, PG8_SP2, true, 0x79, 0x7b>(ring, g, S, E, F.tid);     } }
        }
        PHASE_BEGIN(); if (EN(13) && IN(pb + 9)) { for (int rep_ = 0; rep_ < 1 + (int)DUP(13); ++rep_) { if (rep_) __syncthreads();
            { pg8::Gemm g{(const bf16*)(F.ws + WS_X1B8), (const bf16*)(F.ws + WS_WPG8 + (size_t)l * 1024 * 1024), M, D, D / 2};
              pg8::StaticOrder S; S.init(M, D, F.G, (int)blockIdx.x);
              pg8::EpiPle E{(const bf16*)(F.ws + WS_PP) + (size_t)l * M * 1024, (bf16*)(F.ws + WS_PLEG)};
              pg8::gemm_phase<pg8::EpiPle, pg8::StaticOrder, PG8_ALIGN, PG8_SP2, true, 0x79, 0x7b>(ring, g, S, E, F.tid); } }
        } SEAM(pb + 9);
        PHASE_BEGIN(); if (EN(11) && IN(pb + 10)) { for (int rep_ = 0; rep_ < 1 + (int)DUP(11); ++rep_) { if (rep_) __syncthreads();
            if (!multi) moe_tables(F, l);
            pg8::Gemm g{(const bf16*)(F.ws + WS_H), (const bf16*)(F.ws + WS_WDN + (size_t)l * NE * 1024 * 1024), MOE_ROWS, NE * 1024, D / 2};
            pg8::MoeOrder<4, false> S{(const LAS int*)(F.LC + LC_TILEE), (const LAS int*)(F.LC + LC_PSTART), __builtin_amdgcn_readfirstlane((int)F.LC[LC_NT]), F.G, F.vcu};
            pg8::EpiYS8 E{F.ws + WS_YS, ap->in[40] + (size_t)l * NE * 1024};
            pg8::gemm_phase<pg8::EpiYS8, pg8::MoeOrder<4, false>, PG8_ALIGN, PG8_SP2, true, 0x79, 0x7d>(ring, g, S, E, F.tid);     }
        } SEAM(pb + 10);
        PHASE_BEGIN(); if (EN(12) && IN(pb + 11)) { phase_combine_ln2(F, ap, l, !multi); if (DUP(12)) { __syncthreads(); phase_combine_ln2(F, ap, l, !multi); } } SEAM(pb + 11);
    }
#undef IN
#undef SEAM
}

#ifndef MK_ONE_LAUNCH
#define MK_ONE_LAUNCH 1
#endif
extern "C" void kernel_launch(void* const* d_in, const int* in_sizes, int n_in, void* d_out, int out_size, void* d_ws, size_t ws_size, hipStream_t stream) {
    static int grid = 0;
    if (grid == 0) {
        if (n_in != 45 || out_size != M * D || ws_size < WS_END) { fprintf(stderr, "kernel_launch: unexpected problem (n_in %d, out %d, ws %zu)\n", n_in, out_size, ws_size); grid = -1; return; }
        int dev = 0, cus = 0, per_cu = 0;
        if (hipGetDevice(&dev) != hipSuccess || hipDeviceGetAttribute(&cus, hipDeviceAttributeMultiprocessorCount, dev) != hipSuccess) { grid = -1; return; }
        if (hipFuncSetAttribute((const void*)mega_fwd, hipFuncAttributeMaxDynamicSharedMemorySize, LDS_BYTES) != hipSuccess) { fprintf(stderr, "kernel_launch: hipFuncSetAttribute failed\n"); grid = -1; return; }
        if (hipOccupancyMaxActiveBlocksPerMultiprocessor(&per_cu, (const void*)mega_fwd, NTHR, LDS_BYTES) != hipSuccess || per_cu < 1) fprintf(stderr, "kernel_launch: occupancy query says %d\n", per_cu);
        (void)hipGetLastError();
        grid = cus;
    }
    if (grid < 0) return;
    if (hipMemsetAsync((char*)d_ws + WS_CTL, 0, CTL_ZERO_BYTES, stream) != hipSuccess) return;
    Args a{};
    for (int i = 0; i < 45; ++i) a.in[i] = (const float*)d_in[i];
    a.out = (float*)d_out; a.ws = (unsigned char*)d_ws;
#if MK_ONE_LAUNCH
    a.ph_lo = 0; a.ph_hi = N_PHASES;
    hipLaunchKernelGGL(mega_fwd, dim3(grid), dim3(NTHR), LDS_BYTES, stream, a);
#else
    for (int ph = 0; ph < N_PHASES; ++ph) { a.ph_lo = ph; a.ph_hi = ph + 1; hipLaunchKernelGGL(mega_fwd, dim3(grid), dim3(NTHR), LDS_BYTES, stream, a); }
#endif
}
```
